# Optimizing an MI355X kernel written in HIP

```python
import jax
import jax.numpy as jnp
from jax import lax
import numpy as np

D_MODEL = 2048
BATCH = 1
SEQ = 16384
DEPTH = 2

RET_HEADS = 8
RET_DK = 128
RET_DV = 128
RET_W = RET_HEADS * RET_DV
RET_CHUNK = 128
ROPE_BASE = 10000.0
LRU_W = 1024
LRU_BLOCKS = 8
LRU_BS = LRU_W // LRU_BLOCKS
LRU_C = 8.0
CONV_K = 4
GDN_HEADS = 8
GDN_DK = 128
GDN_DV = 128
GDN_W = GDN_HEADS * GDN_DV
GDN_CHUNK = 64
N_BRANCH = 3
N_GROUPS = 4
EXPERTS_PER_GROUP = 8
N_EXPERTS = N_GROUPS * EXPERTS_PER_GROUP
TOP_K = 2
D_EXPERT = 512
MOE_BLOCK = 128
EPS = 1e-6

IN_SPLITS = [RET_HEADS * RET_DK, RET_HEADS * RET_DK, RET_W, RET_W,
             LRU_W, LRU_W,
             GDN_HEADS * GDN_DK, GDN_HEADS * GDN_DK, GDN_W, GDN_W,
             GDN_HEADS, GDN_HEADS,
             N_BRANCH * D_MODEL]
IN_COLS = 4 * RET_W + 2 * LRU_W + 4 * GDN_W + 2 * GDN_HEADS + N_BRANCH * D_MODEL

kernel_name = 'hybrid_retention_rglru_gdeltanet_hmoe'

F32 = jnp.float32


def rms_norm(x, g):
    x32 = x.astype(F32)
    y = x32 * lax.rsqrt(jnp.mean(x32 * x32, axis=-1, keepdims=True) + EPS)
    return (y * g.astype(F32)).astype(x.dtype)


def head_rms(x):
    x32 = x.astype(F32)
    return (x32 * lax.rsqrt(jnp.mean(x32 * x32, axis=-1, keepdims=True) + EPS)).astype(x.dtype)


def l2_normalize(x):
    x32 = x.astype(F32)
    return x32 * lax.rsqrt(jnp.sum(x32 * x32, axis=-1, keepdims=True) + EPS)


def rope(x, positions):
    d = x.shape[-1]
    half = d // 2
    inv_freq = ROPE_BASE ** (-jnp.arange(half, dtype=F32) * (2.0 / d))
    ang = positions.astype(F32)[..., None] * inv_freq
    cos = jnp.cos(ang)[:, :, None, :]
    sin = jnp.sin(ang)[:, :, None, :]
    x32 = x.astype(F32)
    x1, x2 = x32[..., :half], x32[..., half:]
    return jnp.concatenate([x1 * cos - x2 * sin, x2 * cos + x1 * sin], axis=-1).astype(x.dtype)


def causal_dwconv(x, w):
    K = w.shape[0]
    S = x.shape[1]
    xp = jnp.pad(x, ((0, 0), (K - 1, 0), (0, 0)))
    y = xp[:, 0:S] * w[0]
    for k in range(1, K):
        y = y + xp[:, k:k + S] * w[k]
    return y


def to_chunks(t, C):
    B, S = t.shape[0], t.shape[1]
    t = t.astype(F32).reshape((B, S // C, C) + t.shape[2:])
    return jnp.moveaxis(t, 3, 1)


def from_chunks(t):
    B, H, N, C, d = t.shape
    return jnp.moveaxis(t, 1, 3).reshape(B, N * C, H, d)


def retention_chunkwise(q, k, v):
    out_dtype = v.dtype
    B, S, H, dk = q.shape
    dv = v.shape[-1]
    C = RET_CHUNK
    log_g = jnp.log1p(-jnp.exp2(-5.0 - jnp.arange(H, dtype=F32)))
    q = to_chunks(q, C)
    k = to_chunks(k, C) * (dk ** -0.5)
    v = to_chunks(v, C)
    pos = jnp.arange(C, dtype=F32)
    rel = pos[:, None] - pos[None, :]
    intra = jnp.where(rel >= 0, jnp.exp(log_g[:, None, None] * jnp.maximum(rel, 0.0)), 0.0)
    scores = jnp.einsum('bhncd,bhnmd->bhncm', q, k) * intra[:, None]
    o_intra = jnp.einsum('bhncm,bhnme->bhnce', scores, v)
    k_dec = k * jnp.exp(log_g[:, None] * (C - 1.0 - pos))[:, None, :, None]
    q_dec = q * jnp.exp(log_g[:, None] * (pos + 1.0))[:, None, :, None]
    kv = jnp.einsum('bhncd,bhnce->nbhde', k_dec, v)
    chunk_decay = jnp.exp(log_g * C)[:, None, None]

    def step(R, kv_n):
        return R * chunk_decay + kv_n, R

    _, R_prev = lax.scan(step, jnp.zeros((B, H, dk, dv), F32), kv)
    o_inter = jnp.einsum('bhncd,nbhde->bhnce', q_dec, R_prev)
    return from_chunks(o_intra + o_inter).astype(out_dtype)


def block_diag_linear(x, w, b):
    B, S, _ = x.shape
    nb, bs, _ = w.shape
    y = jnp.einsum('bsni,nij->bsnj', x.reshape(B, S, nb, bs), w)
    return y.reshape(B, S, nb * bs) + b


def rg_lru(x, wa, ba, wx, bx, lam):
    dtype = x.dtype
    r = jax.nn.sigmoid(block_diag_linear(x, wa, ba).astype(F32))
    i = jax.nn.sigmoid(block_diag_linear(x, wx, bx).astype(F32))
    log_a = -LRU_C * r * jax.nn.softplus(-lam.astype(F32))
    a = jnp.exp(log_a)
    b = jnp.sqrt(-jnp.expm1(2.0 * log_a)) * (i * x.astype(F32))

    def combine(e, l):
        return (e[0] * l[0], l[0] * e[1] + l[1])

    _, h = lax.associative_scan(combine, (a, b), axis=1)
    return h.astype(dtype)


def gated_delta_chunked(q, k, v, g, beta):
    out_dtype = v.dtype
    B, S, H, dk = q.shape
    dv = v.shape[-1]
    C = GDN_CHUNK
    q = to_chunks(q, C) * (dk ** -0.5)
    k = to_chunks(k, C)
    v = to_chunks(v, C)
    g = to_chunks(g, C)
    beta = to_chunks(beta, C)
    gc = jnp.cumsum(g, axis=-1)
    incl = jnp.tril(jnp.ones((C, C), bool))
    strict = jnp.tril(jnp.ones((C, C), bool), -1)
    decay = jnp.exp(jnp.where(incl, gc[..., :, None] - gc[..., None, :], -jnp.inf))
    kb = k * beta[..., None]
    vb = v * beta[..., None]
    m = jnp.where(strict, jnp.einsum('bhncd,bhnmd->bhncm', kb, k) * decay, 0.0)
    a = m + jnp.eye(C, dtype=F32)
    rhs = jnp.concatenate([vb, kb * jnp.exp(gc)[..., None]], axis=-1)
    sol = lax.linalg.triangular_solve(a, rhs, left_side=True, lower=True, unit_diagonal=True)
    u, w = sol[..., :dv], sol[..., dv:]
    attn = jnp.einsum('bhncd,bhnmd->bhncm', q, k) * decay
    q_dec = q * jnp.exp(gc)[..., None]
    k_dec = k * jnp.exp(gc[..., -1:] - gc)[..., None]
    g_last = jnp.exp(gc[..., -1])
    xs = (jnp.moveaxis(u, 2, 0), jnp.moveaxis(w, 2, 0), jnp.moveaxis(attn, 2, 0),
          jnp.moveaxis(q_dec, 2, 0), jnp.moveaxis(k_dec, 2, 0), jnp.moveaxis(g_last, 2, 0))

    def step(state, inp):
        u_n, w_n, attn_n, qd_n, kd_n, gl_n = inp
        v_new = u_n - jnp.einsum('bhck,bhkv->bhcv', w_n, state)
        o = jnp.einsum('bhck,bhkv->bhcv', qd_n, state) + jnp.einsum('bhcm,bhmv->bhcv', attn_n, v_new)
        state = state * gl_n[..., None, None] + jnp.einsum('bhck,bhcv->bhkv', kd_n, v_new)
        return state, o

    _, o = lax.scan(step, jnp.zeros((B, H, dk, dv), F32), xs)
    return from_chunks(jnp.moveaxis(o, 0, 2)).astype(out_dtype)


def hybrid_mixer(h, positions, w_in, lru_conv_w, lru_conv_b, lru_wa, lru_ba, lru_wx, lru_bx,
                 lru_lambda, gdn_conv_w, gdn_a_log, gdn_dt_bias, gdn_norm_g, branch_proj, w_out):
    B, S, _ = h.shape
    z = h @ w_in
    idx = [int(i) for i in np.cumsum(IN_SPLITS)[:-1]]
    rq, rk, rv, rg, lx, lg, gq, gk, gv, gz, ga, gb, br = jnp.split(z, idx, axis=-1)

    rq = rope(rq.reshape(B, S, RET_HEADS, RET_DK), positions)
    rk = rope(rk.reshape(B, S, RET_HEADS, RET_DK), positions)
    ro = retention_chunkwise(rq, rk, rv.reshape(B, S, RET_HEADS, RET_DV))
    y_ret = (head_rms(ro) * jax.nn.silu(rg.reshape(B, S, RET_HEADS, RET_DV))).reshape(B, S, RET_W)

    lx = causal_dwconv(lx, lru_conv_w) + lru_conv_b
    y_lru = rg_lru(lx, lru_wa, lru_ba, lru_wx, lru_bx, lru_lambda) * jax.nn.gelu(lg)

    qkv = jax.nn.silu(causal_dwconv(jnp.concatenate([gq, gk, gv], axis=-1), gdn_conv_w))
    gq, gk, gv = jnp.split(qkv, [GDN_HEADS * GDN_DK, 2 * GDN_HEADS * GDN_DK], axis=-1)
    gq = l2_normalize(gq.reshape(B, S, GDN_HEADS, GDN_DK))
    gk = l2_normalize(gk.reshape(B, S, GDN_HEADS, GDN_DK))
    beta = jax.nn.sigmoid(gb.astype(F32))
    g = -jnp.exp(gdn_a_log.astype(F32)) * jax.nn.softplus(ga.astype(F32) + gdn_dt_bias.astype(F32))
    go = gated_delta_chunked(gq, gk, gv.reshape(B, S, GDN_HEADS, GDN_DV), g, beta)
    y_gdn = (head_rms(go) * gdn_norm_g * jax.nn.silu(gz.reshape(B, S, GDN_HEADS, GDN_DV))).reshape(B, S, GDN_W)

    gates = jax.nn.sigmoid(br).reshape(B, S, N_BRANCH, D_MODEL)
    merged = (gates[:, :, 0] * (y_ret @ branch_proj[0])
              + gates[:, :, 1] * (y_lru @ branch_proj[1])
              + gates[:, :, 2] * (y_gdn @ branch_proj[2]))
    return merged @ w_out


def hier_moe(h, wg, bg, we, be, w1, w3, w2):
    B, S, D = h.shape
    T = B * S
    xf = h.reshape(T, D)
    logits_g = (xf @ wg + bg).astype(F32)
    p_g = jax.nn.softmax(logits_g, axis=-1)
    pg_top, g_sel = lax.top_k(p_g, 1)
    logits_e = (xf @ we + be).astype(F32).reshape(T, N_GROUPS, EXPERTS_PER_GROUP)
    logits_in = jnp.take_along_axis(logits_e, g_sel[:, :, None], axis=1)[:, 0]
    top_v, top_i = lax.top_k(logits_in, TOP_K)
    weights = jax.nn.softmax(top_v, axis=-1) * pg_top
    expert = g_sel * EXPERTS_PER_GROUP + top_i

    A = T * TOP_K
    e_flat = expert.reshape(A)
    tok_flat = jnp.repeat(jnp.arange(T, dtype=jnp.int32), TOP_K)
    w_flat = weights.reshape(A)
    order = jnp.argsort(e_flat)
    e_s, tok_s, w_s = e_flat[order], tok_flat[order], w_flat[order]
    counts = jnp.bincount(e_flat, length=N_EXPERTS)
    start = jnp.cumsum(counts) - counts
    padded = ((counts + MOE_BLOCK - 1) // MOE_BLOCK) * MOE_BLOCK
    pend = jnp.cumsum(padded)
    pstart = pend - padded
    dest = pstart[e_s] + (jnp.arange(A) - start[e_s])
    n_blocks = -(-A // MOE_BLOCK) + N_EXPERTS
    P = n_blocks * MOE_BLOCK
    buf_tok = jnp.full((P,), T, jnp.int32).at[dest].set(tok_s)
    buf_w = jnp.zeros((P,), F32).at[dest].set(w_s)
    block_e = jnp.clip(jnp.searchsorted(pend, jnp.arange(n_blocks) * MOE_BLOCK, side='right'),
                       0, N_EXPERTS - 1)
    x_pad = jnp.concatenate([xf, jnp.zeros((1, D), xf.dtype)], axis=0)
    xb = x_pad[buf_tok].reshape(n_blocks, MOE_BLOCK, D)

    def expert_block(args):
        xblk, e = args
        return (jax.nn.silu(xblk @ w1[e]) * (xblk @ w3[e])) @ w2[e]

    yb = lax.map(expert_block, (xb, block_e)).reshape(P, D)
    out = jnp.zeros((T + 1, D), xf.dtype).at[buf_tok].add(yb * buf_w[:, None].astype(xf.dtype))
    return out[:T].reshape(B, S, D)


def setup_inputs(seed: int = 0) -> dict:
    key = jax.random.key(seed)
    keys = jax.random.split(key, 40)
    ctr = [0]

    def nk():
        ctr[0] += 1
        return keys[ctr[0] - 1]

    def nrm(shape, scale):
        return jax.random.normal(nk(), shape, F32) * scale

    L, D = DEPTH, D_MODEL
    x = nrm((BATCH, SEQ, D), 1.0)
    c = nrm((BATCH, D), 1.0)
    positions = (jax.random.randint(nk(), (BATCH, 1), 0, 1024, jnp.int32)
                 + jnp.arange(SEQ, dtype=jnp.int32)[None, :])
    ada_w = nrm((L, D, 6 * D), 0.5 * D ** -0.5)
    ada_b = nrm((L, 6 * D), 0.01)
    norm1_g = 1.0 + nrm((L, D), 0.01)
    norm2_g = 1.0 + nrm((L, D), 0.01)
    w_in = nrm((L, D, IN_COLS), D ** -0.5)
    lru_conv_w = nrm((L, CONV_K, LRU_W), CONV_K ** -0.5)
    lru_conv_b = nrm((L, LRU_W), 0.01)
    lru_wa = nrm((L, LRU_BLOCKS, LRU_BS, LRU_BS), LRU_BS ** -0.5)
    lru_ba = nrm((L, LRU_W), 0.1)
    lru_wx = nrm((L, LRU_BLOCKS, LRU_BS, LRU_BS), LRU_BS ** -0.5)
    lru_bx = nrm((L, LRU_W), 0.1)
    a0 = jax.random.uniform(nk(), (L, LRU_W), F32, 0.9, 0.999)
    s = a0 ** (1.0 / LRU_C)
    lru_lambda = jnp.log(s) - jnp.log1p(-s)
    gdn_conv_w = nrm((L, CONV_K, 2 * GDN_HEADS * GDN_DK + GDN_W), CONV_K ** -0.5)
    gdn_a_log = jnp.log(jax.random.uniform(nk(), (L, GDN_HEADS), F32, 1.0, 16.0))
    dt = jnp.exp(jax.random.uniform(nk(), (L, GDN_HEADS), F32, float(np.log(1e-3)), float(np.log(1e-1))))
    gdn_dt_bias = dt + jnp.log(-jnp.expm1(-dt))
    gdn_norm_g = 1.0 + nrm((L, GDN_DV), 0.01)
    branch_proj = nrm((L, N_BRANCH, RET_W, D), RET_W ** -0.5)
    w_out = nrm((L, D, D), D ** -0.5)
    router_grp_w = nrm((L, D, N_GROUPS), D ** -0.5)
    router_grp_b = nrm((L, N_GROUPS), 0.01)
    router_exp_w = nrm((L, D, N_EXPERTS), D ** -0.5)
    router_exp_b = nrm((L, N_EXPERTS), 0.01)
    moe_w1 = nrm((L, N_EXPERTS, D, D_EXPERT), D ** -0.5)
    moe_w3 = nrm((L, N_EXPERTS, D, D_EXPERT), D ** -0.5)
    moe_w2 = nrm((L, N_EXPERTS, D_EXPERT, D), D_EXPERT ** -0.5)
    final_g = 1.0 + nrm((D,), 0.01)
    return {'x': x, 'c': c, 'positions': positions, 'ada_w': ada_w, 'ada_b': ada_b,
            'norm1_g': norm1_g, 'norm2_g': norm2_g, 'w_in': w_in,
            'lru_conv_w': lru_conv_w, 'lru_conv_b': lru_conv_b, 'lru_wa': lru_wa, 'lru_ba': lru_ba,
            'lru_wx': lru_wx, 'lru_bx': lru_bx, 'lru_lambda': lru_lambda,
            'gdn_conv_w': gdn_conv_w, 'gdn_a_log': gdn_a_log, 'gdn_dt_bias': gdn_dt_bias,
            'gdn_norm_g': gdn_norm_g, 'branch_proj': branch_proj, 'w_out': w_out,
            'router_grp_w': router_grp_w, 'router_grp_b': router_grp_b,
            'router_exp_w': router_exp_w, 'router_exp_b': router_exp_b,
            'moe_w1': moe_w1, 'moe_w3': moe_w3, 'moe_w2': moe_w2, 'final_g': final_g}


def reference(x, c, positions, ada_w, ada_b, norm1_g, norm2_g, w_in, lru_conv_w, lru_conv_b,
              lru_wa, lru_ba, lru_wx, lru_bx, lru_lambda, gdn_conv_w, gdn_a_log, gdn_dt_bias,
              gdn_norm_g, branch_proj, w_out, router_grp_w, router_grp_b, router_exp_w,
              router_exp_b, moe_w1, moe_w3, moe_w2, final_g):
    cond = jax.nn.silu(c)
    for l in range(DEPTH):
        mod = (cond @ ada_w[l] + ada_b[l])[:, None, :]
        sh1, sc1, gt1, sh2, sc2, gt2 = jnp.split(mod, 6, axis=-1)
        h = rms_norm(x, norm1_g[l]) * (1 + sc1) + sh1
        x = x + gt1 * hybrid_mixer(h, positions, w_in[l], lru_conv_w[l], lru_conv_b[l], lru_wa[l],
                                   lru_ba[l], lru_wx[l], lru_bx[l], lru_lambda[l], gdn_conv_w[l],
                                   gdn_a_log[l], gdn_dt_bias[l], gdn_norm_g[l], branch_proj[l], w_out[l])
        h = rms_norm(x, norm2_g[l]) * (1 + sc2) + sh2
        x = x + gt2 * hier_moe(h, router_grp_w[l], router_grp_b[l], router_exp_w[l], router_exp_b[l],
                               moe_w1[l], moe_w3[l], moe_w2[l])
    return rms_norm(x, final_g)
```

```cpp
#include <hip/hip_runtime.h>
#include <cstdio>
#include <cstdint>

#ifndef ONE_LAUNCH
#define ONE_LAUNCH 1
#endif
#ifndef DBG_NOSEQ
#define DBG_NOSEQ 0
#endif
#ifndef DBG_NOMOE
#define DBG_NOMOE 0
#endif
#ifndef DBG_NOMIX
#define DBG_NOMIX 0
#endif
#ifndef DBG_MOE_SCALE
#define DBG_MOE_SCALE 1.0f
#endif
#ifndef DBG_M
#define DBG_M 0
#endif
#ifndef DBG_ZERO_BR
#define DBG_ZERO_BR 0
#endif

#define LAS __attribute__((address_space(3)))
typedef unsigned short bf16_t;
typedef short bf16x8 __attribute__((ext_vector_type(8)));
typedef float f32x4 __attribute__((ext_vector_type(4)));
typedef float f32x2 __attribute__((ext_vector_type(2)));
typedef unsigned u32x4 __attribute__((ext_vector_type(4)));
typedef unsigned u32x2 __attribute__((ext_vector_type(2)));

constexpr int S_ = 16384, D_ = 2048, NL = 2;
constexpr int NZ = 16384;
constexpr int NZP = 16640;
constexpr int INC = 16400;
constexpr int NWAVES = 8, NTHR = 512;
constexpr float EPS = 1e-6f;
constexpr int ZC_RQ = 0, ZC_RK = 1024, ZC_RV = 2048, ZC_RG = 3072, ZC_LX = 4096, ZC_LG = 5120, ZC_GQ = 6144, ZC_GK = 7168, ZC_GV = 8192, ZC_GZ = 9216, ZC_BR = 10240;
constexpr int MO_SH1 = 0, MO_SC1 = 2048, MO_GT1 = 4096, MO_SH2 = 6144, MO_SC2 = 8192, MO_GT2 = 10240;

constexpr size_t MiB = 1u << 20;
constexpr size_t WS_CTL = 0, CTL_BYTES = 1 * MiB;
constexpr size_t WS_MODV = 1 * MiB;
constexpr size_t WS_RTW = 2 * MiB;
constexpr size_t WS_GAB = 3 * MiB;
constexpr size_t WS_GABW = 2 * MiB + 512 * 1024;
constexpr size_t WS_ROWINFO = 4 * MiB;
constexpr size_t WS_TOK = 5 * MiB;
constexpr size_t WS_WIN = 8 * MiB;
constexpr size_t WS_BP = 73 * MiB;
constexpr size_t WS_WO = 85 * MiB;
constexpr size_t WS_W13 = 93 * MiB;
constexpr size_t WS_W2 = 221 * MiB;
constexpr size_t WS_H = 285 * MiB;
constexpr size_t WS_Y = 349 * MiB;
constexpr size_t WS_MF = 445 * MiB;
constexpr size_t WS_Z = 573 * MiB;
constexpr size_t WS_XB = WS_Z;
constexpr size_t WS_HID = WS_Z + 160 * MiB;
constexpr size_t WS_SLOT = WS_Z + 200 * MiB;
constexpr size_t WS_LWT = 1085 * MiB;
constexpr size_t WS_LPH = 1086 * MiB;
constexpr size_t WS_LCARRY = 1088 * MiB;
constexpr size_t WS_ROPE_C = 1089 * MiB;
constexpr size_t WS_ROPE_S = 1093 * MiB;
constexpr size_t WS_KV = 1100 * MiB;
constexpr size_t WS_GP2 = 1164 * MiB;
constexpr size_t WS_GPO = WS_GP2 + 64 * MiB;
constexpr size_t WS_GSV = 445 * MiB;
constexpr size_t WS_GUP = 1276 * MiB;
constexpr size_t WS_GGL = 1340 * MiB;
constexpr size_t WS_GO = 1341 * MiB;
constexpr size_t WS_END = 1373 * MiB;
constexpr int CW_BAR = 4096;
constexpr int CW_CNT = 16384;
constexpr int CW_SUB = 17408;
constexpr int CW_MOEQ = 65536;

constexpr int LDS_STAGE = 131072;
constexpr int LDS_BYTES = 163840;
constexpr int LDS_MISC = LDS_BYTES - 1024;
constexpr int MAXTILES = 160;

constexpr int PH_MOD = 0, PH_L0 = 1, PH_PER_LAYER = 11, PH_FINAL = 23, NPH = 24;

struct Params { const float* in[29]; float* out; unsigned char* ws; int ph_lo, ph_hi; };


#define CAS __attribute__((address_space(4)))
__device__ __forceinline__ const CAS char* karg_base() { const CAS char* ka = (const CAS char*)__builtin_amdgcn_kernarg_segment_ptr(); asm volatile("" : "+s"(ka)); return ka; }
__device__ __forceinline__ const float* KIN(int i) { return *(const float* const CAS*)(karg_base() + 8 * i); }
__device__ __forceinline__ float* KOUT() { return *(float* const CAS*)(karg_base() + 232); }
__device__ __forceinline__ unsigned char* KWS() { return *(unsigned char* const CAS*)(karg_base() + 240); }

typedef __bf16 bf16x2_n __attribute__((ext_vector_type(2)));
__device__ __forceinline__ unsigned pk2(float lo, float hi) { const f32x2 f = {lo, hi}; const bf16x2_n b = __builtin_convertvector(f, bf16x2_n); return __builtin_bit_cast(unsigned, b); }
__device__ __forceinline__ unsigned f2bf(float f) { return pk2(f, 0.f) & 0xffffu; }
__device__ __forceinline__ float bf2f(unsigned short b) { return __builtin_bit_cast(float, ((unsigned)b) << 16); }
__device__ __forceinline__ float bflo(unsigned w) { return __builtin_bit_cast(float, w << 16); }
__device__ __forceinline__ float bfhi(unsigned w) { return __builtin_bit_cast(float, w & 0xffff0000u); }
__device__ __forceinline__ float wave_sum(float v) {
#pragma unroll
    for (int o = 1; o < 64; o <<= 1) v += __shfl_xor(v, o);
    return v;
}
__device__ __forceinline__ float sigm(float x) { return 1.0f / (1.0f + expf(-x)); }
__device__ __forceinline__ float fexp(float x) { return __builtin_amdgcn_exp2f(x * 1.4426950408889634f); }
__device__ __forceinline__ float fsigm(float x) { return __builtin_amdgcn_rcpf(1.0f + __builtin_amdgcn_exp2f(-x * 1.4426950408889634f)); }
__device__ __forceinline__ float fsilu(float x) { return x * fsigm(x); }
__device__ __forceinline__ float siluf(float x) { return x * sigm(x); }
__device__ __forceinline__ float softplusf(float x) { return fmaxf(x, 0.f) + log1pf(expf(-fabsf(x))); }
__device__ __forceinline__ void unpack8(const u32x4 a, float (&o)[8]) { o[0] = bflo(a.x); o[1] = bfhi(a.x); o[2] = bflo(a.y); o[3] = bfhi(a.y); o[4] = bflo(a.z); o[5] = bfhi(a.z); o[6] = bflo(a.w); o[7] = bfhi(a.w); }
__device__ __forceinline__ float gelu_tanh(float x) { return 0.5f * x * (1.0f + tanhf(0.7978845608028654f * (x + 0.044715f * x * x * x))); }

#define XB_TMO      128
#define XB_XCNT(j)  (256  + 64 * (j))
#define XB_XSUB(j)  (1280 + 64 * (j))
#define XB_XGEN(j)  (2304 + 64 * (j))
#define XB_TOP      3328
#define XB_TOPGEN   3392
#define XCD_BAR_WORDS 3456
#define XB_SPIN_CAP (1u << 24)
__device__ __forceinline__ unsigned xb_ld(unsigned* p)              { return __hip_atomic_load(p, __ATOMIC_RELAXED, __HIP_MEMORY_SCOPE_AGENT); }
__device__ __forceinline__ unsigned xb_add(unsigned* p, unsigned v) { return __hip_atomic_fetch_add(p, v, __ATOMIC_RELAXED, __HIP_MEMORY_SCOPE_AGENT); }
__device__ __forceinline__ unsigned xb_xcc_id() { return (unsigned)__builtin_amdgcn_s_getreg((3 << 11) | 20) & 0xFu; }
#define XB_SPIN(cond, bar) do { unsigned _sp = 0; while (cond) { __builtin_amdgcn_s_sleep(1); \
    if ((++_sp & 255u) == 0u) { if (xb_ld(&(bar)[XB_TMO])) break; if (_sp > XB_SPIN_CAP) { atomicAdd(&(bar)[XB_TMO], 1u); break; } } } } while (0)
struct XcdBarrier { unsigned* bar; unsigned x; volatile LAS unsigned* st; };
__device__ __forceinline__ XcdBarrier xcd_barrier_post(unsigned* bar, volatile LAS unsigned* st) {
    XcdBarrier b; b.bar = bar; b.x = xb_xcc_id(); b.st = st;
    if (threadIdx.x == 0) (void)xb_add(&bar[XB_XCNT(b.x)], 1u);
    return b;
}
__device__ __forceinline__ void xcd_barrier_complete(unsigned* bar, unsigned x, unsigned& nloc, unsigned& nx) {
    const unsigned G = gridDim.x * gridDim.y * gridDim.z;
    unsigned sum, cnt, mine, sp = 0u;
    for (;;) {
        sum = 0u; cnt = 0u; mine = 0u;
#pragma unroll 1
        for (unsigned j = 0; j < 16; ++j) { const unsigned c = xb_ld(&bar[XB_XCNT(j)]); sum += c; cnt += (c > 0u) ? 1u : 0u; mine = (j == x) ? c : mine; }
        if (sum == G) break;
        __builtin_amdgcn_s_sleep(1);
        if ((++sp & 255u) == 0u) { if (xb_ld(&bar[XB_TMO])) break; if (sp > XB_SPIN_CAP) { atomicAdd(&bar[XB_TMO], 1u); break; } }
    }
    nloc = mine > 0u ? mine : 1u; nx = cnt > 0u ? cnt : 1u;
}
__device__ __forceinline__ void xcd_barrier(const XcdBarrier& b) {
    asm volatile("s_waitcnt vmcnt(0)" ::: "memory");
    __syncthreads();
    if (threadIdx.x == 0) {
        unsigned* bar = b.bar;
        __builtin_amdgcn_s_waitcnt(0);
        unsigned nloc = b.st[0], nx = b.st[1];
        if (nloc == 0u) { xcd_barrier_complete(bar, b.x, nloc, nx); b.st[0] = nloc; b.st[1] = nx; }
        const unsigned old = xb_add(&bar[XB_XSUB(b.x)], 1u);
        const unsigned gen = old / nloc;
        if (old + 1u == (gen + 1u) * nloc) {
            __builtin_amdgcn_fence(__ATOMIC_RELEASE, "agent");
            asm volatile("s_waitcnt vmcnt(0)" ::: "memory");
            const unsigned og = xb_add(&bar[XB_TOP], 1u);
            const unsigned tg = og / nx;
            if (og + 1u == (tg + 1u) * nx) xb_add(&bar[XB_TOPGEN], 1u);
            else XB_SPIN(xb_ld(&bar[XB_TOPGEN]) == tg, bar);
            __builtin_amdgcn_fence(__ATOMIC_ACQUIRE, "agent");
            xb_add(&bar[XB_XGEN(b.x)], 1u);
            asm volatile("s_waitcnt vmcnt(0)" ::: "memory");
        } else {
            XB_SPIN(xb_ld(&bar[XB_XGEN(b.x)]) == gen, bar);
            __builtin_amdgcn_fence(__ATOMIC_ACQUIRE, "agent");
            asm volatile("s_waitcnt vmcnt(0)" ::: "memory");
        }
    }
    __syncthreads();
}


__device__ __forceinline__ void sub_barrier(unsigned* cnt, unsigned target, unsigned* tmo) {
    asm volatile("s_waitcnt vmcnt(0)" ::: "memory");
    __syncthreads();
    if (threadIdx.x == 0) {
        __builtin_amdgcn_fence(__ATOMIC_RELEASE, "agent");
        asm volatile("s_waitcnt vmcnt(0)" ::: "memory");
        (void)xb_add(cnt, 1u);
        unsigned sp = 0u;
        while (xb_ld(cnt) < target) { __builtin_amdgcn_s_sleep(1); if ((++sp & 255u) == 0u) { if (xb_ld(tmo)) break; if (sp > XB_SPIN_CAP) { atomicAdd(tmo, 1u); break; } } }
        __builtin_amdgcn_fence(__ATOMIC_ACQUIRE, "agent");
        asm volatile("s_waitcnt vmcnt(0)" ::: "memory");
    }
    __syncthreads();
}

namespace pg8 {
constexpr int BM = 256, BK = 64, HALF = 128, HTB = HALF * BK * 2, STAGE_BYTES = 8 * HTB, NXCD = 8, WGM = 8;
__device__ __forceinline__ int lds_byte(int r, int c) { const int st = (r >> 4) * 2 + (c >> 5), rr = r & 15, cc = c & 31, ob = rr * 64 + cc * 2; return st * 1024 + (ob ^ (((ob >> 9) & 1) << 5)); }
__device__ __forceinline__ void stage_rc(int b, int& R, int& C) { const int st = b / 1024, sb = b % 1024, swz = sb ^ (((sb >> 9) & 1) << 5); R = (st >> 1) * 16 + swz / 64; C = (st & 1) * 32 + (swz % 64) / 2; }
__device__ __forceinline__ int perm32(int rho) { const int n = rho >> 4, i = rho & 15; return 8 * (i >> 2) + 4 * n + (i & 3); }
struct Unit { int pm, pn, aoff; };
struct Gemm { const bf16_t* A; const bf16_t* Bt; int lda, ldb, K; };
__device__ __forceinline__ bool static_tile(int L, int nM, int nN, int& pm, int& pn) {
    const int nwg = nM * nN; if (L >= nwg) return false;
    int wgid = L; { const int q = nwg / NXCD, r = nwg % NXCD, xcd = wgid % NXCD, off = wgid / NXCD; wgid = (xcd < r ? xcd * (q + 1) : r * (q + 1) + (xcd - r) * q) + off; }
    const int nig = WGM * nN, gid = wgid / nig, fm = gid * WGM, gsz = (nM - fm) < WGM ? (nM - fm) : WGM;
    pm = fm + ((wgid % nig) % gsz); pn = (wgid % nig) / gsz; return true;
}
__device__ __forceinline__ unsigned cvt_pk_bf16(float lo, float hi) { return pk2(lo, hi); }

template <class E, class = void> struct epi_early { static constexpr bool value = false; };
template <class E> struct epi_early<E, decltype((void)E::EARLY)> { static constexpr bool value = E::EARLY; };
template <class Epi, class Sched>
__device__ __forceinline__ void gemm_phase(LAS unsigned char* lds, const Gemm g, const Sched& S, const Epi& E) {
    int tid = threadIdx.x; asm volatile("" : "+v"(tid)); const int wid = __builtin_amdgcn_readfirstlane(tid >> 6), lane = tid & 63, wr = wid >> 2, wc = wid & 3, fr = lane & 15, fq = lane >> 4;
    int K = g.K; asm volatile("" : "+s"(K)); const int nt = K / BK; int lda_ = g.lda, ldb_ = g.ldb; asm volatile("" : "+s"(lda_), "+s"(ldb_));
    unsigned voffA[2], voffB[2];
#pragma unroll
    for (int i = 0; i < 2; ++i) { int R, C; stage_rc(tid * 16 + i * 8192, R, C); const int Rb = Epi::PERM ? ((R & ~31) + perm32(R & 31)) : R;
        voffA[i] = (unsigned)(R * lda_ + C) * 2u; voffB[i] = (unsigned)(Rb * ldb_ + C) * 2u; }
    const size_t kstep = (size_t)(BK * 2);
    const int* rtab = S.row_table();
    const size_t hstepA = Sched::GATHER ? (size_t)0 : (size_t)HALF * lda_ * 2, hstepB = (size_t)HALF * ldb_ * 2;
    const size_t tstepA = 2 * hstepA, tstepB = 2 * hstepB;
    unsigned vc0[2], vc1[2], vn0[2], vn1[2];
#define PG8_ROWS(pm_, o0, o1) do { _Pragma("unroll") for (int _i = 0; _i < 2; ++_i) { int _R, _C; stage_rc(tid * 16 + _i * 8192, _R, _C); \
        if (Sched::GATHER) { o0[_i] = (unsigned)(rtab[(pm_) * 256 + _R] * lda_ + _C) * 2u; o1[_i] = (unsigned)(rtab[(pm_) * 256 + 128 + _R] * lda_ + _C) * 2u; } else { o0[_i] = voffA[_i]; o1[_i] = voffA[_i]; } } } while (0)
    const unsigned ldsw = (unsigned)wid * 1024u;
    const int aoff = lds_byte(wr * 64 + fr, fq * 8), boff = lds_byte(wc * 32 + fr, fq * 8);
#define PG8_SA(b, h) (((b) * 2 + (h)) * HTB)
#define PG8_SB(b, h) ((4 + (b) * 2 + (h)) * HTB)
#define PG8_STAGE(bufoff, gbase, voff) do { _Pragma("unroll") for (int _i = 0; _i < 2; ++_i) \
        __builtin_amdgcn_global_load_lds((const unsigned*)((const char*)(gbase) + (voff)[_i]), (LAS unsigned*)(lds + (bufoff) + ldsw + _i * 8192), 16, 0, 0); } while (0)
#define PG8_LDA(dst, b, h) do { _Pragma("unroll") for (int m = 0; m < 4; ++m) _Pragma("unroll") for (int k = 0; k < 2; ++k) dst[m][k] = *(const LAS bf16x8*)(lds + PG8_SA(b, h) + aoff + m * 2048 + k * 1024); } while (0)
#define PG8_LDB(dst, b, h) do { _Pragma("unroll") for (int n = 0; n < 2; ++n) _Pragma("unroll") for (int k = 0; k < 2; ++k) dst[n][k] = *(const LAS bf16x8*)(lds + PG8_SB(b, h) + boff + n * 2048 + k * 1024); } while (0)
#define PG8_MMA(ai, bj, At, Bt) do { __builtin_amdgcn_s_setprio(1); _Pragma("unroll") for (int m = 0; m < 4; ++m) _Pragma("unroll") for (int n = 0; n < 2; ++n) _Pragma("unroll") for (int k = 0; k < 2; ++k) \
        acc[ai][bj][m][n] = __builtin_amdgcn_mfma_f32_16x16x32_bf16(Bt[n][k], At[m][k], acc[ai][bj][m][n], 0, 0, 0); __builtin_amdgcn_s_setprio(0); } while (0)
#define PG8_WAIT_V(n) asm volatile("s_waitcnt vmcnt(" #n ")" ::: "memory")
#define PG8_WAIT_L(n) asm volatile("s_waitcnt lgkmcnt(" #n ")" ::: "memory")
#define PG8_BAR __builtin_amdgcn_s_barrier()
#define PG8_SCHED __builtin_amdgcn_sched_barrier(0)
    Unit cur, nxt; int ui = 0;
    if (!S.next(0, cur)) return;
    f32x4 acc[2][2][4][2];
#pragma unroll
    for (int a = 0; a < 2; ++a)
#pragma unroll
        for (int b = 0; b < 2; ++b)
#pragma unroll
            for (int m = 0; m < 4; ++m)
#pragma unroll
                for (int n = 0; n < 2; ++n) acc[a][b][m][n] = (f32x4){0.f, 0.f, 0.f, 0.f};
    bf16x8 At[4][2], B0[2][2], B1[2][2];
    const char* cA = (const char*)g.A + (size_t)cur.pm * tstepA + (size_t)cur.aoff; const char* cB = (const char*)g.Bt + (size_t)cur.pn * tstepB;
    PG8_ROWS(cur.pm, vc0, vc1);
#define PG8_PROLOGUE_A(cA_, cB_, v0_, v1_) do { PG8_STAGE(PG8_SB(0, 0), cB_, voffB); PG8_STAGE(PG8_SA(0, 0), cA_, v0_); PG8_STAGE(PG8_SB(0, 1), (cB_) + hstepB, voffB); PG8_STAGE(PG8_SA(0, 1), (cA_) + hstepA, v1_); } while (0)
#define PG8_PROLOGUE_B() do { if (wr == 1) PG8_BAR; PG8_WAIT_V(4); PG8_BAR; \
        PG8_STAGE(PG8_SB(1, 0), cB + kstep, voffB); PG8_STAGE(PG8_SA(1, 0), cA + kstep, vc0); PG8_STAGE(PG8_SB(1, 1), cB + hstepB + kstep, voffB); \
        PG8_WAIT_V(6); PG8_BAR; } while (0)
#define PG8_PROLOGUE() do { PG8_PROLOGUE_A(cA, cB, vc0, vc1); PG8_PROLOGUE_B(); } while (0)
    if (!Epi::LDS_EPI) PG8_PROLOGUE();
    for (;;) {
        const bool has_next = S.next(ui + 1, nxt);
        if (Epi::LDS_EPI) { S.ready(cur); if (!(epi_early<Epi>::value && ui > 0)) PG8_PROLOGUE_A(cA, cB, vc0, vc1); PG8_PROLOGUE_B(); }
        const bool chain = has_next && !Epi::LDS_EPI;
        const char* nA = chain ? (const char*)g.A + (size_t)nxt.pm * tstepA + (size_t)nxt.aoff : cA; const char* nB = chain ? (const char*)g.Bt + (size_t)nxt.pn * tstepB : cB;
        if (chain) PG8_ROWS(nxt.pm, vn0, vn1); else { vn0[0] = vc0[0]; vn0[1] = vc0[1]; vn1[0] = vc1[0]; vn1[1] = vc1[1]; }
        for (int t = 0; t < nt; t += 2) {
            const bool last = (t == nt - 2);
            const char* a1 = cA + (size_t)(t + 1) * kstep;
            const char* a2 = last ? nA : cA + (size_t)(t + 2) * kstep; const char* b2 = last ? nB : cB + (size_t)(t + 2) * kstep;
            const char* a3 = a2 + kstep; const char* b3 = b2 + kstep;
            unsigned x0[2], x1[2]; x0[0] = last ? vn0[0] : vc0[0]; x0[1] = last ? vn0[1] : vc0[1]; x1[0] = last ? vn1[0] : vc1[0]; x1[1] = last ? vn1[1] : vc1[1];
            PG8_LDB(B0, 0, 0); PG8_SCHED; PG8_LDA(At, 0, 0); PG8_STAGE(PG8_SA(1, 1), a1 + hstepA, vc1);
            PG8_WAIT_L(8); PG8_BAR; PG8_WAIT_L(0); PG8_MMA(0, 0, At, B0); PG8_BAR; PG8_SCHED;
            PG8_LDB(B1, 0, 1); PG8_STAGE(PG8_SB(0, 0), b2, voffB);
            PG8_BAR; PG8_WAIT_L(0); PG8_MMA(0, 1, At, B1); PG8_BAR;
            PG8_LDA(At, 0, 1); PG8_STAGE(PG8_SA(0, 0), a2, x0);
            PG8_BAR; PG8_WAIT_L(0); PG8_MMA(1, 0, At, B0); PG8_BAR; PG8_SCHED;
            PG8_STAGE(PG8_SB(0, 1), b2 + hstepB, voffB);
            PG8_WAIT_V(6); PG8_BAR; PG8_MMA(1, 1, At, B1); PG8_BAR;
            PG8_LDB(B0, 1, 0); PG8_SCHED; PG8_LDA(At, 1, 0); PG8_STAGE(PG8_SA(0, 1), a2 + hstepA, x1);
            PG8_WAIT_L(8); PG8_BAR; PG8_WAIT_L(0); PG8_MMA(0, 0, At, B0); PG8_BAR; PG8_SCHED;
            PG8_LDB(B1, 1, 1); PG8_STAGE(PG8_SB(1, 0), b3, voffB);
            PG8_BAR; PG8_WAIT_L(0); PG8_MMA(0, 1, At, B1); PG8_BAR;
            PG8_LDA(At, 1, 1); PG8_STAGE(PG8_SA(1, 0), a3, x0);
            PG8_BAR; PG8_WAIT_L(0); PG8_MMA(1, 0, At, B0); PG8_BAR; PG8_SCHED;
            PG8_STAGE(PG8_SB(1, 1), b3 + hstepB, voffB);
            PG8_WAIT_V(6); PG8_BAR; PG8_MMA(1, 1, At, B1); PG8_BAR;
        }
        if (Epi::LDS_EPI) { PG8_WAIT_V(0); if (wr == 0) PG8_BAR; PG8_BAR;
            if constexpr (epi_early<Epi>::value) { static_assert(!Sched::GATHER, "early prologue: plain row tiles only");
                E.run_a(acc, cur, wr, wc, lds, tid);
                if (has_next) { const char* eA = (const char*)g.A + (size_t)nxt.pm * tstepA + (size_t)nxt.aoff; const char* eB = (const char*)g.Bt + (size_t)nxt.pn * tstepB; PG8_PROLOGUE_A(eA, eB, voffA, voffA); }
                E.run_b(cur, lds, tid); }
            else E.run(acc, cur, wr, wc, fr, fq, lds, tid); }
        else E(acc, cur, wr, wc, fr, fq);
        if (!has_next) break;
        if (!E.keep(cur))
#pragma unroll
        for (int a = 0; a < 2; ++a)
#pragma unroll
            for (int b = 0; b < 2; ++b)
#pragma unroll
                for (int m = 0; m < 4; ++m)
#pragma unroll
                    for (int n = 0; n < 2; ++n) acc[a][b][m][n] = (f32x4){0.f, 0.f, 0.f, 0.f};
        if (Epi::LDS_EPI) { cur = nxt; cA = (const char*)g.A + (size_t)cur.pm * tstepA + (size_t)cur.aoff; cB = (const char*)g.Bt + (size_t)cur.pn * tstepB; ++ui; PG8_ROWS(cur.pm, vc0, vc1); }
        else { cur = nxt; cA = nA; cB = nB; ++ui; vc0[0] = vn0[0]; vc0[1] = vn0[1]; vc1[0] = vn1[0]; vc1[1] = vn1[1]; }
    }
    if (!Epi::LDS_EPI) { PG8_WAIT_V(0); if (wr == 0) PG8_BAR; PG8_BAR; }
#undef PG8_ROWS
#undef PG8_PROLOGUE
#undef PG8_PROLOGUE_A
#undef PG8_PROLOGUE_B
#undef PG8_SA
#undef PG8_SB
#undef PG8_STAGE
#undef PG8_LDA
#undef PG8_LDB
#undef PG8_MMA
#undef PG8_WAIT_V
#undef PG8_WAIT_L
#undef PG8_BAR
#undef PG8_SCHED
}
}
using pg8::Unit;

struct SchedStatic { static constexpr bool GATHER = false; __device__ __forceinline__ const int* row_table() const { return nullptr; } __device__ __forceinline__ void ready(const Unit&) const {} int nM, nN, G, c;
    __device__ __forceinline__ bool next(int i, Unit& u) const { int pm, pn; if (!pg8::static_tile(i * G + c, nM, nN, pm, pn)) return false; u.pm = pm; u.pn = pn; u.aoff = 0; return true; } };
struct SchedMerge { static constexpr bool GATHER = false; __device__ __forceinline__ const int* row_table() const { return nullptr; } __device__ __forceinline__ void ready(const Unit&) const {} int G, c;
    __device__ __forceinline__ bool next(int i, Unit& u) const { const int ti = i / 3, b = i - 3 * ti; int pm, pn; if (!pg8::static_tile(ti * G + c, 64, 8, pm, pn)) return false;
        u.pm = pm; u.pn = b * 8 + pn; u.aoff = b * 1024 * 2; return true; } };
template <bool GATH>
struct SchedMoe { static constexpr bool GATHER = GATH; const int* rtab; __device__ __forceinline__ const int* row_table() const { return rtab; } __device__ __forceinline__ void ready(const Unit&) const {} int G, c, nN; const LAS int* tbl;
    __device__ __forceinline__ bool next(int i, Unit& u) const { const int L = i * G + c; const int ntl = __builtin_amdgcn_readfirstlane(tbl[224]); if (L >= ntl * nN) return false;
        const int pm = L / nN; u.pm = pm; u.pn = __builtin_amdgcn_readfirstlane(tbl[pm]) * nN + (L - pm * nN); u.aoff = 0; return true; } };
struct SchedMoeDyn { static constexpr bool GATHER = false; __device__ __forceinline__ const int* row_table() const { return nullptr; } int nN; const LAS int* tbl; volatile LAS int* slot; unsigned* done; unsigned* tmo;
    __device__ __forceinline__ bool next(int i, Unit& u) const { const int L = __builtin_amdgcn_readfirstlane(slot[i & 1]); const int ntl = __builtin_amdgcn_readfirstlane(tbl[224]); if (L >= ntl * nN) return false;
        const int pm = L / nN; u.pm = pm; u.pn = __builtin_amdgcn_readfirstlane(tbl[pm]) * nN + (L - pm * nN); u.aoff = 0; return true; }
    __device__ __forceinline__ void ready(const Unit& u) const {
        if (threadIdx.x == 0) { if (slot[4] == 0) { unsigned* d = done + 64 * (u.pm + 1); unsigned sp = 0u;
                while (xb_ld(d) < 32u) { __builtin_amdgcn_s_sleep(1); if ((++sp & 255u) == 0u) { if (xb_ld(tmo)) break; if (sp > XB_SPIN_CAP) { atomicAdd(tmo, 1u); break; } } } }
            slot[4] = 0; __builtin_amdgcn_fence(__ATOMIC_ACQUIRE, "agent"); asm volatile("s_waitcnt vmcnt(0)" ::: "memory"); }
        asm volatile("s_waitcnt lgkmcnt(0)" ::: "memory"); __builtin_amdgcn_s_barrier(); asm volatile("" ::: "memory"); } };

struct EpiZ { static constexpr bool LDS_EPI = false; template <class A_> __device__ __forceinline__ void run(A_&, const Unit&, int, int, int, int, LAS unsigned char*, int) const {} __device__ __forceinline__ bool keep(const Unit&) const { return false; } static constexpr bool PERM = true; bf16_t* Z; float* GAB;
    __device__ __forceinline__ void operator()(const f32x4 (&acc)[2][2][4][2], const Unit& u, int wr, int wc, int fr, int fq) const {
        const int row0 = u.pm * 256 + wr * 64 + fr;
        if (u.pn < 64) {
            const int col0 = u.pn * 256 + wc * 32 + 8 * fq;
#pragma unroll
            for (int ai = 0; ai < 2; ++ai)
#pragma unroll
                for (int m = 0; m < 4; ++m) { bf16_t* rowp = Z + (size_t)(row0 + ai * 128 + m * 16) * NZ + col0;
#pragma unroll
                    for (int bj = 0; bj < 2; ++bj) { const f32x4 v0 = acc[ai][bj][m][0], v1 = acc[ai][bj][m][1]; u32x4 w;
                        w.x = pg8::cvt_pk_bf16(v0[0], v0[1]); w.y = pg8::cvt_pk_bf16(v0[2], v0[3]); w.z = pg8::cvt_pk_bf16(v1[0], v1[1]); w.w = pg8::cvt_pk_bf16(v1[2], v1[3]);
                        *(u32x4*)(rowp + bj * 128) = w; } }
        } else if (wc == 0 && fq < 2) {
#pragma unroll
            for (int ai = 0; ai < 2; ++ai)
#pragma unroll
                for (int m = 0; m < 4; ++m) { float* gp = GAB + (size_t)(row0 + ai * 128 + m * 16) * 16 + 8 * fq;
                    *(f32x4*)gp = acc[ai][0][m][0]; *(f32x4*)(gp + 4) = acc[ai][0][m][1]; }
        }
    } };
struct EpiZL { static constexpr bool LDS_EPI = true, PERM = true, EARLY = true; bf16_t* Z;
    __device__ __forceinline__ bool keep(const Unit&) const { return false; }
    __device__ __forceinline__ void operator()(const f32x4 (&)[2][2][4][2], const Unit&, int, int, int, int) const {}
    template <class A_> __device__ __forceinline__ void run(A_&, const Unit&, int, int, int, int, LAS unsigned char*, int) const {}
    __device__ __forceinline__ void rows_out(const Unit& u, LAS unsigned char* lds, int tid, int i) const { const int c = tid & 31; const int row = (tid >> 5) + 16 * i;
        const u32x4 w = *(const LAS u32x4*)(lds + row * 512 + ((c ^ (row & 31)) << 4)); __builtin_nontemporal_store(w, (u32x4*)(Z + (size_t)(u.pm * 256 + row) * NZ + u.pn * 256 + c * 8)); }
    __device__ __forceinline__ void run_a(const f32x4 (&acc)[2][2][4][2], const Unit& u, int wr, int wc, LAS unsigned char* lds, int tid_) const {
        int tid = tid_; asm volatile("" : "+v"(tid));
        const int fr = tid & 15, fq = (tid >> 4) & 3;
#pragma unroll
        for (int ai = 0; ai < 2; ++ai)
#pragma unroll
            for (int m = 0; m < 4; ++m) { const int r = ai * 128 + wr * 64 + m * 16 + fr;
#pragma unroll
                for (int bj = 0; bj < 2; ++bj) { const int c16 = 16 * bj + 4 * wc + fq; const f32x4 v0 = acc[ai][bj][m][0], v1 = acc[ai][bj][m][1]; u32x4 w;
                    w.x = pk2(v0[0], v0[1]); w.y = pk2(v0[2], v0[3]); w.z = pk2(v1[0], v1[1]); w.w = pk2(v1[2], v1[3]);
                    *(LAS u32x4*)(lds + r * 512 + ((c16 ^ (r & 31)) << 4)) = w; }
                asm volatile("" ::: "memory"); }
        __syncthreads();
#pragma unroll
        for (int i = 0; i < 4; ++i) rows_out(u, lds, tid, i);
        asm volatile("" ::: "memory");
#pragma unroll
        for (int i = 8; i < 12; ++i) rows_out(u, lds, tid, i);
        asm volatile("s_waitcnt lgkmcnt(0)" ::: "memory"); __builtin_amdgcn_s_barrier(); asm volatile("" ::: "memory");
    }
    __device__ __forceinline__ void run_b(const Unit& u, LAS unsigned char* lds, int tid_) const {
        int tid = tid_; asm volatile("" : "+v"(tid));
#pragma unroll
        for (int i = 4; i < 8; ++i) rows_out(u, lds, tid, i);
        asm volatile("" ::: "memory");
#pragma unroll
        for (int i = 12; i < 16; ++i) rows_out(u, lds, tid, i);
        asm volatile("s_waitcnt lgkmcnt(0)" ::: "memory"); __builtin_amdgcn_s_barrier(); asm volatile("" ::: "memory");
    } };
struct EpiMerge { static constexpr bool LDS_EPI = false; template <class A_> __device__ __forceinline__ void run(A_&, const Unit&, int, int, int, int, LAS unsigned char*, int) const {} static constexpr bool PERM = true; const bf16_t* Z; bf16_t* OUT;
    __device__ __forceinline__ bool keep(const Unit& u) const { return (u.pn >> 3) < 2; }
    __device__ __forceinline__ void operator()(f32x4 (&acc)[2][2][4][2], const Unit& u, int wr, int wc, int fr, int fq) const {
        const int b = u.pn >> 3, pnl = u.pn & 7; const int row0 = u.pm * 256 + wr * 64 + fr, col0 = pnl * 256 + wc * 32 + 8 * fq;
        const bf16_t* zb = Z + ZC_BR + b * 2048 + col0;
        u32x4 gb[2][2][2], gn[2][2][2];
#define EM_LOAD(slot, aim_) do { const int ai_ = (aim_) >> 1, mh_ = (aim_) & 1; _Pragma("unroll") for (int mm = 0; mm < 2; ++mm) _Pragma("unroll") for (int bj = 0; bj < 2; ++bj) { \
            const bf16_t* zp = zb + (size_t)(row0 + ai_ * 128 + (2 * mh_ + mm) * 16) * NZ + bj * 128; gb[slot][mm][bj] = *(const u32x4*)zp; gn[slot][mm][bj] = (b < 2) ? *(const u32x4*)(zp + 2048) : (u32x4){0u, 0u, 0u, 0u}; } } while (0)
        EM_LOAD(0, 0);
#pragma unroll
        for (int aim = 0; aim < 4; ++aim) { const int ai = aim >> 1, mh = aim & 1, sl = aim & 1;
            if (aim + 1 < 4) EM_LOAD((aim + 1) & 1, aim + 1);
#pragma unroll
            for (int mm = 0; mm < 2; ++mm) { const int m = 2 * mh + mm;
#pragma unroll
                for (int bj = 0; bj < 2; ++bj) { float eb[8]; { float x[8]; unpack8(gb[sl][mm][bj], x);
#pragma unroll
                        for (int i = 0; i < 8; ++i) eb[i] = __builtin_amdgcn_rcpf(1.0f + fexp(-fmaxf(fminf(x[i], 30.f), -30.f))); }
                    if (b < 2) { float x[8]; unpack8(gn[sl][mm][bj], x);
#pragma unroll
                        for (int i = 0; i < 8; ++i) eb[i] *= 1.0f + fexp(-fmaxf(fminf(x[i], 30.f), -30.f)); }
                    f32x4& v0 = acc[ai][bj][m][0]; f32x4& v1 = acc[ai][bj][m][1];
                    v0[0] *= eb[0]; v0[1] *= eb[1]; v0[2] *= eb[2]; v0[3] *= eb[3]; v1[0] *= eb[4]; v1[1] *= eb[5]; v1[2] *= eb[6]; v1[3] *= eb[7];
                    if (b == 2) { u32x4 w; w.x = pg8::cvt_pk_bf16(v0[0], v0[1]); w.y = pg8::cvt_pk_bf16(v0[2], v0[3]); w.z = pg8::cvt_pk_bf16(v1[0], v1[1]); w.w = pg8::cvt_pk_bf16(v1[2], v1[3]);
                        *(u32x4*)(OUT + (size_t)(row0 + ai * 128 + m * 16) * 2048 + col0 + bj * 128) = w; } } }
        }
#undef EM_LOAD
    } };
struct EpiWout { static constexpr bool LDS_EPI = false; template <class A_> __device__ __forceinline__ void run(A_&, const Unit&, int, int, int, int, LAS unsigned char*, int) const {} __device__ __forceinline__ bool keep(const Unit&) const { return false; } static constexpr bool PERM = false; const float* xsrc; float* xdst; const float* gt;
    __device__ __forceinline__ void operator()(const f32x4 (&acc)[2][2][4][2], const Unit& u, int wr, int wc, int fr, int fq) const {
        const int row0 = u.pm * 256 + wr * 64 + fr, col0 = u.pn * 256 + wc * 32 + 4 * fq;
        f32x4 gv[2][2];
#pragma unroll
        for (int bj = 0; bj < 2; ++bj)
#pragma unroll
            for (int n = 0; n < 2; ++n) gv[bj][n] = *(const f32x4*)(gt + col0 + bj * 128 + n * 16);
        f32x4 xo[2][2][2][2];
#define EW_LOAD(slot, q_) do { const int ai_ = (q_) >> 1, mh_ = (q_) & 1; _Pragma("unroll") for (int mm = 0; mm < 2; ++mm) { const size_t off_ = (size_t)(row0 + ai_ * 128 + (2 * mh_ + mm) * 16) * 2048 + col0; \
            _Pragma("unroll") for (int bj = 0; bj < 2; ++bj) _Pragma("unroll") for (int n = 0; n < 2; ++n) xo[slot][mm][bj][n] = *(const f32x4*)(xsrc + off_ + bj * 128 + n * 16); } } while (0)
        EW_LOAD(0, 0);
#pragma unroll
        for (int q = 0; q < 4; ++q) { const int ai = q >> 1, mh = q & 1, sl = q & 1;
            if (q + 1 < 4) EW_LOAD((q + 1) & 1, q + 1);
#pragma unroll
            for (int mm = 0; mm < 2; ++mm) { const int m = 2 * mh + mm; const size_t off = (size_t)(row0 + ai * 128 + m * 16) * 2048 + col0;
#pragma unroll
                for (int bj = 0; bj < 2; ++bj)
#pragma unroll
                    for (int n = 0; n < 2; ++n) *(f32x4*)(xdst + off + bj * 128 + n * 16) = xo[sl][mm][bj][n] + gv[bj][n] * acc[ai][bj][m][n]; } }
#undef EW_LOAD
    } };
struct EpiW13 { static constexpr bool LDS_EPI = false; template <class A_> __device__ __forceinline__ void run(A_&, const Unit&, int, int, int, int, LAS unsigned char*, int) const {} __device__ __forceinline__ bool keep(const Unit&) const { return false; } static constexpr bool PERM = true; bf16_t* HID; unsigned* done;
    __device__ __forceinline__ void operator()(const f32x4 (&acc)[2][2][4][2], const Unit& u, int wr, int wc, int fr, int fq) const {
        const int pnl = u.pn & 3; const int row0 = u.pm * 256 + wr * 64 + fr, col0 = pnl * 128 + wc * 32 + 8 * fq;
        const __amdgpu_buffer_rsrc_t rs = __builtin_amdgcn_make_buffer_rsrc(HID, 0, MAXTILES * 256 * 512 * 2, 0x00020000);
#pragma unroll
        for (int ai = 0; ai < 2; ++ai)
#pragma unroll
            for (int m = 0; m < 4; ++m) { float hv[8];
#pragma unroll
                for (int n = 0; n < 2; ++n)
#pragma unroll
                    for (int j = 0; j < 4; ++j) hv[n * 4 + j] = fsilu(acc[ai][0][m][n][j]) * acc[ai][1][m][n][j];
                u32x4 w; w.x = pg8::cvt_pk_bf16(hv[0], hv[1]); w.y = pg8::cvt_pk_bf16(hv[2], hv[3]); w.z = pg8::cvt_pk_bf16(hv[4], hv[5]); w.w = pg8::cvt_pk_bf16(hv[6], hv[7]);
                __builtin_amdgcn_raw_buffer_store_b128(w, rs, (unsigned)(((row0 + ai * 128 + m * 16) * 512 + col0) * 2), 0,   16); }
        asm volatile("s_waitcnt vmcnt(0)" ::: "memory");
        if (fr == 0 && fq == 0) (void)xb_add(done + 64 * (u.pm + 1), 1u);
    } };
struct EpiW2 { static constexpr bool LDS_EPI = false; template <class A_> __device__ __forceinline__ void run(A_&, const Unit&, int, int, int, int, LAS unsigned char*, int) const {} __device__ __forceinline__ bool keep(const Unit&) const { return false; } static constexpr bool PERM = true; bf16_t* SLOT; const u32x2* rowinfo; const LAS int* tbl;
    __device__ __forceinline__ void operator()(const f32x4 (&acc)[2][2][4][2], const Unit& u, int wr, int wc, int fr, int fq) const {
        const int e = u.pn >> 3, pnl = u.pn & 7; const int row0 = u.pm * 256 + wr * 64 + fr, col0 = pnl * 256 + wc * 32 + 8 * fq; const int rend = __builtin_amdgcn_readfirstlane(tbl[192 + e]);
        u32x2 inf[2][4];
#pragma unroll
        for (int ai = 0; ai < 2; ++ai)
#pragma unroll
            for (int m = 0; m < 4; ++m) inf[ai][m] = rowinfo[row0 + ai * 128 + m * 16];
#pragma unroll
        for (int ai = 0; ai < 2; ++ai)
#pragma unroll
            for (int m = 0; m < 4; ++m) { const int r = row0 + ai * 128 + m * 16;
                if (r < rend) { const unsigned wbits = inf[ai][m].y; const float w = __uint_as_float(wbits); const unsigned tx = inf[ai][m].x; const unsigned tok = tx >> 1, k = tx & 1u;
                    bf16_t* dst = SLOT + ((size_t)k * S_ + tok) * 2048 + col0;
#pragma unroll
                    for (int bj = 0; bj < 2; ++bj) { const f32x4 v0 = acc[ai][bj][m][0] * w, v1 = acc[ai][bj][m][1] * w; u32x4 o;
                        o.x = pg8::cvt_pk_bf16(v0[0], v0[1]); o.y = pg8::cvt_pk_bf16(v0[2], v0[3]); o.z = pg8::cvt_pk_bf16(v1[0], v1[1]); o.w = pg8::cvt_pk_bf16(v1[2], v1[3]);
                        *(u32x4*)(dst + bj * 128) = o; } } }
    } };

struct EpiW2L { static constexpr bool LDS_EPI = true, PERM = true; bf16_t* SLOT; const u32x2* rowinfo; const LAS int* tbl; unsigned* q; volatile LAS int* slot; unsigned* done;
    __device__ __forceinline__ bool keep(const Unit&) const { return false; }
    __device__ __forceinline__ void operator()(const f32x4 (&)[2][2][4][2], const Unit&, int, int, int, int) const {}
    __device__ __forceinline__ void run(const f32x4 (&acc)[2][2][4][2], const Unit& u, int wr, int wc, int fr_, int fq_, LAS unsigned char* lds, int tid_) const {
        int tid = tid_; asm volatile("" : "+v"(tid));
        int qn = 0; unsigned dn = 0u;
        if (tid == 0) { qn = (int)xb_add(q, 1u); const int Ln = slot[(slot[2] + 1) & 1]; if (Ln < tbl[224] * 8) dn = xb_ld(done + 64 * ((Ln >> 3) + 1)); }
        const int fr = tid & 15, fq = (tid >> 4) & 3; const int e = u.pn >> 3, pnl = u.pn & 7; const int rend = __builtin_amdgcn_readfirstlane(tbl[192 + e]);
        LAS unsigned* rowx = (LAS unsigned*)(lds + 131072);
        u32x2 inf[2][4];
#pragma unroll
        for (int ai = 0; ai < 2; ++ai)
#pragma unroll
            for (int m = 0; m < 4; ++m) inf[ai][m] = rowinfo[u.pm * 256 + ai * 128 + wr * 64 + m * 16 + fr];
#pragma unroll
        for (int ai = 0; ai < 2; ++ai)
#pragma unroll
            for (int m = 0; m < 4; ++m) { const int r = ai * 128 + wr * 64 + m * 16 + fr; const bool valid = (u.pm * 256 + r) < rend; const float w = valid ? __uint_as_float(inf[ai][m].y) : 0.f;
                if (wc == 0 && fq == 0) rowx[r] = valid ? inf[ai][m].x : 0xffffffffu;
#pragma unroll
                for (int bj = 0; bj < 2; ++bj) { const int c16 = 16 * bj + 4 * wc + fq; const f32x4 v0 = acc[ai][bj][m][0] * w, v1 = acc[ai][bj][m][1] * w; u32x4 o;
                    o.x = pk2(v0[0], v0[1]); o.y = pk2(v0[2], v0[3]); o.z = pk2(v1[0], v1[1]); o.w = pk2(v1[2], v1[3]);
                    *(LAS u32x4*)(lds + r * 512 + ((c16 ^ (r & 31)) << 4)) = o; }
                asm volatile("" ::: "memory"); }
        __syncthreads();
        const int c = tid & 31;
#pragma unroll
        for (int i = 0; i < 16; ++i) { const int row = (tid >> 5) + 16 * i; const unsigned tx = rowx[row];
            if (tx != 0xffffffffu) { const u32x4 o = *(const LAS u32x4*)(lds + row * 512 + ((c ^ (row & 31)) << 4));
                *(u32x4*)(SLOT + ((size_t)(tx & 1u) * S_ + (tx >> 1)) * 2048 + pnl * 256 + c * 8) = o; }
            if ((i & 3) == 3) asm volatile("" ::: "memory"); }
        if (tid == 0) { const int n = slot[2]; slot[n & 1] = qn; slot[2] = n + 1; slot[4] = dn >= 32u ? 1 : 0; }
        asm volatile("s_waitcnt lgkmcnt(0)" ::: "memory"); __builtin_amdgcn_s_barrier(); asm volatile("" ::: "memory");
    } };

struct Frame { LAS unsigned char* lds; unsigned char* ldsg; int tid, lane, wave, G, bx; };
extern __shared__ __attribute__((aligned(16))) unsigned char lds_raw[];
__device__ __forceinline__ Frame make_frame() { Frame F; int tz = threadIdx.x; asm volatile("" : "+v"(tz)); F.lds = (LAS unsigned char*)lds_raw; F.ldsg = lds_raw; F.tid = tz; F.lane = tz & 63;
    F.wave = __builtin_amdgcn_readfirstlane(tz >> 6); F.G = gridDim.x; F.bx = blockIdx.x; return F; }

struct TItem { const float* W; bf16_t* WT; int ldw, srccol, k0, ldk, dstrow; };
__device__ __forceinline__ void titem_load(const TItem& t, f32x4 (&x)[8], int lane) {
    const int n4 = (lane & 7) * 4, kr = lane >> 3;
#pragma unroll
    for (int i = 0; i < 8; ++i) x[i] = __builtin_nontemporal_load((const f32x4*)(t.W + (size_t)(t.k0 + kr + 8 * i) * t.ldw + t.srccol + n4));
}
__device__ __forceinline__ void titem_store(const TItem& t, const f32x4 (&x)[8], float* scr, int lane) {
    const int n4 = (lane & 7) * 4, kr = lane >> 3;
#pragma unroll
    for (int i = 0; i < 8; ++i) { float* s = scr + (kr + 8 * i) * 33 + n4; s[0] = x[i][0]; s[1] = x[i][1]; s[2] = x[i][2]; s[3] = x[i][3]; }
    asm volatile("s_waitcnt lgkmcnt(0)" ::: "memory");
    const int c = lane & 7;
#pragma unroll
    for (int j = 0; j < 4; ++j) { const int n = (lane >> 3) + 8 * j; const float* s = scr + (8 * c) * 33 + n;
        u32x4 o; o.x = pk2(s[0 * 33], s[1 * 33]); o.y = pk2(s[2 * 33], s[3 * 33]); o.z = pk2(s[4 * 33], s[5 * 33]); o.w = pk2(s[6 * 33], s[7 * 33]);
        *(u32x4*)(t.WT + (size_t)(t.dstrow + n) * t.ldk + t.k0 + 8 * c) = o; }
    asm volatile("s_waitcnt lgkmcnt(0)" ::: "memory");
}

__device__ __forceinline__ void phase_mod(const Frame& F, const Params& p) {
    const float* cvec = KIN(1); const float* ada_w = KIN(3); const float* ada_b = KIN(4);
    float* modv = (float*)(KWS() + WS_MODV);
    float* sc = (float*)F.ldsg;
    f32x2* red = (f32x2*)(sc + 2048);
    for (int k = F.tid; k < 2048; k += NTHR) sc[k] = siluf(cvec[k]);
    __syncthreads();
    for (int u = F.bx; u < 2 * 96; u += F.G) {
        const int l = u / 96, cb = u % 96, col = cb * 128 + 2 * F.lane;
        const float* wp = ada_w + ((size_t)l * 2048 + F.wave * 256) * 12288 + col; const float* sp = sc + F.wave * 256;
        f32x2 acc = (f32x2){0.f, 0.f};
#pragma unroll 16
        for (int k = 0; k < 256; ++k) { const f32x2 w = __builtin_nontemporal_load((const f32x2*)(wp + (size_t)k * 12288)); const float s = sp[k]; acc[0] += s * w[0]; acc[1] += s * w[1]; }
        red[F.wave * 64 + F.lane] = acc;
        __syncthreads();
        if (F.wave == 0) { f32x2 s = *(const f32x2*)(ada_b + l * 12288 + col);
#pragma unroll
            for (int w = 0; w < 8; ++w) s += red[w * 64 + F.lane];
            *(f32x2*)(modv + l * 12288 + col) = s; }
        __syncthreads();
    }
}

__device__ __forceinline__ void phase_convert(const Frame& F, const Params& p, int l) {
    float* scr = (float*)(F.ldsg + F.wave * 8448);
    const int gw = F.bx * NWAVES + F.wave, NGW = F.G * NWAVES;
    bf16_t* WIN = (bf16_t*)(KWS() + WS_WIN); bf16_t* BP = (bf16_t*)(KWS() + WS_BP); bf16_t* WO = (bf16_t*)(KWS() + WS_WO); bf16_t* W13 = (bf16_t*)(KWS() + WS_W13); bf16_t* W2 = (bf16_t*)(KWS() + WS_W2);
    const float* w_in = KIN(7) + (size_t)l * 2048 * INC;
    const float* bp = KIN(19) + (size_t)l * 3 * 1024 * 2048;
    const float* wo = KIN(20) + (size_t)l * 2048 * 2048;
    const float* w1 = KIN(25) + (size_t)l * 32 * 2048 * 512; const float* w3 = KIN(26) + (size_t)l * 32 * 2048 * 512; const float* w2 = KIN(27) + (size_t)l * 32 * 512 * 2048;
    const float* lwa = KIN(10) + (size_t)l * 8 * 16384; const float* lwx = KIN(12) + (size_t)l * 8 * 16384; bf16_t* LWT = (bf16_t*)(KWS() + WS_LWT);
    constexpr int I_IN = 512 * 32, I_BP = 3 * 16 * 64, I_WO = 32 * 64, I_W13 = 32 * 2 * 512, I_W2 = 32 * 512, I_LRU = 8 * 2 * 8;
    constexpr int NITEMS = I_IN + I_BP + I_WO + I_W13 + I_W2 + I_LRU;
    auto decode = [&](int it) -> TItem { TItem t; int r = it;
        if (r < I_IN) { const int nb = r % 512, kb = r / 512; t.W = w_in; t.ldw = INC; t.srccol = (nb < 320) ? 32 * nb : 10256 + 32 * (nb - 320); t.k0 = 64 * kb; t.WT = WIN; t.ldk = 2048; t.dstrow = 32 * nb; return t; }
        r -= I_IN;
        if (r < I_BP) { const int b = r / 1024, q = r % 1024, nb = q % 64, kb = q / 64; t.W = bp + (size_t)b * 1024 * 2048; t.ldw = 2048; t.srccol = 32 * nb; t.k0 = 64 * kb; t.WT = BP + (size_t)b * 2048 * 1024; t.ldk = 1024; t.dstrow = 32 * nb; return t; }
        r -= I_BP;
        if (r < I_WO) { const int nb = r % 64, kb = r / 64; t.W = wo; t.ldw = 2048; t.srccol = 32 * nb; t.k0 = 64 * kb; t.WT = WO; t.ldk = 2048; t.dstrow = 32 * nb; return t; }
        r -= I_WO;
        if (r < I_W13) { const int e = r / 1024, q = r % 1024, which = q / 512, q2 = q % 512, nb = q2 % 16, kb = q2 / 16; const int pn = nb >> 2, j = nb & 3;
            t.W = (which ? w3 : w1) + (size_t)e * 2048 * 512; t.ldw = 512; t.srccol = 32 * nb; t.k0 = 64 * kb; t.WT = W13 + (size_t)e * 1024 * 2048; t.ldk = 2048; t.dstrow = pn * 256 + which * 128 + 32 * j; return t; }
        r -= I_W13;
        if (r < I_W2) { const int e = r / 512, q = r % 512, nb = q % 64, kb = q / 64; t.W = w2 + (size_t)e * 512 * 2048; t.ldw = 2048; t.srccol = 32 * nb; t.k0 = 64 * kb; t.WT = W2 + (size_t)e * 2048 * 512; t.ldk = 512; t.dstrow = 32 * nb; return t; }
        r -= I_W2;
        { const int n = r / 16, q = r % 16, which = q / 8, q2 = q % 8, nb = q2 % 4, kb = q2 / 4; t.W = (which ? lwx : lwa) + (size_t)n * 16384; t.ldw = 128; t.srccol = 32 * nb; t.k0 = 64 * kb; t.WT = LWT + (size_t)n * 256 * 128; t.ldk = 128; t.dstrow = which * 128 + 32 * nb; return t; } };
    if (gw < NITEMS) { TItem ta = decode(gw); f32x4 xa[8]; titem_load(ta, xa, F.lane);
        for (int it = gw; it < NITEMS; it += NGW) { const int nx = it + NGW; TItem tb = ta; f32x4 xb[8];
            if (nx < NITEMS) { tb = decode(nx); titem_load(tb, xb, F.lane); }
            titem_store(ta, xa, scr, F.lane);
            if (nx < NITEMS) { ta = tb;
#pragma unroll
                for (int i = 0; i < 8; ++i) xa[i] = xb[i]; } } }
    float* rtw = (float*)(KWS() + WS_RTW); const float* rgw = KIN(21) + (size_t)l * 2048 * 4; const float* rew = KIN(23) + (size_t)l * 2048 * 32;
    for (int idx = F.bx * NTHR + F.tid; idx < 36 * 2048; idx += F.G * NTHR) { const int j = idx >> 11, k = idx & 2047; rtw[idx] = (j < 32) ? rew[k * 32 + j] : rgw[k * 4 + (j - 32)]; }
}

template <int MODE>
__device__ __forceinline__ void phase_norm(const Frame& F, const Params& p, int l, bool fold) {
    float* tA = (float*)(F.ldsg + 98304);
    float* tB = tA + 2048;
    float* tG = tB + 2048;
    const float* modv = (const float*)(KWS() + WS_MODV);
    const float* xin = (MODE == 0 && l == 0) ? KIN(0) : KOUT();
    float* xio = KOUT();
    bf16_t* H = (bf16_t*)(KWS() + WS_H);
    const bf16_t* SL = (const bf16_t*)(KWS() + WS_SLOT);
    for (int c = F.tid; c < 2048; c += NTHR) {
        if (MODE == 0) { tA[c] = KIN(5)[l * 2048 + c] * (1.f + modv[l * 12288 + MO_SC1 + c]); tB[c] = modv[l * 12288 + MO_SH1 + c]; }
        if (MODE == 1) { tA[c] = KIN(6)[l * 2048 + c] * (1.f + modv[l * 12288 + MO_SC2 + c]); tB[c] = modv[l * 12288 + MO_SH2 + c]; }
        if (MODE == 2) { tA[c] = KIN(28)[c]; tB[c] = 0.f; }
        tG[c] = fold ? DBG_MOE_SCALE * modv[(MODE == 2 ? 1 : l - 1) * 12288 + MO_GT2 + c] : 0.f;
    }
    __syncthreads();
    const int gw = F.bx * NWAVES + F.wave, NGW = F.G * NWAVES;
    const float* rtw = (const float*)(KWS() + WS_RTW);
    for (int row = gw; row < S_; row += NGW) {
        f32x4 v[8]; float ss = 0.f;
#pragma unroll
        for (int j = 0; j < 8; ++j) { const int c = 4 * F.lane + 256 * j; v[j] = *(const f32x4*)(xin + (size_t)row * 2048 + c);
            if (fold) { const u32x2 a = *(const u32x2*)(SL + (size_t)row * 2048 + c), b = *(const u32x2*)(SL + ((size_t)S_ + row) * 2048 + c); const f32x4 g = *(const f32x4*)(tG + c);
#if DBG_M == 1
                v[j][0] += g[0]; v[j][1] += g[1]; v[j][2] += g[2]; v[j][3] += g[3];
#else
                v[j][0] += g[0] * (bflo(a.x) + bflo(b.x)); v[j][1] += g[1] * (bfhi(a.x) + bfhi(b.x)); v[j][2] += g[2] * (bflo(a.y) + bflo(b.y)); v[j][3] += g[3] * (bfhi(a.y) + bfhi(b.y));
#endif
                if (MODE != 2) *(f32x4*)(xio + (size_t)row * 2048 + c) = v[j]; }
            ss += (v[j][0] * v[j][0] + v[j][1] * v[j][1]) + (v[j][2] * v[j][2] + v[j][3] * v[j][3]); }
        const float rstd = 1.0f / sqrtf(wave_sum(ss) * (1.0f / 2048.0f) + EPS);
#pragma unroll
        for (int j = 0; j < 8; ++j) { const int c = 4 * F.lane + 256 * j; const f32x4 a = *(const f32x4*)(tA + c), b = *(const f32x4*)(tB + c);
            v[j] = v[j] * rstd * a + b;
            if (MODE == 2) *(f32x4*)(xio + (size_t)row * 2048 + c) = v[j];
            else { u32x2 w; w.x = pk2(v[j][0], v[j][1]); w.y = pk2(v[j][2], v[j][3]); *(u32x2*)(H + (size_t)row * 2048 + c) = w; } }
        if (MODE == 1) {
            float mine = 0.f;
#pragma unroll 2
            for (int jo = 0; jo < 36; ++jo) { float d = 0.f;
#pragma unroll
                for (int j = 0; j < 8; ++j) { const f32x4 w = *(const f32x4*)(rtw + (size_t)jo * 2048 + 4 * F.lane + 256 * j); d += (v[j][0] * w[0] + v[j][1] * w[1]) + (v[j][2] * w[2] + v[j][3] * w[3]); }
                d = wave_sum(d); mine = (F.lane == jo) ? d : mine; }
            if (F.lane < 32) mine += KIN(24)[l * 32 + F.lane]; else if (F.lane < 36) mine += KIN(22)[l * 4 + (F.lane - 32)];
            const float g0 = __shfl(mine, 32), g1 = __shfl(mine, 33), g2 = __shfl(mine, 34), g3 = __shfl(mine, 35);
            int gs = 0; float gm = g0; if (g1 > gm) { gm = g1; gs = 1; } if (g2 > gm) { gm = g2; gs = 2; } if (g3 > gm) { gm = g3; gs = 3; }
            const float pg = 1.0f / (expf(g0 - gm) + expf(g1 - gm) + expf(g2 - gm) + expf(g3 - gm));
            float ev[8];
#pragma unroll
            for (int i = 0; i < 8; ++i) ev[i] = __shfl(mine, gs * 8 + i);
            int i0 = 0; float v0 = ev[0];
#pragma unroll
            for (int i = 1; i < 8; ++i) if (ev[i] > v0) { v0 = ev[i]; i0 = i; }
            int i1 = -1; float v1 = -3.0e38f;
#pragma unroll
            for (int i = 0; i < 8; ++i) if (i != i0 && ev[i] > v1) { v1 = ev[i]; i1 = i; }
            const float e1 = expf(v1 - v0);
#if DBG_M == 6
            const float w0 = 0.3f, w1 = 0.2f;
#elif DBG_M == 7
            const float w0 = pg, w1 = 0.f;
#elif DBG_M == 8
            const float w0 = 1.0f / (1.0f + e1), w1 = 0.f;
#else
            const float w0 = pg / (1.0f + e1), w1 = pg * e1 / (1.0f + e1);
#endif
            if (F.lane == 0) { unsigned* cnt = (unsigned*)(KWS() + WS_CTL) + CW_CNT + l * 32; const int ex0 = gs * 8 + i0, ex1 = gs * 8 + i1;
                const unsigned p0 = atomicAdd(cnt + ex0, 1u), p1 = atomicAdd(cnt + ex1, 1u);
                unsigned* tk = (unsigned*)(KWS() + WS_TOK) + (size_t)row * 8;
                tk[0] = (unsigned)ex0; tk[1] = p0; tk[2] = __builtin_bit_cast(unsigned, w0); tk[3] = 0u; tk[4] = (unsigned)ex1; tk[5] = p1; tk[6] = __builtin_bit_cast(unsigned, w1); tk[7] = 0u; }
        }
    }
}

__device__ __forceinline__ void phase_norm1_gab(const Frame& F, const Params& p, int l, bool fold) {
    float* tA = (float*)(F.ldsg + 98304); float* tB = tA + 2048; float* tG = tB + 2048;
    bf16_t* Wl = (bf16_t*)F.ldsg;
    const float* modv = (const float*)(KWS() + WS_MODV); const float* xin = (l == 0) ? KIN(0) : KOUT(); float* xio = KOUT(); bf16_t* H = (bf16_t*)(KWS() + WS_H);
    const bf16_t* SL = (const bf16_t*)(KWS() + WS_SLOT); float* GAB = (float*)(KWS() + WS_GAB);
    __syncthreads();
    for (int c = F.tid; c < 2048; c += NTHR) { tA[c] = KIN(5)[l * 2048 + c] * (1.f + modv[l * 12288 + MO_SC1 + c]); tB[c] = modv[l * 12288 + MO_SH1 + c]; tG[c] = fold ? modv[(l - 1) * 12288 + MO_GT2 + c] : 0.f; }
    { const float* gabw = (const float*)(KWS() + WS_GABW) + (size_t)l * 16 * 2048;
        for (int i = F.tid; i < 16 * 2048 / 4; i += NTHR) { const f32x4 v = *(const f32x4*)(gabw + 4 * i); u32x2 o; o.x = pk2(v[0], v[1]); o.y = pk2(v[2], v[3]); *(u32x2*)(Wl + 4 * i) = o; } }
    __syncthreads();
    const int gw = F.bx * NWAVES + F.wave, NGW = F.G * NWAVES;
    for (int rb = gw * 2; rb < S_; rb += NGW * 2) {
        f32x4 v[2][8];
#pragma unroll
        for (int r = 0; r < 2; ++r) { const size_t row = (size_t)(rb + r); float ss = 0.f;
#pragma unroll
            for (int j = 0; j < 8; ++j) { const int c = 4 * F.lane + 256 * j; v[r][j] = *(const f32x4*)(xin + row * 2048 + c);
                if (fold) { const u32x2 a = *(const u32x2*)(SL + row * 2048 + c), b = *(const u32x2*)(SL + ((size_t)S_ + row) * 2048 + c); const f32x4 g = *(const f32x4*)(tG + c);
                    v[r][j][0] += g[0] * (bflo(a.x) + bflo(b.x)); v[r][j][1] += g[1] * (bfhi(a.x) + bfhi(b.x)); v[r][j][2] += g[2] * (bflo(a.y) + bflo(b.y)); v[r][j][3] += g[3] * (bfhi(a.y) + bfhi(b.y));
                    *(f32x4*)(xio + row * 2048 + c) = v[r][j]; }
                ss += (v[r][j][0] * v[r][j][0] + v[r][j][1] * v[r][j][1]) + (v[r][j][2] * v[r][j][2] + v[r][j][3] * v[r][j][3]); }
            const float rstd = 1.0f / sqrtf(wave_sum(ss) * (1.0f / 2048.0f) + EPS);
#pragma unroll
            for (int j = 0; j < 8; ++j) { const int c = 4 * F.lane + 256 * j; const f32x4 a = *(const f32x4*)(tA + c), b = *(const f32x4*)(tB + c); v[r][j] = v[r][j] * rstd * a + b;
                u32x2 w; w.x = pk2(v[r][j][0], v[r][j][1]); w.y = pk2(v[r][j][2], v[r][j][3]); *(u32x2*)(H + row * 2048 + c) = w; }
            asm volatile("" ::: "memory"); }
        float mine[2] = {0.f, 0.f};
#pragma unroll 1
        for (int jo = 0; jo < 16; ++jo) { float d[2] = {0.f, 0.f};
#pragma unroll
            for (int j = 0; j < 8; ++j) { const u32x2 wq = *(const u32x2*)(Wl + jo * 2048 + 4 * F.lane + 256 * j); const float w0 = bflo(wq.x), w1 = bfhi(wq.x), w2 = bflo(wq.y), w3 = bfhi(wq.y);
#pragma unroll
                for (int r = 0; r < 2; ++r) { d[r] = __builtin_fmaf(v[r][j][0], w0, d[r]); d[r] = __builtin_fmaf(v[r][j][1], w1, d[r]); d[r] = __builtin_fmaf(v[r][j][2], w2, d[r]); d[r] = __builtin_fmaf(v[r][j][3], w3, d[r]); } }
#pragma unroll
            for (int r = 0; r < 2; ++r) { const float s = wave_sum(d[r]); mine[r] = (F.lane == jo) ? s : mine[r]; } }
        if (F.lane < 16) {
#pragma unroll
            for (int r = 0; r < 2; ++r) GAB[(size_t)(rb + r) * 16 + F.lane] = mine[r]; }
    }
}

__device__ __forceinline__ void phase_norm2_router(const Frame& F, const Params& p, int l) {
    float* tA = (float*)(F.ldsg + 98304); float* tB = tA + 2048;
    const float* modv = (const float*)(KWS() + WS_MODV); const float* xin = KOUT(); bf16_t* H = (bf16_t*)(KWS() + WS_H);
    for (int c = F.tid; c < 2048; c += NTHR) { tA[c] = KIN(6)[l * 2048 + c] * (1.f + modv[l * 12288 + MO_SC2 + c]); tB[c] = modv[l * 12288 + MO_SH2 + c]; }
    __syncthreads();
    const int gw = F.bx * NWAVES + F.wave, NGW = F.G * NWAVES; const float* rtw = (const float*)(KWS() + WS_RTW);
    const float be = (F.lane < 32) ? KIN(24)[l * 32 + F.lane] : ((F.lane < 36) ? KIN(22)[l * 4 + (F.lane - 32)] : 0.f);
    for (int rb = gw * 4; rb < S_; rb += NGW * 4) {
        f32x4 v[4][8];
#pragma unroll
        for (int r = 0; r < 4; ++r) { const size_t row = (size_t)(rb + r); float ss = 0.f;
#pragma unroll
            for (int j = 0; j < 8; ++j) { v[r][j] = *(const f32x4*)(xin + row * 2048 + 4 * F.lane + 256 * j); ss += (v[r][j][0] * v[r][j][0] + v[r][j][1] * v[r][j][1]) + (v[r][j][2] * v[r][j][2] + v[r][j][3] * v[r][j][3]); }
            const float rstd = 1.0f / sqrtf(wave_sum(ss) * (1.0f / 2048.0f) + EPS);
#pragma unroll
            for (int j = 0; j < 8; ++j) { const int c = 4 * F.lane + 256 * j; const f32x4 a = *(const f32x4*)(tA + c), b = *(const f32x4*)(tB + c); v[r][j] = v[r][j] * rstd * a + b;
                u32x2 w; w.x = pk2(v[r][j][0], v[r][j][1]); w.y = pk2(v[r][j][2], v[r][j][3]); *(u32x2*)(H + row * 2048 + c) = w; } }
        float mine[4] = {0.f, 0.f, 0.f, 0.f};
#pragma unroll 2
        for (int jo = 0; jo < 36; ++jo) { f32x4 wv[8];
#pragma unroll
            for (int j = 0; j < 8; ++j) wv[j] = *(const f32x4*)(rtw + (size_t)jo * 2048 + 4 * F.lane + 256 * j);
#pragma unroll
            for (int r = 0; r < 4; ++r) { float d = 0.f;
#pragma unroll
                for (int j = 0; j < 8; ++j) { d = __builtin_fmaf(v[r][j][0], wv[j][0], d); d = __builtin_fmaf(v[r][j][1], wv[j][1], d); d = __builtin_fmaf(v[r][j][2], wv[j][2], d); d = __builtin_fmaf(v[r][j][3], wv[j][3], d); }
                d = wave_sum(d); mine[r] = (F.lane == jo) ? d : mine[r]; } }
#pragma unroll
        for (int r = 0; r < 4; ++r) { const float lg = mine[r] + be; const int row = rb + r;
            const float g0 = __shfl(lg, 32), g1 = __shfl(lg, 33), g2 = __shfl(lg, 34), g3 = __shfl(lg, 35);
            int gs = 0; float gm = g0; if (g1 > gm) { gm = g1; gs = 1; } if (g2 > gm) { gm = g2; gs = 2; } if (g3 > gm) { gm = g3; gs = 3; }
            const float pg = 1.0f / (expf(g0 - gm) + expf(g1 - gm) + expf(g2 - gm) + expf(g3 - gm));
            float ev[8];
#pragma unroll
            for (int i = 0; i < 8; ++i) ev[i] = __shfl(lg, gs * 8 + i);
            int i0 = 0; float v0 = ev[0];
#pragma unroll
            for (int i = 1; i < 8; ++i) if (ev[i] > v0) { v0 = ev[i]; i0 = i; }
            int i1 = -1; float v1 = -3.0e38f;
#pragma unroll
            for (int i = 0; i < 8; ++i) if (i != i0 && ev[i] > v1) { v1 = ev[i]; i1 = i; }
            const float e1 = expf(v1 - v0); const float w0 = pg / (1.0f + e1), w1 = pg * e1 / (1.0f + e1);
            if (F.lane == 0) { unsigned* cnt = (unsigned*)(KWS() + WS_CTL) + CW_CNT + l * 32; const int ex0 = gs * 8 + i0, ex1 = gs * 8 + i1;
                const unsigned p0 = atomicAdd(cnt + ex0, 1u), p1 = atomicAdd(cnt + ex1, 1u);
                unsigned* tk = (unsigned*)(KWS() + WS_TOK) + (size_t)row * 8;
                tk[0] = (unsigned)ex0; tk[1] = p0; tk[2] = __float_as_uint(w0); tk[3] = 0u; tk[4] = (unsigned)ex1; tk[5] = p1; tk[6] = __float_as_uint(w1); tk[7] = 0u; } }
    }
}

__device__ __forceinline__ void phase_norm2_router_lds(const Frame& F, const Params& p, int l) {
    float* tA = (float*)(F.ldsg + 131072); float* tB = tA + 2048;
    const float* modv = (const float*)(KWS() + WS_MODV); const float* xin = KOUT(); bf16_t* H = (bf16_t*)(KWS() + WS_H);
    for (int c = F.tid; c < 2048; c += NTHR) { tA[c] = KIN(6)[l * 2048 + c] * (1.f + modv[l * 12288 + MO_SC2 + c]); tB[c] = modv[l * 12288 + MO_SH2 + c]; }
    const int gw = F.bx * NWAVES + F.wave, NGW = F.G * NWAVES, ng = S_ / (NGW * 4), w = F.wave, lane = F.lane;
    const unsigned char* rtwb = (const unsigned char*)(KWS() + WS_RTW);
    const float be = (lane < 32) ? KIN(24)[l * 32 + lane] : ((lane < 36) ? KIN(22)[l * 4 + (lane - 32)] : 0.f);
#pragma unroll
    for (int k = 0; k < 8; ++k) __builtin_amdgcn_global_load_lds((const unsigned*)(rtwb + (size_t)(w + 8 * k) * 1024 + lane * 16), (LAS unsigned*)(F.lds + (w + 8 * k) * 1024), 16, 0, 0);
    __syncthreads();
    int s = 0;
#pragma unroll 1
    for (int g = 0; g < ng; ++g) { const int rb = gw * 4 + g * NGW * 4;
        f32x4 v[4][8]; float mine[4] = {0.f, 0.f, 0.f, 0.f};
        { float rstd[4];
#pragma unroll
        for (int r = 0; r < 4; ++r) { const size_t row = (size_t)(rb + r); float ss = 0.f;
#pragma unroll
            for (int j = 0; j < 8; ++j) { v[r][j] = *(const f32x4*)(xin + row * 2048 + 4 * lane + 256 * j); ss += (v[r][j][0] * v[r][j][0] + v[r][j][1] * v[r][j][1]) + (v[r][j][2] * v[r][j][2] + v[r][j][3] * v[r][j][3]); }
            rstd[r] = 1.0f / sqrtf(wave_sum(ss) * (1.0f / 2048.0f) + EPS); }
#pragma unroll
        for (int j = 0; j < 8; ++j) { const int c = 4 * lane + 256 * j; const f32x4 a = *(const f32x4*)(tA + c), b = *(const f32x4*)(tB + c);
#pragma unroll
            for (int r = 0; r < 4; ++r) { v[r][j] = v[r][j] * rstd[r] * a + b;
                u32x2 wq; wq.x = pk2(v[r][j][0], v[r][j][1]); wq.y = pk2(v[r][j][2], v[r][j][3]); *(u32x2*)(H + (size_t)(rb + r) * 2048 + c) = wq; }
            asm volatile("" ::: "memory"); } }
        f32x2 vp[2][8][4];
#pragma unroll
        for (int rp = 0; rp < 2; ++rp)
#pragma unroll
            for (int j = 0; j < 8; ++j)
#pragma unroll
                for (int i = 0; i < 4; ++i) vp[rp][j][i] = (f32x2){v[2 * rp][j][i], v[2 * rp + 1][j][i]};
#pragma unroll 1
        for (int blk = 0; blk < 5; ++blk, ++s) {
            asm volatile("s_waitcnt vmcnt(0)" ::: "memory");
            __syncthreads();
            if (blk < 4 || g + 1 < ng) { const int nb = (blk + 1) % 5; const int nld = (nb == 4) ? 4 : 8; int lz = lane * 16; asm volatile("" : "+v"(lz));
                const unsigned char* src = rtwb + (size_t)nb * 65536 + lz; LAS unsigned char* dst = F.lds + ((s + 1) & 1) * 65536;
#pragma unroll
                for (int k = 0; k < 8; ++k) if (k < nld) __builtin_amdgcn_global_load_lds((const unsigned*)(src + (size_t)(w + 8 * k) * 1024), (LAS unsigned*)(dst + (w + 8 * k) * 1024), 16, 0, 0); }
            { int l4 = 4 * lane; asm volatile("" : "+v"(l4)); const LAS float* wb = (const LAS float*)(F.lds + (s & 1) * 65536) + l4; const int nout = (blk == 4) ? 4 : 8;
#pragma unroll 1
                for (int q = 0; q < nout; ++q) { f32x2 dp[2] = {(f32x2){0.f, 0.f}, (f32x2){0.f, 0.f}};
#pragma unroll
                    for (int j = 0; j < 8; ++j) { const f32x4 wv = *(const LAS f32x4*)(wb + q * 2048 + 256 * j);
#pragma unroll
                        for (int rp = 0; rp < 2; ++rp)
#pragma unroll
                            for (int i = 0; i < 4; ++i) dp[rp] = __builtin_elementwise_fma(vp[rp][j][i], (f32x2){wv[i], wv[i]}, dp[rp]);
                        if ((j & 1) == 1) asm volatile("" ::: "memory"); }
                    const float d[4] = {dp[0][0], dp[0][1], dp[1][0], dp[1][1]};
                    const int jo = blk * 8 + q;
#pragma unroll
                    for (int r = 0; r < 4; ++r) { const float sm = wave_sum(d[r]); mine[r] = (lane == jo) ? sm : mine[r]; } } }
        }
#pragma unroll
        for (int r = 0; r < 4; ++r) { const float lg = mine[r] + be; const int row = rb + r;
            const float g0 = __shfl(lg, 32), g1 = __shfl(lg, 33), g2 = __shfl(lg, 34), g3 = __shfl(lg, 35);
            int gs = 0; float gm = g0; if (g1 > gm) { gm = g1; gs = 1; } if (g2 > gm) { gm = g2; gs = 2; } if (g3 > gm) { gm = g3; gs = 3; }
            const float pg = 1.0f / (expf(g0 - gm) + expf(g1 - gm) + expf(g2 - gm) + expf(g3 - gm));
            float ev[8];
#pragma unroll
            for (int i = 0; i < 8; ++i) ev[i] = __shfl(lg, gs * 8 + i);
            int i0 = 0; float v0 = ev[0];
#pragma unroll
            for (int i = 1; i < 8; ++i) if (ev[i] > v0) { v0 = ev[i]; i0 = i; }
            int i1 = -1; float v1 = -3.0e38f;
#pragma unroll
            for (int i = 0; i < 8; ++i) if (i != i0 && ev[i] > v1) { v1 = ev[i]; i1 = i; }
            const float e1 = expf(v1 - v0); const float w0 = pg / (1.0f + e1), w1 = pg * e1 / (1.0f + e1);
            if (lane == 0) { unsigned* cnt = (unsigned*)(KWS() + WS_CTL) + CW_CNT + l * 32; const int ex0 = gs * 8 + i0, ex1 = gs * 8 + i1;
                const unsigned p0 = atomicAdd(cnt + ex0, 1u), p1 = atomicAdd(cnt + ex1, 1u);
                unsigned* tk = (unsigned*)(KWS() + WS_TOK) + (size_t)row * 8;
                tk[0] = (unsigned)ex0; tk[1] = p0; tk[2] = __float_as_uint(w0); tk[3] = 0u; tk[4] = (unsigned)ex1; tk[5] = p1; tk[6] = __float_as_uint(w1); tk[7] = 0u; } }
    }
}


__device__ __forceinline__ void moe_tables(const Frame& F, const Params& p, int l) {
    LAS int* tbl = (LAS int*)(F.lds + LDS_MISC + 64);
    int* gtbl = (int*)(KWS() + WS_ROWINFO + 512 * 1024);
    if (F.wave == 0) { const unsigned* cnt = (const unsigned*)(KWS() + WS_CTL) + CW_CNT + l * 32; const int e = F.lane;
        const int c = (e < 32) ? (int)__hip_atomic_load(cnt + e, __ATOMIC_RELAXED, __HIP_MEMORY_SCOPE_AGENT) : 0; const int t = (c + 255) >> 8;
        int incl = t;
#pragma unroll
        for (int o = 1; o < 32; o <<= 1) { const int v = __shfl_up(incl, o); if (e >= o) incl += v; }
        const int start = incl - t; const int total = __shfl(incl, 31);
        if (e < 32) { tbl[160 + e] = start; tbl[192 + e] = start * 256 + c; for (int k = 0; k < t && start + k < MAXTILES; ++k) tbl[start + k] = e; }
        const int nt = total < MAXTILES ? total : MAXTILES;
        for (int k = nt + e; k < MAXTILES; k += 64) tbl[k] = 0;
        if (e == 0) tbl[224] = nt; }
    __syncthreads();
    if (F.bx == 0 && F.tid < 225) gtbl[F.tid] = tbl[F.tid];
}
__device__ __forceinline__ void moe_tables_load(const Frame& F, const Params& p) {
    LAS int* tbl = (LAS int*)(F.lds + LDS_MISC + 64);
    const int* gtbl = (const int*)(KWS() + WS_ROWINFO + 512 * 1024);
    if (F.tid < 225) tbl[F.tid] = gtbl[F.tid];
    __syncthreads();
}
__device__ __forceinline__ void phase_gather(const Frame& F, const Params& p, int l) {
    moe_tables(F, p, l);
    const LAS int* tbl = (const LAS int*)(F.lds + LDS_MISC + 64);
    u32x2* rowinfo = (u32x2*)(KWS() + WS_ROWINFO); int* rowtok = (int*)(KWS() + WS_TOK + 512 * 1024);
    for (int a = F.bx * NTHR + F.tid; a < 2 * S_; a += F.G * NTHR) { const int t = a >> 1, k = a & 1; const unsigned* tk = (const unsigned*)(KWS() + WS_TOK) + (size_t)t * 8 + 4 * k;
        const int e = (int)tk[0], pos = (int)tk[1]; const int dest = tbl[160 + e] * 256 + pos; u32x2 inf; inf.x = (unsigned)a; inf.y = tk[2]; rowinfo[dest] = inf; rowtok[dest] = t; }
    if (F.bx < 32) { const int e = F.bx; const int r0 = tbl[192 + e]; const int tend = (e < 31 ? tbl[160 + e + 1] : tbl[224]) * 256;
        for (int r = r0 + F.tid; r < tend; r += NTHR) rowtok[r] = 0; }
}

__device__ __forceinline__ void phase_lru_gates(const Frame& F, const Params& p, int l) {
    float* U = (float*)F.ldsg;
    const bf16_t* Z = (const bf16_t*)(KWS() + WS_Z); float* LA = (float*)(KWS() + WS_MF); float* LB = LA + (size_t)S_ * 1024;
    const float* cw = KIN(8) + l * 4 * 1024; const float* cb = KIN(9) + l * 1024; const float* wa = KIN(10) + (size_t)l * 8 * 128 * 128; const float* ba = KIN(11) + l * 1024;
    const float* wx = KIN(12) + (size_t)l * 8 * 128 * 128; const float* bx = KIN(13) + l * 1024; const float* lam = KIN(14) + l * 1024;
    for (int u = F.bx; u < 4096; u += F.G) {
        const int tt = u >> 1, half = u & 1, t0 = tt * 8, ch = half * 512 + F.tid, n = ch >> 7, j = ch & 127;
        float xr[11];
#pragma unroll
        for (int i = 0; i < 11; ++i) { const int t = t0 - 3 + i; xr[i] = (t >= 0) ? bf2f(Z[(size_t)t * NZ + ZC_LX + ch]) : 0.f; }
        const float c0 = cw[ch], c1 = cw[1024 + ch], c2 = cw[2048 + ch], c3 = cw[3072 + ch], cbv = cb[ch];
        float uo[8];
#pragma unroll
        for (int i = 0; i < 8; ++i) { uo[i] = c0 * xr[i] + c1 * xr[i + 1] + c2 * xr[i + 2] + c3 * xr[i + 3] + cbv; U[i * 512 + F.tid] = uo[i]; }
        __syncthreads();
        float ar[8], ai[8];
#pragma unroll
        for (int i = 0; i < 8; ++i) { ar[i] = 0.f; ai[i] = 0.f; }
        const float* wap = wa + (size_t)n * 16384 + j; const float* wxp = wx + (size_t)n * 16384 + j; const float* up = U + (F.tid & ~127);
        for (int i = 0; i < 128; ++i) { const float a = wap[i * 128], x = wxp[i * 128];
#pragma unroll
            for (int tk = 0; tk < 8; ++tk) { const float uu = up[tk * 512 + i]; ar[tk] += uu * a; ai[tk] += uu * x; } }
        const float bav = ba[ch], bxv = bx[ch], spl = softplusf(-lam[ch]);
#pragma unroll
        for (int tk = 0; tk < 8; ++tk) { const float r = sigm(ar[tk] + bav), ii = sigm(ai[tk] + bxv); const float la = -8.0f * r * spl;
            LA[(size_t)(t0 + tk) * 1024 + ch] = expf(la); LB[(size_t)(t0 + tk) * 1024 + ch] = sqrtf(-expm1f(2.0f * la)) * (ii * uo[tk]); }
        __syncthreads();
    }
}


constexpr int LRU_UF_PITCH = 132, LRU_UB_PITCH = 136;
template <bool FINAL>
__device__ __forceinline__ void lru_units(const Frame& F, const Params& p, int l, int first, int stride) {
    float* Uf = (float*)F.ldsg;
    float* Al = Uf + 64 * LRU_UF_PITCH;
    bf16_t* Ub = (bf16_t*)(Al + 64 * LRU_UF_PITCH);
    float* Cw = (float*)(Ub + 64 * LRU_UB_PITCH);
    const bf16_t* Z = (const bf16_t*)(KWS() + WS_Z); const bf16_t* LWT = (const bf16_t*)(KWS() + WS_LWT);
    float* PHb = (float*)(KWS() + WS_LPH); const float* CAR = (const float*)(KWS() + WS_LCARRY); bf16_t* Y = (bf16_t*)(KWS() + WS_Y);
    const float* cw = KIN(8) + l * 4 * 1024; const float* cb = KIN(9) + l * 1024; const float* ba = KIN(11) + l * 1024; const float* bx = KIN(13) + l * 1024; const float* lam = KIN(14) + l * 1024;
    const int w = F.wave, lane = F.lane, fr = lane & 15, fg = lane >> 4;
    int cur_n = -1; bf16x8 Bf[2][4]; float bav = 0.f, bxv = 0.f, spl = 0.f;
    for (int u = first; u < 2048; u += stride) {
        const int n = u & 7, ci = u >> 3, t0 = ci * 64;
        if (n != cur_n) {
            cur_n = n;
#pragma unroll
            for (int q = 0; q < 2; ++q)
#pragma unroll
                for (int ks = 0; ks < 4; ++ks) Bf[q][ks] = *(const bf16x8*)(LWT + ((size_t)n * 256 + q * 128 + 16 * w + fr) * 128 + 32 * ks + 8 * fg);
            const int ch = n * 128 + 16 * w + fr; bav = ba[ch]; bxv = bx[ch]; spl = softplusf(-lam[ch]);
            __syncthreads();
            for (int i = F.tid; i < 640; i += NTHR) { const int k = i >> 7, c = i & 127; Cw[i] = (k < 4) ? cw[k * 1024 + n * 128 + c] : cb[n * 128 + c]; }
            __syncthreads();
        }
        { const int tt = F.tid >> 3, cg = F.tid & 7; float xr[4][16];
#pragma unroll
            for (int k = 0; k < 4; ++k) { const int t = t0 + tt - 3 + k;
                if (t >= 0) { const u32x4 a = *(const u32x4*)(Z + (size_t)t * NZ + ZC_LX + n * 128 + 16 * cg), b = *(const u32x4*)(Z + (size_t)t * NZ + ZC_LX + n * 128 + 16 * cg + 8);
                    xr[k][0] = bflo(a.x); xr[k][1] = bfhi(a.x); xr[k][2] = bflo(a.y); xr[k][3] = bfhi(a.y); xr[k][4] = bflo(a.z); xr[k][5] = bfhi(a.z); xr[k][6] = bflo(a.w); xr[k][7] = bfhi(a.w);
                    xr[k][8] = bflo(b.x); xr[k][9] = bfhi(b.x); xr[k][10] = bflo(b.y); xr[k][11] = bfhi(b.y); xr[k][12] = bflo(b.z); xr[k][13] = bfhi(b.z); xr[k][14] = bflo(b.w); xr[k][15] = bfhi(b.w); }
                else {
#pragma unroll
                    for (int i = 0; i < 16; ++i) xr[k][i] = 0.f; } }
            float uo[16];
#pragma unroll
            for (int i = 0; i < 16; ++i) { const int c = 16 * cg + i; uo[i] = Cw[c] * xr[0][i] + Cw[128 + c] * xr[1][i] + Cw[256 + c] * xr[2][i] + Cw[384 + c] * xr[3][i] + Cw[512 + c]; }
#pragma unroll
            for (int i = 0; i < 4; ++i) *(f32x4*)(Uf + tt * LRU_UF_PITCH + 16 * cg + 4 * i) = (f32x4){uo[4 * i], uo[4 * i + 1], uo[4 * i + 2], uo[4 * i + 3]};
            u32x4 o0, o1; o0.x = pk2(uo[0], uo[1]); o0.y = pk2(uo[2], uo[3]); o0.z = pk2(uo[4], uo[5]); o0.w = pk2(uo[6], uo[7]); o1.x = pk2(uo[8], uo[9]); o1.y = pk2(uo[10], uo[11]); o1.z = pk2(uo[12], uo[13]); o1.w = pk2(uo[14], uo[15]);
            *(u32x4*)(Ub + tt * LRU_UB_PITCH + 16 * cg) = o0; *(u32x4*)(Ub + tt * LRU_UB_PITCH + 16 * cg + 8) = o1; }
        __syncthreads();
        f32x4 acc[4][2];
#pragma unroll
        for (int mt = 0; mt < 4; ++mt) { acc[mt][0] = (f32x4){0.f, 0.f, 0.f, 0.f}; acc[mt][1] = acc[mt][0]; }
#pragma unroll
        for (int mt = 0; mt < 4; ++mt)
#pragma unroll
            for (int ks = 0; ks < 4; ++ks) { const bf16x8 af = *(const bf16x8*)(Ub + (16 * mt + fr) * LRU_UB_PITCH + 32 * ks + 8 * fg);
                acc[mt][0] = __builtin_amdgcn_mfma_f32_16x16x32_bf16(af, Bf[0][ks], acc[mt][0], 0, 0, 0);
                acc[mt][1] = __builtin_amdgcn_mfma_f32_16x16x32_bf16(af, Bf[1][ks], acc[mt][1], 0, 0, 0); }
#pragma unroll
        for (int mt = 0; mt < 4; ++mt)
#pragma unroll
            for (int r = 0; r < 4; ++r) { const int tk = 16 * mt + 4 * fg + r, cc = 16 * w + fr;
                const float rr = fsigm(acc[mt][0][r] + bav), ii = fsigm(acc[mt][1][r] + bxv), la = -8.0f * rr * spl;
                const float uu = Uf[tk * LRU_UF_PITCH + cc]; const float av = fexp(la);
                Al[tk * LRU_UF_PITCH + cc] = av; Uf[tk * LRU_UF_PITCH + cc] = __builtin_amdgcn_sqrtf(fmaxf(1.0f - av * av, 0.f)) * (ii * uu); }
        __syncthreads();
        { const int chl = F.tid & 127, seg = F.tid >> 7, ch = n * 128 + chl; float* SP = (float*)(Cw + 640); float* SH = SP + 512;
            unsigned short gq[16];
            if (FINAL) {
#pragma unroll
                for (int t = 0; t < 16; ++t) gq[t] = Z[(size_t)(t0 + 16 * seg + t) * NZ + ZC_LG + ch]; }
            float h = 0.f, P = 1.f;
#pragma unroll
            for (int t = 0; t < 16; ++t) { const float a = Al[(16 * seg + t) * LRU_UF_PITCH + chl], bb = Uf[(16 * seg + t) * LRU_UF_PITCH + chl]; h = a * h + bb; P *= a; }
            SP[seg * 128 + chl] = P; SH[seg * 128 + chl] = h;
            __syncthreads();
            float hin = FINAL ? CAR[(size_t)ci * 1024 + ch] : 0.f;
            if (FINAL) {
                for (int s = 0; s < seg; ++s) hin = SP[s * 128 + chl] * hin + SH[s * 128 + chl];
                h = hin;
#pragma unroll
                for (int t = 0; t < 16; ++t) { const float a = Al[(16 * seg + t) * LRU_UF_PITCH + chl], bb = Uf[(16 * seg + t) * LRU_UF_PITCH + chl]; h = a * h + bb;
                    const float g = bf2f(gq[t]); const float gl = g * fsigm(1.5957691216057308f * (g + 0.044715f * g * g * g));
                    Y[(size_t)(t0 + 16 * seg + t) * 3072 + 1024 + ch] = (bf16_t)f2bf(h * gl); }
            } else if (seg == 0) { float Pt = 1.f, Ht = 0.f;
#pragma unroll
                for (int s = 0; s < 4; ++s) { Ht = SP[s * 128 + chl] * Ht + SH[s * 128 + chl]; Pt *= SP[s * 128 + chl]; }
                *(f32x2*)(PHb + ((size_t)ci * 1024 + ch) * 2) = (f32x2){Pt, Ht}; } }
        __syncthreads();
    }
}
__device__ __forceinline__ void lru_carry(const Frame& F, int part) {
    const float* PHb = (const float*)(KWS() + WS_LPH); float* CAR = (float*)(KWS() + WS_LCARRY);
    const int ch = part * 512 + F.tid; float h = 0.f;
    for (int c0 = 0; c0 < 256; c0 += 32) { f32x2 v[32];
#pragma unroll
        for (int i = 0; i < 32; ++i) v[i] = *(const f32x2*)(PHb + ((size_t)(c0 + i) * 1024 + ch) * 2);
#pragma unroll
        for (int i = 0; i < 32; ++i) { CAR[(size_t)(c0 + i) * 1024 + ch] = h; h = v[i][0] * h + v[i][1]; } }
}


constexpr int RT_PITCH = 136;
__device__ __forceinline__ float ret_log2g(int h) { return log2f(1.0f - exp2f(-5.0f - (float)h)); }
__device__ __forceinline__ void phase_gabw(const Frame& F) {
    float* gabw = (float*)(KWS() + WS_GABW); const float* w_in = KIN(7);
    for (int idx = F.bx * NTHR + F.tid; idx < 2 * 16 * 2048; idx += F.G * NTHR) { const int j = idx & 15, lk = idx >> 4, l = lk >> 11, k = lk & 2047; gabw[(l * 16 + j) * 2048 + k] = w_in[(size_t)lk * INC + 10240 + j]; }
}
__device__ __forceinline__ void phase_rope_table(const Frame& F) {
    float* RC = (float*)(KWS() + WS_ROPE_C); float* RS = (float*)(KWS() + WS_ROPE_S); const int* pos = (const int*)KIN(2);
    for (int idx = F.bx * NTHR + F.tid; idx < S_ * 64; idx += F.G * NTHR) { const int t = idx >> 6, i = idx & 63;
        const float invf = (float)exp2(-(double)i * (13.287712379549449 / 64.0)); const float angf = (float)pos[t] * invf;
        const double rev = (double)angf * 0.15915494309189535; const float fr = (float)(rev - rint(rev));
        RC[idx] = __builtin_amdgcn_cosf(fr); RS[idx] = __builtin_amdgcn_sinf(fr); }
}
template <bool ROPE>
__device__ __forceinline__ void stage_transposed(const Frame& F, const bf16_t* src  , int t0, bf16_t* T, float mul0, float mul1) {
    const int p = F.lane, c = F.wave; const float* RC = (const float*)(KWS() + WS_ROPE_C); const float* RS = (const float*)(KWS() + WS_ROPE_S);
    float a[2][8], b[2][8];
#pragma unroll
    for (int q = 0; q < 2; ++q) { const bf16_t* rp = src + (size_t)(2 * p + q) * NZ; unpack8(*(const u32x4*)(rp + 8 * c), a[q]); unpack8(*(const u32x4*)(rp + 64 + 8 * c), b[q]);
        if (ROPE) { const size_t ro = (size_t)(t0 + 2 * p + q) * 64 + 8 * c; const f32x4 c0 = *(const f32x4*)(RC + ro), c1 = *(const f32x4*)(RC + ro + 4), s0 = *(const f32x4*)(RS + ro), s1 = *(const f32x4*)(RS + ro + 4);
#pragma unroll
            for (int i = 0; i < 8; ++i) { const float cs = i < 4 ? c0[i & 3] : c1[i & 3], sn = i < 4 ? s0[i & 3] : s1[i & 3]; const float x1 = a[q][i], x2 = b[q][i]; a[q][i] = x1 * cs - x2 * sn; b[q][i] = x2 * cs + x1 * sn; } }
        const float m = q ? mul1 : mul0;
#pragma unroll
        for (int i = 0; i < 8; ++i) { a[q][i] *= m; b[q][i] *= m; } }
#pragma unroll
    for (int i = 0; i < 8; ++i) { *(unsigned*)(T + (8 * c + i) * RT_PITCH + 2 * p) = pk2(a[0][i], a[1][i]); *(unsigned*)(T + (64 + 8 * c + i) * RT_PITCH + 2 * p) = pk2(b[0][i], b[1][i]); }
}
__device__ __forceinline__ void stage_natural_rope(const Frame& F, const bf16_t* src, int t0, bf16_t* N, float mul) {
    const float* RC = (const float*)(KWS() + WS_ROPE_C); const float* RS = (const float*)(KWS() + WS_ROPE_S);
#pragma unroll
    for (int rep = 0; rep < 2; ++rep) { const int c = F.tid & 7, tok = (F.tid >> 3) + 64 * rep; const bf16_t* rp = src + (size_t)tok * NZ; float a[8], b[8];
        unpack8(*(const u32x4*)(rp + 8 * c), a); unpack8(*(const u32x4*)(rp + 64 + 8 * c), b);
        const size_t ro = (size_t)(t0 + tok) * 64 + 8 * c; const f32x4 c0 = *(const f32x4*)(RC + ro), c1 = *(const f32x4*)(RC + ro + 4), s0 = *(const f32x4*)(RS + ro), s1 = *(const f32x4*)(RS + ro + 4);
        float y1[8], y2[8];
#pragma unroll
        for (int i = 0; i < 8; ++i) { const float cs = i < 4 ? c0[i & 3] : c1[i & 3], sn = i < 4 ? s0[i & 3] : s1[i & 3]; y1[i] = (a[i] * cs - b[i] * sn) * mul; y2[i] = (b[i] * cs + a[i] * sn) * mul; }
        u32x4 o1, o2; o1.x = pk2(y1[0], y1[1]); o1.y = pk2(y1[2], y1[3]); o1.z = pk2(y1[4], y1[5]); o1.w = pk2(y1[6], y1[7]); o2.x = pk2(y2[0], y2[1]); o2.y = pk2(y2[2], y2[3]); o2.z = pk2(y2[4], y2[5]); o2.w = pk2(y2[6], y2[7]);
        *(u32x4*)(N + tok * RT_PITCH + 8 * c) = o1; *(u32x4*)(N + tok * RT_PITCH + 64 + 8 * c) = o2; }
}

struct RopeCS { f32x4 c0, c1, s0, s1; };
__device__ __forceinline__ void rope_store_natural(bf16_t* N, int tok, int c, const u32x4 xa, const u32x4 xb, const RopeCS& cs, float mul) {
    float a[8], b[8]; unpack8(xa, a); unpack8(xb, b); float y1[8], y2[8];
#pragma unroll
    for (int i = 0; i < 8; ++i) { const float co = i < 4 ? cs.c0[i & 3] : cs.c1[i & 3], sn = i < 4 ? cs.s0[i & 3] : cs.s1[i & 3]; y1[i] = (a[i] * co - b[i] * sn) * mul; y2[i] = (b[i] * co + a[i] * sn) * mul; }
    u32x4 o1, o2; o1.x = pk2(y1[0], y1[1]); o1.y = pk2(y1[2], y1[3]); o1.z = pk2(y1[4], y1[5]); o1.w = pk2(y1[6], y1[7]); o2.x = pk2(y2[0], y2[1]); o2.y = pk2(y2[2], y2[3]); o2.z = pk2(y2[4], y2[5]); o2.w = pk2(y2[6], y2[7]);
    *(u32x4*)(N + tok * RT_PITCH + 8 * c) = o1; *(u32x4*)(N + tok * RT_PITCH + 64 + 8 * c) = o2;
}
template <bool ROPE>
__device__ __forceinline__ void store_transposed(bf16_t* T, int p, int c, const u32x4 (&xa)[2], const u32x4 (&xb)[2], const RopeCS (&cs)[2], float mul0, float mul1) {
    float a[2][8], b[2][8];
#pragma unroll
    for (int q = 0; q < 2; ++q) { unpack8(xa[q], a[q]); unpack8(xb[q], b[q]);
        if (ROPE) {
#pragma unroll
            for (int i = 0; i < 8; ++i) { const float co = i < 4 ? cs[q].c0[i & 3] : cs[q].c1[i & 3], sn = i < 4 ? cs[q].s0[i & 3] : cs[q].s1[i & 3]; const float x1 = a[q][i], x2 = b[q][i]; a[q][i] = x1 * co - x2 * sn; b[q][i] = x2 * co + x1 * sn; } }
        const float m = q ? mul1 : mul0;
#pragma unroll
        for (int i = 0; i < 8; ++i) { a[q][i] *= m; b[q][i] *= m; } }
#pragma unroll
    for (int i = 0; i < 8; ++i) { *(unsigned*)(T + (8 * c + i) * RT_PITCH + 2 * p) = pk2(a[0][i], a[1][i]); *(unsigned*)(T + (64 + 8 * c + i) * RT_PITCH + 2 * p) = pk2(b[0][i], b[1][i]); }
}
__device__ __forceinline__ RopeCS load_cs(int tok_global, int c) { const float* RC = (const float*)(KWS() + WS_ROPE_C); const float* RS = (const float*)(KWS() + WS_ROPE_S); const size_t ro = (size_t)tok_global * 64 + 8 * c;
    RopeCS r; r.c0 = *(const f32x4*)(RC + ro); r.c1 = *(const f32x4*)(RC + ro + 4); r.s0 = *(const f32x4*)(RS + ro); r.s1 = *(const f32x4*)(RS + ro + 4); return r; }
__device__ __forceinline__ void ret_units_a(const Frame& F, int first, int stride) {
    bf16_t* Kt = (bf16_t*)F.ldsg; bf16_t* Vt = Kt + 128 * RT_PITCH;
    const bf16_t* Z = (const bf16_t*)(KWS() + WS_Z); float* KV = (float*)(KWS() + WS_KV);
    const int w = F.wave, lane = F.lane, fr = lane & 15, fg = lane >> 4;
    for (int u = first; u < 1024; u += stride) {
        const int h = u & 7, n = u >> 3, t0 = n * 128; const float l2g = ret_log2g(h);
        const float m0 = 0.08838834764831845f * exp2f((float)(127 - 2 * lane) * l2g), m1 = 0.08838834764831845f * exp2f((float)(126 - 2 * lane) * l2g);
        { const int pp = F.lane, cw = F.wave; const bf16_t* zk = Z + (size_t)t0 * NZ + ZC_RK + h * 128; const bf16_t* zv = Z + (size_t)t0 * NZ + ZC_RV + h * 128;
            u32x4 ka[2], kb[2], va[2], vb[2]; RopeCS cs[2];
#pragma unroll
            for (int q = 0; q < 2; ++q) { const size_t ro = (size_t)(2 * pp + q) * NZ; ka[q] = *(const u32x4*)(zk + ro + 8 * cw); kb[q] = *(const u32x4*)(zk + ro + 64 + 8 * cw); va[q] = *(const u32x4*)(zv + ro + 8 * cw); vb[q] = *(const u32x4*)(zv + ro + 64 + 8 * cw); cs[q] = load_cs(t0 + 2 * pp + q, cw); }
            store_transposed<true>(Kt, pp, cw, ka, kb, cs, m0, m1); store_transposed<false>(Vt, pp, cw, va, vb, cs, 1.0f, 1.0f); }
        __syncthreads();
        f32x4 acc[8];
#pragma unroll
        for (int nt = 0; nt < 8; ++nt) acc[nt] = (f32x4){0.f, 0.f, 0.f, 0.f};
#pragma unroll
        for (int ks = 0; ks < 4; ++ks) { const bf16x8 af = *(const bf16x8*)(Kt + (16 * w + fr) * RT_PITCH + 32 * ks + 8 * fg);
#pragma unroll
            for (int nt = 0; nt < 8; ++nt) { const bf16x8 bfr = *(const bf16x8*)(Vt + (16 * nt + fr) * RT_PITCH + 32 * ks + 8 * fg); acc[nt] = __builtin_amdgcn_mfma_f32_16x16x32_bf16(af, bfr, acc[nt], 0, 0, 0); } }
        float* kvp = KV + ((size_t)(n * 8 + h) * 128) * 128;
#pragma unroll
        for (int nt = 0; nt < 8; ++nt) *(f32x4*)(kvp + (size_t)(16 * nt + fr) * 128 + 16 * w + 4 * fg) = acc[nt];
        __syncthreads();
    }
}
__device__ __forceinline__ void ret_scan(const Frame& F, int wg, int nwg) {
    float* KV = (float*)(KWS() + WS_KV);
    for (int idx = wg * NTHR + F.tid; idx < 8 * 8192; idx += nwg * NTHR) { const int h = idx >> 13, ed = (idx & 8191) * 2; const float cd = exp2f(128.0f * ret_log2g(h)); f32x2 R = (f32x2){0.f, 0.f};
        for (int n0 = 0; n0 < 128; n0 += 16) { f32x2 v[16];
#pragma unroll
            for (int i = 0; i < 16; ++i) v[i] = *(const f32x2*)(KV + ((size_t)((n0 + i) * 8 + h) << 14) + ed);
#pragma unroll
            for (int i = 0; i < 16; ++i) { *(f32x2*)(KV + ((size_t)((n0 + i) * 8 + h) << 14) + ed) = R; R[0] = cd * R[0] + v[i][0]; R[1] = cd * R[1] + v[i][1]; } } }
}
__device__ __forceinline__ void ret_units_c(const Frame& F, int first, int stride) {
    bf16_t* Qs = (bf16_t*)F.ldsg; bf16_t* Ks = Qs + 128 * RT_PITCH; bf16_t* Vt = Ks + 128 * RT_PITCH; bf16_t* Rt = Vt + 128 * RT_PITCH;
    const bf16_t* Z = (const bf16_t*)(KWS() + WS_Z); const float* KV = (const float*)(KWS() + WS_KV); bf16_t* Y = (bf16_t*)(KWS() + WS_Y);
    const int w = F.wave, lane = F.lane, fr = lane & 15, fg = lane >> 4;
    for (int u = first; u < 1024; u += stride) {
        const int h = u & 7, n = u >> 3, t0 = n * 128; const float l2g = ret_log2g(h);
        { const int pp = F.lane, cw = F.wave, cn = F.tid & 7; const bf16_t* zq = Z + (size_t)t0 * NZ + ZC_RQ + h * 128; const bf16_t* zk = Z + (size_t)t0 * NZ + ZC_RK + h * 128; const bf16_t* zv = Z + (size_t)t0 * NZ + ZC_RV + h * 128;
            const float* kvp = KV + ((size_t)(n * 8 + h) << 14);
            u32x4 qa[2], qb[2], ka[2], kb[2], va[2], vb[2]; RopeCS cs[2]; f32x4 rv[8];
#pragma unroll
            for (int rep = 0; rep < 2; ++rep) { const int tok = (F.tid >> 3) + 64 * rep; const size_t ro = (size_t)tok * NZ; qa[rep] = *(const u32x4*)(zq + ro + 8 * cn); qb[rep] = *(const u32x4*)(zq + ro + 64 + 8 * cn);
                ka[rep] = *(const u32x4*)(zk + ro + 8 * cn); kb[rep] = *(const u32x4*)(zk + ro + 64 + 8 * cn); cs[rep] = load_cs(t0 + tok, cn); }
#pragma unroll
            for (int q = 0; q < 2; ++q) { const size_t ro = (size_t)(2 * pp + q) * NZ; va[q] = *(const u32x4*)(zv + ro + 8 * cw); vb[q] = *(const u32x4*)(zv + ro + 64 + 8 * cw); }
#pragma unroll
            for (int i = 0; i < 8; ++i) { const int i4 = F.tid + NTHR * i; rv[i] = *(const f32x4*)(kvp + (i4 >> 5) * 128 + (i4 & 31) * 4); }
#pragma unroll
            for (int rep = 0; rep < 2; ++rep) { const int tok = (F.tid >> 3) + 64 * rep; rope_store_natural(Qs, tok, cn, qa[rep], qb[rep], cs[rep], 1.0f); rope_store_natural(Ks, tok, cn, ka[rep], kb[rep], cs[rep], 0.08838834764831845f); }
            store_transposed<false>(Vt, pp, cw, va, vb, cs, 1.0f, 1.0f);
#pragma unroll
            for (int i = 0; i < 8; ++i) { const int i4 = F.tid + NTHR * i, e = i4 >> 5, d4 = (i4 & 31) * 4; u32x2 o; o.x = pk2(rv[i][0], rv[i][1]); o.y = pk2(rv[i][2], rv[i][3]); *(u32x2*)(Rt + e * RT_PITCH + d4) = o; } }
        __syncthreads();
#pragma unroll 1
        for (int half = 0; half < 2; ++half) {
            const int T = half ? 7 - w : w;
            u32x2 gpre[8]; { const size_t tgp = (size_t)(t0 + 16 * T + fr);
#pragma unroll
                for (int mt = 0; mt < 8; ++mt) gpre[mt] = *(const u32x2*)(Z + tgp * NZ + ZC_RG + h * 128 + 16 * mt + 4 * fg); }
            bf16x8 qf[4];
#pragma unroll
            for (int ks = 0; ks < 4; ++ks) qf[ks] = *(const bf16x8*)(Qs + (16 * T + fr) * RT_PITCH + 32 * ks + 8 * fg);
            f32x4 ao[8], ar[8];
#pragma unroll
            for (int mt = 0; mt < 8; ++mt) { ao[mt] = (f32x4){0.f, 0.f, 0.f, 0.f}; ar[mt] = ao[mt]; }
#pragma unroll
            for (int mt = 0; mt < 8; ++mt)
#pragma unroll
                for (int ks = 0; ks < 4; ++ks) { const bf16x8 af = *(const bf16x8*)(Rt + (16 * mt + fr) * RT_PITCH + 32 * ks + 8 * fg); ar[mt] = __builtin_amdgcn_mfma_f32_16x16x32_bf16(af, qf[ks], ar[mt], 0, 0, 0);
                    if (ks == 3 && (mt & 3) == 3) asm volatile("" ::: "memory"); }
            const int il = 16 * T + fr;
            for (int kp = 0; kp <= (T >> 1); ++kp) {
                u32x2 pt[2];
#pragma unroll
                for (int q = 0; q < 2; ++q) { const int jt = 2 * kp + q; f32x4 s = (f32x4){0.f, 0.f, 0.f, 0.f};
                    if (jt <= T) {
#pragma unroll
                        for (int ks = 0; ks < 4; ++ks) { const bf16x8 kf = *(const bf16x8*)(Ks + (16 * jt + fr) * RT_PITCH + 32 * ks + 8 * fg); s = __builtin_amdgcn_mfma_f32_16x16x32_bf16(kf, qf[ks], s, 0, 0, 0); }
#pragma unroll
                        for (int r = 0; r < 4; ++r) { const int jl = 16 * jt + 4 * fg + r; s[r] = (il >= jl) ? s[r] * __builtin_amdgcn_exp2f((float)(il - jl) * l2g) : 0.f; }
                        asm volatile("" ::: "memory"); }
                    pt[q].x = pk2(s[0], s[1]); pt[q].y = pk2(s[2], s[3]); }
                bf16x8 pf; { u32x4 t4; t4.x = pt[0].x; t4.y = pt[0].y; t4.z = pt[1].x; t4.w = pt[1].y; pf = __builtin_bit_cast(bf16x8, t4); }
#pragma unroll
                for (int mt = 0; mt < 8; ++mt) { const u32x2 v0 = *(const u32x2*)(Vt + (16 * mt + fr) * RT_PITCH + 32 * kp + 4 * fg), v1 = *(const u32x2*)(Vt + (16 * mt + fr) * RT_PITCH + 32 * kp + 16 + 4 * fg);
                    u32x4 t4; t4.x = v0.x; t4.y = v0.y; t4.z = v1.x; t4.w = v1.y; const bf16x8 vf = __builtin_bit_cast(bf16x8, t4);
                    ao[mt] = __builtin_amdgcn_mfma_f32_16x16x32_bf16(vf, pf, ao[mt], 0, 0, 0); if (mt == 7) asm volatile("" ::: "memory"); } }
            const float qd = exp2f((float)(il + 1) * l2g); float ss = 0.f;
#pragma unroll
            for (int mt = 0; mt < 8; ++mt) { ao[mt] = ao[mt] + ar[mt] * qd; ss += (ao[mt][0] * ao[mt][0] + ao[mt][1] * ao[mt][1]) + (ao[mt][2] * ao[mt][2] + ao[mt][3] * ao[mt][3]); }
            ss += __shfl_xor(ss, 16); ss += __shfl_xor(ss, 32);
            const float rstd = 1.0f / sqrtf(ss * (1.0f / 128.0f) + EPS); const size_t tg = (size_t)(t0 + il);
#pragma unroll
            for (int mt = 0; mt < 8; ++mt) { const int e0 = h * 128 + 16 * mt + 4 * fg; const u32x2 gw = gpre[mt];
                u32x2 o; o.x = pk2(ao[mt][0] * rstd * fsilu(bflo(gw.x)), ao[mt][1] * rstd * fsilu(bfhi(gw.x))); o.y = pk2(ao[mt][2] * rstd * fsilu(bflo(gw.y)), ao[mt][3] * rstd * fsilu(bfhi(gw.y)));
                *(u32x2*)(Y + tg * 3072 + e0) = o; }
        }
        __syncthreads();
    }
}


constexpr int GP = 136;
constexpr int GMP = 68;
constexpr int GS_FRAGS = 32, GS_PACK_BYTES = GS_FRAGS * 1024, GO_FRAGS = 24, GO_PACK_BYTES = GO_FRAGS * 1024;
__device__ __forceinline__ bf16x8 mk_frag(u32x2 lo, u32x2 hi) { u32x4 t; t.x = lo.x; t.y = lo.y; t.z = hi.x; t.w = hi.y; return __builtin_bit_cast(bf16x8, t); }
__device__ __forceinline__ bf16x8 pack_acc2(const f32x4 a, const f32x4 b) { u32x4 t; t.x = pk2(a[0], a[1]); t.y = pk2(a[2], a[3]); t.z = pk2(b[0], b[1]); t.w = pk2(b[2], b[3]); return __builtin_bit_cast(bf16x8, t); }
__device__ __forceinline__ u32x4 tile_frag_scaled(const bf16_t* T, int mt, int ks, int fr, int fg, float sc) {
    const u32x2 lo = *(const u32x2*)(T + (16 * mt + fr) * GP + 32 * ks + 4 * fg), hi = *(const u32x2*)(T + (16 * mt + fr) * GP + 32 * ks + 16 + 4 * fg);
    u32x4 o; o.x = pk2(bflo(lo.x) * sc, bfhi(lo.x) * sc); o.y = pk2(bflo(lo.y) * sc, bfhi(lo.y) * sc); o.z = pk2(bflo(hi.x) * sc, bfhi(hi.x) * sc); o.w = pk2(bflo(hi.y) * sc, bfhi(hi.y) * sc); return o;
}
__device__ __forceinline__ void gdn_units_a(const Frame& F, const Params& p, int l) {
    bf16_t* Qn = (bf16_t*)F.ldsg; bf16_t* Kn = Qn + 64 * GP; bf16_t* Vn = Kn + 64 * GP; bf16_t* Wl = Vn + 64 * GP;
    float* Mm = (float*)(Wl + 64 * GP);
    float* gcv = Mm + 64 * GMP; float* bet = gcv + 64; float* beg = bet + 64; float* ekd = beg + 64; float* egc = ekd + 64;
    float* cwl = egc + 64;
    const bf16_t* Z = (const bf16_t*)(KWS() + WS_Z); const float* GAB = (const float*)(KWS() + WS_GAB);
    unsigned char* P2 = KWS() + WS_GP2; float* UP = (float*)(KWS() + WS_GUP); float* GL = (float*)(KWS() + WS_GGL);
    const float* cw = KIN(15) + (size_t)l * 4 * 3072;
    const int w = F.wave, lane = F.lane, fr = lane & 15, fg = lane >> 4;
    int cur_h = -1; float Aexp = 0.f, dtb = 0.f;
    for (int u = F.bx; u < 2048; u += F.G) {
        const int h = u & 7, n = u >> 3, t0 = n * 64;
        if (h != cur_h) { cur_h = h; Aexp = expf(KIN(16)[l * 8 + h]); dtb = KIN(17)[l * 8 + h];
            __syncthreads();
            for (int i = F.tid; i < 1536; i += NTHR) { const int ten = i >> 9, k = (i >> 7) & 3, c = i & 127; cwl[i] = cw[k * 3072 + ten * 1024 + h * 128 + c]; }
            __syncthreads(); }
        { const int tt = F.tid >> 3, cg = F.tid & 7;
#pragma unroll
            for (int ten = 0; ten < 3; ++ten) { float y[16];
#pragma unroll
                for (int i = 0; i < 16; ++i) y[i] = 0.f;
#pragma unroll
                for (int k = 0; k < 4; ++k) { const int t = t0 + tt - 3 + k;
                    if (t >= 0) { const bf16_t* zp = Z + (size_t)t * NZ + ZC_GQ + ten * 1024 + h * 128 + 16 * cg; float x[16]; float x8a[8], x8b[8]; unpack8(*(const u32x4*)zp, x8a); unpack8(*(const u32x4*)(zp + 8), x8b);
#pragma unroll
                        for (int i = 0; i < 8; ++i) { x[i] = x8a[i]; x[8 + i] = x8b[i]; }
#pragma unroll
                        for (int i = 0; i < 16; ++i) y[i] += cwl[(ten * 4 + k) * 128 + 16 * cg + i] * x[i]; } }
                float ss = 0.f;
#pragma unroll
                for (int i = 0; i < 16; ++i) { y[i] = fsilu(y[i]); ss += y[i] * y[i]; }
                float mul = 1.0f;
                if (ten < 2) { ss += __shfl_xor(ss, 1); ss += __shfl_xor(ss, 2); ss += __shfl_xor(ss, 4); mul = (1.0f / sqrtf(ss + EPS)) * (ten == 0 ? 0.08838834764831845f : 1.0f); }
                bf16_t* dst = (ten == 0 ? Qn : (ten == 1 ? Kn : Vn)) + tt * GP + 16 * cg; u32x4 o0, o1;
                o0.x = pk2(y[0] * mul, y[1] * mul); o0.y = pk2(y[2] * mul, y[3] * mul); o0.z = pk2(y[4] * mul, y[5] * mul); o0.w = pk2(y[6] * mul, y[7] * mul);
                o1.x = pk2(y[8] * mul, y[9] * mul); o1.y = pk2(y[10] * mul, y[11] * mul); o1.z = pk2(y[12] * mul, y[13] * mul); o1.w = pk2(y[14] * mul, y[15] * mul);
                *(u32x4*)dst = o0; *(u32x4*)(dst + 8) = o1;
                asm volatile("" ::: "memory"); } }
        if (w == 0) { const size_t gi = (size_t)(t0 + lane) * 16; const float g = -Aexp * softplusf(GAB[gi + h] + dtb); const float beta = sigm(GAB[gi + 8 + h]);
            float gc = g;
#pragma unroll
            for (int o = 1; o < 64; o <<= 1) { const float t = __shfl_up(gc, o); if (lane >= o) gc += t; }
            const float gl = __shfl(gc, 63);
            gcv[lane] = gc; bet[lane] = beta; { const float eg = expf(gc); egc[lane] = eg; beg[lane] = beta * eg; } ekd[lane] = expf(gl - gc);
            if (lane == 0) GL[u] = expf(gl); }
        __syncthreads();
        unsigned char* pk = P2 + (size_t)u * GS_PACK_BYTES; unsigned char* pko = KWS() + WS_GPO + (size_t)u * GO_PACK_BYTES;
        { const int mt = w >> 1;
#pragma unroll
            for (int q = 0; q < 2; ++q) { const int nt = 2 * (w & 1) + q;
                if (nt <= mt) { f32x4 s = (f32x4){0.f, 0.f, 0.f, 0.f};
#pragma unroll
                    for (int ks = 0; ks < 4; ++ks) { const bf16x8 af = *(const bf16x8*)(Kn + (16 * mt + fr) * GP + 32 * ks + 8 * fg), bf_ = *(const bf16x8*)(Kn + (16 * nt + fr) * GP + 32 * ks + 8 * fg); s = __builtin_amdgcn_mfma_f32_16x16x32_bf16(af, bf_, s, 0, 0, 0); }
                    const int j = 16 * nt + fr; const float gj = gcv[j];
#pragma unroll
                    for (int r = 0; r < 4; ++r) { const int i = 16 * mt + 4 * fg + r; Mm[i * GMP + j] = (i > j) ? bet[i] * s[r] * fexp(gcv[i] - gj) : 0.f; } } } }
        { const int it = w >> 1, ksA = w & 1; f32x4 s2[2];
#pragma unroll
            for (int q = 0; q < 2; ++q) { const int jt = 2 * ksA + q; s2[q] = (f32x4){0.f, 0.f, 0.f, 0.f};
                if (jt <= it) {
#pragma unroll
                    for (int ks = 0; ks < 4; ++ks) { const bf16x8 af = *(const bf16x8*)(Kn + (16 * jt + fr) * GP + 32 * ks + 8 * fg), bf_ = *(const bf16x8*)(Qn + (16 * it + fr) * GP + 32 * ks + 8 * fg); s2[q] = __builtin_amdgcn_mfma_f32_16x16x32_bf16(af, bf_, s2[q], 0, 0, 0); }
                    const int i = 16 * it + fr; const float gi = gcv[i];
#pragma unroll
                    for (int r = 0; r < 4; ++r) { const int j = 16 * jt + 4 * fg + r; s2[q][r] = (i >= j) ? s2[q][r] * fexp(gi - gcv[j]) : 0.f; } } }
            *(bf16x8*)(pko + (size_t)(16 + it * 2 + ksA) * 1024 + lane * 16) = pack_acc2(s2[0], s2[1]); }
        __syncthreads();
        if (w < 4) { const int c = F.tid; float sol[64];
#pragma unroll
            for (int i = 0; i < 64; ++i) sol[i] = 0.f;
            LAS const bf16_t* colp = (LAS const bf16_t*)(F.lds) + ((c < 128) ? (2 * 64 * GP + c) : (64 * GP + (c - 128))); asm volatile("" : "+v"(colp));
            LAS const float* mm = (LAS const float*)(F.lds + 4 * 64 * GP * 2); asm volatile("" : "+v"(mm));
            LAS const float* tb = mm + 64 * GMP + ((c < 128) ? 64 : 128); asm volatile("" : "+v"(tb));
#pragma unroll
            for (int i = 0; i < 64; ++i) { float a = bf2f(colp[i * GP]) * tb[i];
#pragma unroll
                for (int jb = 0; jb < (i + 3) / 4; ++jb) { const f32x4 m4 = *(LAS const f32x4*)(mm + i * GMP + 4 * jb);
                    a -= m4[0] * sol[4 * jb]; a -= m4[1] * sol[4 * jb + 1]; a -= m4[2] * sol[4 * jb + 2]; a -= m4[3] * sol[4 * jb + 3];
                    if ((jb & 3) == 3) asm volatile("" ::: "memory"); }
                sol[i] = a; asm volatile("" ::: "memory"); }
            if (c < 128) { float* up = UP + (size_t)u * 8192 + (size_t)(c >> 4) * 1024;
#pragma unroll
                for (int t = 0; t < 4; ++t)
#pragma unroll
                    for (int G = 0; G < 4; ++G) *(f32x4*)(up + (t * 64 + (c & 15) + 16 * G) * 4) = (f32x4){sol[16 * t + 4 * G], sol[16 * t + 4 * G + 1], sol[16 * t + 4 * G + 2], sol[16 * t + 4 * G + 3]}; }
            else { const int d = c - 128;
#pragma unroll
                for (int i = 0; i < 64; ++i) Wl[i * GP + d] = (bf16_t)f2bf(-sol[i]); }
        } else { const int w4 = w - 4;
#pragma unroll
            for (int q = 0; q < 4; ++q) { const int f = w4 * 4 + q, mt = f >> 2, ks = f & 3;
                *(u32x4*)(pko + (size_t)f * 1024 + lane * 16) = tile_frag_scaled(Qn, mt, ks, fr, fg, egc[16 * mt + fr]); }
#pragma unroll
            for (int q = 0; q < 4; ++q) { const int f = w4 * 4 + q, mt = f >> 1, ks = f & 1;
                float v[8];
#pragma unroll
                for (int jj = 0; jj < 8; ++jj) { const int tk = 32 * ks + 16 * (jj >> 2) + 4 * fg + (jj & 3); v[jj] = bf2f(Kn[tk * GP + 16 * mt + fr]) * ekd[tk]; }
                u32x4 o; o.x = pk2(v[0], v[1]); o.y = pk2(v[2], v[3]); o.z = pk2(v[4], v[5]); o.w = pk2(v[6], v[7]);
                *(u32x4*)(pk + (size_t)(16 + f) * 1024 + lane * 16) = o; } }
        __syncthreads();
#pragma unroll
        for (int q = 0; q < 2; ++q) { const int f = w * 2 + q, mt = f >> 2, ks = f & 3; *(u32x4*)(pk + (size_t)f * 1024 + lane * 16) = tile_frag_scaled(Wl, mt, ks, fr, fg, 1.0f); }
        __syncthreads();
    }
}

constexpr int GA_SET = 3 * 64 * GP * 2 + 5 * 64 * 4, GA_WL = 2 * GA_SET, GA_MM = GA_WL + 64 * GP * 2, GA_CW = GA_MM + 64 * GMP * 4, GA_END = GA_CW + 1536 * 4;
static_assert(GA_END <= LDS_MISC, "gdn prep LDS map");
__device__ __forceinline__ void gdn_stage_unit(const Frame& F, const Params& p, int l, int u, int h, float Aexp, float dtb, unsigned char* setb, const float* cwl) {
    bf16_t* Qn = (bf16_t*)setb; bf16_t* Kn = Qn + 64 * GP; bf16_t* Vn = Kn + 64 * GP; float* gcv = (float*)(Vn + 64 * GP); float* bet = gcv + 64; float* beg = bet + 64; float* ekd = beg + 64; float* egc = ekd + 64;
    const bf16_t* Z = (const bf16_t*)(KWS() + WS_Z); const float* GAB = (const float*)(KWS() + WS_GAB); float* GL = (float*)(KWS() + WS_GGL);
    const int n = u >> 3, t0 = n * 64, lane = F.lane;
    float ga_pre = 0.f, gb_pre = 0.f; if (F.wave == 4) { const size_t gi = (size_t)(t0 + lane) * 16; ga_pre = GAB[gi + h]; gb_pre = GAB[gi + 8 + h]; }
#pragma unroll 1
    for (int rep = 0; rep < 2; ++rep) { const int it = (F.tid - 256) + 256 * rep, tt = it >> 3, cg = it & 7;
        u32x4 raw[3][4][2];
#pragma unroll
        for (int ten = 0; ten < 3; ++ten)
#pragma unroll
            for (int k = 0; k < 4; ++k) { const int t = t0 + tt - 3 + k;
                if (t >= 0) { const bf16_t* zp = Z + (size_t)t * NZ + ZC_GQ + ten * 1024 + h * 128 + 16 * cg; raw[ten][k][0] = *(const u32x4*)zp; raw[ten][k][1] = *(const u32x4*)(zp + 8); }
                else { raw[ten][k][0] = (u32x4){0u, 0u, 0u, 0u}; raw[ten][k][1] = raw[ten][k][0]; } }
#pragma unroll
        for (int ten = 0; ten < 3; ++ten) { float y[16];
#pragma unroll
            for (int i = 0; i < 16; ++i) y[i] = 0.f;
#pragma unroll
            for (int k = 0; k < 4; ++k) { float x8a[8], x8b[8]; unpack8(raw[ten][k][0], x8a); unpack8(raw[ten][k][1], x8b);
#pragma unroll
                for (int i = 0; i < 8; ++i) { y[i] += cwl[(ten * 4 + k) * 128 + 16 * cg + i] * x8a[i]; y[8 + i] += cwl[(ten * 4 + k) * 128 + 16 * cg + 8 + i] * x8b[i]; } }
            float ss = 0.f;
#pragma unroll
            for (int i = 0; i < 16; ++i) { y[i] = fsilu(y[i]); ss += y[i] * y[i]; }
            float mul = 1.0f;
            if (ten < 2) { ss += __shfl_xor(ss, 1); ss += __shfl_xor(ss, 2); ss += __shfl_xor(ss, 4); mul = (1.0f / sqrtf(ss + EPS)) * (ten == 0 ? 0.08838834764831845f : 1.0f); }
            bf16_t* dst = (ten == 0 ? Qn : (ten == 1 ? Kn : Vn)) + tt * GP + 16 * cg; u32x4 o0, o1;
            o0.x = pk2(y[0] * mul, y[1] * mul); o0.y = pk2(y[2] * mul, y[3] * mul); o0.z = pk2(y[4] * mul, y[5] * mul); o0.w = pk2(y[6] * mul, y[7] * mul);
            o1.x = pk2(y[8] * mul, y[9] * mul); o1.y = pk2(y[10] * mul, y[11] * mul); o1.z = pk2(y[12] * mul, y[13] * mul); o1.w = pk2(y[14] * mul, y[15] * mul);
            *(u32x4*)dst = o0; *(u32x4*)(dst + 8) = o1; }
        asm volatile("" ::: "memory"); }
    if (F.wave == 4) { const float g = -Aexp * softplusf(ga_pre + dtb); const float beta = sigm(gb_pre);
        float gc = g;
#pragma unroll
        for (int o = 1; o < 64; o <<= 1) { const float t = __shfl_up(gc, o); if (lane >= o) gc += t; }
        const float gl = __shfl(gc, 63);
        gcv[lane] = gc; bet[lane] = beta; { const float eg = expf(gc); egc[lane] = eg; beg[lane] = beta * eg; } ekd[lane] = expf(gl - gc);
        if (lane == 0) GL[u] = expf(gl); }
}
__device__ __forceinline__ void gdn_units_a_pipe(const Frame& F, const Params& p, int l) {
    unsigned char* L = F.ldsg; bf16_t* Wl = (bf16_t*)(L + GA_WL); float* Mm = (float*)(L + GA_MM); float* cwl = (float*)(L + GA_CW);
    unsigned char* P2 = KWS() + WS_GP2; float* UP = (float*)(KWS() + WS_GUP);
    const float* cw = KIN(15) + (size_t)l * 4 * 3072;
    const int w = F.wave, lane = F.lane, fr = lane & 15, fg = lane >> 4, h = F.bx & 7;
    const float Aexp = expf(KIN(16)[l * 8 + h]), dtb = KIN(17)[l * 8 + h];
    for (int i = F.tid; i < 1536; i += NTHR) { const int ten = i >> 9, k = (i >> 7) & 3, c = i & 127; cwl[i] = cw[k * 3072 + ten * 1024 + h * 128 + c]; }
    __syncthreads();
    if (w >= 4 && F.bx < 2048) gdn_stage_unit(F, p, l, F.bx, h, Aexp, dtb, L, cwl);
    __syncthreads();
    int prev_u = -1, it = 0;
    for (int u = F.bx; u < 2048; u += F.G, ++it) {
        unsigned char* setb = L + (it & 1) * GA_SET; unsigned char* setn = L + ((it + 1) & 1) * GA_SET;
        const bf16_t* Qn = (const bf16_t*)setb; const bf16_t* Kn = Qn + 64 * GP; const float* gcv = (const float*)(Kn + 2 * 64 * GP); const float* bet = gcv + 64; const float* ekd = gcv + 192; const float* egc = gcv + 256;
        unsigned char* pk = P2 + (size_t)u * GS_PACK_BYTES; unsigned char* pko = KWS() + WS_GPO + (size_t)u * GO_PACK_BYTES;
        if (prev_u >= 0) { unsigned char* pkp = P2 + (size_t)prev_u * GS_PACK_BYTES;
#pragma unroll
            for (int q = 0; q < 2; ++q) { const int f = w * 2 + q, mt = f >> 2, ks = f & 3; *(u32x4*)(pkp + (size_t)f * 1024 + lane * 16) = tile_frag_scaled(Wl, mt, ks, fr, fg, 1.0f); } }
        { const int mt = w >> 1;
#pragma unroll
            for (int q = 0; q < 2; ++q) { const int nt = 2 * (w & 1) + q;
                if (nt <= mt) { f32x4 s = (f32x4){0.f, 0.f, 0.f, 0.f};
#pragma unroll
                    for (int ks = 0; ks < 4; ++ks) { const bf16x8 af = *(const bf16x8*)(Kn + (16 * mt + fr) * GP + 32 * ks + 8 * fg), bf_ = *(const bf16x8*)(Kn + (16 * nt + fr) * GP + 32 * ks + 8 * fg); s = __builtin_amdgcn_mfma_f32_16x16x32_bf16(af, bf_, s, 0, 0, 0); }
                    const int j = 16 * nt + fr; const float gj = gcv[j];
#pragma unroll
                    for (int r = 0; r < 4; ++r) { const int i = 16 * mt + 4 * fg + r; Mm[i * GMP + j] = (i > j) ? bet[i] * s[r] * fexp(gcv[i] - gj) : 0.f; } } } }
        { const int itl = w >> 1, ksA = w & 1; f32x4 s2[2];
#pragma unroll
            for (int q = 0; q < 2; ++q) { const int jt = 2 * ksA + q; s2[q] = (f32x4){0.f, 0.f, 0.f, 0.f};
                if (jt <= itl) {
#pragma unroll
                    for (int ks = 0; ks < 4; ++ks) { const bf16x8 af = *(const bf16x8*)(Kn + (16 * jt + fr) * GP + 32 * ks + 8 * fg), bf_ = *(const bf16x8*)(Qn + (16 * itl + fr) * GP + 32 * ks + 8 * fg); s2[q] = __builtin_amdgcn_mfma_f32_16x16x32_bf16(af, bf_, s2[q], 0, 0, 0); }
                    const int i = 16 * itl + fr; const float gi = gcv[i];
#pragma unroll
                    for (int r = 0; r < 4; ++r) { const int j = 16 * jt + 4 * fg + r; s2[q][r] = (i >= j) ? s2[q][r] * fexp(gi - gcv[j]) : 0.f; } } }
            *(bf16x8*)(pko + (size_t)(16 + itl * 2 + ksA) * 1024 + lane * 16) = pack_acc2(s2[0], s2[1]); }
#pragma unroll
        for (int q = 0; q < 2; ++q) { const int f = w * 2 + q, mt = f >> 2, ks = f & 3;
            *(u32x4*)(pko + (size_t)f * 1024 + lane * 16) = tile_frag_scaled(Qn, mt, ks, fr, fg, egc[16 * mt + fr]); }
#pragma unroll
        for (int q = 0; q < 2; ++q) { const int f = w * 2 + q, mt = f >> 1, ks = f & 1; float v[8];
#pragma unroll
            for (int jj = 0; jj < 8; ++jj) { const int tk = 32 * ks + 16 * (jj >> 2) + 4 * fg + (jj & 3); v[jj] = bf2f(Kn[tk * GP + 16 * mt + fr]) * ekd[tk]; }
            u32x4 o; o.x = pk2(v[0], v[1]); o.y = pk2(v[2], v[3]); o.z = pk2(v[4], v[5]); o.w = pk2(v[6], v[7]);
            *(u32x4*)(pk + (size_t)(16 + f) * 1024 + lane * 16) = o; }
        __syncthreads();
        if (w < 4) { const int c = F.tid; float sol[64];
#pragma unroll
            for (int i = 0; i < 64; ++i) sol[i] = 0.f;
            LAS const bf16_t* colp = (LAS const bf16_t*)(F.lds + (it & 1) * GA_SET) + ((c < 128) ? (2 * 64 * GP + c) : (64 * GP + (c - 128))); asm volatile("" : "+v"(colp));
            LAS const float* mm = (LAS const float*)(F.lds + GA_MM); asm volatile("" : "+v"(mm));
            LAS const float* tb = (LAS const float*)(F.lds + (it & 1) * GA_SET + 3 * 64 * GP * 2) + ((c < 128) ? 64 : 128); asm volatile("" : "+v"(tb));
#pragma unroll
            for (int i = 0; i < 64; ++i) { float a = bf2f(colp[i * GP]) * tb[i];
#pragma unroll
                for (int jb = 0; jb < (i + 3) / 4; ++jb) { const f32x4 m4 = *(LAS const f32x4*)(mm + i * GMP + 4 * jb);
                    a -= m4[0] * sol[4 * jb]; a -= m4[1] * sol[4 * jb + 1]; a -= m4[2] * sol[4 * jb + 2]; a -= m4[3] * sol[4 * jb + 3];
                    if ((jb & 3) == 3) asm volatile("" ::: "memory"); }
                sol[i] = a; asm volatile("" ::: "memory"); }
            if (c < 128) { float* up = UP + (size_t)u * 8192 + (size_t)(c >> 4) * 1024;
#pragma unroll
                for (int t = 0; t < 4; ++t)
#pragma unroll
                    for (int G = 0; G < 4; ++G) *(f32x4*)(up + (t * 64 + (c & 15) + 16 * G) * 4) = (f32x4){sol[16 * t + 4 * G], sol[16 * t + 4 * G + 1], sol[16 * t + 4 * G + 2], sol[16 * t + 4 * G + 3]}; }
            else { const int d = c - 128;
#pragma unroll
                for (int i = 0; i < 64; ++i) Wl[i * GP + d] = (bf16_t)f2bf(-sol[i]); }
        } else if (u + F.G < 2048) gdn_stage_unit(F, p, l, u + F.G, h, Aexp, dtb, setn, cwl);
        __syncthreads();
        prev_u = u;
    }
    if (prev_u >= 0) { unsigned char* pkp = P2 + (size_t)prev_u * GS_PACK_BYTES;
#pragma unroll
        for (int q = 0; q < 2; ++q) { const int f = w * 2 + q, mt = f >> 2, ks = f & 3; *(u32x4*)(pkp + (size_t)f * 1024 + lane * 16) = tile_frag_scaled(Wl, mt, ks, fr, fg, 1.0f); } }
    __syncthreads();
}

__device__ __forceinline__ void gdn_scan(const Frame& F, int b) {
    const int h = b >> 1, w = F.wave, lane = F.lane; const int slice = (b & 1) * 4 + (w & 3); const bool comp = w < 4;
    const unsigned char* P2 = KWS() + WS_GP2; const float* UP = (const float*)(KWS() + WS_GUP); const float* GL = (const float*)(KWS() + WS_GGL); unsigned char* SV = KWS() + WS_GSV;
    f32x4 S[8];
#pragma unroll
    for (int i = 0; i < 8; ++i) S[i] = (f32x4){0.f, 0.f, 0.f, 0.f};
    if (!comp) {
#pragma unroll
        for (int c = 0; c < 3; ++c) { const unsigned char* src = P2 + (size_t)(c * 8 + h) * GS_PACK_BYTES;
#pragma unroll
            for (int i = 0; i < 8; ++i) { const int f = (w - 4) + 4 * i; __builtin_amdgcn_global_load_lds((const unsigned*)(src + f * 1024 + lane * 16), (LAS unsigned*)(F.lds + c * GS_PACK_BYTES + f * 1024), 16, 0, 0); } }
        asm volatile("s_waitcnt vmcnt(16)" ::: "memory"); }
    f32x4 ua[4], ub[4]; float gla = 0.f, glb = 0.f;
#pragma unroll
    for (int t = 0; t < 4; ++t) { ua[t] = (f32x4){0.f, 0.f, 0.f, 0.f}; ub[t] = ua[t]; }
    if (comp) {
#pragma unroll
        for (int t = 0; t < 4; ++t) { ua[t] = *(const f32x4*)(UP + (size_t)h * 8192 + slice * 1024 + (t * 64 + lane) * 4); ub[t] = *(const f32x4*)(UP + (size_t)(8 + h) * 8192 + slice * 1024 + (t * 64 + lane) * 4); }
        gla = GL[h]; glb = GL[8 + h]; }
    __syncthreads();
    for (int n = 0; n < 256; ++n) {
        const int unit = n * 8 + h; const LAS unsigned char* buf = F.lds + (n & 3) * GS_PACK_BYTES;
        if (!comp) {
            if (n + 3 < 256) { const unsigned char* src = P2 + (size_t)(unit + 24) * GS_PACK_BYTES; LAS unsigned char* dstb = F.lds + ((n + 3) & 3) * GS_PACK_BYTES;
#pragma unroll
                for (int i = 0; i < 8; ++i) { const int f = (w - 4) + 4 * i; __builtin_amdgcn_global_load_lds((const unsigned*)(src + f * 1024 + lane * 16), (LAS unsigned*)(dstb + f * 1024), 16, 0, 0); }
                asm volatile("s_waitcnt vmcnt(16)" ::: "memory"); }
            else asm volatile("s_waitcnt vmcnt(0)" ::: "memory");
        } else {
            f32x4 vn[4];
#pragma unroll
            for (int t = 0; t < 4; ++t) { vn[t] = ua[t]; ua[t] = ub[t]; }
            const float gl = gla; gla = glb;
            if (n + 2 < 256) {
#pragma unroll
                for (int t = 0; t < 4; ++t) ub[t] = *(const f32x4*)(UP + (size_t)(unit + 16) * 8192 + slice * 1024 + (t * 64 + lane) * 4);
                glb = GL[unit + 16]; }
            bf16x8* svp = (bf16x8*)(SV + ((size_t)(unit * 8 + slice) * 6) * 1024 + lane * 16);
            bf16x8 Sb[4];
#pragma unroll
            for (int ks = 0; ks < 4; ++ks) { Sb[ks] = pack_acc2(S[2 * ks], S[2 * ks + 1]); svp[ks * 64] = Sb[ks]; }
#pragma unroll
            for (int t = 0; t < 4; ++t)
#pragma unroll
                for (int ks = 0; ks < 4; ++ks) vn[t] = __builtin_amdgcn_mfma_f32_16x16x32_bf16(*(const LAS bf16x8*)(buf + (t * 4 + ks) * 1024 + lane * 16), Sb[ks], vn[t], 0, 0, 0);
            bf16x8 vb[2];
#pragma unroll
            for (int ks = 0; ks < 2; ++ks) { vb[ks] = pack_acc2(vn[2 * ks], vn[2 * ks + 1]); svp[(4 + ks) * 64] = vb[ks]; }
#pragma unroll
            for (int dt = 0; dt < 8; ++dt) { S[dt] = S[dt] * gl;
#pragma unroll
                for (int ks = 0; ks < 2; ++ks) S[dt] = __builtin_amdgcn_mfma_f32_16x16x32_bf16(*(const LAS bf16x8*)(buf + (16 + dt * 2 + ks) * 1024 + lane * 16), vb[ks], S[dt], 0, 0, 0); }
        }
        __syncthreads();
    }
}
constexpr int GO_PITCH = 132;
__device__ __forceinline__ void gdn_output(const Frame& F, const Params& p, int l) {
    float* Ot = (float*)F.ldsg;
    const unsigned char* PO = KWS() + WS_GPO; const unsigned char* SV = KWS() + WS_GSV; const bf16_t* Z = (const bf16_t*)(KWS() + WS_Z); bf16_t* Y = (bf16_t*)(KWS() + WS_Y); const float* ng = KIN(18) + l * 128;
    const int w = F.wave, lane = F.lane, fr = lane & 15, fg = lane >> 4;
    const int tt = F.tid >> 3, cg = F.tid & 7; float gn[16];
#pragma unroll
    for (int i = 0; i < 16; ++i) gn[i] = ng[16 * cg + i];
    for (int u = F.bx; u < 2048; u += F.G) {
        const int h = u & 7, n = u >> 3;
        const bf16x8* svp = (const bf16x8*)(SV + ((size_t)(u * 8 + w) * 6) * 1024 + lane * 16); const bf16x8* pop = (const bf16x8*)(PO + (size_t)u * GO_PACK_BYTES + lane * 16);
        const u32x4 gzp0 = *(const u32x4*)(Z + (size_t)(n * 64 + tt) * NZ + ZC_GZ + h * 128 + 16 * cg), gzp1 = *(const u32x4*)(Z + (size_t)(n * 64 + tt) * NZ + ZC_GZ + h * 128 + 16 * cg + 8);
        bf16x8 Sb[4], vb[2];
#pragma unroll
        for (int ks = 0; ks < 4; ++ks) Sb[ks] = svp[ks * 64];
#pragma unroll
        for (int ks = 0; ks < 2; ++ks) vb[ks] = svp[(4 + ks) * 64];
#pragma unroll
        for (int t = 0; t < 4; ++t) { f32x4 o = (f32x4){0.f, 0.f, 0.f, 0.f};
#pragma unroll
            for (int ks = 0; ks < 4; ++ks) o = __builtin_amdgcn_mfma_f32_16x16x32_bf16(pop[(t * 4 + ks) * 64], Sb[ks], o, 0, 0, 0);
#pragma unroll
            for (int ks = 0; ks < 2; ++ks) o = __builtin_amdgcn_mfma_f32_16x16x32_bf16(pop[(16 + t * 2 + ks) * 64], vb[ks], o, 0, 0, 0);
#pragma unroll
            for (int r = 0; r < 4; ++r) Ot[(16 * t + 4 * fg + r) * GO_PITCH + 16 * w + fr] = o[r]; }
        __syncthreads();
        { const size_t tg = (size_t)(n * 64 + tt); float o[16], g[8], g2[8]; float ss = 0.f;
#pragma unroll
            for (int i = 0; i < 4; ++i) { const f32x4 v = *(const f32x4*)(Ot + tt * GO_PITCH + 16 * cg + 4 * i); o[4 * i] = v[0]; o[4 * i + 1] = v[1]; o[4 * i + 2] = v[2]; o[4 * i + 3] = v[3]; }
#pragma unroll
            for (int i = 0; i < 16; ++i) ss += o[i] * o[i];
            ss += __shfl_xor(ss, 1); ss += __shfl_xor(ss, 2); ss += __shfl_xor(ss, 4);
            const float rstd = 1.0f / sqrtf(ss * (1.0f / 128.0f) + EPS);
            unpack8(gzp0, g); unpack8(gzp1, g2);
            float y[16];
#pragma unroll
            for (int i = 0; i < 8; ++i) { y[i] = o[i] * rstd * gn[i] * fsilu(g[i]); y[8 + i] = o[8 + i] * rstd * gn[8 + i] * fsilu(g2[i]); }
            u32x4 o0, o1; o0.x = pk2(y[0], y[1]); o0.y = pk2(y[2], y[3]); o0.z = pk2(y[4], y[5]); o0.w = pk2(y[6], y[7]); o1.x = pk2(y[8], y[9]); o1.y = pk2(y[10], y[11]); o1.z = pk2(y[12], y[13]); o1.w = pk2(y[14], y[15]);
            bf16_t* yp = Y + tg * 3072 + 2048 + h * 128 + 16 * cg; *(u32x4*)yp = o0; *(u32x4*)(yp + 8) = o1; }
        __syncthreads();
    }
}

__device__ __forceinline__ void seq_retention(const Frame& F, const Params& p, int h) {
    float* sq = (float*)F.ldsg; float* sk = sq + 128; float* red = sk + 128;
    const bf16_t* Z = (const bf16_t*)(KWS() + WS_Z); bf16_t* Y = (bf16_t*)(KWS() + WS_Y); const int* pos = (const int*)KIN(2);
    const int c = F.tid & 127; const bool act = F.tid < 128, rot = F.tid < 64;
    float R[128];
#pragma unroll
    for (int d = 0; d < 128; ++d) R[d] = 0.f;
    const float gamma = 1.0f - exp2f(-5.0f - (float)h);
    const float invf = (float)exp2(-(double)(F.tid & 63) * (13.287712379549449 / 64.0));
    unsigned short nq1 = 0, nq2 = 0, nk1 = 0, nk2 = 0, nv = 0, ng = 0; int npos = 0;
    if (rot) { nq1 = Z[ZC_RQ + h * 128 + F.tid]; nq2 = Z[ZC_RQ + h * 128 + 64 + F.tid]; nk1 = Z[ZC_RK + h * 128 + F.tid]; nk2 = Z[ZC_RK + h * 128 + 64 + F.tid]; npos = pos[0]; }
    if (act) { nv = Z[ZC_RV + h * 128 + c]; ng = Z[ZC_RG + h * 128 + c]; }
    for (int t = 0; t < S_; ++t) {
        const unsigned short q1 = nq1, q2 = nq2, k1 = nk1, k2 = nk2, vv = nv, gg = ng; const int ps = npos;
        if (t + 1 < S_) { const size_t zo = (size_t)(t + 1) * NZ;
            if (rot) { nq1 = Z[zo + ZC_RQ + h * 128 + F.tid]; nq2 = Z[zo + ZC_RQ + h * 128 + 64 + F.tid]; nk1 = Z[zo + ZC_RK + h * 128 + F.tid]; nk2 = Z[zo + ZC_RK + h * 128 + 64 + F.tid]; npos = pos[t + 1]; }
            if (act) { nv = Z[zo + ZC_RV + h * 128 + c]; ng = Z[zo + ZC_RG + h * 128 + c]; } }
        if (rot) { const float angf = (float)ps * invf; const double ad = (double)angf; const double nn = rint(ad * 0.15915494309189535); const float rr = (float)(ad - nn * 6.283185307179586);
            const float cs = cosf(rr), sn = sinf(rr); const float a1 = bf2f(q1), a2 = bf2f(q2), b1 = bf2f(k1), b2 = bf2f(k2);
            sq[F.tid] = a1 * cs - a2 * sn; sq[F.tid + 64] = a2 * cs + a1 * sn;
            sk[F.tid] = (b1 * cs - b2 * sn) * 0.08838834764831845f; sk[F.tid + 64] = (b2 * cs + b1 * sn) * 0.08838834764831845f; }
        __syncthreads();
        float o = 0.f;
        if (act) { const float v = bf2f(vv);
#pragma unroll
            for (int d0 = 0; d0 < 128; d0 += 16) {
#pragma unroll
                for (int d = d0; d < d0 + 16; ++d) { R[d] = gamma * R[d] + sk[d] * v; o += sq[d] * R[d]; }
                asm volatile("" ::: "memory"); }
            const float ss = wave_sum(o * o); if (F.lane == 0) red[F.wave] = ss; }
        __syncthreads();
        if (act) { const float ms = (red[0] + red[1]) * (1.0f / 128.0f); const float y = o * (1.0f / sqrtf(ms + EPS)) * siluf(bf2f(gg)); Y[(size_t)t * 3072 + h * 128 + c] = (bf16_t)f2bf(y); }
    }
}
__device__ __forceinline__ void seq_gdn(const Frame& F, const Params& p, int l, int h) {
    float* sq = (float*)F.ldsg; float* sk = sq + 128; float* red = sk + 128; float* red2 = red + 8;
    const bf16_t* Z = (const bf16_t*)(KWS() + WS_Z); bf16_t* Y = (bf16_t*)(KWS() + WS_Y); const float* GAB = (const float*)(KWS() + WS_GAB);
    const int c = F.tid & 127; const bool act = F.tid < 128;
    float St[128];
#pragma unroll
    for (int d = 0; d < 128; ++d) St[d] = 0.f;
    const float* cw = KIN(15) + (size_t)l * 4 * 3072;
    float wq[4], wk[4], wv[4];
#pragma unroll
    for (int k = 0; k < 4; ++k) { wq[k] = cw[k * 3072 + h * 128 + c]; wk[k] = cw[k * 3072 + 1024 + h * 128 + c]; wv[k] = cw[k * 3072 + 2048 + h * 128 + c]; }
    const float Aexp = expf(KIN(16)[l * 8 + h]), dtb = KIN(17)[l * 8 + h], ngain = KIN(18)[l * 128 + c];
    float xq1 = 0, xq2 = 0, xq3 = 0, xk1 = 0, xk2 = 0, xk3 = 0, xv1 = 0, xv2 = 0, xv3 = 0;
    unsigned short nq = 0, nk = 0, nv = 0, nz = 0; float nga = 0.f, ngb = 0.f;
    if (act) { nq = Z[ZC_GQ + h * 128 + c]; nk = Z[ZC_GK + h * 128 + c]; nv = Z[ZC_GV + h * 128 + c]; nz = Z[ZC_GZ + h * 128 + c]; nga = GAB[h]; ngb = GAB[8 + h]; }
    for (int t = 0; t < S_; ++t) {
        const float rq = bf2f(nq), rk = bf2f(nk), rv = bf2f(nv), gz = bf2f(nz), ga = nga, gb = ngb;
        if (act && t + 1 < S_) { const size_t zo = (size_t)(t + 1) * NZ; nq = Z[zo + ZC_GQ + h * 128 + c]; nk = Z[zo + ZC_GK + h * 128 + c]; nv = Z[zo + ZC_GV + h * 128 + c]; nz = Z[zo + ZC_GZ + h * 128 + c];
            nga = GAB[(size_t)(t + 1) * 16 + h]; ngb = GAB[(size_t)(t + 1) * 16 + 8 + h]; }
        float q = 0.f, k = 0.f, v = 0.f;
        if (act) { const float cq = wq[0] * xq3 + wq[1] * xq2 + wq[2] * xq1 + wq[3] * rq, ck = wk[0] * xk3 + wk[1] * xk2 + wk[2] * xk1 + wk[3] * rk, cv = wv[0] * xv3 + wv[1] * xv2 + wv[2] * xv1 + wv[3] * rv;
            xq3 = xq2; xq2 = xq1; xq1 = rq; xk3 = xk2; xk2 = xk1; xk1 = rk; xv3 = xv2; xv2 = xv1; xv1 = rv;
            q = siluf(cq); k = siluf(ck); v = siluf(cv);
            const float s1 = wave_sum(q * q), s2 = wave_sum(k * k); if (F.lane == 0) { red[F.wave] = s1; red[2 + F.wave] = s2; } }
        __syncthreads();
        if (act) { sq[c] = q * (1.0f / sqrtf(red[0] + red[1] + EPS)) * 0.08838834764831845f; sk[c] = k * (1.0f / sqrtf(red[2] + red[3] + EPS)); }
        __syncthreads();
        float o = 0.f;
        if (act) { const float g = -Aexp * softplusf(ga + dtb), e = expf(g), beta = sigm(gb);
            float dot = 0.f;
#pragma unroll
            for (int d0 = 0; d0 < 128; d0 += 16) {
#pragma unroll
                for (int d = d0; d < d0 + 16; ++d) dot += sk[d] * St[d];
                asm volatile("" ::: "memory"); }
            const float coef = beta * (v - e * dot);
#pragma unroll
            for (int d0 = 0; d0 < 128; d0 += 16) {
#pragma unroll
                for (int d = d0; d < d0 + 16; ++d) { St[d] = e * St[d] + sk[d] * coef; o += sq[d] * St[d]; }
                asm volatile("" ::: "memory"); }
            const float ss = wave_sum(o * o); if (F.lane == 0) red2[F.wave] = ss; }
        __syncthreads();
        if (act) { const float ms = (red2[0] + red2[1]) * (1.0f / 128.0f); const float y = o * (1.0f / sqrtf(ms + EPS)) * ngain * siluf(gz); Y[(size_t)t * 3072 + 2048 + h * 128 + c] = (bf16_t)f2bf(y); }
    }
}
__device__ __forceinline__ void seq_lru(const Frame& F, const Params& p, int part) {
    const bf16_t* Z = (const bf16_t*)(KWS() + WS_Z); bf16_t* Y = (bf16_t*)(KWS() + WS_Y); const float* LA = (const float*)(KWS() + WS_MF); const float* LB = LA + (size_t)S_ * 1024;
    const int ch = part * 512 + F.tid; float h = 0.f;
    for (int t0 = 0; t0 < S_; t0 += 8) { float a[8], b[8]; unsigned short g[8];
#pragma unroll
        for (int i = 0; i < 8; ++i) { a[i] = LA[(size_t)(t0 + i) * 1024 + ch]; b[i] = LB[(size_t)(t0 + i) * 1024 + ch]; g[i] = Z[(size_t)(t0 + i) * NZ + ZC_LG + ch]; }
#pragma unroll
        for (int i = 0; i < 8; ++i) { h = a[i] * h + b[i]; Y[(size_t)(t0 + i) * 3072 + 1024 + ch] = (bf16_t)f2bf(h * gelu_tanh(bf2f(g[i]))); } }
}

__device__ __forceinline__ void phase_seq(const Frame& F, const Params& p, int l) {
#if DBG_NOSEQ
    { u32x4* yy = (u32x4*)(KWS() + WS_Y); for (size_t i = (size_t)F.bx * NTHR + F.tid; i < (size_t)S_ * 3072 / 8; i += (size_t)F.G * NTHR) yy[i] = (u32x4){0u, 0u, 0u, 0u}; }
#else
    if (F.bx < 16) { gdn_scan(F, ((F.bx & 7) << 1) | (F.bx >> 3)); return; }
    const int wg = F.bx - 16, nwg = F.G - 16; unsigned* ctl = (unsigned*)(KWS() + WS_CTL); unsigned* cnt = ctl + CW_SUB + 64 * l; unsigned* tmo = ctl + CW_BAR + XB_TMO;
    const int rwg = (wg + nwg - (2048 % nwg)) % nwg;
    lru_units<false>(F, p, l, wg, nwg); __syncthreads(); ret_units_a(F, rwg, nwg);
    sub_barrier(cnt, (unsigned)nwg, tmo);
    if (wg < 2) lru_carry(F, wg); else ret_scan(F, wg - 2, nwg - 2);
    sub_barrier(cnt, 2u * (unsigned)nwg, tmo);
    lru_units<true>(F, p, l, wg, nwg); __syncthreads(); ret_units_c(F, rwg, nwg);
#endif
}

#define LAYER(l) do { \
const int pb = PH_L0 + l * PH_PER_LAYER; \
        if (EN(0) && IN(pb + 0)) { const Frame F = make_frame(); phase_convert(F, p, l); phase_norm1_gab(F, p, l, l > 0 && !DBG_NOMOE); __syncthreads(); } \
        SEAM(pb + 0); \
        if (EN(1) && IN(pb + 1)) { const Frame F = make_frame(); pg8::Gemm g{(const bf16_t*)(KWS() + WS_H), (const bf16_t*)(KWS() + WS_WIN), 2048, 2048, 2048}; SchedStatic sc{64, 64, F.G, F.bx}; \
            EpiZL E{(bf16_t*)(KWS() + WS_Z)}; pg8::gemm_phase(F.lds, g, sc, E); } \
        SEAM(pb + 1); \
        if (EN(2) && IN(pb + 2)) { const Frame F = make_frame(); if ((F.G & 7) == 0) gdn_units_a_pipe(F, p, l); else gdn_units_a(F, p, l); } \
        SEAM(pb + 2); \
        if (EN(3) && IN(pb + 3)) { const Frame F = make_frame(); \
            phase_seq(F, p, l); \
        } \
        SEAM(pb + 3); \
        if (EN(4) && IN(pb + 4)) { const Frame F = make_frame(); gdn_output(F, p, l); } \
        SEAM(pb + 4); \
        if (EN(5) && IN(pb + 5)) { const Frame F = make_frame(); pg8::Gemm g{(const bf16_t*)(KWS() + WS_Y), (const bf16_t*)(KWS() + WS_BP), 3072, 1024, 1024}; SchedMerge sc{F.G, F.bx}; \
            EpiMerge E{(const bf16_t*)(KWS() + WS_Z), (bf16_t*)(KWS() + WS_H)}; pg8::gemm_phase(F.lds, g, sc, E); } \
        SEAM(pb + 5); \
        if (EN(6) && IN(pb + 6)) { const Frame F = make_frame(); pg8::Gemm g{(const bf16_t*)(KWS() + WS_H), (const bf16_t*)(KWS() + WS_WO), 2048, 2048, 2048}; SchedStatic sc{64, 8, F.G, F.bx}; \
            EpiWout E{l == 0 ? KIN(0) : KOUT(), KOUT(), (const float*)(KWS() + WS_MODV) + l * 12288 + MO_GT1}; pg8::gemm_phase(F.lds, g, sc, E); } \
        SEAM(pb + 6); \
        if (!DBG_NOMOE && EN(7) && IN(pb + 7)) { const Frame F = make_frame(); if ((S_ % (F.G * NWAVES * 4)) == 0) phase_norm2_router_lds(F, p, l); else phase_norm2_router(F, p, l); __syncthreads(); } \
        SEAM(pb + 7); \
        if (!DBG_NOMOE && EN(8) && IN(pb + 8)) { const Frame F = make_frame(); phase_gather(F, p, l); } \
        SEAM(pb + 8); \
        if (!DBG_NOMOE && EN(9) && IN(pb + 9)) { const Frame F = make_frame(); moe_tables_load(F, p); unsigned* mq = (unsigned*)(KWS() + WS_CTL) + CW_MOEQ + l * 16384; \
            { pg8::Gemm g{(const bf16_t*)(KWS() + WS_H), (const bf16_t*)(KWS() + WS_W13), 2048, 2048, 2048}; SchedMoe<true> sc{(const int*)(KWS() + WS_TOK + 512 * 1024), F.G, F.bx, 4, (const LAS int*)(F.lds + LDS_MISC + 64)}; \
              EpiW13 E{(bf16_t*)(KWS() + WS_HID), mq}; pg8::gemm_phase(F.lds, g, sc, E); } \
            { volatile LAS int* slot = (volatile LAS int*)(F.lds + LDS_MISC + 32); \
              if (F.tid == 0) { const int q0 = (int)xb_add(mq, 1u), q1 = (int)xb_add(mq, 1u); slot[0] = q0; slot[1] = q1; slot[2] = 2; slot[4] = 0; } __syncthreads(); \
              pg8::Gemm g{(const bf16_t*)(KWS() + WS_HID), (const bf16_t*)(KWS() + WS_W2), 512, 512, 512}; SchedMoeDyn sc{8, (const LAS int*)(F.lds + LDS_MISC + 64), slot, mq, (unsigned*)(KWS() + WS_CTL) + CW_BAR + XB_TMO}; \
              EpiW2L E{(bf16_t*)(KWS() + WS_SLOT), (const u32x2*)(KWS() + WS_ROWINFO), (const LAS int*)(F.lds + LDS_MISC + 64), mq, slot, mq}; pg8::gemm_phase(F.lds, g, sc, E); } } \
        SEAM(pb + 10); \
    } while (0)
template <unsigned PMASK, bool ALL>
__global__ void __launch_bounds__(NTHR, 2) fwd(Params p) {
    Frame F = make_frame();
    if (F.tid < 4) ((LAS unsigned*)(F.lds + LDS_MISC))[F.tid] = 0u;
    __syncthreads();
    unsigned* ctl = (unsigned*)(KWS() + WS_CTL);
    XcdBarrier bar; bar.bar = ctl + CW_BAR; bar.x = 0; bar.st = nullptr;
    const int lo = p.ph_lo, hi = p.ph_hi;
    const bool multi = ALL || (hi - lo) > 1;
    if (multi) bar = xcd_barrier_post(ctl + CW_BAR, (volatile LAS unsigned*)(F.lds + LDS_MISC));
#define IN(k) (ALL || (lo <= (k) && (k) < hi))
#define EN(b) ((PMASK >> (b)) & 1u)
#define SEAM(k) do { if (IN(k) && IN((k) + 1)) xcd_barrier(bar); } while (0)

    if (EN(11) && IN(PH_MOD)) { const Frame F = make_frame(); phase_mod(F, p); phase_rope_table(F); phase_gabw(F); }
    SEAM(PH_MOD);
    LAYER(0);
    LAYER(1);
    if (EN(12) && IN(PH_FINAL)) { const Frame F = make_frame(); phase_norm<2>(F, p, 0, !DBG_NOMOE); }
#undef IN
#undef SEAM
}

typedef void (*KernelFn)(Params);
static int phase_bit(int ph) { if (ph == PH_MOD) return 11; if (ph == PH_FINAL) return 12; return (ph - PH_L0) % PH_PER_LAYER; }
extern "C" void kernel_launch(void* const* d_in, const int* in_sizes, int n_in, void* d_out, int out_size, void* d_ws, size_t ws_size, hipStream_t stream) {
    static int grid = 0;
#if ONE_LAUNCH
    static KernelFn fns[1] = { fwd<0x1FFFu, true> };
    constexpr int NFN = 1;
#else
    static KernelFn fns[13] = { fwd<0x001u, false>, fwd<0x002u, false>, fwd<0x004u, false>, fwd<0x008u, false>, fwd<0x010u, false>, fwd<0x020u, false>, fwd<0x040u, false>, fwd<0x080u, false>, fwd<0x100u, false>, fwd<0x200u, false>, fwd<0x400u, false>, fwd<0x800u, false>, fwd<0x1000u, false> };
    constexpr int NFN = 13;
#endif
    if (grid == 0) {
        if (n_in != 29 || out_size != S_ * D_ || ws_size < WS_END) { fprintf(stderr, "kernel_launch: unexpected shapes (n_in %d out %d ws %zu)\n", n_in, out_size, ws_size); grid = -1; return; }
        int dev = 0, cus = 0, per_cu = 0;
        if (hipGetDevice(&dev) != hipSuccess || hipDeviceGetAttribute(&cus, hipDeviceAttributeMultiprocessorCount, dev) != hipSuccess) { grid = -1; return; }
        for (int i = 0; i < NFN; ++i) {
            if (hipFuncSetAttribute((const void*)fns[i], hipFuncAttributeMaxDynamicSharedMemorySize, LDS_BYTES) != hipSuccess) { fprintf(stderr, "kernel_launch: hipFuncSetAttribute failed\n"); grid = -1; return; }
            if (hipOccupancyMaxActiveBlocksPerMultiprocessor(&per_cu, (const void*)fns[i], NTHR, LDS_BYTES) != hipSuccess || per_cu < 1) fprintf(stderr, "kernel_launch: occupancy query says %d for fn %d\n", per_cu, i);
        }
        (void)hipGetLastError();
        grid = cus > 0 ? cus : 256;
    }
    if (grid < 0) return;
    (void)hipMemsetAsync((char*)d_ws + WS_CTL, 0, CTL_BYTES, stream);
    Params p{};
    for (int i = 0; i < 29; ++i) p.in[i] = (const float*)d_in[i];
    p.out = (float*)d_out; p.ws = (unsigned char*)d_ws;
#if ONE_LAUNCH
    p.ph_lo = 0; p.ph_hi = NPH;
    { void* args[] = {&p}; (void)hipLaunchKernel((const void*)fns[0], dim3(grid), dim3(NTHR), args, LDS_BYTES, stream); }
#else
    for (int ph = 0; ph < NPH; ++ph) { p.ph_lo = ph; p.ph_hi = ph + 1; void* args[] = {&p}; (void)hipLaunchKernel((const void*)fns[phase_bit(ph)], dim3(grid), dim3(NTHR), args, LDS_BYTES, stream); }
#endif
}
```

```cpp
#include <hip/hip_runtime.h>
#include <cstdio>
#include <cstdint>

#ifndef ONE_LAUNCH
#define ONE_LAUNCH 1
#endif
#ifndef DBG_NOSEQ
#define DBG_NOSEQ 0
#endif
#ifndef DBG_NOMOE
#define DBG_NOMOE 0
#endif
#ifndef DBG_NOMIX
#define DBG_NOMIX 0
#endif
#ifndef DBG_MOE_SCALE
#define DBG_MOE_SCALE 1.0f
#endif
#ifndef DBG_M
#define DBG_M 0
#endif
#ifndef DBG_ZERO_BR
#define DBG_ZERO_BR 0
#endif

#define LAS __attribute__((address_space(3)))
typedef unsigned short bf16_t;
typedef short bf16x8 __attribute__((ext_vector_type(8)));
typedef float f32x4 __attribute__((ext_vector_type(4)));
typedef float f32x2 __attribute__((ext_vector_type(2)));
typedef unsigned u32x4 __attribute__((ext_vector_type(4)));
typedef unsigned u32x2 __attribute__((ext_vector_type(2)));

constexpr int S_ = 16384, D_ = 2048, NL = 2;
constexpr int NZ = 16384;
constexpr int NZP = 16640;
constexpr int INC = 16400;
constexpr int NWAVES = 8, NTHR = 512;
constexpr float EPS = 1e-6f;
constexpr int ZC_RQ = 0, ZC_RK = 1024, ZC_RV = 2048, ZC_RG = 3072, ZC_LX = 4096, ZC_LG = 5120, ZC_GQ = 6144, ZC_GK = 7168, ZC_GV = 8192, ZC_GZ = 9216, ZC_BR = 10240;
constexpr int MO_SH1 = 0, MO_SC1 = 2048, MO_GT1 = 4096, MO_SH2 = 6144, MO_SC2 = 8192, MO_GT2 = 10240;

constexpr size_t MiB = 1u << 20;
constexpr size_t WS_CTL = 0, CTL_BYTES = 1 * MiB;
constexpr size_t WS_MODV = 1 * MiB;
constexpr size_t WS_RTW = 2 * MiB;
constexpr size_t WS_GAB = 3 * MiB;
constexpr size_t WS_GABW = 2 * MiB + 512 * 1024;
constexpr size_t WS_ROWINFO = 4 * MiB;
constexpr size_t WS_TOK = 5 * MiB;
constexpr size_t WS_WIN = 8 * MiB;
constexpr size_t WS_BP = 73 * MiB;
constexpr size_t WS_WO = 85 * MiB;
constexpr size_t WS_W13 = 93 * MiB;
constexpr size_t WS_W2 = 221 * MiB;
constexpr size_t WS_H = 285 * MiB;
constexpr size_t WS_Y = 349 * MiB;
constexpr size_t WS_MF = 445 * MiB;
constexpr size_t WS_Z = 573 * MiB;
constexpr size_t WS_XB = WS_Z;
constexpr size_t WS_HID = WS_Z + 160 * MiB;
constexpr size_t WS_SLOT = WS_Z + 200 * MiB;
constexpr size_t WS_LWT = 1085 * MiB;
constexpr size_t WS_LPH = 1086 * MiB;
constexpr size_t WS_LCARRY = 1088 * MiB;
constexpr size_t WS_ROPE_C = 1089 * MiB;
constexpr size_t WS_ROPE_S = 1093 * MiB;
constexpr size_t WS_KV = 1100 * MiB;
constexpr size_t WS_GP2 = 1164 * MiB;
constexpr size_t WS_GPO = WS_GP2 + 64 * MiB;
constexpr size_t WS_GSV = 445 * MiB;
constexpr size_t WS_GUP = 1276 * MiB;
constexpr size_t WS_GGL = 1340 * MiB;
constexpr size_t WS_GO = 1341 * MiB;
constexpr size_t WS_END = 1373 * MiB;
constexpr int CW_BAR = 4096;
constexpr int CW_CNT = 16384;
constexpr int CW_SUB = 17408;
constexpr int CW_MOEQ = 65536;

constexpr int LDS_STAGE = 131072;
constexpr int LDS_BYTES = 163840;
constexpr int LDS_MISC = LDS_BYTES - 1024;
constexpr int MAXTILES = 160;

constexpr int PH_MOD = 0, PH_L0 = 1, PH_PER_LAYER = 11, PH_FINAL = 23, NPH = 24;

struct Params { const float* in[29]; float* out; unsigned char* ws; int ph_lo, ph_hi; };


#define CAS __attribute__((address_space(4)))
__device__ __forceinline__ const CAS char* karg_base() { const CAS char* ka = (const CAS char*)__builtin_amdgcn_kernarg_segment_ptr(); asm volatile("" : "+s"(ka)); return ka; }
__device__ __forceinline__ const float* KIN(int i) { return *(const float* const CAS*)(karg_base() + 8 * i); }
__device__ __forceinline__ float* KOUT() { return *(float* const CAS*)(karg_base() + 232); }
__device__ __forceinline__ unsigned char* KWS() { return *(unsigned char* const CAS*)(karg_base() + 240); }

typedef __bf16 bf16x2_n __attribute__((ext_vector_type(2)));
__device__ __forceinline__ unsigned pk2(float lo, float hi) { const f32x2 f = {lo, hi}; const bf16x2_n b = __builtin_convertvector(f, bf16x2_n); return __builtin_bit_cast(unsigned, b); }
__device__ __forceinline__ unsigned f2bf(float f) { return pk2(f, 0.f) & 0xffffu; }
__device__ __forceinline__ float bf2f(unsigned short b) { return __builtin_bit_cast(float, ((unsigned)b) << 16); }
__device__ __forceinline__ float bflo(unsigned w) { return __builtin_bit_cast(float, w << 16); }
__device__ __forceinline__ float bfhi(unsigned w) { return __builtin_bit_cast(float, w & 0xffff0000u); }
__device__ __forceinline__ float wave_sum(float v) {
#pragma unroll
    for (int o = 1; o < 64; o <<= 1) v += __shfl_xor(v, o);
    return v;
}
__device__ __forceinline__ float sigm(float x) { return 1.0f / (1.0f + expf(-x)); }
__device__ __forceinline__ float fexp(float x) { return __builtin_amdgcn_exp2f(x * 1.4426950408889634f); }
__device__ __forceinline__ float fsigm(float x) { return __builtin_amdgcn_rcpf(1.0f + __builtin_amdgcn_exp2f(-x * 1.4426950408889634f)); }
__device__ __forceinline__ float fsilu(float x) { return x * fsigm(x); }
__device__ __forceinline__ float siluf(float x) { return x * sigm(x); }
__device__ __forceinline__ float softplusf(float x) { return fmaxf(x, 0.f) + log1pf(expf(-fabsf(x))); }
__device__ __forceinline__ void unpack8(const u32x4 a, float (&o)[8]) { o[0] = bflo(a.x); o[1] = bfhi(a.x); o[2] = bflo(a.y); o[3] = bfhi(a.y); o[4] = bflo(a.z); o[5] = bfhi(a.z); o[6] = bflo(a.w); o[7] = bfhi(a.w); }
__device__ __forceinline__ float gelu_tanh(float x) { return 0.5f * x * (1.0f + tanhf(0.7978845608028654f * (x + 0.044715f * x * x * x))); }

#define XB_TMO      128
#define XB_XCNT(j)  (256  + 64 * (j))
#define XB_XSUB(j)  (1280 + 64 * (j))
#define XB_XGEN(j)  (2304 + 64 * (j))
#define XB_TOP      3328
#define XB_TOPGEN   3392
#define XCD_BAR_WORDS 3456
#define XB_SPIN_CAP (1u << 24)
__device__ __forceinline__ unsigned xb_ld(unsigned* p)              { return __hip_atomic_load(p, __ATOMIC_RELAXED, __HIP_MEMORY_SCOPE_AGENT); }
__device__ __forceinline__ unsigned xb_add(unsigned* p, unsigned v) { return __hip_atomic_fetch_add(p, v, __ATOMIC_RELAXED, __HIP_MEMORY_SCOPE_AGENT); }
__device__ __forceinline__ unsigned xb_xcc_id() { return (unsigned)__builtin_amdgcn_s_getreg((3 << 11) | 20) & 0xFu; }
#define XB_SPIN(cond, bar) do { unsigned _sp = 0; while (cond) { __builtin_amdgcn_s_sleep(1); \
    if ((++_sp & 255u) == 0u) { if (xb_ld(&(bar)[XB_TMO])) break; if (_sp > XB_SPIN_CAP) { atomicAdd(&(bar)[XB_TMO], 1u); break; } } } } while (0)
struct XcdBarrier { unsigned* bar; unsigned x; volatile LAS unsigned* st; };
__device__ __forceinline__ XcdBarrier xcd_barrier_post(unsigned* bar, volatile LAS unsigned* st) {
    XcdBarrier b; b.bar = bar; b.x = xb_xcc_id(); b.st = st;
    if (threadIdx.x == 0) (void)xb_add(&bar[XB_XCNT(b.x)], 1u);
    return b;
}
__device__ __forceinline__ void xcd_barrier_complete(unsigned* bar, unsigned x, unsigned& nloc, unsigned& nx) {
    const unsigned G = gridDim.x * gridDim.y * gridDim.z;
    unsigned sum, cnt, mine, sp = 0u;
    for (;;) {
        sum = 0u; cnt = 0u; mine = 0u;
#pragma unroll 1
        for (unsigned j = 0; j < 16; ++j) { const unsigned c = xb_ld(&bar[XB_XCNT(j)]); sum += c; cnt += (c > 0u) ? 1u : 0u; mine = (j == x) ? c : mine; }
        if (sum == G) break;
        __builtin_amdgcn_s_sleep(1);
        if ((++sp & 255u) == 0u) { if (xb_ld(&bar[XB_TMO])) break; if (sp > XB_SPIN_CAP) { atomicAdd(&bar[XB_TMO], 1u); break; } }
    }
    nloc = mine > 0u ? mine : 1u; nx = cnt > 0u ? cnt : 1u;
}
__device__ __forceinline__ void xcd_barrier(const XcdBarrier& b) {
    asm volatile("s_waitcnt vmcnt(0)" ::: "memory");
    __syncthreads();
    if (threadIdx.x == 0) {
        unsigned* bar = b.bar;
        __builtin_amdgcn_s_waitcnt(0);
        unsigned nloc = b.st[0], nx = b.st[1];
        if (nloc == 0u) { xcd_barrier_complete(bar, b.x, nloc, nx); b.st[0] = nloc; b.st[1] = nx; }
        const unsigned old = xb_add(&bar[XB_XSUB(b.x)], 1u);
        const unsigned gen = old / nloc;
        if (old + 1u == (gen + 1u) * nloc) {
            __builtin_amdgcn_fence(__ATOMIC_RELEASE, "agent");
            asm volatile("s_waitcnt vmcnt(0)" ::: "memory");
            const unsigned og = xb_add(&bar[XB_TOP], 1u);
            const unsigned tg = og / nx;
            if (og + 1u == (tg + 1u) * nx) xb_add(&bar[XB_TOPGEN], 1u);
            else XB_SPIN(xb_ld(&bar[XB_TOPGEN]) == tg, bar);
            __builtin_amdgcn_fence(__ATOMIC_ACQUIRE, "agent");
            xb_add(&bar[XB_XGEN(b.x)], 1u);
            asm volatile("s_waitcnt vmcnt(0)" ::: "memory");
        } else {
            XB_SPIN(xb_ld(&bar[XB_XGEN(b.x)]) == gen, bar);
            __builtin_amdgcn_fence(__ATOMIC_ACQUIRE, "agent");
            asm volatile("s_waitcnt vmcnt(0)" ::: "memory");
        }
    }
    __syncthreads();
}


__device__ __forceinline__ void sub_barrier(unsigned* cnt, unsigned target, unsigned* tmo) {
    asm volatile("s_waitcnt vmcnt(0)" ::: "memory");
    __syncthreads();
    if (threadIdx.x == 0) {
        __builtin_amdgcn_fence(__ATOMIC_RELEASE, "agent");
        asm volatile("s_waitcnt vmcnt(0)" ::: "memory");
        (void)xb_add(cnt, 1u);
        unsigned sp = 0u;
        while (xb_ld(cnt) < target) { __builtin_amdgcn_s_sleep(1); if ((++sp & 255u) == 0u) { if (xb_ld(tmo)) break; if (sp > XB_SPIN_CAP) { atomicAdd(tmo, 1u); break; } } }
        __builtin_amdgcn_fence(__ATOMIC_ACQUIRE, "agent");
        asm volatile("s_waitcnt vmcnt(0)" ::: "memory");
    }
    __syncthreads();
}

namespace pg8 {
constexpr int BM = 256, BK = 64, HALF = 128, HTB = HALF * BK * 2, STAGE_BYTES = 8 * HTB, NXCD = 8, WGM = 8;
__device__ __forceinline__ int lds_byte(int r, int c) { const int st = (r >> 4) * 2 + (c >> 5), rr = r & 15, cc = c & 31, ob = rr * 64 + cc * 2; return st * 1024 + (ob ^ (((ob >> 9) & 1) << 5)); }
__device__ __forceinline__ void stage_rc(int b, int& R, int& C) { const int st = b / 1024, sb = b % 1024, swz = sb ^ (((sb >> 9) & 1) << 5); R = (st >> 1) * 16 + swz / 64; C = (st & 1) * 32 + (swz % 64) / 2; }
__device__ __forceinline__ int perm32(int rho) { const int n = rho >> 4, i = rho & 15; return 8 * (i >> 2) + 4 * n + (i & 3); }
struct Unit { int pm, pn, aoff; };
struct Gemm { const bf16_t* A; const bf16_t* Bt; int lda, ldb, K; };
__device__ __forceinline__ bool static_tile(int L, int nM, int nN, int& pm, int& pn) {
    const int nwg = nM * nN; if (L >= nwg) return false;
    int wgid = L; { const int q = nwg / NXCD, r = nwg % NXCD, xcd = wgid % NXCD, off = wgid / NXCD; wgid = (xcd < r ? xcd * (q + 1) : r * (q + 1) + (xcd - r) * q) + off; }
    const int nig = WGM * nN, gid = wgid / nig, fm = gid * WGM, gsz = (nM - fm) < WGM ? (nM - fm) : WGM;
    pm = fm + ((wgid % nig) % gsz); pn = (wgid % nig) / gsz; return true;
}
__device__ __forceinline__ unsigned cvt_pk_bf16(float lo, float hi) { return pk2(lo, hi); }

template <class E, class = void> struct epi_early { static constexpr bool value = false; };
template <class E> struct epi_early<E, decltype((void)E::EARLY)> { static constexpr bool value = E::EARLY; };
template <class Epi, class Sched>
__device__ __forceinline__ void gemm_phase(LAS unsigned char* lds, const Gemm g, const Sched& S, const Epi& E) {
    int tid = threadIdx.x; asm volatile("" : "+v"(tid)); const int wid = __builtin_amdgcn_readfirstlane(tid >> 6), lane = tid & 63, wr = wid >> 2, wc = wid & 3, fr = lane & 15, fq = lane >> 4;
    int K = g.K; asm volatile("" : "+s"(K)); const int nt = K / BK; int lda_ = g.lda, ldb_ = g.ldb; asm volatile("" : "+s"(lda_), "+s"(ldb_));
    unsigned voffA[2], voffB[2];
#pragma unroll
    for (int i = 0; i < 2; ++i) { int R, C; stage_rc(tid * 16 + i * 8192, R, C); const int Rb = Epi::PERM ? ((R & ~31) + perm32(R & 31)) : R;
        voffA[i] = (unsigned)(R * lda_ + C) * 2u; voffB[i] = (unsigned)(Rb * ldb_ + C) * 2u; }
    const size_t kstep = (size_t)(BK * 2);
    const int* rtab = S.row_table();
    const size_t hstepA = Sched::GATHER ? (size_t)0 : (size_t)HALF * lda_ * 2, hstepB = (size_t)HALF * ldb_ * 2;
    const size_t tstepA = 2 * hstepA, tstepB = 2 * hstepB;
    unsigned vc0[2], vc1[2], vn0[2], vn1[2];
#define PG8_ROWS(pm_, o0, o1) do { _Pragma("unroll") for (int _i = 0; _i < 2; ++_i) { int _R, _C; stage_rc(tid * 16 + _i * 8192, _R, _C); \
        if (Sched::GATHER) { o0[_i] = (unsigned)(rtab[(pm_) * 256 + _R] * lda_ + _C) * 2u; o1[_i] = (unsigned)(rtab[(pm_) * 256 + 128 + _R] * lda_ + _C) * 2u; } else { o0[_i] = voffA[_i]; o1[_i] = voffA[_i]; } } } while (0)
    const unsigned ldsw = (unsigned)wid * 1024u;
    const int aoff = lds_byte(wr * 64 + fr, fq * 8), boff = lds_byte(wc * 32 + fr, fq * 8);
#define PG8_SA(b, h) (((b) * 2 + (h)) * HTB)
#define PG8_SB(b, h) ((4 + (b) * 2 + (h)) * HTB)
#define PG8_STAGE(bufoff, gbase, voff) do { _Pragma("unroll") for (int _i = 0; _i < 2; ++_i) \
        __builtin_amdgcn_global_load_lds((const unsigned*)((const char*)(gbase) + (voff)[_i]), (LAS unsigned*)(lds + (bufoff) + ldsw + _i * 8192), 16, 0, 0); } while (0)
#define PG8_LDA(dst, b, h) do { _Pragma("unroll") for (int m = 0; m < 4; ++m) _Pragma("unroll") for (int k = 0; k < 2; ++k) dst[m][k] = *(const LAS bf16x8*)(lds + PG8_SA(b, h) + aoff + m * 2048 + k * 1024); } while (0)
#define PG8_LDB(dst, b, h) do { _Pragma("unroll") for (int n = 0; n < 2; ++n) _Pragma("unroll") for (int k = 0; k < 2; ++k) dst[n][k] = *(const LAS bf16x8*)(lds + PG8_SB(b, h) + boff + n * 2048 + k * 1024); } while (0)
#define PG8_MMA(ai, bj, At, Bt) do { __builtin_amdgcn_s_setprio(1); _Pragma("unroll") for (int m = 0; m < 4; ++m) _Pragma("unroll") for (int n = 0; n < 2; ++n) _Pragma("unroll") for (int k = 0; k < 2; ++k) \
        acc[ai][bj][m][n] = __builtin_amdgcn_mfma_f32_16x16x32_bf16(Bt[n][k], At[m][k], acc[ai][bj][m][n], 0, 0, 0); __builtin_amdgcn_s_setprio(0); } while (0)
#define PG8_WAIT_V(n) asm volatile("s_waitcnt vmcnt(" #n ")" ::: "memory")
#define PG8_WAIT_L(n) asm volatile("s_waitcnt lgkmcnt(" #n ")" ::: "memory")
#define PG8_BAR __builtin_amdgcn_s_barrier()
#define PG8_SCHED __builtin_amdgcn_sched_barrier(0)
    Unit cur, nxt; int ui = 0;
    if (!S.next(0, cur)) return;
    f32x4 acc[2][2][4][2];
#pragma unroll
    for (int a = 0; a < 2; ++a)
#pragma unroll
        for (int b = 0; b < 2; ++b)
#pragma unroll
            for (int m = 0; m < 4; ++m)
#pragma unroll
                for (int n = 0; n < 2; ++n) acc[a][b][m][n] = (f32x4){0.f, 0.f, 0.f, 0.f};
    bf16x8 At[4][2], B0[2][2], B1[2][2];
    const char* cA = (const char*)g.A + (size_t)cur.pm * tstepA + (size_t)cur.aoff; const char* cB = (const char*)g.Bt + (size_t)cur.pn * tstepB;
    PG8_ROWS(cur.pm, vc0, vc1);
#define PG8_PROLOGUE_A(cA_, cB_, v0_, v1_) do { PG8_STAGE(PG8_SB(0, 0), cB_, voffB); PG8_STAGE(PG8_SA(0, 0), cA_, v0_); PG8_STAGE(PG8_SB(0, 1), (cB_) + hstepB, voffB); PG8_STAGE(PG8_SA(0, 1), (cA_) + hstepA, v1_); } while (0)
#define PG8_PROLOGUE_B() do { if (wr == 1) PG8_BAR; PG8_WAIT_V(4); PG8_BAR; \
        PG8_STAGE(PG8_SB(1, 0), cB + kstep, voffB); PG8_STAGE(PG8_SA(1, 0), cA + kstep, vc0); PG8_STAGE(PG8_SB(1, 1), cB + hstepB + kstep, voffB); \
        PG8_WAIT_V(6); PG8_BAR; } while (0)
#define PG8_PROLOGUE() do { PG8_PROLOGUE_A(cA, cB, vc0, vc1); PG8_PROLOGUE_B(); } while (0)
    if (!Epi::LDS_EPI) PG8_PROLOGUE();
    for (;;) {
        const bool has_next = S.next(ui + 1, nxt);
        if (Epi::LDS_EPI) { S.ready(cur); if (!(epi_early<Epi>::value && ui > 0)) PG8_PROLOGUE_A(cA, cB, vc0, vc1); PG8_PROLOGUE_B(); }
        const bool chain = has_next && !Epi::LDS_EPI;
        const char* nA = chain ? (const char*)g.A + (size_t)nxt.pm * tstepA + (size_t)nxt.aoff : cA; const char* nB = chain ? (const char*)g.Bt + (size_t)nxt.pn * tstepB : cB;
        if (chain) PG8_ROWS(nxt.pm, vn0, vn1); else { vn0[0] = vc0[0]; vn0[1] = vc0[1]; vn1[0] = vc1[0]; vn1[1] = vc1[1]; }
        for (int t = 0; t < nt; t += 2) {
            const bool last = (t == nt - 2);
            const char* a1 = cA + (size_t)(t + 1) * kstep;
            const char* a2 = last ? nA : cA + (size_t)(t + 2) * kstep; const char* b2 = last ? nB : cB + (size_t)(t + 2) * kstep;
            const char* a3 = a2 + kstep; const char* b3 = b2 + kstep;
            unsigned x0[2], x1[2]; x0[0] = last ? vn0[0] : vc0[0]; x0[1] = last ? vn0[1] : vc0[1]; x1[0] = last ? vn1[0] : vc1[0]; x1[1] = last ? vn1[1] : vc1[1];
            PG8_LDB(B0, 0, 0); PG8_SCHED; PG8_LDA(At, 0, 0); PG8_STAGE(PG8_SA(1, 1), a1 + hstepA, vc1);
            PG8_WAIT_L(8); PG8_BAR; PG8_WAIT_L(0); PG8_MMA(0, 0, At, B0); PG8_BAR; PG8_SCHED;
            PG8_LDB(B1, 0, 1); PG8_STAGE(PG8_SB(0, 0), b2, voffB);
            PG8_BAR; PG8_WAIT_L(0); PG8_MMA(0, 1, At, B1); PG8_BAR;
            PG8_LDA(At, 0, 1); PG8_STAGE(PG8_SA(0, 0), a2, x0);
            PG8_BAR; PG8_WAIT_L(0); PG8_MMA(1, 0, At, B0); PG8_BAR; PG8_SCHED;
            PG8_STAGE(PG8_SB(0, 1), b2 + hstepB, voffB);
            PG8_WAIT_V(6); PG8_BAR; PG8_MMA(1, 1, At, B1); PG8_BAR;
            PG8_LDB(B0, 1, 0); PG8_SCHED; PG8_LDA(At, 1, 0); PG8_STAGE(PG8_SA(0, 1), a2 + hstepA, x1);
            PG8_WAIT_L(8); PG8_BAR; PG8_WAIT_L(0); PG8_MMA(0, 0, At, B0); PG8_BAR; PG8_SCHED;
            PG8_LDB(B1, 1, 1); PG8_STAGE(PG8_SB(1, 0), b3, voffB);
            PG8_BAR; PG8_WAIT_L(0); PG8_MMA(0, 1, At, B1); PG8_BAR;
            PG8_LDA(At, 1, 1); PG8_STAGE(PG8_SA(1, 0), a3, x0);
            PG8_BAR; PG8_WAIT_L(0); PG8_MMA(1, 0, At, B0); PG8_BAR; PG8_SCHED;
            PG8_STAGE(PG8_SB(1, 1), b3 + hstepB, voffB);
            PG8_WAIT_V(6); PG8_BAR; PG8_MMA(1, 1, At, B1); PG8_BAR;
        }
        if (Epi::LDS_EPI) { PG8_WAIT_V(0); if (wr == 0) PG8_BAR; PG8_BAR;
            if constexpr (epi_early<Epi>::value) { static_assert(!Sched::GATHER, "early prologue: plain row tiles only");
                E.run_a(acc, cur, wr, wc, lds, tid);
                if (has_next) { const char* eA = (const char*)g.A + (size_t)nxt.pm * tstepA + (size_t)nxt.aoff; const char* eB = (const char*)g.Bt + (size_t)nxt.pn * tstepB; PG8_PROLOGUE_A(eA, eB, voffA, voffA); }
                E.run_b(cur, lds, tid); }
            else E.run(acc, cur, wr, wc, fr, fq, lds, tid); }
        else E(acc, cur, wr, wc, fr, fq);
        if (!has_next) break;
        if (!E.keep(cur))
#pragma unroll
        for (int a = 0; a < 2; ++a)
#pragma unroll
            for (int b = 0; b < 2; ++b)
#pragma unroll
                for (int m = 0; m < 4; ++m)
#pragma unroll
                    for (int n = 0; n < 2; ++n) acc[a][b][m][n] = (f32x4){0.f, 0.f, 0.f, 0.f};
        if (Epi::LDS_EPI) { cur = nxt; cA = (const char*)g.A + (size_t)cur.pm * tstepA + (size_t)cur.aoff; cB = (const char*)g.Bt + (size_t)cur.pn * tstepB; ++ui; PG8_ROWS(cur.pm, vc0, vc1); }
        else { cur = nxt; cA = nA; cB = nB; ++ui; vc0[0] = vn0[0]; vc0[1] = vn0[1]; vc1[0] = vn1[0]; vc1[1] = vn1[1]; }
    }
    if (!Epi::LDS_EPI) { PG8_WAIT_V(0); if (wr == 0) PG8_BAR; PG8_BAR; }
#undef PG8_ROWS
#undef PG8_PROLOGUE
#undef PG8_PROLOGUE_A
#undef PG8_PROLOGUE_B
#undef PG8_SA
#undef PG8_SB
#undef PG8_STAGE
#undef PG8_LDA
#undef PG8_LDB
#undef PG8_MMA
#undef PG8_WAIT_V
#undef PG8_WAIT_L
#undef PG8_BAR
#undef PG8_SCHED
}
}
using pg8::Unit;

struct SchedStatic { static constexpr bool GATHER = false; __device__ __forceinline__ const int* row_table() const { return nullptr; } __device__ __forceinline__ void ready(const Unit&) const {} int nM, nN, G, c;
    __device__ __forceinline__ bool next(int i, Unit& u) const { int pm, pn; if (!pg8::static_tile(i * G + c, nM, nN, pm, pn)) return false; u.pm = pm; u.pn = pn; u.aoff = 0; return true; } };
struct SchedMerge { static constexpr bool GATHER = false; __device__ __forceinline__ const int* row_table() const { return nullptr; } __device__ __forceinline__ void ready(const Unit&) const {} int G, c;
    __device__ __forceinline__ bool next(int i, Unit& u) const { const int ti = i / 3, b = i - 3 * ti; int pm, pn; if (!pg8::static_tile(ti * G + c, 64, 8, pm, pn)) return false;
        u.pm = pm; u.pn = b * 8 + pn; u.aoff = b * 1024 * 2; return true; } };
template <bool GATH>
struct SchedMoe { static constexpr bool GATHER = GATH; const int* rtab; __device__ __forceinline__ const int* row_table() const { return rtab; } __device__ __forceinline__ void ready(const Unit&) const {} int G, c, nN; const LAS int* tbl;
    __device__ __forceinline__ bool next(int i, Unit& u) const { const int L = i * G + c; const int ntl = __builtin_amdgcn_readfirstlane(tbl[224]); if (L >= ntl * nN) return false;
        const int pm = L / nN; u.pm = pm; u.pn = __builtin_amdgcn_readfirstlane(tbl[pm]) * nN + (L - pm * nN); u.aoff = 0; return true; } };
struct SchedMoeDyn { static constexpr bool GATHER = false; __device__ __forceinline__ const int* row_table() const { return nullptr; } int nN; const LAS int* tbl; volatile LAS int* slot; unsigned* done; unsigned* tmo;
    __device__ __forceinline__ bool next(int i, Unit& u) const { const int L = __builtin_amdgcn_readfirstlane(slot[i & 1]); const int ntl = __builtin_amdgcn_readfirstlane(tbl[224]); if (L >= ntl * nN) return false;
        const int pm = L / nN; u.pm = pm; u.pn = __builtin_amdgcn_readfirstlane(tbl[pm]) * nN + (L - pm * nN); u.aoff = 0; return true; }
    __device__ __forceinline__ void ready(const Unit& u) const {
        if (threadIdx.x == 0) { if (slot[4] == 0) { unsigned* d = done + 64 * (u.pm + 1); unsigned sp = 0u;
                while (xb_ld(d) < 32u) { __builtin_amdgcn_s_sleep(1); if ((++sp & 255u) == 0u) { if (xb_ld(tmo)) break; if (sp > XB_SPIN_CAP) { atomicAdd(tmo, 1u); break; } } } }
            slot[4] = 0; __builtin_amdgcn_fence(__ATOMIC_ACQUIRE, "agent"); asm volatile("s_waitcnt vmcnt(0)" ::: "memory"); }
        asm volatile("s_waitcnt lgkmcnt(0)" ::: "memory"); __builtin_amdgcn_s_barrier(); asm volatile("" ::: "memory"); } };

struct EpiZ { static constexpr bool LDS_EPI = false; template <class A_> __device__ __forceinline__ void run(A_&, const Unit&, int, int, int, int, LAS unsigned char*, int) const {} __device__ __forceinline__ bool keep(const Unit&) const { return false; } static constexpr bool PERM = true; bf16_t* Z; float* GAB;
    __device__ __forceinline__ void operator()(const f32x4 (&acc)[2][2][4][2], const Unit& u, int wr, int wc, int fr, int fq) const {
        const int row0 = u.pm * 256 + wr * 64 + fr;
        if (u.pn < 64) {
            const int col0 = u.pn * 256 + wc * 32 + 8 * fq;
#pragma unroll
            for (int ai = 0; ai < 2; ++ai)
#pragma unroll
                for (int m = 0; m < 4; ++m) { bf16_t* rowp = Z + (size_t)(row0 + ai * 128 + m * 16) * NZ + col0;
#pragma unroll
                    for (int bj = 0; bj < 2; ++bj) { const f32x4 v0 = acc[ai][bj][m][0], v1 = acc[ai][bj][m][1]; u32x4 w;
                        w.x = pg8::cvt_pk_bf16(v0[0], v0[1]); w.y = pg8::cvt_pk_bf16(v0[2], v0[3]); w.z = pg8::cvt_pk_bf16(v1[0], v1[1]); w.w = pg8::cvt_pk_bf16(v1[2], v1[3]);
                        *(u32x4*)(rowp + bj * 128) = w; } }
        } else if (wc == 0 && fq < 2) {
#pragma unroll
            for (int ai = 0; ai < 2; ++ai)
#pragma unroll
                for (int m = 0; m < 4; ++m) { float* gp = GAB + (size_t)(row0 + ai * 128 + m * 16) * 16 + 8 * fq;
                    *(f32x4*)gp = acc[ai][0][m][0]; *(f32x4*)(gp + 4) = acc[ai][0][m][1]; }
        }
    } };
struct EpiZL { static constexpr bool LDS_EPI = true, PERM = true, EARLY = true; bf16_t* Z;
    __device__ __forceinline__ bool keep(const Unit&) const { return false; }
    __device__ __forceinline__ void operator()(const f32x4 (&)[2][2][4][2], const Unit&, int, int, int, int) const {}
    template <class A_> __device__ __forceinline__ void run(A_&, const Unit&, int, int, int, int, LAS unsigned char*, int) const {}
    __device__ __forceinline__ void rows_out(const Unit& u, LAS unsigned char* lds, int tid, int i) const { const int c = tid & 31; const int row = (tid >> 5) + 16 * i;
        const u32x4 w = *(const LAS u32x4*)(lds + row * 512 + ((c ^ (row & 31)) << 4)); __builtin_nontemporal_store(w, (u32x4*)(Z + (size_t)(u.pm * 256 + row) * NZ + u.pn * 256 + c * 8)); }
    __device__ __forceinline__ void run_a(const f32x4 (&acc)[2][2][4][2], const Unit& u, int wr, int wc, LAS unsigned char* lds, int tid_) const {
        int tid = tid_; asm volatile("" : "+v"(tid));
        const int fr = tid & 15, fq = (tid >> 4) & 3;
#pragma unroll
        for (int ai = 0; ai < 2; ++ai)
#pragma unroll
            for (int m = 0; m < 4; ++m) { const int r = ai * 128 + wr * 64 + m * 16 + fr;
#pragma unroll
                for (int bj = 0; bj < 2; ++bj) { const int c16 = 16 * bj + 4 * wc + fq; const f32x4 v0 = acc[ai][bj][m][0], v1 = acc[ai][bj][m][1]; u32x4 w;
                    w.x = pk2(v0[0], v0[1]); w.y = pk2(v0[2], v0[3]); w.z = pk2(v1[0], v1[1]); w.w = pk2(v1[2], v1[3]);
                    *(LAS u32x4*)(lds + r * 512 + ((c16 ^ (r & 31)) << 4)) = w; }
                asm volatile("" ::: "memory"); }
        __syncthreads();
#pragma unroll
        for (int i = 0; i < 4; ++i) rows_out(u, lds, tid, i);
        asm volatile("" ::: "memory");
#pragma unroll
        for (int i = 8; i < 12; ++i) rows_out(u, lds, tid, i);
        asm volatile("s_waitcnt lgkmcnt(0)" ::: "memory"); __builtin_amdgcn_s_barrier(); asm volatile("" ::: "memory");
    }
    __device__ __forceinline__ void run_b(const Unit& u, LAS unsigned char* lds, int tid_) const {
        int tid = tid_; asm volatile("" : "+v"(tid));
#pragma unroll
        for (int i = 4; i < 8; ++i) rows_out(u, lds, tid, i);
        asm volatile("" ::: "memory");
#pragma unroll
        for (int i = 12; i < 16; ++i) rows_out(u, lds, tid, i);
        asm volatile("s_waitcnt lgkmcnt(0)" ::: "memory"); __builtin_amdgcn_s_barrier(); asm volatile("" ::: "memory");
    } };
struct EpiMerge { static constexpr bool LDS_EPI = false; template <class A_> __device__ __forceinline__ void run(A_&, const Unit&, int, int, int, int, LAS unsigned char*, int) const {} static constexpr bool PERM = true; const bf16_t* Z; bf16_t* OUT;
    __device__ __forceinline__ bool keep(const Unit& u) const { return (u.pn >> 3) < 2; }
    __device__ __forceinline__ void operator()(f32x4 (&acc)[2][2][4][2], const Unit& u, int wr, int wc, int fr, int fq) const {
        const int b = u.pn >> 3, pnl = u.pn & 7; const int row0 = u.pm * 256 + wr * 64 + fr, col0 = pnl * 256 + wc * 32 + 8 * fq;
        const bf16_t* zb = Z + ZC_BR + b * 2048 + col0;
        u32x4 gb[2][2][2], gn[2][2][2];
#define EM_LOAD(slot, aim_) do { const int ai_ = (aim_) >> 1, mh_ = (aim_) & 1; _Pragma("unroll") for (int mm = 0; mm < 2; ++mm) _Pragma("unroll") for (int bj = 0; bj < 2; ++bj) { \
            const bf16_t* zp = zb + (size_t)(row0 + ai_ * 128 + (2 * mh_ + mm) * 16) * NZ + bj * 128; gb[slot][mm][bj] = *(const u32x4*)zp; gn[slot][mm][bj] = (b < 2) ? *(const u32x4*)(zp + 2048) : (u32x4){0u, 0u, 0u, 0u}; } } while (0)
        EM_LOAD(0, 0);
#pragma unroll
        for (int aim = 0; aim < 4; ++aim) { const int ai = aim >> 1, mh = aim & 1, sl = aim & 1;
            if (aim + 1 < 4) EM_LOAD((aim + 1) & 1, aim + 1);
#pragma unroll
            for (int mm = 0; mm < 2; ++mm) { const int m = 2 * mh + mm;
#pragma unroll
                for (int bj = 0; bj < 2; ++bj) { float eb[8]; { float x[8]; unpack8(gb[sl][mm][bj], x);
#pragma unroll
                        for (int i = 0; i < 8; ++i) eb[i] = __builtin_amdgcn_rcpf(1.0f + fexp(-fmaxf(fminf(x[i], 30.f), -30.f))); }
                    if (b < 2) { float x[8]; unpack8(gn[sl][mm][bj], x);
#pragma unroll
                        for (int i = 0; i < 8; ++i) eb[i] *= 1.0f + fexp(-fmaxf(fminf(x[i], 30.f), -30.f)); }
                    f32x4& v0 = acc[ai][bj][m][0]; f32x4& v1 = acc[ai][bj][m][1];
                    v0[0] *= eb[0]; v0[1] *= eb[1]; v0[2] *= eb[2]; v0[3] *= eb[3]; v1[0] *= eb[4]; v1[1] *= eb[5]; v1[2] *= eb[6]; v1[3] *= eb[7];
                    if (b == 2) { u32x4 w; w.x = pg8::cvt_pk_bf16(v0[0], v0[1]); w.y = pg8::cvt_pk_bf16(v0[2], v0[3]); w.z = pg8::cvt_pk_bf16(v1[0], v1[1]); w.w = pg8::cvt_pk_bf16(v1[2], v1[3]);
                        *(u32x4*)(OUT + (size_t)(row0 + ai * 128 + m * 16) * 2048 + col0 + bj * 128) = w; } } }
        }
#undef EM_LOAD
    } };
struct EpiWout { static constexpr bool LDS_EPI = false; template <class A_> __device__ __forceinline__ void run(A_&, const Unit&, int, int, int, int, LAS unsigned char*, int) const {} __device__ __forceinline__ bool keep(const Unit&) const { return false; } static constexpr bool PERM = false; const float* xsrc; float* xdst; const float* gt;
    __device__ __forceinline__ void operator()(const f32x4 (&acc)[2][2][4][2], const Unit& u, int wr, int wc, int fr, int fq) const {
        const int row0 = u.pm * 256 + wr * 64 + fr, col0 = u.pn * 256 + wc * 32 + 4 * fq;
        f32x4 gv[2][2];
#pragma unroll
        for (int bj = 0; bj < 2; ++bj)
#pragma unroll
            for (int n = 0; n < 2; ++n) gv[bj][n] = *(const f32x4*)(gt + col0 + bj * 128 + n * 16);
        f32x4 xo[2][2][2][2];
#define EW_LOAD(slot, q_) do { const int ai_ = (q_) >> 1, mh_ = (q_) & 1; _Pragma("unroll") for (int mm = 0; mm < 2; ++mm) { const size_t off_ = (size_t)(row0 + ai_ * 128 + (2 * mh_ + mm) * 16) * 2048 + col0; \
            _Pragma("unroll") for (int bj = 0; bj < 2; ++bj) _Pragma("unroll") for (int n = 0; n < 2; ++n) xo[slot][mm][bj][n] = *(const f32x4*)(xsrc + off_ + bj * 128 + n * 16); } } while (0)
        EW_LOAD(0, 0);
#pragma unroll
        for (int q = 0; q < 4; ++q) { const int ai = q >> 1, mh = q & 1, sl = q & 1;
            if (q + 1 < 4) EW_LOAD((q + 1) & 1, q + 1);
#pragma unroll
            for (int mm = 0; mm < 2; ++mm) { const int m = 2 * mh + mm; const size_t off = (size_t)(row0 + ai * 128 + m * 16) * 2048 + col0;
#pragma unroll
                for (int bj = 0; bj < 2; ++bj)
#pragma unroll
                    for (int n = 0; n < 2; ++n) *(f32x4*)(xdst + off + bj * 128 + n * 16) = xo[sl][mm][bj][n] + gv[bj][n] * acc[ai][bj][m][n]; } }
#undef EW_LOAD
    } };
struct EpiW13 { static constexpr bool LDS_EPI = false; template <class A_> __device__ __forceinline__ void run(A_&, const Unit&, int, int, int, int, LAS unsigned char*, int) const {} __device__ __forceinline__ bool keep(const Unit&) const { return false; } static constexpr bool PERM = true; bf16_t* HID; unsigned* done;
    __device__ __forceinline__ void operator()(const f32x4 (&acc)[2][2][4][2], const Unit& u, int wr, int wc, int fr, int fq) const {
        const int pnl = u.pn & 3; const int row0 = u.pm * 256 + wr * 64 + fr, col0 = pnl * 128 + wc * 32 + 8 * fq;
        const __amdgpu_buffer_rsrc_t rs = __builtin_amdgcn_make_buffer_rsrc(HID, 0, MAXTILES * 256 * 512 * 2, 0x00020000);
#pragma unroll
        for (int ai = 0; ai < 2; ++ai)
#pragma unroll
            for (int m = 0; m < 4; ++m) { float hv[8];
#pragma unroll
                for (int n = 0; n < 2; ++n)
#pragma unroll
                    for (int j = 0; j < 4; ++j) hv[n * 4 + j] = fsilu(acc[ai][0][m][n][j]) * acc[ai][1][m][n][j];
                u32x4 w; w.x = pg8::cvt_pk_bf16(hv[0], hv[1]); w.y = pg8::cvt_pk_bf16(hv[2], hv[3]); w.z = pg8::cvt_pk_bf16(hv[4], hv[5]); w.w = pg8::cvt_pk_bf16(hv[6], hv[7]);
                __builtin_amdgcn_raw_buffer_store_b128(w, rs, (unsigned)(((row0 + ai * 128 + m * 16) * 512 + col0) * 2), 0,   16); }
        asm volatile("s_waitcnt vmcnt(0)" ::: "memory");
        if (fr == 0 && fq == 0) (void)xb_add(done + 64 * (u.pm + 1), 1u);
    } };
struct EpiW2 { static constexpr bool LDS_EPI = false; template <class A_> __device__ __forceinline__ void run(A_&, const Unit&, int, int, int, int, LAS unsigned char*, int) const {} __device__ __forceinline__ bool keep(const Unit&) const { return false; } static constexpr bool PERM = true; bf16_t* SLOT; const u32x2* rowinfo; const LAS int* tbl;
    __device__ __forceinline__ void operator()(const f32x4 (&acc)[2][2][4][2], const Unit& u, int wr, int wc, int fr, int fq) const {
        const int e = u.pn >> 3, pnl = u.pn & 7; const int row0 = u.pm * 256 + wr * 64 + fr, col0 = pnl * 256 + wc * 32 + 8 * fq; const int rend = __builtin_amdgcn_readfirstlane(tbl[192 + e]);
        u32x2 inf[2][4];
#pragma unroll
        for (int ai = 0; ai < 2; ++ai)
#pragma unroll
            for (int m = 0; m < 4; ++m) inf[ai][m] = rowinfo[row0 + ai * 128 + m * 16];
#pragma unroll
        for (int ai = 0; ai < 2; ++ai)
#pragma unroll
            for (int m = 0; m < 4; ++m) { const int r = row0 + ai * 128 + m * 16;
                if (r < rend) { const unsigned wbits = inf[ai][m].y; const float w = __uint_as_float(wbits); const unsigned tx = inf[ai][m].x; const unsigned tok = tx >> 1, k = tx & 1u;
                    bf16_t* dst = SLOT + ((size_t)k * S_ + tok) * 2048 + col0;
#pragma unroll
                    for (int bj = 0; bj < 2; ++bj) { const f32x4 v0 = acc[ai][bj][m][0] * w, v1 = acc[ai][bj][m][1] * w; u32x4 o;
                        o.x = pg8::cvt_pk_bf16(v0[0], v0[1]); o.y = pg8::cvt_pk_bf16(v0[2], v0[3]); o.z = pg8::cvt_pk_bf16(v1[0], v1[1]); o.w = pg8::cvt_pk_bf16(v1[2], v1[3]);
                        *(u32x4*)(dst + bj * 128) = o; } } }
    } };

struct EpiW2L { static constexpr bool LDS_EPI = true, PERM = true; bf16_t* SLOT; const u32x2* rowinfo; const LAS int* tbl; unsigned* q; volatile LAS int* slot; unsigned* done;
    __device__ __forceinline__ bool keep(const Unit&) const { return false; }
    __device__ __forceinline__ void operator()(const f32x4 (&)[2][2][4][2], const Unit&, int, int, int, int) const {}
    __device__ __forceinline__ void run(const f32x4 (&acc)[2][2][4][2], const Unit& u, int wr, int wc, int fr_, int fq_, LAS unsigned char* lds, int tid_) const {
        int tid = tid_; asm volatile("" : "+v"(tid));
        int qn = 0; unsigned dn = 0u;
        if (tid == 0) { qn = (int)xb_add(q, 1u); const int Ln = slot[(slot[2] + 1) & 1]; if (Ln < tbl[224] * 8) dn = xb_ld(done + 64 * ((Ln >> 3) + 1)); }
        const int fr = tid & 15, fq = (tid >> 4) & 3; const int e = u.pn >> 3, pnl = u.pn & 7; const int rend = __builtin_amdgcn_readfirstlane(tbl[192 + e]);
        LAS unsigned* rowx = (LAS unsigned*)(lds + 131072);
        u32x2 inf[2][4];
#pragma unroll
        for (int ai = 0; ai < 2; ++ai)
#pragma unroll
            for (int m = 0; m < 4; ++m) inf[ai][m] = rowinfo[u.pm * 256 + ai * 128 + wr * 64 + m * 16 + fr];
#pragma unroll
        for (int ai = 0; ai < 2; ++ai)
#pragma unroll
            for (int m = 0; m < 4; ++m) { const int r = ai * 128 + wr * 64 + m * 16 + fr; const bool valid = (u.pm * 256 + r) < rend; const float w = valid ? __uint_as_float(inf[ai][m].y) : 0.f;
                if (wc == 0 && fq == 0) rowx[r] = valid ? inf[ai][m].x : 0xffffffffu;
#pragma unroll
                for (int bj = 0; bj < 2; ++bj) { const int c16 = 16 * bj + 4 * wc + fq; const f32x4 v0 = acc[ai][bj][m][0] * w, v1 = acc[ai][bj][m][1] * w; u32x4 o;
                    o.x = pk2(v0[0], v0[1]); o.y = pk2(v0[2], v0[3]); o.z = pk2(v1[0], v1[1]); o.w = pk2(v1[2], v1[3]);
                    *(LAS u32x4*)(lds + r * 512 + ((c16 ^ (r & 31)) << 4)) = o; }
                asm volatile("" ::: "memory"); }
        __syncthreads();
        const int c = tid & 31;
#pragma unroll
        for (int i = 0; i < 16; ++i) { const int row = (tid >> 5) + 16 * i; const unsigned tx = rowx[row];
            if (tx != 0xffffffffu) { const u32x4 o = *(const LAS u32x4*)(lds + row * 512 + ((c ^ (row & 31)) << 4));
                *(u32x4*)(SLOT + ((size_t)(tx & 1u) * S_ + (tx >> 1)) * 2048 + pnl * 256 + c * 8) = o; }
            if ((i & 3) == 3) asm volatile("" ::: "memory"); }
        if (tid == 0) { const int n = slot[2]; slot[n & 1] = qn; slot[2] = n + 1; slot[4] = dn >= 32u ? 1 : 0; }
        asm volatile("s_waitcnt lgkmcnt(0)" ::: "memory"); __builtin_amdgcn_s_barrier(); asm volatile("" ::: "memory");
    } };

struct Frame { LAS unsigned char* lds; unsigned char* ldsg; int tid, lane, wave, G, bx; };
extern __shared__ __attribute__((aligned(16))) unsigned char lds_raw[];
__device__ __forceinline__ Frame make_frame() { Frame F; int tz = threadIdx.x; asm volatile("" : "+v"(tz)); F.lds = (LAS unsigned char*)lds_raw; F.ldsg = lds_raw; F.tid = tz; F.lane = tz & 63;
    F.wave = __builtin_amdgcn_readfirstlane(tz >> 6); F.G = gridDim.x; F.bx = blockIdx.x; return F; }

struct TItem { const float* W; bf16_t* WT; int ldw, srccol, k0, ldk, dstrow; };
__device__ __forceinline__ void titem_load(const TItem& t, f32x4 (&x)[8], int lane) {
    const int n4 = (lane & 7) * 4, kr = lane >> 3;
#pragma unroll
    for (int i = 0; i < 8; ++i) x[i] = __builtin_nontemporal_load((const f32x4*)(t.W + (size_t)(t.k0 + kr + 8 * i) * t.ldw + t.srccol + n4));
}
__device__ __forceinline__ void titem_store(const TItem& t, const f32x4 (&x)[8], float* scr, int lane) {
    const int n4 = (lane & 7) * 4, kr = lane >> 3;
#pragma unroll
    for (int i = 0; i < 8; ++i) { float* s = scr + (kr + 8 * i) * 33 + n4; s[0] = x[i][0]; s[1] = x[i][1]; s[2] = x[i][2]; s[3] = x[i][3]; }
    asm volatile("s_waitcnt lgkmcnt(0)" ::: "memory");
    const int c = lane & 7;
#pragma unroll
    for (int j = 0; j < 4; ++j) { const int n = (lane >> 3) + 8 * j; const float* s = scr + (8 * c) * 33 + n;
        u32x4 o; o.x = pk2(s[0 * 33], s[1 * 33]); o.y = pk2(s[2 * 33], s[3 * 33]); o.z = pk2(s[4 * 33], s[5 * 33]); o.w = pk2(s[6 * 33], s[7 * 33]);
        *(u32x4*)(t.WT + (size_t)(t.dstrow + n) * t.ldk + t.k0 + 8 * c) = o; }
    asm volatile("s_waitcnt lgkmcnt(0)" ::: "memory");
}

__device__ __forceinline__ void phase_mod(const Frame& F, const Params& p) {
    const float* cvec = KIN(1); const float* ada_w = KIN(3); const float* ada_b = KIN(4);
    float* modv = (float*)(KWS() + WS_MODV);
    float* sc = (float*)F.ldsg;
    f32x2* red = (f32x2*)(sc + 2048);
    for (int k = F.tid; k < 2048; k += NTHR) sc[k] = siluf(cvec[k]);
    __syncthreads();
    for (int u = F.bx; u < 2 * 96; u += F.G) {
        const int l = u / 96, cb = u % 96, col = cb * 128 + 2 * F.lane;
        const float* wp = ada_w + ((size_t)l * 2048 + F.wave * 256) * 12288 + col; const float* sp = sc + F.wave * 256;
        f32x2 acc = (f32x2){0.f, 0.f};
#pragma unroll 16
        for (int k = 0; k < 256; ++k) { const f32x2 w = __builtin_nontemporal_load((const f32x2*)(wp + (size_t)k * 12288)); const float s = sp[k]; acc[0] += s * w[0]; acc[1] += s * w[1]; }
        red[F.wave * 64 + F.lane] = acc;
        __syncthreads();
        if (F.wave == 0) { f32x2 s = *(const f32x2*)(ada_b + l * 12288 + col);
#pragma unroll
            for (int w = 0; w < 8; ++w) s += red[w * 64 + F.lane];
            *(f32x2*)(modv + l * 12288 + col) = s; }
        __syncthreads();
    }
}

__device__ __forceinline__ void phase_convert(const Frame& F, const Params& p, int l) {
    float* scr = (float*)(F.ldsg + F.wave * 8448);
    const int gw = F.bx * NWAVES + F.wave, NGW = F.G * NWAVES;
    bf16_t* WIN = (bf16_t*)(KWS() + WS_WIN); bf16_t* BP = (bf16_t*)(KWS() + WS_BP); bf16_t* WO = (bf16_t*)(KWS() + WS_WO); bf16_t* W13 = (bf16_t*)(KWS() + WS_W13); bf16_t* W2 = (bf16_t*)(KWS() + WS_W2);
    const float* w_in = KIN(7) + (size_t)l * 2048 * INC;
    const float* bp = KIN(19) + (size_t)l * 3 * 1024 * 2048;
    const float* wo = KIN(20) + (size_t)l * 2048 * 2048;
    const float* w1 = KIN(25) + (size_t)l * 32 * 2048 * 512; const float* w3 = KIN(26) + (size_t)l * 32 * 2048 * 512; const float* w2 = KIN(27) + (size_t)l * 32 * 512 * 2048;
    const float* lwa = KIN(10) + (size_t)l * 8 * 16384; const float* lwx = KIN(12) + (size_t)l * 8 * 16384; bf16_t* LWT = (bf16_t*)(KWS() + WS_LWT);
    constexpr int I_IN = 512 * 32, I_BP = 3 * 16 * 64, I_WO = 32 * 64, I_W13 = 32 * 2 * 512, I_W2 = 32 * 512, I_LRU = 8 * 2 * 8;
    constexpr int NITEMS = I_IN + I_BP + I_WO + I_W13 + I_W2 + I_LRU;
    auto decode = [&](int it) -> TItem { TItem t; int r = it;
        if (r < I_IN) { const int nb = r % 512, kb = r / 512; t.W = w_in; t.ldw = INC; t.srccol = (nb < 320) ? 32 * nb : 10256 + 32 * (nb - 320); t.k0 = 64 * kb; t.WT = WIN; t.ldk = 2048; t.dstrow = 32 * nb; return t; }
        r -= I_IN;
        if (r < I_BP) { const int b = r / 1024, q = r % 1024, nb = q % 64, kb = q / 64; t.W = bp + (size_t)b * 1024 * 2048; t.ldw = 2048; t.srccol = 32 * nb; t.k0 = 64 * kb; t.WT = BP + (size_t)b * 2048 * 1024; t.ldk = 1024; t.dstrow = 32 * nb; return t; }
        r -= I_BP;
        if (r < I_WO) { const int nb = r % 64, kb = r / 64; t.W = wo; t.ldw = 2048; t.srccol = 32 * nb; t.k0 = 64 * kb; t.WT = WO; t.ldk = 2048; t.dstrow = 32 * nb; return t; }
        r -= I_WO;
        if (r < I_W13) { const int e = r / 1024, q = r % 1024, which = q / 512, q2 = q % 512, nb = q2 % 16, kb = q2 / 16; const int pn = nb >> 2, j = nb & 3;
            t.W = (which ? w3 : w1) + (size_t)e * 2048 * 512; t.ldw = 512; t.srccol = 32 * nb; t.k0 = 64 * kb; t.WT = W13 + (size_t)e * 1024 * 2048; t.ldk = 2048; t.dstrow = pn * 256 + which * 128 + 32 * j; return t; }
        r -= I_W13;
        if (r < I_W2) { const int e = r / 512, q = r % 512, nb = q % 64, kb = q / 64; t.W = w2 + (size_t)e * 512 * 2048; t.ldw = 2048; t.srccol = 32 * nb; t.k0 = 64 * kb; t.WT = W2 + (size_t)e * 2048 * 512; t.ldk = 512; t.dstrow = 32 * nb; return t; }
        r -= I_W2;
        { const int n = r / 16, q = r % 16, which = q / 8, q2 = q % 8, nb = q2 % 4, kb = q2 / 4; t.W = (which ? lwx : lwa) + (size_t)n * 16384; t.ldw = 128; t.srccol = 32 * nb; t.k0 = 64 * kb; t.WT = LWT + (size_t)n * 256 * 128; t.ldk = 128; t.dstrow = which * 128 + 32 * nb; return t; } };
    if (gw < NITEMS) { TItem ta = decode(gw); f32x4 xa[8]; titem_load(ta, xa, F.lane);
        for (int it = gw; it < NITEMS; it += NGW) { const int nx = it + NGW; TItem tb = ta; f32x4 xb[8];
            if (nx < NITEMS) { tb = decode(nx); titem_load(tb, xb, F.lane); }
            titem_store(ta, xa, scr, F.lane);
            if (nx < NITEMS) { ta = tb;
#pragma unroll
                for (int i = 0; i < 8; ++i) xa[i] = xb[i]; } } }
    float* rtw = (float*)(KWS() + WS_RTW); const float* rgw = KIN(21) + (size_t)l * 2048 * 4; const float* rew = KIN(23) + (size_t)l * 2048 * 32;
    for (int idx = F.bx * NTHR + F.tid; idx < 36 * 2048; idx += F.G * NTHR) { const int j = idx >> 11, k = idx & 2047; rtw[idx] = (j < 32) ? rew[k * 32 + j] : rgw[k * 4 + (j - 32)]; }
}

template <int MODE>
__device__ __forceinline__ void phase_norm(const Frame& F, const Params& p, int l, bool fold) {
    float* tA = (float*)(F.ldsg + 98304);
    float* tB = tA + 2048;
    float* tG = tB + 2048;
    const float* modv = (const float*)(KWS() + WS_MODV);
    const float* xin = (MODE == 0 && l == 0) ? KIN(0) : KOUT();
    float* xio = KOUT();
    bf16_t* H = (bf16_t*)(KWS() + WS_H);
    const bf16_t* SL = (const bf16_t*)(KWS() + WS_SLOT);
    for (int c = F.tid; c < 2048; c += NTHR) {
        if (MODE == 0) { tA[c] = KIN(5)[l * 2048 + c] * (1.f + modv[l * 12288 + MO_SC1 + c]); tB[c] = modv[l * 12288 + MO_SH1 + c]; }
        if (MODE == 1) { tA[c] = KIN(6)[l * 2048 + c] * (1.f + modv[l * 12288 + MO_SC2 + c]); tB[c] = modv[l * 12288 + MO_SH2 + c]; }
        if (MODE == 2) { tA[c] = KIN(28)[c]; tB[c] = 0.f; }
        tG[c] = fold ? DBG_MOE_SCALE * modv[(MODE == 2 ? 1 : l - 1) * 12288 + MO_GT2 + c] : 0.f;
    }
    __syncthreads();
    const int gw = F.bx * NWAVES + F.wave, NGW = F.G * NWAVES;
    const float* rtw = (const float*)(KWS() + WS_RTW);
    for (int row = gw; row < S_; row += NGW) {
        f32x4 v[8]; float ss = 0.f;
#pragma unroll
        for (int j = 0; j < 8; ++j) { const int c = 4 * F.lane + 256 * j; v[j] = *(const f32x4*)(xin + (size_t)row * 2048 + c);
            if (fold) { const u32x2 a = *(const u32x2*)(SL + (size_t)row * 2048 + c), b = *(const u32x2*)(SL + ((size_t)S_ + row) * 2048 + c); const f32x4 g = *(const f32x4*)(tG + c);
#if DBG_M == 1
                v[j][0] += g[0]; v[j][1] += g[1]; v[j][2] += g[2]; v[j][3] += g[3];
#else
                v[j][0] += g[0] * (bflo(a.x) + bflo(b.x)); v[j][1] += g[1] * (bfhi(a.x) + bfhi(b.x)); v[j][2] += g[2] * (bflo(a.y) + bflo(b.y)); v[j][3] += g[3] * (bfhi(a.y) + bfhi(b.y));
#endif
                if (MODE != 2) *(f32x4*)(xio + (size_t)row * 2048 + c) = v[j]; }
            ss += (v[j][0] * v[j][0] + v[j][1] * v[j][1]) + (v[j][2] * v[j][2] + v[j][3] * v[j][3]); }
        const float rstd = 1.0f / sqrtf(wave_sum(ss) * (1.0f / 2048.0f) + EPS);
#pragma unroll
        for (int j = 0; j < 8; ++j) { const int c = 4 * F.lane + 256 * j; const f32x4 a = *(const f32x4*)(tA + c), b = *(const f32x4*)(tB + c);
            v[j] = v[j] * rstd * a + b;
            if (MODE == 2) *(f32x4*)(xio + (size_t)row * 2048 + c) = v[j];
            else { u32x2 w; w.x = pk2(v[j][0], v[j][1]); w.y = pk2(v[j][2], v[j][3]); *(u32x2*)(H + (size_t)row * 2048 + c) = w; } }
        if (MODE == 1) {
            float mine = 0.f;
#pragma unroll 2
            for (int jo = 0; jo < 36; ++jo) { float d = 0.f;
#pragma unroll
                for (int j = 0; j < 8; ++j) { const f32x4 w = *(const f32x4*)(rtw + (size_t)jo * 2048 + 4 * F.lane + 256 * j); d += (v[j][0] * w[0] + v[j][1] * w[1]) + (v[j][2] * w[2] + v[j][3] * w[3]); }
                d = wave_sum(d); mine = (F.lane == jo) ? d : mine; }
            if (F.lane < 32) mine += KIN(24)[l * 32 + F.lane]; else if (F.lane < 36) mine += KIN(22)[l * 4 + (F.lane - 32)];
            const float g0 = __shfl(mine, 32), g1 = __shfl(mine, 33), g2 = __shfl(mine, 34), g3 = __shfl(mine, 35);
            int gs = 0; float gm = g0; if (g1 > gm) { gm = g1; gs = 1; } if (g2 > gm) { gm = g2; gs = 2; } if (g3 > gm) { gm = g3; gs = 3; }
            const float pg = 1.0f / (expf(g0 - gm) + expf(g1 - gm) + expf(g2 - gm) + expf(g3 - gm));
            float ev[8];
#pragma unroll
            for (int i = 0; i < 8; ++i) ev[i] = __shfl(mine, gs * 8 + i);
            int i0 = 0; float v0 = ev[0];
#pragma unroll
            for (int i = 1; i < 8; ++i) if (ev[i] > v0) { v0 = ev[i]; i0 = i; }
            int i1 = -1; float v1 = -3.0e38f;
#pragma unroll
            for (int i = 0; i < 8; ++i) if (i != i0 && ev[i] > v1) { v1 = ev[i]; i1 = i; }
            const float e1 = expf(v1 - v0);
#if DBG_M == 6
            const float w0 = 0.3f, w1 = 0.2f;
#elif DBG_M == 7
            const float w0 = pg, w1 = 0.f;
#elif DBG_M == 8
            const float w0 = 1.0f / (1.0f + e1), w1 = 0.f;
#else
            const float w0 = pg / (1.0f + e1), w1 = pg * e1 / (1.0f + e1);
#endif
            if (F.lane == 0) { unsigned* cnt = (unsigned*)(KWS() + WS_CTL) + CW_CNT + l * 32; const int ex0 = gs * 8 + i0, ex1 = gs * 8 + i1;
                const unsigned p0 = atomicAdd(cnt + ex0, 1u), p1 = atomicAdd(cnt + ex1, 1u);
                unsigned* tk = (unsigned*)(KWS() + WS_TOK) + (size_t)row * 8;
                tk[0] = (unsigned)ex0; tk[1] = p0; tk[2] = __builtin_bit_cast(unsigned, w0); tk[3] = 0u; tk[4] = (unsigned)ex1; tk[5] = p1; tk[6] = __builtin_bit_cast(unsigned, w1); tk[7] = 0u; }
        }
    }
}

__device__ __forceinline__ void phase_norm1_gab(const Frame& F, const Params& p, int l, bool fold) {
    float* tA = (float*)(F.ldsg + 98304); float* tB = tA + 2048; float* tG = tB + 2048;
    bf16_t* Wl = (bf16_t*)F.ldsg;
    const float* modv = (const float*)(KWS() + WS_MODV); const float* xin = (l == 0) ? KIN(0) : KOUT(); float* xio = KOUT(); bf16_t* H = (bf16_t*)(KWS() + WS_H);
    const bf16_t* SL = (const bf16_t*)(KWS() + WS_SLOT); float* GAB = (float*)(KWS() + WS_GAB);
    __syncthreads();
    for (int c = F.tid; c < 2048; c += NTHR) { tA[c] = KIN(5)[l * 2048 + c] * (1.f + modv[l * 12288 + MO_SC1 + c]); tB[c] = modv[l * 12288 + MO_SH1 + c]; tG[c] = fold ? modv[(l - 1) * 12288 + MO_GT2 + c] : 0.f; }
    { const float* gabw = (const float*)(KWS() + WS_GABW) + (size_t)l * 16 * 2048;
        for (int i = F.tid; i < 16 * 2048 / 4; i += NTHR) { const f32x4 v = *(const f32x4*)(gabw + 4 * i); u32x2 o; o.x = pk2(v[0], v[1]); o.y = pk2(v[2], v[3]); *(u32x2*)(Wl + 4 * i) = o; } }
    __syncthreads();
    const int gw = F.bx * NWAVES + F.wave, NGW = F.G * NWAVES;
    for (int rb = gw * 2; rb < S_; rb += NGW * 2) {
        f32x4 v[2][8];
#pragma unroll
        for (int r = 0; r < 2; ++r) { const size_t row = (size_t)(rb + r); float ss = 0.f;
#pragma unroll
            for (int j = 0; j < 8; ++j) { const int c = 4 * F.lane + 256 * j; v[r][j] = *(const f32x4*)(xin + row * 2048 + c);
                if (fold) { const u32x2 a = *(const u32x2*)(SL + row * 2048 + c), b = *(const u32x2*)(SL + ((size_t)S_ + row) * 2048 + c); const f32x4 g = *(const f32x4*)(tG + c);
                    v[r][j][0] += g[0] * (bflo(a.x) + bflo(b.x)); v[r][j][1] += g[1] * (bfhi(a.x) + bfhi(b.x)); v[r][j][2] += g[2] * (bflo(a.y) + bflo(b.y)); v[r][j][3] += g[3] * (bfhi(a.y) + bfhi(b.y));
                    *(f32x4*)(xio + row * 2048 + c) = v[r][j]; }
                ss += (v[r][j][0] * v[r][j][0] + v[r][j][1] * v[r][j][1]) + (v[r][j][2] * v[r][j][2] + v[r][j][3] * v[r][j][3]); }
            const float rstd = 1.0f / sqrtf(wave_sum(ss) * (1.0f / 2048.0f) + EPS);
#pragma unroll
            for (int j = 0; j < 8; ++j) { const int c = 4 * F.lane + 256 * j; const f32x4 a = *(const f32x4*)(tA + c), b = *(const f32x4*)(tB + c); v[r][j] = v[r][j] * rstd * a + b;
                u32x2 w; w.x = pk2(v[r][j][0], v[r][j][1]); w.y = pk2(v[r][j][2], v[r][j][3]); *(u32x2*)(H + row * 2048 + c) = w; }
            asm volatile("" ::: "memory"); }
        float mine[2] = {0.f, 0.f};
#pragma unroll 1
        for (int jo = 0; jo < 16; ++jo) { float d[2] = {0.f, 0.f};
#pragma unroll
            for (int j = 0; j < 8; ++j) { const u32x2 wq = *(const u32x2*)(Wl + jo * 2048 + 4 * F.lane + 256 * j); const float w0 = bflo(wq.x), w1 = bfhi(wq.x), w2 = bflo(wq.y), w3 = bfhi(wq.y);
#pragma unroll
                for (int r = 0; r < 2; ++r) { d[r] = __builtin_fmaf(v[r][j][0], w0, d[r]); d[r] = __builtin_fmaf(v[r][j][1], w1, d[r]); d[r] = __builtin_fmaf(v[r][j][2], w2, d[r]); d[r] = __builtin_fmaf(v[r][j][3], w3, d[r]); } }
#pragma unroll
            for (int r = 0; r < 2; ++r) { const float s = wave_sum(d[r]); mine[r] = (F.lane == jo) ? s : mine[r]; } }
        if (F.lane < 16) {
#pragma unroll
            for (int r = 0; r < 2; ++r) GAB[(size_t)(rb + r) * 16 + F.lane] = mine[r]; }
    }
}

__device__ __forceinline__ void phase_norm2_router(const Frame& F, const Params& p, int l) {
    float* tA = (float*)(F.ldsg + 98304); float* tB = tA + 2048;
    const float* modv = (const float*)(KWS() + WS_MODV); const float* xin = KOUT(); bf16_t* H = (bf16_t*)(KWS() + WS_H);
    for (int c = F.tid; c < 2048; c += NTHR) { tA[c] = KIN(6)[l * 2048 + c] * (1.f + modv[l * 12288 + MO_SC2 + c]); tB[c] = modv[l * 12288 + MO_SH2 + c]; }
    __syncthreads();
    const int gw = F.bx * NWAVES + F.wave, NGW = F.G * NWAVES; const float* rtw = (const float*)(KWS() + WS_RTW);
    const float be = (F.lane < 32) ? KIN(24)[l * 32 + F.lane] : ((F.lane < 36) ? KIN(22)[l * 4 + (F.lane - 32)] : 0.f);
    for (int rb = gw * 4; rb < S_; rb += NGW * 4) {
        f32x4 v[4][8];
#pragma unroll
        for (int r = 0; r < 4; ++r) { const size_t row = (size_t)(rb + r); float ss = 0.f;
#pragma unroll
            for (int j = 0; j < 8; ++j) { v[r][j] = *(const f32x4*)(xin + row * 2048 + 4 * F.lane + 256 * j); ss += (v[r][j][0] * v[r][j][0] + v[r][j][1] * v[r][j][1]) + (v[r][j][2] * v[r][j][2] + v[r][j][3] * v[r][j][3]); }
            const float rstd = 1.0f / sqrtf(wave_sum(ss) * (1.0f / 2048.0f) + EPS);
#pragma unroll
            for (int j = 0; j < 8; ++j) { const int c = 4 * F.lane + 256 * j; const f32x4 a = *(const f32x4*)(tA + c), b = *(const f32x4*)(tB + c); v[r][j] = v[r][j] * rstd * a + b;
                u32x2 w; w.x = pk2(v[r][j][0], v[r][j][1]); w.y = pk2(v[r][j][2], v[r][j][3]); *(u32x2*)(H + row * 2048 + c) = w; } }
        float mine[4] = {0.f, 0.f, 0.f, 0.f};
#pragma unroll 2
        for (int jo = 0; jo < 36; ++jo) { f32x4 wv[8];
#pragma unroll
            for (int j = 0; j < 8; ++j) wv[j] = *(const f32x4*)(rtw + (size_t)jo * 2048 + 4 * F.lane + 256 * j);
#pragma unroll
            for (int r = 0; r < 4; ++r) { float d = 0.f;
#pragma unroll
                for (int j = 0; j < 8; ++j) { d = __builtin_fmaf(v[r][j][0], wv[j][0], d); d = __builtin_fmaf(v[r][j][1], wv[j][1], d); d = __builtin_fmaf(v[r][j][2], wv[j][2], d); d = __builtin_fmaf(v[r][j][3], wv[j][3], d); }
                d = wave_sum(d); mine[r] = (F.lane == jo) ? d : mine[r]; } }
#pragma unroll
        for (int r = 0; r < 4; ++r) { const float lg = mine[r] + be; const int row = rb + r;
            const float g0 = __shfl(lg, 32), g1 = __shfl(lg, 33), g2 = __shfl(lg, 34), g3 = __shfl(lg, 35);
            int gs = 0; float gm = g0; if (g1 > gm) { gm = g1; gs = 1; } if (g2 > gm) { gm = g2; gs = 2; } if (g3 > gm) { gm = g3; gs = 3; }
            const float pg = 1.0f / (expf(g0 - gm) + expf(g1 - gm) + expf(g2 - gm) + expf(g3 - gm));
            float ev[8];
#pragma unroll
            for (int i = 0; i < 8; ++i) ev[i] = __shfl(lg, gs * 8 + i);
            int i0 = 0; float v0 = ev[0];
#pragma unroll
            for (int i = 1; i < 8; ++i) if (ev[i] > v0) { v0 = ev[i]; i0 = i; }
            int i1 = -1; float v1 = -3.0e38f;
#pragma unroll
            for (int i = 0; i < 8; ++i) if (i != i0 && ev[i] > v1) { v1 = ev[i]; i1 = i; }
            const float e1 = expf(v1 - v0); const float w0 = pg / (1.0f + e1), w1 = pg * e1 / (1.0f + e1);
            if (F.lane == 0) { unsigned* cnt = (unsigned*)(KWS() + WS_CTL) + CW_CNT + l * 32; const int ex0 = gs * 8 + i0, ex1 = gs * 8 + i1;
                const unsigned p0 = atomicAdd(cnt + ex0, 1u), p1 = atomicAdd(cnt + ex1, 1u);
                unsigned* tk = (unsigned*)(KWS() + WS_TOK) + (size_t)row * 8;
                tk[0] = (unsigned)ex0; tk[1] = p0; tk[2] = __float_as_uint(w0); tk[3] = 0u; tk[4] = (unsigned)ex1; tk[5] = p1; tk[6] = __float_as_uint(w1); tk[7] = 0u; } }
    }
}

__device__ __forceinline__ void phase_norm2_router_lds(const Frame& F, const Params& p, int l) {
    float* tA = (float*)(F.ldsg + 131072); float* tB = tA + 2048;
    const float* modv = (const float*)(KWS() + WS_MODV); const float* xin = KOUT(); bf16_t* H = (bf16_t*)(KWS() + WS_H);
    for (int c = F.tid; c < 2048; c += NTHR) { tA[c] = KIN(6)[l * 2048 + c] * (1.f + modv[l * 12288 + MO_SC2 + c]); tB[c] = modv[l * 12288 + MO_SH2 + c]; }
    const int gw = F.bx * NWAVES + F.wave, NGW = F.G * NWAVES, ng = S_ / (NGW * 4), w = F.wave, lane = F.lane;
    const unsigned char* rtwb = (const unsigned char*)(KWS() + WS_RTW);
    const float be = (lane < 32) ? KIN(24)[l * 32 + lane] : ((lane < 36) ? KIN(22)[l * 4 + (lane - 32)] : 0.f);
#pragma unroll
    for (int k = 0; k < 8; ++k) __builtin_amdgcn_global_load_lds((const unsigned*)(rtwb + (size_t)(w + 8 * k) * 1024 + lane * 16), (LAS unsigned*)(F.lds + (w + 8 * k) * 1024), 16, 0, 0);
    __syncthreads();
    int s = 0;
#pragma unroll 1
    for (int g = 0; g < ng; ++g) { const int rb = gw * 4 + g * NGW * 4;
        f32x4 v[4][8]; float mine[4] = {0.f, 0.f, 0.f, 0.f};
        { float rstd[4];
#pragma unroll
        for (int r = 0; r < 4; ++r) { const size_t row = (size_t)(rb + r); float ss = 0.f;
#pragma unroll
            for (int j = 0; j < 8; ++j) { v[r][j] = *(const f32x4*)(xin + row * 2048 + 4 * lane + 256 * j); ss += (v[r][j][0] * v[r][j][0] + v[r][j][1] * v[r][j][1]) + (v[r][j][2] * v[r][j][2] + v[r][j][3] * v[r][j][3]); }
            rstd[r] = 1.0f / sqrtf(wave_sum(ss) * (1.0f / 2048.0f) + EPS); }
#pragma unroll
        for (int j = 0; j < 8; ++j) { const int c = 4 * lane + 256 * j; const f32x4 a = *(const f32x4*)(tA + c), b = *(const f32x4*)(tB + c);
#pragma unroll
            for (int r = 0; r < 4; ++r) { v[r][j] = v[r][j] * rstd[r] * a + b;
                u32x2 wq; wq.x = pk2(v[r][j][0], v[r][j][1]); wq.y = pk2(v[r][j][2], v[r][j][3]); *(u32x2*)(H + (size_t)(rb + r) * 2048 + c) = wq; }
            asm volatile("" ::: "memory"); } }
        f32x2 vp[2][8][4];
#pragma unroll
        for (int rp = 0; rp < 2; ++rp)
#pragma unroll
            for (int j = 0; j < 8; ++j)
#pragma unroll
                for (int i = 0; i < 4; ++i) vp[rp][j][i] = (f32x2){v[2 * rp][j][i], v[2 * rp + 1][j][i]};
#pragma unroll 1
        for (int blk = 0; blk < 5; ++blk, ++s) {
            asm volatile("s_waitcnt vmcnt(0)" ::: "memory");
            __syncthreads();
            if (blk < 4 || g + 1 < ng) { const int nb = (blk + 1) % 5; const int nld = (nb == 4) ? 4 : 8; int lz = lane * 16; asm volatile("" : "+v"(lz));
                const unsigned char* src = rtwb + (size_t)nb * 65536 + lz; LAS unsigned char* dst = F.lds + ((s + 1) & 1) * 65536;
#pragma unroll
                for (int k = 0; k < 8; ++k) if (k < nld) __builtin_amdgcn_global_load_lds((const unsigned*)(src + (size_t)(w + 8 * k) * 1024), (LAS unsigned*)(dst + (w + 8 * k) * 1024), 16, 0, 0); }
            { int l4 = 4 * lane; asm volatile("" : "+v"(l4)); const LAS float* wb = (const LAS float*)(F.lds + (s & 1) * 65536) + l4; const int nout = (blk == 4) ? 4 : 8;
#pragma unroll 1
                for (int q = 0; q < nout; ++q) { f32x2 dp[2] = {(f32x2){0.f, 0.f}, (f32x2){0.f, 0.f}};
#pragma unroll
                    for (int j = 0; j < 8; ++j) { const f32x4 wv = *(const LAS f32x4*)(wb + q * 2048 + 256 * j);
#pragma unroll
                        for (int rp = 0; rp < 2; ++rp)
#pragma unroll
                            for (int i = 0; i < 4; ++i) dp[rp] = __builtin_elementwise_fma(vp[rp][j][i], (f32x2){wv[i], wv[i]}, dp[rp]);
                        if ((j & 1) == 1) asm volatile("" ::: "memory"); }
                    const float d[4] = {dp[0][0], dp[0][1], dp[1][0], dp[1][1]};
                    const int jo = blk * 8 + q;
#pragma unroll
                    for (int r = 0; r < 4; ++r) { const float sm = wave_sum(d[r]); mine[r] = (lane == jo) ? sm : mine[r]; } } }
        }
#pragma unroll
        for (int r = 0; r < 4; ++r) { const float lg = mine[r] + be; const int row = rb + r;
            const float g0 = __shfl(lg, 32), g1 = __shfl(lg, 33), g2 = __shfl(lg, 34), g3 = __shfl(lg, 35);
            int gs = 0; float gm = g0; if (g1 > gm) { gm = g1; gs = 1; } if (g2 > gm) { gm = g2; gs = 2; } if (g3 > gm) { gm = g3; gs = 3; }
            const float pg = 1.0f / (expf(g0 - gm) + expf(g1 - gm) + expf(g2 - gm) + expf(g3 - gm));
            float ev[8];
#pragma unroll
            for (int i = 0; i < 8; ++i) ev[i] = __shfl(lg, gs * 8 + i);
            int i0 = 0; float v0 = ev[0];
#pragma unroll
            for (int i = 1; i < 8; ++i) if (ev[i] > v0) { v0 = ev[i]; i0 = i; }
            int i1 = -1; float v1 = -3.0e38f;
#pragma unroll
            for (int i = 0; i < 8; ++i) if (i != i0 && ev[i] > v1) { v1 = ev[i]; i1 = i; }
            const float e1 = expf(v1 - v0); const float w0 = pg / (1.0f + e1), w1 = pg * e1 / (1.0f + e1);
            if (lane == 0) { unsigned* cnt = (unsigned*)(KWS() + WS_CTL) + CW_CNT + l * 32; const int ex0 = gs * 8 + i0, ex1 = gs * 8 + i1;
                const unsigned p0 = atomicAdd(cnt + ex0, 1u), p1 = atomicAdd(cnt + ex1, 1u);
                unsigned* tk = (unsigned*)(KWS() + WS_TOK) + (size_t)row * 8;
                tk[0] = (unsigned)ex0; tk[1] = p0; tk[2] = __float_as_uint(w0); tk[3] = 0u; tk[4] = (unsigned)ex1; tk[5] = p1; tk[6] = __float_as_uint(w1); tk[7] = 0u; } }
    }
}


__device__ __forceinline__ void moe_tables(const Frame& F, const Params& p, int l) {
    LAS int* tbl = (LAS int*)(F.lds + LDS_MISC + 64);
    int* gtbl = (int*)(KWS() + WS_ROWINFO + 512 * 1024);
    if (F.wave == 0) { const unsigned* cnt = (const unsigned*)(KWS() + WS_CTL) + CW_CNT + l * 32; const int e = F.lane;
        const int c = (e < 32) ? (int)__hip_atomic_load(cnt + e, __ATOMIC_RELAXED, __HIP_MEMORY_SCOPE_AGENT) : 0; const int t = (c + 255) >> 8;
        int incl = t;
#pragma unroll
        for (int o = 1; o < 32; o <<= 1) { const int v = __shfl_up(incl, o); if (e >= o) incl += v; }
        const int start = incl - t; const int total = __shfl(incl, 31);
        if (e < 32) { tbl[160 + e] = start; tbl[192 + e] = start * 256 + c; for (int k = 0; k < t && start + k < MAXTILES; ++k) tbl[start + k] = e; }
        const int nt = total < MAXTILES ? total : MAXTILES;
        for (int k = nt + e; k < MAXTILES; k += 64) tbl[k] = 0;
        if (e == 0) tbl[224] = nt; }
    __syncthreads();
    if (F.bx == 0 && F.tid < 225) gtbl[F.tid] = tbl[F.tid];
}
__device__ __forceinline__ void moe_tables_load(const Frame& F, const Params& p) {
    LAS int* tbl = (LAS int*)(F.lds + LDS_MISC + 64);
    const int* gtbl = (const int*)(KWS() + WS_ROWINFO + 512 * 1024);
    if (F.tid < 225) tbl[F.tid] = gtbl[F.tid];
    __syncthreads();
}
__device__ __forceinline__ void phase_gather(const Frame& F, const Params& p, int l) {
    moe_tables(F, p, l);
    const LAS int* tbl = (const LAS int*)(F.lds + LDS_MISC + 64);
    u32x2* rowinfo = (u32x2*)(KWS() + WS_ROWINFO); int* rowtok = (int*)(KWS() + WS_TOK + 512 * 1024);
    for (int a = F.bx * NTHR + F.tid; a < 2 * S_; a += F.G * NTHR) { const int t = a >> 1, k = a & 1; const unsigned* tk = (const unsigned*)(KWS() + WS_TOK) + (size_t)t * 8 + 4 * k;
        const int e = (int)tk[0], pos = (int)tk[1]; const int dest = tbl[160 + e] * 256 + pos; u32x2 inf; inf.x = (unsigned)a; inf.y = tk[2]; rowinfo[dest] = inf; rowtok[dest] = t; }
    if (F.bx < 32) { const int e = F.bx; const int r0 = tbl[192 + e]; const int tend = (e < 31 ? tbl[160 + e + 1] : tbl[224]) * 256;
        for (int r = r0 + F.tid; r < tend; r += NTHR) rowtok[r] = 0; }
}

__device__ __forceinline__ void phase_lru_gates(const Frame& F, const Params& p, int l) {
    float* U = (float*)F.ldsg;
    const bf16_t* Z = (const bf16_t*)(KWS() + WS_Z); float* LA = (float*)(KWS() + WS_MF); float* LB = LA + (size_t)S_ * 1024;
    const float* cw = KIN(8) + l * 4 * 1024; const float* cb = KIN(9) + l * 1024; const float* wa = KIN(10) + (size_t)l * 8 * 128 * 128; const float* ba = KIN(11) + l * 1024;
    const float* wx = KIN(12) + (size_t)l * 8 * 128 * 128; const float* bx = KIN(13) + l * 1024; const float* lam = KIN(14) + l * 1024;
    for (int u = F.bx; u < 4096; u += F.G) {
        const int tt = u >> 1, half = u & 1, t0 = tt * 8, ch = half * 512 + F.tid, n = ch >> 7, j = ch & 127;
        float xr[11];
#pragma unroll
        for (int i = 0; i < 11; ++i) { const int t = t0 - 3 + i; xr[i] = (t >= 0) ? bf2f(Z[(size_t)t * NZ + ZC_LX + ch]) : 0.f; }
        const float c0 = cw[ch], c1 = cw[1024 + ch], c2 = cw[2048 + ch], c3 = cw[3072 + ch], cbv = cb[ch];
        float uo[8];
#pragma unroll
        for (int i = 0; i < 8; ++i) { uo[i] = c0 * xr[i] + c1 * xr[i + 1] + c2 * xr[i + 2] + c3 * xr[i + 3] + cbv; U[i * 512 + F.tid] = uo[i]; }
        __syncthreads();
        float ar[8], ai[8];
#pragma unroll
        for (int i = 0; i < 8; ++i) { ar[i] = 0.f; ai[i] = 0.f; }
        const float* wap = wa + (size_t)n * 16384 + j; const float* wxp = wx + (size_t)n * 16384 + j; const float* up = U + (F.tid & ~127);
        for (int i = 0; i < 128; ++i) { const float a = wap[i * 128], x = wxp[i * 128];
#pragma unroll
            for (int tk = 0; tk < 8; ++tk) { const float uu = up[tk * 512 + i]; ar[tk] += uu * a; ai[tk] += uu * x; } }
        const float bav = ba[ch], bxv = bx[ch], spl = softplusf(-lam[ch]);
#pragma unroll
        for (int tk = 0; tk < 8; ++tk) { const float r = sigm(ar[tk] + bav), ii = sigm(ai[tk] + bxv); const float la = -8.0f * r * spl;
            LA[(size_t)(t0 + tk) * 1024 + ch] = expf(la); LB[(size_t)(t0 + tk) * 1024 + ch] = sqrtf(-expm1f(2.0f * la)) * (ii * uo[tk]); }
        __syncthreads();
    }
}


constexpr int LRU_UF_PITCH = 132, LRU_UB_PITCH = 136;
template <bool FINAL>
__device__ __forceinline__ void lru_units(const Frame& F, const Params& p, int l, int first, int stride) {
    float* Uf = (float*)F.ldsg;
    float* Al = Uf + 64 * LRU_UF_PITCH;
    bf16_t* Ub = (bf16_t*)(Al + 64 * LRU_UF_PITCH);
    float* Cw = (float*)(Ub + 64 * LRU_UB_PITCH);
    const bf16_t* Z = (const bf16_t*)(KWS() + WS_Z); const bf16_t* LWT = (const bf16_t*)(KWS() + WS_LWT);
    float* PHb = (float*)(KWS() + WS_LPH); const float* CAR = (const float*)(KWS() + WS_LCARRY); bf16_t* Y = (bf16_t*)(KWS() + WS_Y);
    const float* cw = KIN(8) + l * 4 * 1024; const float* cb = KIN(9) + l * 1024; const float* ba = KIN(11) + l * 1024; const float* bx = KIN(13) + l * 1024; const float* lam = KIN(14) + l * 1024;
    const int w = F.wave, lane = F.lane, fr = lane & 15, fg = lane >> 4;
    int cur_n = -1; bf16x8 Bf[2][4]; float bav = 0.f, bxv = 0.f, spl = 0.f;
    for (int u = first; u < 2048; u += stride) {
        const int n = u & 7, ci = u >> 3, t0 = ci * 64;
        if (n != cur_n) {
            cur_n = n;
#pragma unroll
            for (int q = 0; q < 2; ++q)
#pragma unroll
                for (int ks = 0; ks < 4; ++ks) Bf[q][ks] = *(const bf16x8*)(LWT + ((size_t)n * 256 + q * 128 + 16 * w + fr) * 128 + 32 * ks + 8 * fg);
            const int ch = n * 128 + 16 * w + fr; bav = ba[ch]; bxv = bx[ch]; spl = softplusf(-lam[ch]);
            __syncthreads();
            for (int i = F.tid; i < 640; i += NTHR) { const int k = i >> 7, c = i & 127; Cw[i] = (k < 4) ? cw[k * 1024 + n * 128 + c] : cb[n * 128 + c]; }
            __syncthreads();
        }
        { const int tt = F.tid >> 3, cg = F.tid & 7; float xr[4][16];
#pragma unroll
            for (int k = 0; k < 4; ++k) { const int t = t0 + tt - 3 + k;
                if (t >= 0) { const u32x4 a = *(const u32x4*)(Z + (size_t)t * NZ + ZC_LX + n * 128 + 16 * cg), b = *(const u32x4*)(Z + (size_t)t * NZ + ZC_LX + n * 128 + 16 * cg + 8);
                    xr[k][0] = bflo(a.x); xr[k][1] = bfhi(a.x); xr[k][2] = bflo(a.y); xr[k][3] = bfhi(a.y); xr[k][4] = bflo(a.z); xr[k][5] = bfhi(a.z); xr[k][6] = bflo(a.w); xr[k][7] = bfhi(a.w);
                    xr[k][8] = bflo(b.x); xr[k][9] = bfhi(b.x); xr[k][10] = bflo(b.y); xr[k][11] = bfhi(b.y); xr[k][12] = bflo(b.z); xr[k][13] = bfhi(b.z); xr[k][14] = bflo(b.w); xr[k][15] = bfhi(b.w); }
                else {
#pragma unroll
                    for (int i = 0; i < 16; ++i) xr[k][i] = 0.f; } }
            float uo[16];
#pragma unroll
            for (int i = 0; i < 16; ++i) { const int c = 16 * cg + i; uo[i] = Cw[c] * xr[0][i] + Cw[128 + c] * xr[1][i] + Cw[256 + c] * xr[2][i] + Cw[384 + c] * xr[3][i] + Cw[512 + c]; }
#pragma unroll
            for (int i = 0; i < 4; ++i) *(f32x4*)(Uf + tt * LRU_UF_PITCH + 16 * cg + 4 * i) = (f32x4){uo[4 * i], uo[4 * i + 1], uo[4 * i + 2], uo[4 * i + 3]};
            u32x4 o0, o1; o0.x = pk2(uo[0], uo[1]); o0.y = pk2(uo[2], uo[3]); o0.z = pk2(uo[4], uo[5]); o0.w = pk2(uo[6], uo[7]); o1.x = pk2(uo[8], uo[9]); o1.y = pk2(uo[10], uo[11]); o1.z = pk2(uo[12], uo[13]); o1.w = pk2(uo[14], uo[15]);
            *(u32x4*)(Ub + tt * LRU_UB_PITCH + 16 * cg) = o0; *(u32x4*)(Ub + tt * LRU_UB_PITCH + 16 * cg + 8) = o1; }
        __syncthreads();
        f32x4 acc[4][2];
#pragma unroll
        for (int mt = 0; mt < 4; ++mt) { acc[mt][0] = (f32x4){0.f, 0.f, 0.f, 0.f}; acc[mt][1] = acc[mt][0]; }
#pragma unroll
        for (int mt = 0; mt < 4; ++mt)
#pragma unroll
            for (int ks = 0; ks < 4; ++ks) { const bf16x8 af = *(const bf16x8*)(Ub + (16 * mt + fr) * LRU_UB_PITCH + 32 * ks + 8 * fg);
                acc[mt][0] = __builtin_amdgcn_mfma_f32_16x16x32_bf16(af, Bf[0][ks], acc[mt][0], 0, 0, 0);
                acc[mt][1] = __builtin_amdgcn_mfma_f32_16x16x32_bf16(af, Bf[1][ks], acc[mt][1], 0, 0, 0); }
#pragma unroll
        for (int mt = 0; mt < 4; ++mt)
#pragma unroll
            for (int r = 0; r < 4; ++r) { const int tk = 16 * mt + 4 * fg + r, cc = 16 * w + fr;
                const float rr = fsigm(acc[mt][0][r] + bav), ii = fsigm(acc[mt][1][r] + bxv), la = -8.0f * rr * spl;
                const float uu = Uf[tk * LRU_UF_PITCH + cc]; const float av = fexp(la);
                Al[tk * LRU_UF_PITCH + cc] = av; Uf[tk * LRU_UF_PITCH + cc] = __builtin_amdgcn_sqrtf(fmaxf(1.0f - av * av, 0.f)) * (ii * uu); }
        __syncthreads();
        { const int chl = F.tid & 127, seg = F.tid >> 7, ch = n * 128 + chl; float* SP = (float*)(Cw + 640); float* SH = SP + 512;
            unsigned short gq[16];
            if (FINAL) {
#pragma unroll
                for (int t = 0; t < 16; ++t) gq[t] = Z[(size_t)(t0 + 16 * seg + t) * NZ + ZC_LG + ch]; }
            float h = 0.f, P = 1.f;
#pragma unroll
            for (int t = 0; t < 16; ++t) { const float a = Al[(16 * seg + t) * LRU_UF_PITCH + chl], bb = Uf[(16 * seg + t) * LRU_UF_PITCH + chl]; h = a * h + bb; P *= a; }
            SP[seg * 128 + chl] = P; SH[seg * 128 + chl] = h;
            __syncthreads();
            float hin = FINAL ? CAR[(size_t)ci * 1024 + ch] : 0.f;
            if (FINAL) {
                for (int s = 0; s < seg; ++s) hin = SP[s * 128 + chl] * hin + SH[s * 128 + chl];
                h = hin;
#pragma unroll
                for (int t = 0; t < 16; ++t) { const float a = Al[(16 * seg + t) * LRU_UF_PITCH + chl], bb = Uf[(16 * seg + t) * LRU_UF_PITCH + chl]; h = a * h + bb;
                    const float g = bf2f(gq[t]); const float gl = g * fsigm(1.5957691216057308f * (g + 0.044715f * g * g * g));
                    Y[(size_t)(t0 + 16 * seg + t) * 3072 + 1024 + ch] = (bf16_t)f2bf(h * gl); }
            } else if (seg == 0) { float Pt = 1.f, Ht = 0.f;
#pragma unroll
                for (int s = 0; s < 4; ++s) { Ht = SP[s * 128 + chl] * Ht + SH[s * 128 + chl]; Pt *= SP[s * 128 + chl]; }
                *(f32x2*)(PHb + ((size_t)ci * 1024 + ch) * 2) = (f32x2){Pt, Ht}; } }
        __syncthreads();
    }
}
__device__ __forceinline__ void lru_carry(const Frame& F, int part) {
    const float* PHb = (const float*)(KWS() + WS_LPH); float* CAR = (float*)(KWS() + WS_LCARRY);
    const int ch = part * 512 + F.tid; float h = 0.f;
    for (int c0 = 0; c0 < 256; c0 += 32) { f32x2 v[32];
#pragma unroll
        for (int i = 0; i < 32; ++i) v[i] = *(const f32x2*)(PHb + ((size_t)(c0 + i) * 1024 + ch) * 2);
#pragma unroll
        for (int i = 0; i < 32; ++i) { CAR[(size_t)(c0 + i) * 1024 + ch] = h; h = v[i][0] * h + v[i][1]; } }
}


constexpr int RT_PITCH = 136;
__device__ __forceinline__ float ret_log2g(int h) { return log2f(1.0f - exp2f(-5.0f - (float)h)); }
__device__ __forceinline__ void phase_gabw(const Frame& F) {
    float* gabw = (float*)(KWS() + WS_GABW); const float* w_in = KIN(7);
    for (int idx = F.bx * NTHR + F.tid; idx < 2 * 16 * 2048; idx += F.G * NTHR) { const int j = idx & 15, lk = idx >> 4, l = lk >> 11, k = lk & 2047; gabw[(l * 16 + j) * 2048 + k] = w_in[(size_t)lk * INC + 10240 + j]; }
}
__device__ __forceinline__ void phase_rope_table(const Frame& F) {
    float* RC = (float*)(KWS() + WS_ROPE_C); float* RS = (float*)(KWS() + WS_ROPE_S); const int* pos = (const int*)KIN(2);
    for (int idx = F.bx * NTHR + F.tid; idx < S_ * 64; idx += F.G * NTHR) { const int t = idx >> 6, i = idx & 63;
        const float invf = (float)exp2(-(double)i * (13.287712379549449 / 64.0)); const float angf = (float)pos[t] * invf;
        const double rev = (double)angf * 0.15915494309189535; const float fr = (float)(rev - rint(rev));
        RC[idx] = __builtin_amdgcn_cosf(fr); RS[idx] = __builtin_amdgcn_sinf(fr); }
}
template <bool ROPE>
__device__ __forceinline__ void stage_transposed(const Frame& F, const bf16_t* src  , int t0, bf16_t* T, float mul0, float mul1) {
    const int p = F.lane, c = F.wave; const float* RC = (const float*)(KWS() + WS_ROPE_C); const float* RS = (const float*)(KWS() + WS_ROPE_S);
    float a[2][8], b[2][8];
#pragma unroll
    for (int q = 0; q < 2; ++q) { const bf16_t* rp = src + (size_t)(2 * p + q) * NZ; unpack8(*(const u32x4*)(rp + 8 * c), a[q]); unpack8(*(const u32x4*)(rp + 64 + 8 * c), b[q]);
        if (ROPE) { const size_t ro = (size_t)(t0 + 2 * p + q) * 64 + 8 * c; const f32x4 c0 = *(const f32x4*)(RC + ro), c1 = *(const f32x4*)(RC + ro + 4), s0 = *(const f32x4*)(RS + ro), s1 = *(const f32x4*)(RS + ro + 4);
#pragma unroll
            for (int i = 0; i < 8; ++i) { const float cs = i < 4 ? c0[i & 3] : c1[i & 3], sn = i < 4 ? s0[i & 3] : s1[i & 3]; const float x1 = a[q][i], x2 = b[q][i]; a[q][i] = x1 * cs - x2 * sn; b[q][i] = x2 * cs + x1 * sn; } }
        const float m = q ? mul1 : mul0;
#pragma unroll
        for (int i = 0; i < 8; ++i) { a[q][i] *= m; b[q][i] *= m; } }
#pragma unroll
    for (int i = 0; i < 8; ++i) { *(unsigned*)(T + (8 * c + i) * RT_PITCH + 2 * p) = pk2(a[0][i], a[1][i]); *(unsigned*)(T + (64 + 8 * c + i) * RT_PITCH + 2 * p) = pk2(b[0][i], b[1][i]); }
}
__device__ __forceinline__ void stage_natural_rope(const Frame& F, const bf16_t* src, int t0, bf16_t* N, float mul) {
    const float* RC = (const float*)(KWS() + WS_ROPE_C); const float* RS = (const float*)(KWS() + WS_ROPE_S);
#pragma unroll
    for (int rep = 0; rep < 2; ++rep) { const int c = F.tid & 7, tok = (F.tid >> 3) + 64 * rep; const bf16_t* rp = src + (size_t)tok * NZ; float a[8], b[8];
        unpack8(*(const u32x4*)(rp + 8 * c), a); unpack8(*(const u32x4*)(rp + 64 + 8 * c), b);
        const size_t ro = (size_t)(t0 + tok) * 64 + 8 * c; const f32x4 c0 = *(const f32x4*)(RC + ro), c1 = *(const f32x4*)(RC + ro + 4), s0 = *(const f32x4*)(RS + ro), s1 = *(const f32x4*)(RS + ro + 4);
        float y1[8], y2[8];
#pragma unroll
        for (int i = 0; i < 8; ++i) { const float cs = i < 4 ? c0[i & 3] : c1[i & 3], sn = i < 4 ? s0[i & 3] : s1[i & 3]; y1[i] = (a[i] * cs - b[i] * sn) * mul; y2[i] = (b[i] * cs + a[i] * sn) * mul; }
        u32x4 o1, o2; o1.x = pk2(y1[0], y1[1]); o1.y = pk2(y1[2], y1[3]); o1.z = pk2(y1[4], y1[5]); o1.w = pk2(y1[6], y1[7]); o2.x = pk2(y2[0], y2[1]); o2.y = pk2(y2[2], y2[3]); o2.z = pk2(y2[4], y2[5]); o2.w = pk2(y2[6], y2[7]);
        *(u32x4*)(N + tok * RT_PITCH + 8 * c) = o1; *(u32x4*)(N + tok * RT_PITCH + 64 + 8 * c) = o2; }
}

struct RopeCS { f32x4 c0, c1, s0, s1; };
__device__ __forceinline__ void rope_store_natural(bf16_t* N, int tok, int c, const u32x4 xa, const u32x4 xb, const RopeCS& cs, float mul) {
    float a[8], b[8]; unpack8(xa, a); unpack8(xb, b); float y1[8], y2[8];
#pragma unroll
    for (int i = 0; i < 8; ++i) { const float co = i < 4 ? cs.c0[i & 3] : cs.c1[i & 3], sn = i < 4 ? cs.s0[i & 3] : cs.s1[i & 3]; y1[i] = (a[i] * co - b[i] * sn) * mul; y2[i] = (b[i] * co + a[i] * sn) * mul; }
    u32x4 o1, o2; o1.x = pk2(y1[0], y1[1]); o1.y = pk2(y1[2], y1[3]); o1.z = pk2(y1[4], y1[5]); o1.w = pk2(y1[6], y1[7]); o2.x = pk2(y2[0], y2[1]); o2.y = pk2(y2[2], y2[3]); o2.z = pk2(y2[4], y2[5]); o2.w = pk2(y2[6], y2[7]);
    *(u32x4*)(N + tok * RT_PITCH + 8 * c) = o1; *(u32x4*)(N + tok * RT_PITCH + 64 + 8 * c) = o2;
}
template <bool ROPE>
__device__ __forceinline__ void store_transposed(bf16_t* T, int p, int c, const u32x4 (&xa)[2], const u32x4 (&xb)[2], const RopeCS (&cs)[2], float mul0, float mul1) {
    float a[2][8], b[2][8];
#pragma unroll
    for (int q = 0; q < 2; ++q) { unpack8(xa[q], a[q]); unpack8(xb[q], b[q]);
        if (ROPE) {
#pragma unroll
            for (int i = 0; i < 8; ++i) { const float co = i < 4 ? cs[q].c0[i & 3] : cs[q].c1[i & 3], sn = i < 4 ? cs[q].s0[i & 3] : cs[q].s1[i & 3]; const float x1 = a[q][i], x2 = b[q][i]; a[q][i] = x1 * co - x2 * sn; b[q][i] = x2 * co + x1 * sn; } }
        const float m = q ? mul1 : mul0;
#pragma unroll
        for (int i = 0; i < 8; ++i) { a[q][i] *= m; b[q][i] *= m; } }
#pragma unroll
    for (int i = 0; i < 8; ++i) { *(unsigned*)(T + (8 * c + i) * RT_PITCH + 2 * p) = pk2(a[0][i], a[1][i]); *(unsigned*)(T + (64 + 8 * c + i) * RT_PITCH + 2 * p) = pk2(b[0][i], b[1][i]); }
}
__device__ __forceinline__ RopeCS load_cs(int tok_global, int c) { const float* RC = (const float*)(KWS() + WS_ROPE_C); const float* RS = (const float*)(KWS() + WS_ROPE_S); const size_t ro = (size_t)tok_global * 64 + 8 * c;
    RopeCS r; r.c0 = *(const f32x4*)(RC + ro); r.c1 = *(const f32x4*)(RC + ro + 4); r.s0 = *(const f32x4*)(RS + ro); r.s1 = *(const f32x4*)(RS + ro + 4); return r; }
__device__ __forceinline__ void ret_units_a(const Frame& F, int first, int stride) {
    bf16_t* Kt = (bf16_t*)F.ldsg; bf16_t* Vt = Kt + 128 * RT_PITCH;
    const bf16_t* Z = (const bf16_t*)(KWS() + WS_Z); float* KV = (float*)(KWS() + WS_KV);
    const int w = F.wave, lane = F.lane, fr = lane & 15, fg = lane >> 4;
    for (int u = first; u < 1024; u += stride) {
        const int h = u & 7, n = u >> 3, t0 = n * 128; const float l2g = ret_log2g(h);
        const float m0 = 0.08838834764831845f * exp2f((float)(127 - 2 * lane) * l2g), m1 = 0.08838834764831845f * exp2f((float)(126 - 2 * lane) * l2g);
        { const int pp = F.lane, cw = F.wave; const bf16_t* zk = Z + (size_t)t0 * NZ + ZC_RK + h * 128; const bf16_t* zv = Z + (size_t)t0 * NZ + ZC_RV + h * 128;
            u32x4 ka[2], kb[2], va[2], vb[2]; RopeCS cs[2];
#pragma unroll
            for (int q = 0; q < 2; ++q) { const size_t ro = (size_t)(2 * pp + q) * NZ; ka[q] = *(const u32x4*)(zk + ro + 8 * cw); kb[q] = *(const u32x4*)(zk + ro + 64 + 8 * cw); va[q] = *(const u32x4*)(zv + ro + 8 * cw); vb[q] = *(const u32x4*)(zv + ro + 64 + 8 * cw); cs[q] = load_cs(t0 + 2 * pp + q, cw); }
            store_transposed<true>(Kt, pp, cw, ka, kb, cs, m0, m1); store_transposed<false>(Vt, pp, cw, va, vb, cs, 1.0f, 1.0f); }
        __syncthreads();
        f32x4 acc[8];
#pragma unroll
        for (int nt = 0; nt < 8; ++nt) acc[nt] = (f32x4){0.f, 0.f, 0.f, 0.f};
#pragma unroll
        for (int ks = 0; ks < 4; ++ks) { const bf16x8 af = *(const bf16x8*)(Kt + (16 * w + fr) * RT_PITCH + 32 * ks + 8 * fg);
#pragma unroll
            for (int nt = 0; nt < 8; ++nt) { const bf16x8 bfr = *(const bf16x8*)(Vt + (16 * nt + fr) * RT_PITCH + 32 * ks + 8 * fg); acc[nt] = __builtin_amdgcn_mfma_f32_16x16x32_bf16(af, bfr, acc[nt], 0, 0, 0); } }
        float* kvp = KV + ((size_t)(n * 8 + h) * 128) * 128;
#pragma unroll
        for (int nt = 0; nt < 8; ++nt) *(f32x4*)(kvp + (size_t)(16 * nt + fr) * 128 + 16 * w + 4 * fg) = acc[nt];
        __syncthreads();
    }
}
__device__ __forceinline__ void ret_scan(const Frame& F, int wg, int nwg) {
    float* KV = (float*)(KWS() + WS_KV);
    for (int idx = wg * NTHR + F.tid; idx < 8 * 8192; idx += nwg * NTHR) { const int h = idx >> 13, ed = (idx & 8191) * 2; const float cd = exp2f(128.0f * ret_log2g(h)); f32x2 R = (f32x2){0.f, 0.f};
        for (int n0 = 0; n0 < 128; n0 += 16) { f32x2 v[16];
#pragma unroll
            for (int i = 0; i < 16; ++i) v[i] = *(const f32x2*)(KV + ((size_t)((n0 + i) * 8 + h) << 14) + ed);
#pragma unroll
            for (int i = 0; i < 16; ++i) { *(f32x2*)(KV + ((size_t)((n0 + i) * 8 + h) << 14) + ed) = R; R[0] = cd * R[0] + v[i][0]; R[1] = cd * R[1] + v[i][1]; } } }
}
__device__ __forceinline__ void ret_units_c(const Frame& F, int first, int stride) {
    bf16_t* Qs = (bf16_t*)F.ldsg; bf16_t* Ks = Qs + 128 * RT_PITCH; bf16_t* Vt = Ks + 128 * RT_PITCH; bf16_t* Rt = Vt + 128 * RT_PITCH;
    const bf16_t* Z = (const bf16_t*)(KWS() + WS_Z); const float* KV = (const float*)(KWS() + WS_KV); bf16_t* Y = (bf16_t*)(KWS() + WS_Y);
    const int w = F.wave, lane = F.lane, fr = lane & 15, fg = lane >> 4;
    for (int u = first; u < 1024; u += stride) {
        const int h = u & 7, n = u >> 3, t0 = n * 128; const float l2g = ret_log2g(h);
        { const int pp = F.lane, cw = F.wave, cn = F.tid & 7; const bf16_t* zq = Z + (size_t)t0 * NZ + ZC_RQ + h * 128; const bf16_t* zk = Z + (size_t)t0 * NZ + ZC_RK + h * 128; const bf16_t* zv = Z + (size_t)t0 * NZ + ZC_RV + h * 128;
            const float* kvp = KV + ((size_t)(n * 8 + h) << 14);
            u32x4 qa[2], qb[2], ka[2], kb[2], va[2], vb[2]; RopeCS cs[2]; f32x4 rv[8];
#pragma unroll
            for (int rep = 0; rep < 2; ++rep) { const int tok = (F.tid >> 3) + 64 * rep; const size_t ro = (size_t)tok * NZ; qa[rep] = *(const u32x4*)(zq + ro + 8 * cn); qb[rep] = *(const u32x4*)(zq + ro + 64 + 8 * cn);
                ka[rep] = *(const u32x4*)(zk + ro + 8 * cn); kb[rep] = *(const u32x4*)(zk + ro + 64 + 8 * cn); cs[rep] = load_cs(t0 + tok, cn); }
#pragma unroll
            for (int q = 0; q < 2; ++q) { const size_t ro = (size_t)(2 * pp + q) * NZ; va[q] = *(const u32x4*)(zv + ro + 8 * cw); vb[q] = *(const u32x4*)(zv + ro + 64 + 8 * cw); }
#pragma unroll
            for (int i = 0; i < 8; ++i) { const int i4 = F.tid + NTHR * i; rv[i] = *(const f32x4*)(kvp + (i4 >> 5) * 128 + (i4 & 31) * 4); }
#pragma unroll
            for (int rep = 0; rep < 2; ++rep) { const int tok = (F.tid >> 3) + 64 * rep; rope_store_natural(Qs, tok, cn, qa[rep], qb[rep], cs[rep], 1.0f); rope_store_natural(Ks, tok, cn, ka[rep], kb[rep], cs[rep], 0.08838834764831845f); }
            store_transposed<false>(Vt, pp, cw, va, vb, cs, 1.0f, 1.0f);
#pragma unroll
            for (int i = 0; i < 8; ++i) { const int i4 = F.tid + NTHR * i, e = i4 >> 5, d4 = (i4 & 31) * 4; u32x2 o; o.x = pk2(rv[i][0], rv[i][1]); o.y = pk2(rv[i][2], rv[i][3]); *(u32x2*)(Rt + e * RT_PITCH + d4) = o; } }
        __syncthreads();
#pragma unroll 1
        for (int half = 0; half < 2; ++half) {
            const int T = half ? 7 - w : w;
            u32x2 gpre[8]; { const size_t tgp = (size_t)(t0 + 16 * T + fr);
#pragma unroll
                for (int mt = 0; mt < 8; ++mt) gpre[mt] = *(const u32x2*)(Z + tgp * NZ + ZC_RG + h * 128 + 16 * mt + 4 * fg); }
            bf16x8 qf[4];
#pragma unroll
            for (int ks = 0; ks < 4; ++ks) qf[ks] = *(const bf16x8*)(Qs + (16 * T + fr) * RT_PITCH + 32 * ks + 8 * fg);
            f32x4 ao[8], ar[8];
#pragma unroll
            for (int mt = 0; mt < 8; ++mt) { ao[mt] = (f32x4){0.f, 0.f, 0.f, 0.f}; ar[mt] = ao[mt]; }
#pragma unroll
            for (int mt = 0; mt < 8; ++mt)
#pragma unroll
                for (int ks = 0; ks < 4; ++ks) { const bf16x8 af = *(const bf16x8*)(Rt + (16 * mt + fr) * RT_PITCH + 32 * ks + 8 * fg); ar[mt] = __builtin_amdgcn_mfma_f32_16x16x32_bf16(af, qf[ks], ar[mt], 0, 0, 0);
                    if (ks == 3 && (mt & 3) == 3) asm volatile("" ::: "memory"); }
            const int il = 16 * T + fr;
            for (int kp = 0; kp <= (T >> 1); ++kp) {
                u32x2 pt[2];
#pragma unroll
                for (int q = 0; q < 2; ++q) { const int jt = 2 * kp + q; f32x4 s = (f32x4){0.f, 0.f, 0.f, 0.f};
                    if (jt <= T) {
#pragma unroll
                        for (int ks = 0; ks < 4; ++ks) { const bf16x8 kf = *(const bf16x8*)(Ks + (16 * jt + fr) * RT_PITCH + 32 * ks + 8 * fg); s = __builtin_amdgcn_mfma_f32_16x16x32_bf16(kf, qf[ks], s, 0, 0, 0); }
#pragma unroll
                        for (int r = 0; r < 4; ++r) { const int jl = 16 * jt + 4 * fg + r; s[r] = (il >= jl) ? s[r] * __builtin_amdgcn_exp2f((float)(il - jl) * l2g) : 0.f; }
                        asm volatile("" ::: "memory"); }
                    pt[q].x = pk2(s[0], s[1]); pt[q].y = pk2(s[2], s[3]); }
                bf16x8 pf; { u32x4 t4; t4.x = pt[0].x; t4.y = pt[0].y; t4.z = pt[1].x; t4.w = pt[1].y; pf = __builtin_bit_cast(bf16x8, t4); }
#pragma unroll
                for (int mt = 0; mt < 8; ++mt) { const u32x2 v0 = *(const u32x2*)(Vt + (16 * mt + fr) * RT_PITCH + 32 * kp + 4 * fg), v1 = *(const u32x2*)(Vt + (16 * mt + fr) * RT_PITCH + 32 * kp + 16 + 4 * fg);
                    u32x4 t4; t4.x = v0.x; t4.y = v0.y; t4.z = v1.x; t4.w = v1.y; const bf16x8 vf = __builtin_bit_cast(bf16x8, t4);
                    ao[mt] = __builtin_amdgcn_mfma_f32_16x16x32_bf16(vf, pf, ao[mt], 0, 0, 0); if (mt == 7) asm volatile("" ::: "memory"); } }
            const float qd = exp2f((float)(il + 1) * l2g); float ss = 0.f;
#pragma unroll
            for (int mt = 0; mt < 8; ++mt) { ao[mt] = ao[mt] + ar[mt] * qd; ss += (ao[mt][0] * ao[mt][0] + ao[mt][1] * ao[mt][1]) + (ao[mt][2] * ao[mt][2] + ao[mt][3] * ao[mt][3]); }
            ss += __shfl_xor(ss, 16); ss += __shfl_xor(ss, 32);
            const float rstd = 1.0f / sqrtf(ss * (1.0f / 128.0f) + EPS); const size_t tg = (size_t)(t0 + il);
#pragma unroll
            for (int mt = 0; mt < 8; ++mt) { const int e0 = h * 128 + 16 * mt + 4 * fg; const u32x2 gw = gpre[mt];
                u32x2 o; o.x = pk2(ao[mt][0] * rstd * fsilu(bflo(gw.x)), ao[mt][1] * rstd * fsilu(bfhi(gw.x))); o.y = pk2(ao[mt][2] * rstd * fsilu(bflo(gw.y)), ao[mt][3] * rstd * fsilu(bfhi(gw.y)));
                *(u32x2*)(Y + tg * 3072 + e0) = o; }
        }
        __syncthreads();
    }
}


constexpr int GP = 136;
constexpr int GMP = 68;
constexpr int GS_FRAGS = 32, GS_PACK_BYTES = GS_FRAGS * 1024, GO_FRAGS = 24, GO_PACK_BYTES = GO_FRAGS * 1024;
__device__ __forceinline__ bf16x8 mk_frag(u32x2 lo, u32x2 hi) { u32x4 t; t.x = lo.x; t.y = lo.y; t.z = hi.x; t.w = hi.y; return __builtin_bit_cast(bf16x8, t); }
__device__ __forceinline__ bf16x8 pack_acc2(const f32x4 a, const f32x4 b) { u32x4 t; t.x = pk2(a[0], a[1]); t.y = pk2(a[2], a[3]); t.z = pk2(b[0], b[1]); t.w = pk2(b[2], b[3]); return __builtin_bit_cast(bf16x8, t); }
__device__ __forceinline__ u32x4 tile_frag_scaled(const bf16_t* T, int mt, int ks, int fr, int fg, float sc) {
    const u32x2 lo = *(const u32x2*)(T + (16 * mt + fr) * GP + 32 * ks + 4 * fg), hi = *(const u32x2*)(T + (16 * mt + fr) * GP + 32 * ks + 16 + 4 * fg);
    u32x4 o; o.x = pk2(bflo(lo.x) * sc, bfhi(lo.x) * sc); o.y = pk2(bflo(lo.y) * sc, bfhi(lo.y) * sc); o.z = pk2(bflo(hi.x) * sc, bfhi(hi.x) * sc); o.w = pk2(bflo(hi.y) * sc, bfhi(hi.y) * sc); return o;
}
__device__ __forceinline__ void gdn_units_a(const Frame& F, const Params& p, int l) {
    bf16_t* Qn = (bf16_t*)F.ldsg; bf16_t* Kn = Qn + 64 * GP; bf16_t* Vn = Kn + 64 * GP; bf16_t* Wl = Vn + 64 * GP;
    float* Mm = (float*)(Wl + 64 * GP);
    float* gcv = Mm + 64 * GMP; float* bet = gcv + 64; float* beg = bet + 64; float* ekd = beg + 64; float* egc = ekd + 64;
    float* cwl = egc + 64;
    const bf16_t* Z = (const bf16_t*)(KWS() + WS_Z); const float* GAB = (const float*)(KWS() + WS_GAB);
    unsigned char* P2 = KWS() + WS_GP2; float* UP = (float*)(KWS() + WS_GUP); float* GL = (float*)(KWS() + WS_GGL);
    const float* cw = KIN(15) + (size_t)l * 4 * 3072;
    const int w = F.wave, lane = F.lane, fr = lane & 15, fg = lane >> 4;
    int cur_h = -1; float Aexp = 0.f, dtb = 0.f;
    for (int u = F.bx; u < 2048; u += F.G) {
        const int h = u & 7, n = u >> 3, t0 = n * 64;
        if (h != cur_h) { cur_h = h; Aexp = expf(KIN(16)[l * 8 + h]); dtb = KIN(17)[l * 8 + h];
            __syncthreads();
            for (int i = F.tid; i < 1536; i += NTHR) { const int ten = i >> 9, k = (i >> 7) & 3, c = i & 127; cwl[i] = cw[k * 3072 + ten * 1024 + h * 128 + c]; }
            __syncthreads(); }
        { const int tt = F.tid >> 3, cg = F.tid & 7;
#pragma unroll
            for (int ten = 0; ten < 3; ++ten) { float y[16];
#pragma unroll
                for (int i = 0; i < 16; ++i) y[i] = 0.f;
#pragma unroll
                for (int k = 0; k < 4; ++k) { const int t = t0 + tt - 3 + k;
                    if (t >= 0) { const bf16_t* zp = Z + (size_t)t * NZ + ZC_GQ + ten * 1024 + h * 128 + 16 * cg; float x[16]; float x8a[8], x8b[8]; unpack8(*(const u32x4*)zp, x8a); unpack8(*(const u32x4*)(zp + 8), x8b);
#pragma unroll
                        for (int i = 0; i < 8; ++i) { x[i] = x8a[i]; x[8 + i] = x8b[i]; }
#pragma unroll
                        for (int i = 0; i < 16; ++i) y[i] += cwl[(ten * 4 + k) * 128 + 16 * cg + i] * x[i]; } }
                float ss = 0.f;
#pragma unroll
                for (int i = 0; i < 16; ++i) { y[i] = fsilu(y[i]); ss += y[i] * y[i]; }
                float mul = 1.0f;
                if (ten < 2) { ss += __shfl_xor(ss, 1); ss += __shfl_xor(ss, 2); ss += __shfl_xor(ss, 4); mul = (1.0f / sqrtf(ss + EPS)) * (ten == 0 ? 0.08838834764831845f : 1.0f); }
                bf16_t* dst = (ten == 0 ? Qn : (ten == 1 ? Kn : Vn)) + tt * GP + 16 * cg; u32x4 o0, o1;
                o0.x = pk2(y[0] * mul, y[1] * mul); o0.y = pk2(y[2] * mul, y[3] * mul); o0.z = pk2(y[4] * mul, y[5] * mul); o0.w = pk2(y[6] * mul, y[7] * mul);
                o1.x = pk2(y[8] * mul, y[9] * mul); o1.y = pk2(y[10] * mul, y[11] * mul); o1.z = pk2(y[12] * mul, y[13] * mul); o1.w = pk2(y[14] * mul, y[15] * mul);
                *(u32x4*)dst = o0; *(u32x4*)(dst + 8) = o1;
                asm volatile("" ::: "memory"); } }
        if (w == 0) { const size_t gi = (size_t)(t0 + lane) * 16; const float g = -Aexp * softplusf(GAB[gi + h] + dtb); const float beta = sigm(GAB[gi + 8 + h]);
            float gc = g;
#pragma unroll
            for (int o = 1; o < 64; o <<= 1) { const float t = __shfl_up(gc, o); if (lane >= o) gc += t; }
            const float gl = __shfl(gc, 63);
            gcv[lane] = gc; bet[lane] = beta; { const float eg = expf(gc); egc[lane] = eg; beg[lane] = beta * eg; } ekd[lane] = expf(gl - gc);
            if (lane == 0) GL[u] = expf(gl); }
        __syncthreads();
        unsigned char* pk = P2 + (size_t)u * GS_PACK_BYTES; unsigned char* pko = KWS() + WS_GPO + (size_t)u * GO_PACK_BYTES;
        { const int mt = w >> 1;
#pragma unroll
            for (int q = 0; q < 2; ++q) { const int nt = 2 * (w & 1) + q;
                if (nt <= mt) { f32x4 s = (f32x4){0.f, 0.f, 0.f, 0.f};
#pragma unroll
                    for (int ks = 0; ks < 4; ++ks) { const bf16x8 af = *(const bf16x8*)(Kn + (16 * mt + fr) * GP + 32 * ks + 8 * fg), bf_ = *(const bf16x8*)(Kn + (16 * nt + fr) * GP + 32 * ks + 8 * fg); s = __builtin_amdgcn_mfma_f32_16x16x32_bf16(af, bf_, s, 0, 0, 0); }
                    const int j = 16 * nt + fr; const float gj = gcv[j];
#pragma unroll
                    for (int r = 0; r < 4; ++r) { const int i = 16 * mt + 4 * fg + r; Mm[i * GMP + j] = (i > j) ? bet[i] * s[r] * fexp(gcv[i] - gj) : 0.f; } } } }
        { const int it = w >> 1, ksA = w & 1; f32x4 s2[2];
#pragma unroll
            for (int q = 0; q < 2; ++q) { const int jt = 2 * ksA + q; s2[q] = (f32x4){0.f, 0.f, 0.f, 0.f};
                if (jt <= it) {
#pragma unroll
                    for (int ks = 0; ks < 4; ++ks) { const bf16x8 af = *(const bf16x8*)(Kn + (16 * jt + fr) * GP + 32 * ks + 8 * fg), bf_ = *(const bf16x8*)(Qn + (16 * it + fr) * GP + 32 * ks + 8 * fg); s2[q] = __builtin_amdgcn_mfma_f32_16x16x32_bf16(af, bf_, s2[q], 0, 0, 0); }
                    const int i = 16 * it + fr; const float gi = gcv[i];
#pragma unroll
                    for (int r = 0; r < 4; ++r) { const int j = 16 * jt + 4 * fg + r; s2[q][r] = (i >= j) ? s2[q][r] * fexp(gi - gcv[j]) : 0.f; } } }
            *(bf16x8*)(pko + (size_t)(16 + it * 2 + ksA) * 1024 + lane * 16) = pack_acc2(s2[0], s2[1]); }
        __syncthreads();
        if (w < 4) { const int c = F.tid; float sol[64];
#pragma unroll
            for (int i = 0; i < 64; ++i) sol[i] = 0.f;
            LAS const bf16_t* colp = (LAS const bf16_t*)(F.lds) + ((c < 128) ? (2 * 64 * GP + c) : (64 * GP + (c - 128))); asm volatile("" : "+v"(colp));
            LAS const float* mm = (LAS const float*)(F.lds + 4 * 64 * GP * 2); asm volatile("" : "+v"(mm));
            LAS const float* tb = mm + 64 * GMP + ((c < 128) ? 64 : 128); asm volatile("" : "+v"(tb));
#pragma unroll
            for (int i = 0; i < 64; ++i) { float a = bf2f(colp[i * GP]) * tb[i];
#pragma unroll
                for (int jb = 0; jb < (i + 3) / 4; ++jb) { const f32x4 m4 = *(LAS const f32x4*)(mm + i * GMP + 4 * jb);
                    a -= m4[0] * sol[4 * jb]; a -= m4[1] * sol[4 * jb + 1]; a -= m4[2] * sol[4 * jb + 2]; a -= m4[3] * sol[4 * jb + 3];
                    if ((jb & 3) == 3) asm volatile("" ::: "memory"); }
                sol[i] = a; asm volatile("" ::: "memory"); }
            if (c < 128) { float* up = UP + (size_t)u * 8192 + (size_t)(c >> 4) * 1024;
#pragma unroll
                for (int t = 0; t < 4; ++t)
#pragma unroll
                    for (int G = 0; G < 4; ++G) *(f32x4*)(up + (t * 64 + (c & 15) + 16 * G) * 4) = (f32x4){sol[16 * t + 4 * G], sol[16 * t + 4 * G + 1], sol[16 * t + 4 * G + 2], sol[16 * t + 4 * G + 3]}; }
            else { const int d = c - 128;
#pragma unroll
                for (int i = 0; i < 64; ++i) Wl[i * GP + d] = (bf16_t)f2bf(-sol[i]); }
        } else { const int w4 = w - 4;
#pragma unroll
            for (int q = 0; q < 4; ++q) { const int f = w4 * 4 + q, mt = f >> 2, ks = f & 3;
                *(u32x4*)(pko + (size_t)f * 1024 + lane * 16) = tile_frag_scaled(Qn, mt, ks, fr, fg, egc[16 * mt + fr]); }
#pragma unroll
            for (int q = 0; q < 4; ++q) { const int f = w4 * 4 + q, mt = f >> 1, ks = f & 1;
                float v[8];
#pragma unroll
                for (int jj = 0; jj < 8; ++jj) { const int tk = 32 * ks + 16 * (jj >> 2) + 4 * fg + (jj & 3); v[jj] = bf2f(Kn[tk * GP + 16 * mt + fr]) * ekd[tk]; }
                u32x4 o; o.x = pk2(v[0], v[1]); o.y = pk2(v[2], v[3]); o.z = pk2(v[4], v[5]); o.w = pk2(v[6], v[7]);
                *(u32x4*)(pk + (size_t)(16 + f) * 1024 + lane * 16) = o; } }
        __syncthreads();
#pragma unroll
        for (int q = 0; q < 2; ++q) { const int f = w * 2 + q, mt = f >> 2, ks = f & 3; *(u32x4*)(pk + (size_t)f * 1024 + lane * 16) = tile_frag_scaled(Wl, mt, ks, fr, fg, 1.0f); }
        __syncthreads();
    }
}

constexpr int GA_SET = 3 * 64 * GP * 2 + 5 * 64 * 4, GA_WL = 2 * GA_SET, GA_MM = GA_WL + 64 * GP * 2, GA_CW = GA_MM + 64 * GMP * 4, GA_END = GA_CW + 1536 * 4;
static_assert(GA_END <= LDS_MISC, "gdn prep LDS map");
__device__ __forceinline__ void gdn_stage_unit(const Frame& F, const Params& p, int l, int u, int h, float Aexp, float dtb, unsigned char* setb, const float* cwl) {
    bf16_t* Qn = (bf16_t*)setb; bf16_t* Kn = Qn + 64 * GP; bf16_t* Vn = Kn + 64 * GP; float* gcv = (float*)(Vn + 64 * GP); float* bet = gcv + 64; float* beg = bet + 64; float* ekd = beg + 64; float* egc = ekd + 64;
    const bf16_t* Z = (const bf16_t*)(KWS() + WS_Z); const float* GAB = (const float*)(KWS() + WS_GAB); float* GL = (float*)(KWS() + WS_GGL);
    const int n = u >> 3, t0 = n * 64, lane = F.lane;
    float ga_pre = 0.f, gb_pre = 0.f; if (F.wave == 4) { const size_t gi = (size_t)(t0 + lane) * 16; ga_pre = GAB[gi + h]; gb_pre = GAB[gi + 8 + h]; }
#pragma unroll 1
    for (int rep = 0; rep < 2; ++rep) { const int it = (F.tid - 256) + 256 * rep, tt = it >> 3, cg = it & 7;
        u32x4 raw[3][4][2];
#pragma unroll
        for (int ten = 0; ten < 3; ++ten)
#pragma unroll
            for (int k = 0; k < 4; ++k) { const int t = t0 + tt - 3 + k;
                if (t >= 0) { const bf16_t* zp = Z + (size_t)t * NZ + ZC_GQ + ten * 1024 + h * 128 + 16 * cg; raw[ten][k][0] = *(const u32x4*)zp; raw[ten][k][1] = *(const u32x4*)(zp + 8); }
                else { raw[ten][k][0] = (u32x4){0u, 0u, 0u, 0u}; raw[ten][k][1] = raw[ten][k][0]; } }
#pragma unroll
        for (int ten = 0; ten < 3; ++ten) { float y[16];
#pragma unroll
            for (int i = 0; i < 16; ++i) y[i] = 0.f;
#pragma unroll
            for (int k = 0; k < 4; ++k) { float x8a[8], x8b[8]; unpack8(raw[ten][k][0], x8a); unpack8(raw[ten][k][1], x8b);
#pragma unroll
                for (int i = 0; i < 8; ++i) { y[i] += cwl[(ten * 4 + k) * 128 + 16 * cg + i] * x8a[i]; y[8 + i] += cwl[(ten * 4 + k) * 128 + 16 * cg + 8 + i] * x8b[i]; } }
            float ss = 0.f;
#pragma unroll
            for (int i = 0; i < 16; ++i) { y[i] = fsilu(y[i]); ss += y[i] * y[i]; }
            float mul = 1.0f;
            if (ten < 2) { ss += __shfl_xor(ss, 1); ss += __shfl_xor(ss, 2); ss += __shfl_xor(ss, 4); mul = (1.0f / sqrtf(ss + EPS)) * (ten == 0 ? 0.08838834764831845f : 1.0f); }
            bf16_t* dst = (ten == 0 ? Qn : (ten == 1 ? Kn : Vn)) + tt * GP + 16 * cg; u32x4 o0, o1;
            o0.x = pk2(y[0] * mul, y[1] * mul); o0.y = pk2(y[2] * mul, y[3] * mul); o0.z = pk2(y[4] * mul, y[5] * mul); o0.w = pk2(y[6] * mul, y[7] * mul);
            o1.x = pk2(y[8] * mul, y[9] * mul); o1.y = pk2(y[10] * mul, y[11] * mul); o1.z = pk2(y[12] * mul, y[13] * mul); o1.w = pk2(y[14] * mul, y[15] * mul);
            *(u32x4*)dst = o0; *(u32x4*)(dst + 8) = o1; }
        asm volatile("" ::: "memory"); }
    if (F.wave == 4) { const float g = -Aexp * softplusf(ga_pre + dtb); const float beta = sigm(gb_pre);
        float gc = g;
#pragma unroll
        for (int o = 1; o < 64; o <<= 1) { const float t = __shfl_up(gc, o); if (lane >= o) gc += t; }
        const float gl = __shfl(gc, 63);
        gcv[lane] = gc; bet[lane] = beta; { const float eg = expf(gc); egc[lane] = eg; beg[lane] = beta * eg; } ekd[lane] = expf(gl - gc);
        if (lane == 0) GL[u] = expf(gl); }
}
__device__ __forceinline__ void gdn_units_a_pipe(const Frame& F, const Params& p, int l) {
    unsigned char* L = F.ldsg; bf16_t* Wl = (bf16_t*)(L + GA_WL); float* Mm = (float*)(L + GA_MM); float* cwl = (float*)(L + GA_CW);
    unsigned char* P2 = KWS() + WS_GP2; float* UP = (float*)(KWS() + WS_GUP);
    const float* cw = KIN(15) + (size_t)l * 4 * 3072;
    const int w = F.wave, lane = F.lane, fr = lane & 15, fg = lane >> 4, h = F.bx & 7;
    const float Aexp = expf(KIN(16)[l * 8 + h]), dtb = KIN(17)[l * 8 + h];
    for (int i = F.tid; i < 1536; i += NTHR) { const int ten = i >> 9, k = (i >> 7) & 3, c = i & 127; cwl[i] = cw[k * 3072 + ten * 1024 + h * 128 + c]; }
    __syncthreads();
    if (w >= 4 && F.bx < 2048) gdn_stage_unit(F, p, l, F.bx, h, Aexp, dtb, L, cwl);
    __syncthreads();
    int prev_u = -1, it = 0;
    for (int u = F.bx; u < 2048; u += F.G, ++it) {
        unsigned char* setb = L + (it & 1) * GA_SET; unsigned char* setn = L + ((it + 1) & 1) * GA_SET;
        const bf16_t* Qn = (const bf16_t*)setb; const bf16_t* Kn = Qn + 64 * GP; const float* gcv = (const float*)(Kn + 2 * 64 * GP); const float* bet = gcv + 64; const float* ekd = gcv + 192; const float* egc = gcv + 256;
        unsigned char* pk = P2 + (size_t)u * GS_PACK_BYTES; unsigned char* pko = KWS() + WS_GPO + (size_t)u * GO_PACK_BYTES;
        if (prev_u >= 0) { unsigned char* pkp = P2 + (size_t)prev_u * GS_PACK_BYTES;
#pragma unroll
            for (int q = 0; q < 2; ++q) { const int f = w * 2 + q, mt = f >> 2, ks = f & 3; *(u32x4*)(pkp + (size_t)f * 1024 + lane * 16) = tile_frag_scaled(Wl, mt, ks, fr, fg, 1.0f); } }
        { const int mt = w >> 1;
#pragma unroll
            for (int q = 0; q < 2; ++q) { const int nt = 2 * (w & 1) + q;
                if (nt <= mt) { f32x4 s = (f32x4){0.f, 0.f, 0.f, 0.f};
#pragma unroll
                    for (int ks = 0; ks < 4; ++ks) { const bf16x8 af = *(const bf16x8*)(Kn + (16 * mt + fr) * GP + 32 * ks + 8 * fg), bf_ = *(const bf16x8*)(Kn + (16 * nt + fr) * GP + 32 * ks + 8 * fg); s = __builtin_amdgcn_mfma_f32_16x16x32_bf16(af, bf_, s, 0, 0, 0); }
                    const int j = 16 * nt + fr; const float gj = gcv[j];
#pragma unroll
                    for (int r = 0; r < 4; ++r) { const int i = 16 * mt + 4 * fg + r; Mm[i * GMP + j] = (i > j) ? bet[i] * s[r] * fexp(gcv[i] - gj) : 0.f; } } } }
        { const int itl = w >> 1, ksA = w & 1; f32x4 s2[2];
#pragma unroll
            for (int q = 0; q < 2; ++q) { const int jt = 2 * ksA + q; s2[q] = (f32x4){0.f, 0.f, 0.f, 0.f};
                if (jt <= itl) {
#pragma unroll
                    for (int ks = 0; ks < 4; ++ks) { const bf16x8 af = *(const bf16x8*)(Kn + (16 * jt + fr) * GP + 32 * ks + 8 * fg), bf_ = *(const bf16x8*)(Qn + (16 * itl + fr) * GP + 32 * ks + 8 * fg); s2[q] = __builtin_amdgcn_mfma_f32_16x16x32_bf16(af, bf_, s2[q], 0, 0, 0); }
                    const int i = 16 * itl + fr; const float gi = gcv[i];
#pragma unroll
                    for (int r = 0; r < 4; ++r) { const int j = 16 * jt + 4 * fg + r; s2[q][r] = (i >= j) ? s2[q][r] * fexp(gi - gcv[j]) : 0.f; } } }
            *(bf16x8*)(pko + (size_t)(16 + itl * 2 + ksA) * 1024 + lane * 16) = pack_acc2(s2[0], s2[1]); }
#pragma unroll
        for (int q = 0; q < 2; ++q) { const int f = w * 2 + q, mt = f >> 2, ks = f & 3;
            *(u32x4*)(pko + (size_t)f * 1024 + lane * 16) = tile_frag_scaled(Qn, mt, ks, fr, fg, egc[16 * mt + fr]); }
#pragma unroll
        for (int q = 0; q < 2; ++q) { const int f = w * 2 + q, mt = f >> 1, ks = f & 1; float v[8];
#pragma unroll
            for (int jj = 0; jj < 8; ++jj) { const int tk = 32 * ks + 16 * (jj >> 2) + 4 * fg + (jj & 3); v[jj] = bf2f(Kn[tk * GP + 16 * mt + fr]) * ekd[tk]; }
            u32x4 o; o.x = pk2(v[0], v[1]); o.y = pk2(v[2], v[3]); o.z = pk2(v[4], v[5]); o.w = pk2(v[6], v[7]);
            *(u32x4*)(pk + (size_t)(16 + f) * 1024 + lane * 16) = o; }
        __syncthreads();
        if (w < 4) { const int c = F.tid; float sol[64];
#pragma unroll
            for (int i = 0; i < 64; ++i) sol[i] = 0.f;
            LAS const bf16_t* colp = (LAS const bf16_t*)(F.lds + (it & 1) * GA_SET) + ((c < 128) ? (2 * 64 * GP + c) : (64 * GP + (c - 128))); asm volatile("" : "+v"(colp));
            LAS const float* mm = (LAS const float*)(F.lds + GA_MM); asm volatile("" : "+v"(mm));
            LAS const float* tb = (LAS const float*)(F.lds + (it & 1) * GA_SET + 3 * 64 * GP * 2) + ((c < 128) ? 64 : 128); asm volatile("" : "+v"(tb));
#pragma unroll
            for (int i = 0; i < 64; ++i) { float a = bf2f(colp[i * GP]) * tb[i];
#pragma unroll
                for (int jb = 0; jb < (i + 3) / 4; ++jb) { const f32x4 m4 = *(LAS const f32x4*)(mm + i * GMP + 4 * jb);
                    a -= m4[0] * sol[4 * jb]; a -= m4[1] * sol[4 * jb + 1]; a -= m4[2] * sol[4 * jb + 2]; a -= m4[3] * sol[4 * jb + 3];
                    if ((jb & 3) == 3) asm volatile("" ::: "memory"); }
                sol[i] = a; asm volatile("" ::: "memory"); }
            if (c < 128) { float* up = UP + (size_t)u * 8192 + (size_t)(c >> 4) * 1024;
#pragma unroll
                for (int t = 0; t < 4; ++t)
#pragma unroll
                    for (int G = 0; G < 4; ++G) *(f32x4*)(up + (t * 64 + (c & 15) + 16 * G) * 4) = (f32x4){sol[16 * t + 4 * G], sol[16 * t + 4 * G + 1], sol[16 * t + 4 * G + 2], sol[16 * t + 4 * G + 3]}; }
            else { const int d = c - 128;
#pragma unroll
                for (int i = 0; i < 64; ++i) Wl[i * GP + d] = (bf16_t)f2bf(-sol[i]); }
        } else if (u + F.G < 2048) gdn_stage_unit(F, p, l, u + F.G, h, Aexp, dtb, setn, cwl);
        __syncthreads();
        prev_u = u;
    }
    if (prev_u >= 0) { unsigned char* pkp = P2 + (size_t)prev_u * GS_PACK_BYTES;
#pragma unroll
        for (int q = 0; q < 2; ++q) { const int f = w * 2 + q, mt = f >> 2, ks = f & 3; *(u32x4*)(pkp + (size_t)f * 1024 + lane * 16) = tile_frag_scaled(Wl, mt, ks, fr, fg, 1.0f); } }
    __syncthreads();
}

constexpr int GS_HALF = 16384;
__device__ __forceinline__ void gdn_scan(const Frame& F, int b) {
    const int h = b >> 1, w = F.wave, lane = F.lane; const int slice = (b & 1) * 4 + (w & 3); const bool comp = w < 4;
    const unsigned char* P2 = KWS() + WS_GP2; const float* UP = (const float*)(KWS() + WS_GUP); const float* GL = (const float*)(KWS() + WS_GGL); unsigned char* SV = KWS() + WS_GSV;
    f32x4 S[8];
#pragma unroll
    for (int i = 0; i < 8; ++i) S[i] = (f32x4){0.f, 0.f, 0.f, 0.f};
    if (!comp) {
#pragma unroll
        for (int hf = 0; hf < 7; ++hf) { const unsigned char* src = P2 + (size_t)((hf >> 1) * 8 + h) * GS_PACK_BYTES + (hf & 1) * GS_HALF;
#pragma unroll
            for (int i = 0; i < 4; ++i) { const int f = (w - 4) + 4 * i; __builtin_amdgcn_global_load_lds((const unsigned*)(src + f * 1024 + lane * 16), (LAS unsigned*)(F.lds + hf * GS_HALF + f * 1024), 16, 0, 0); } }
        asm volatile("s_waitcnt vmcnt(20)" ::: "memory"); }
    f32x4 ua[4], ub[4]; float gla = 0.f, glb = 0.f;
#pragma unroll
    for (int t = 0; t < 4; ++t) { ua[t] = (f32x4){0.f, 0.f, 0.f, 0.f}; ub[t] = ua[t]; }
    if (comp) {
#pragma unroll
        for (int t = 0; t < 4; ++t) { ua[t] = *(const f32x4*)(UP + (size_t)h * 8192 + slice * 1024 + (t * 64 + lane) * 4); ub[t] = *(const f32x4*)(UP + (size_t)(8 + h) * 8192 + slice * 1024 + (t * 64 + lane) * 4); }
        gla = GL[h]; glb = GL[8 + h]; }
    __syncthreads();
    int hw = 0;
    for (int n = 0; n < 256; ++n) {
        const int unit = n * 8 + h; const int hk = (hw + 1 >= 9) ? hw + 1 - 9 : hw + 1;
        const LAS unsigned char* bufW = F.lds + hw * GS_HALF; const LAS unsigned char* bufK = F.lds + hk * GS_HALF;
        if (!comp) {
            if (n + 3 < 256) { const int e7 = (hw + 7 >= 9) ? hw + 7 - 9 : hw + 7; const unsigned char* src = P2 + (size_t)(unit + 24) * GS_PACK_BYTES + GS_HALF;
#pragma unroll
                for (int i = 0; i < 4; ++i) { const int f = (w - 4) + 4 * i; __builtin_amdgcn_global_load_lds((const unsigned*)(src + f * 1024 + lane * 16), (LAS unsigned*)(F.lds + e7 * GS_HALF + f * 1024), 16, 0, 0); } }
            if (n + 4 < 256) { const int e8 = (hw + 8 >= 9) ? hw + 8 - 9 : hw + 8; const unsigned char* src = P2 + (size_t)(unit + 32) * GS_PACK_BYTES;
#pragma unroll
                for (int i = 0; i < 4; ++i) { const int f = (w - 4) + 4 * i; __builtin_amdgcn_global_load_lds((const unsigned*)(src + f * 1024 + lane * 16), (LAS unsigned*)(F.lds + e8 * GS_HALF + f * 1024), 16, 0, 0); }
                asm volatile("s_waitcnt vmcnt(20)" ::: "memory"); }
            else asm volatile("s_waitcnt vmcnt(0)" ::: "memory");
        } else {
            f32x4 vn[4];
#pragma unroll
            for (int t = 0; t < 4; ++t) { vn[t] = ua[t]; ua[t] = ub[t]; }
            const float gl = gla; gla = glb;
            if (n + 2 < 256) {
#pragma unroll
                for (int t = 0; t < 4; ++t) ub[t] = *(const f32x4*)(UP + (size_t)(unit + 16) * 8192 + slice * 1024 + (t * 64 + lane) * 4);
                glb = GL[unit + 16]; }
            bf16x8* svp = (bf16x8*)(SV + ((size_t)(unit * 8 + slice) * 6) * 1024 + lane * 16);
            bf16x8 Sb[4];
#pragma unroll
            for (int ks = 0; ks < 4; ++ks) { Sb[ks] = pack_acc2(S[2 * ks], S[2 * ks + 1]); svp[ks * 64] = Sb[ks]; }
#pragma unroll
            for (int t = 0; t < 4; ++t)
#pragma unroll
                for (int ks = 0; ks < 4; ++ks) vn[t] = __builtin_amdgcn_mfma_f32_16x16x32_bf16(*(const LAS bf16x8*)(bufW + (t * 4 + ks) * 1024 + lane * 16), Sb[ks], vn[t], 0, 0, 0);
            bf16x8 vb[2];
#pragma unroll
            for (int ks = 0; ks < 2; ++ks) { vb[ks] = pack_acc2(vn[2 * ks], vn[2 * ks + 1]); svp[(4 + ks) * 64] = vb[ks]; }
#pragma unroll
            for (int dt = 0; dt < 8; ++dt) { S[dt] = S[dt] * gl;
#pragma unroll
                for (int ks = 0; ks < 2; ++ks) S[dt] = __builtin_amdgcn_mfma_f32_16x16x32_bf16(*(const LAS bf16x8*)(bufK + (dt * 2 + ks) * 1024 + lane * 16), vb[ks], S[dt], 0, 0, 0); }
        }
        __syncthreads();
        hw += 2; if (hw >= 9) hw -= 9;
    }
}
constexpr int GO_PITCH = 132;
__device__ __forceinline__ void gdn_output(const Frame& F, const Params& p, int l) {
    float* Ot = (float*)F.ldsg;
    const unsigned char* PO = KWS() + WS_GPO; const unsigned char* SV = KWS() + WS_GSV; const bf16_t* Z = (const bf16_t*)(KWS() + WS_Z); bf16_t* Y = (bf16_t*)(KWS() + WS_Y); const float* ng = KIN(18) + l * 128;
    const int w = F.wave, lane = F.lane, fr = lane & 15, fg = lane >> 4;
    const int tt = F.tid >> 3, cg = F.tid & 7; float gn[16];
#pragma unroll
    for (int i = 0; i < 16; ++i) gn[i] = ng[16 * cg + i];
    for (int u = F.bx; u < 2048; u += F.G) {
        const int h = u & 7, n = u >> 3;
        const bf16x8* svp = (const bf16x8*)(SV + ((size_t)(u * 8 + w) * 6) * 1024 + lane * 16); const bf16x8* pop = (const bf16x8*)(PO + (size_t)u * GO_PACK_BYTES + lane * 16);
        const u32x4 gzp0 = *(const u32x4*)(Z + (size_t)(n * 64 + tt) * NZ + ZC_GZ + h * 128 + 16 * cg), gzp1 = *(const u32x4*)(Z + (size_t)(n * 64 + tt) * NZ + ZC_GZ + h * 128 + 16 * cg + 8);
        bf16x8 Sb[4], vb[2];
#pragma unroll
        for (int ks = 0; ks < 4; ++ks) Sb[ks] = svp[ks * 64];
#pragma unroll
        for (int ks = 0; ks < 2; ++ks) vb[ks] = svp[(4 + ks) * 64];
#pragma unroll
        for (int t = 0; t < 4; ++t) { f32x4 o = (f32x4){0.f, 0.f, 0.f, 0.f};
#pragma unroll
            for (int ks = 0; ks < 4; ++ks) o = __builtin_amdgcn_mfma_f32_16x16x32_bf16(pop[(t * 4 + ks) * 64], Sb[ks], o, 0, 0, 0);
#pragma unroll
            for (int ks = 0; ks < 2; ++ks) o = __builtin_amdgcn_mfma_f32_16x16x32_bf16(pop[(16 + t * 2 + ks) * 64], vb[ks], o, 0, 0, 0);
#pragma unroll
            for (int r = 0; r < 4; ++r) Ot[(16 * t + 4 * fg + r) * GO_PITCH + 16 * w + fr] = o[r]; }
        __syncthreads();
        { const size_t tg = (size_t)(n * 64 + tt); float o[16], g[8], g2[8]; float ss = 0.f;
#pragma unroll
            for (int i = 0; i < 4; ++i) { const f32x4 v = *(const f32x4*)(Ot + tt * GO_PITCH + 16 * cg + 4 * i); o[4 * i] = v[0]; o[4 * i + 1] = v[1]; o[4 * i + 2] = v[2]; o[4 * i + 3] = v[3]; }
#pragma unroll
            for (int i = 0; i < 16; ++i) ss += o[i] * o[i];
            ss += __shfl_xor(ss, 1); ss += __shfl_xor(ss, 2); ss += __shfl_xor(ss, 4);
            const float rstd = 1.0f / sqrtf(ss * (1.0f / 128.0f) + EPS);
            unpack8(gzp0, g); unpack8(gzp1, g2);
            float y[16];
#pragma unroll
            for (int i = 0; i < 8; ++i) { y[i] = o[i] * rstd * gn[i] * fsilu(g[i]); y[8 + i] = o[8 + i] * rstd * gn[8 + i] * fsilu(g2[i]); }
            u32x4 o0, o1; o0.x = pk2(y[0], y[1]); o0.y = pk2(y[2], y[3]); o0.z = pk2(y[4], y[5]); o0.w = pk2(y[6], y[7]); o1.x = pk2(y[8], y[9]); o1.y = pk2(y[10], y[11]); o1.z = pk2(y[12], y[13]); o1.w = pk2(y[14], y[15]);
            bf16_t* yp = Y + tg * 3072 + 2048 + h * 128 + 16 * cg; *(u32x4*)yp = o0; *(u32x4*)(yp + 8) = o1; }
        __syncthreads();
    }
}

__device__ __forceinline__ void seq_retention(const Frame& F, const Params& p, int h) {
    float* sq = (float*)F.ldsg; float* sk = sq + 128; float* red = sk + 128;
    const bf16_t* Z = (const bf16_t*)(KWS() + WS_Z); bf16_t* Y = (bf16_t*)(KWS() + WS_Y); const int* pos = (const int*)KIN(2);
    const int c = F.tid & 127; const bool act = F.tid < 128, rot = F.tid < 64;
    float R[128];
#pragma unroll
    for (int d = 0; d < 128; ++d) R[d] = 0.f;
    const float gamma = 1.0f - exp2f(-5.0f - (float)h);
    const float invf = (float)exp2(-(double)(F.tid & 63) * (13.287712379549449 / 64.0));
    unsigned short nq1 = 0, nq2 = 0, nk1 = 0, nk2 = 0, nv = 0, ng = 0; int npos = 0;
    if (rot) { nq1 = Z[ZC_RQ + h * 128 + F.tid]; nq2 = Z[ZC_RQ + h * 128 + 64 + F.tid]; nk1 = Z[ZC_RK + h * 128 + F.tid]; nk2 = Z[ZC_RK + h * 128 + 64 + F.tid]; npos = pos[0]; }
    if (act) { nv = Z[ZC_RV + h * 128 + c]; ng = Z[ZC_RG + h * 128 + c]; }
    for (int t = 0; t < S_; ++t) {
        const unsigned short q1 = nq1, q2 = nq2, k1 = nk1, k2 = nk2, vv = nv, gg = ng; const int ps = npos;
        if (t + 1 < S_) { const size_t zo = (size_t)(t + 1) * NZ;
            if (rot) { nq1 = Z[zo + ZC_RQ + h * 128 + F.tid]; nq2 = Z[zo + ZC_RQ + h * 128 + 64 + F.tid]; nk1 = Z[zo + ZC_RK + h * 128 + F.tid]; nk2 = Z[zo + ZC_RK + h * 128 + 64 + F.tid]; npos = pos[t + 1]; }
            if (act) { nv = Z[zo + ZC_RV + h * 128 + c]; ng = Z[zo + ZC_RG + h * 128 + c]; } }
        if (rot) { const float angf = (float)ps * invf; const double ad = (double)angf; const double nn = rint(ad * 0.15915494309189535); const float rr = (float)(ad - nn * 6.283185307179586);
            const float cs = cosf(rr), sn = sinf(rr); const float a1 = bf2f(q1), a2 = bf2f(q2), b1 = bf2f(k1), b2 = bf2f(k2);
            sq[F.tid] = a1 * cs - a2 * sn; sq[F.tid + 64] = a2 * cs + a1 * sn;
            sk[F.tid] = (b1 * cs - b2 * sn) * 0.08838834764831845f; sk[F.tid + 64] = (b2 * cs + b1 * sn) * 0.08838834764831845f; }
        __syncthreads();
        float o = 0.f;
        if (act) { const float v = bf2f(vv);
#pragma unroll
            for (int d0 = 0; d0 < 128; d0 += 16) {
#pragma unroll
                for (int d = d0; d < d0 + 16; ++d) { R[d] = gamma * R[d] + sk[d] * v; o += sq[d] * R[d]; }
                asm volatile("" ::: "memory"); }
            const float ss = wave_sum(o * o); if (F.lane == 0) red[F.wave] = ss; }
        __syncthreads();
        if (act) { const float ms = (red[0] + red[1]) * (1.0f / 128.0f); const float y = o * (1.0f / sqrtf(ms + EPS)) * siluf(bf2f(gg)); Y[(size_t)t * 3072 + h * 128 + c] = (bf16_t)f2bf(y); }
    }
}
__device__ __forceinline__ void seq_gdn(const Frame& F, const Params& p, int l, int h) {
    float* sq = (float*)F.ldsg; float* sk = sq + 128; float* red = sk + 128; float* red2 = red + 8;
    const bf16_t* Z = (const bf16_t*)(KWS() + WS_Z); bf16_t* Y = (bf16_t*)(KWS() + WS_Y); const float* GAB = (const float*)(KWS() + WS_GAB);
    const int c = F.tid & 127; const bool act = F.tid < 128;
    float St[128];
#pragma unroll
    for (int d = 0; d < 128; ++d) St[d] = 0.f;
    const float* cw = KIN(15) + (size_t)l * 4 * 3072;
    float wq[4], wk[4], wv[4];
#pragma unroll
    for (int k = 0; k < 4; ++k) { wq[k] = cw[k * 3072 + h * 128 + c]; wk[k] = cw[k * 3072 + 1024 + h * 128 + c]; wv[k] = cw[k * 3072 + 2048 + h * 128 + c]; }
    const float Aexp = expf(KIN(16)[l * 8 + h]), dtb = KIN(17)[l * 8 + h], ngain = KIN(18)[l * 128 + c];
    float xq1 = 0, xq2 = 0, xq3 = 0, xk1 = 0, xk2 = 0, xk3 = 0, xv1 = 0, xv2 = 0, xv3 = 0;
    unsigned short nq = 0, nk = 0, nv = 0, nz = 0; float nga = 0.f, ngb = 0.f;
    if (act) { nq = Z[ZC_GQ + h * 128 + c]; nk = Z[ZC_GK + h * 128 + c]; nv = Z[ZC_GV + h * 128 + c]; nz = Z[ZC_GZ + h * 128 + c]; nga = GAB[h]; ngb = GAB[8 + h]; }
    for (int t = 0; t < S_; ++t) {
        const float rq = bf2f(nq), rk = bf2f(nk), rv = bf2f(nv), gz = bf2f(nz), ga = nga, gb = ngb;
        if (act && t + 1 < S_) { const size_t zo = (size_t)(t + 1) * NZ; nq = Z[zo + ZC_GQ + h * 128 + c]; nk = Z[zo + ZC_GK + h * 128 + c]; nv = Z[zo + ZC_GV + h * 128 + c]; nz = Z[zo + ZC_GZ + h * 128 + c];
            nga = GAB[(size_t)(t + 1) * 16 + h]; ngb = GAB[(size_t)(t + 1) * 16 + 8 + h]; }
        float q = 0.f, k = 0.f, v = 0.f;
        if (act) { const float cq = wq[0] * xq3 + wq[1] * xq2 + wq[2] * xq1 + wq[3] * rq, ck = wk[0] * xk3 + wk[1] * xk2 + wk[2] * xk1 + wk[3] * rk, cv = wv[0] * xv3 + wv[1] * xv2 + wv[2] * xv1 + wv[3] * rv;
            xq3 = xq2; xq2 = xq1; xq1 = rq; xk3 = xk2; xk2 = xk1; xk1 = rk; xv3 = xv2; xv2 = xv1; xv1 = rv;
            q = siluf(cq); k = siluf(ck); v = siluf(cv);
            const float s1 = wave_sum(q * q), s2 = wave_sum(k * k); if (F.lane == 0) { red[F.wave] = s1; red[2 + F.wave] = s2; } }
        __syncthreads();
        if (act) { sq[c] = q * (1.0f / sqrtf(red[0] + red[1] + EPS)) * 0.08838834764831845f; sk[c] = k * (1.0f / sqrtf(red[2] + red[3] + EPS)); }
        __syncthreads();
        float o = 0.f;
        if (act) { const float g = -Aexp * softplusf(ga + dtb), e = expf(g), beta = sigm(gb);
            float dot = 0.f;
#pragma unroll
            for (int d0 = 0; d0 < 128; d0 += 16) {
#pragma unroll
                for (int d = d0; d < d0 + 16; ++d) dot += sk[d] * St[d];
                asm volatile("" ::: "memory"); }
            const float coef = beta * (v - e * dot);
#pragma unroll
            for (int d0 = 0; d0 < 128; d0 += 16) {
#pragma unroll
                for (int d = d0; d < d0 + 16; ++d) { St[d] = e * St[d] + sk[d] * coef; o += sq[d] * St[d]; }
                asm volatile("" ::: "memory"); }
            const float ss = wave_sum(o * o); if (F.lane == 0) red2[F.wave] = ss; }
        __syncthreads();
        if (act) { const float ms = (red2[0] + red2[1]) * (1.0f / 128.0f); const float y = o * (1.0f / sqrtf(ms + EPS)) * ngain * siluf(gz); Y[(size_t)t * 3072 + 2048 + h * 128 + c] = (bf16_t)f2bf(y); }
    }
}
__device__ __forceinline__ void seq_lru(const Frame& F, const Params& p, int part) {
    const bf16_t* Z = (const bf16_t*)(KWS() + WS_Z); bf16_t* Y = (bf16_t*)(KWS() + WS_Y); const float* LA = (const float*)(KWS() + WS_MF); const float* LB = LA + (size_t)S_ * 1024;
    const int ch = part * 512 + F.tid; float h = 0.f;
    for (int t0 = 0; t0 < S_; t0 += 8) { float a[8], b[8]; unsigned short g[8];
#pragma unroll
        for (int i = 0; i < 8; ++i) { a[i] = LA[(size_t)(t0 + i) * 1024 + ch]; b[i] = LB[(size_t)(t0 + i) * 1024 + ch]; g[i] = Z[(size_t)(t0 + i) * NZ + ZC_LG + ch]; }
#pragma unroll
        for (int i = 0; i < 8; ++i) { h = a[i] * h + b[i]; Y[(size_t)(t0 + i) * 3072 + 1024 + ch] = (bf16_t)f2bf(h * gelu_tanh(bf2f(g[i]))); } }
}

__device__ __forceinline__ void phase_seq(const Frame& F, const Params& p, int l) {
#if DBG_NOSEQ
    { u32x4* yy = (u32x4*)(KWS() + WS_Y); for (size_t i = (size_t)F.bx * NTHR + F.tid; i < (size_t)S_ * 3072 / 8; i += (size_t)F.G * NTHR) yy[i] = (u32x4){0u, 0u, 0u, 0u}; }
#else
    if (F.bx < 16) { gdn_scan(F, ((F.bx & 7) << 1) | (F.bx >> 3)); return; }
    const int wg = F.bx - 16, nwg = F.G - 16; unsigned* ctl = (unsigned*)(KWS() + WS_CTL); unsigned* cnt = ctl + CW_SUB + 64 * l; unsigned* tmo = ctl + CW_BAR + XB_TMO;
    const int rwg = (wg + nwg - (2048 % nwg)) % nwg;
    lru_units<false>(F, p, l, wg, nwg); __syncthreads(); ret_units_a(F, rwg, nwg);
    sub_barrier(cnt, (unsigned)nwg, tmo);
    if (wg < 2) lru_carry(F, wg); else ret_scan(F, wg - 2, nwg - 2);
    sub_barrier(cnt, 2u * (unsigned)nwg, tmo);
    lru_units<true>(F, p, l, wg, nwg); __syncthreads(); ret_units_c(F, rwg, nwg);
#endif
}

#define LAYER(l) do { \
const int pb = PH_L0 + l * PH_PER_LAYER; \
        if (EN(0) && IN(pb + 0)) { const Frame F = make_frame(); phase_convert(F, p, l); phase_norm1_gab(F, p, l, l > 0 && !DBG_NOMOE); __syncthreads(); } \
        SEAM(pb + 0); \
        if (EN(1) && IN(pb + 1)) { const Frame F = make_frame(); pg8::Gemm g{(const bf16_t*)(KWS() + WS_H), (const bf16_t*)(KWS() + WS_WIN), 2048, 2048, 2048}; SchedStatic sc{64, 64, F.G, F.bx}; \
            EpiZL E{(bf16_t*)(KWS() + WS_Z)}; pg8::gemm_phase(F.lds, g, sc, E); } \
        SEAM(pb + 1); \
        if (EN(2) && IN(pb + 2)) { const Frame F = make_frame(); if ((F.G & 7) == 0) gdn_units_a_pipe(F, p, l); else gdn_units_a(F, p, l); } \
        SEAM(pb + 2); \
        if (EN(3) && IN(pb + 3)) { const Frame F = make_frame(); \
            phase_seq(F, p, l); \
        } \
        SEAM(pb + 3); \
        if (EN(4) && IN(pb + 4)) { const Frame F = make_frame(); gdn_output(F, p, l); } \
        SEAM(pb + 4); \
        if (EN(5) && IN(pb + 5)) { const Frame F = make_frame(); pg8::Gemm g{(const bf16_t*)(KWS() + WS_Y), (const bf16_t*)(KWS() + WS_BP), 3072, 1024, 1024}; SchedMerge sc{F.G, F.bx}; \
            EpiMerge E{(const bf16_t*)(KWS() + WS_Z), (bf16_t*)(KWS() + WS_H)}; pg8::gemm_phase(F.lds, g, sc, E); } \
        SEAM(pb + 5); \
        if (EN(6) && IN(pb + 6)) { const Frame F = make_frame(); pg8::Gemm g{(const bf16_t*)(KWS() + WS_H), (const bf16_t*)(KWS() + WS_WO), 2048, 2048, 2048}; SchedStatic sc{64, 8, F.G, F.bx}; \
            EpiWout E{l == 0 ? KIN(0) : KOUT(), KOUT(), (const float*)(KWS() + WS_MODV) + l * 12288 + MO_GT1}; pg8::gemm_phase(F.lds, g, sc, E); } \
        SEAM(pb + 6); \
        if (!DBG_NOMOE && EN(7) && IN(pb + 7)) { const Frame F = make_frame(); if ((S_ % (F.G * NWAVES * 4)) == 0) phase_norm2_router_lds(F, p, l); else phase_norm2_router(F, p, l); __syncthreads(); } \
        SEAM(pb + 7); \
        if (!DBG_NOMOE && EN(8) && IN(pb + 8)) { const Frame F = make_frame(); phase_gather(F, p, l); } \
        SEAM(pb + 8); \
        if (!DBG_NOMOE && EN(9) && IN(pb + 9)) { const Frame F = make_frame(); moe_tables_load(F, p); unsigned* mq = (unsigned*)(KWS() + WS_CTL) + CW_MOEQ + l * 16384; \
            { pg8::Gemm g{(const bf16_t*)(KWS() + WS_H), (const bf16_t*)(KWS() + WS_W13), 2048, 2048, 2048}; SchedMoe<true> sc{(const int*)(KWS() + WS_TOK + 512 * 1024), F.G, F.bx, 4, (const LAS int*)(F.lds + LDS_MISC + 64)}; \
              EpiW13 E{(bf16_t*)(KWS() + WS_HID), mq}; pg8::gemm_phase(F.lds, g, sc, E); } \
            { volatile LAS int* slot = (volatile LAS int*)(F.lds + LDS_MISC + 32); \
              if (F.tid == 0) { const int q0 = (int)xb_add(mq, 1u), q1 = (int)xb_add(mq, 1u); slot[0] = q0; slot[1] = q1; slot[2] = 2; slot[4] = 0; } __syncthreads(); \
              pg8::Gemm g{(const bf16_t*)(KWS() + WS_HID), (const bf16_t*)(KWS() + WS_W2), 512, 512, 512}; SchedMoeDyn sc{8, (const LAS int*)(F.lds + LDS_MISC + 64), slot, mq, (unsigned*)(KWS() + WS_CTL) + CW_BAR + XB_TMO}; \
              EpiW2L E{(bf16_t*)(KWS() + WS_SLOT), (const u32x2*)(KWS() + WS_ROWINFO), (const LAS int*)(F.lds + LDS_MISC + 64), mq, slot, mq}; pg8::gemm_phase(F.lds, g, sc, E); } } \
        SEAM(pb + 10); \
    } while (0)
template <unsigned PMASK, bool ALL>
__global__ void __launch_bounds__(NTHR, 2) fwd(Params p) {
    Frame F = make_frame();
    if (F.tid < 4) ((LAS unsigned*)(F.lds + LDS_MISC))[F.tid] = 0u;
    __syncthreads();
    unsigned* ctl = (unsigned*)(KWS() + WS_CTL);
    XcdBarrier bar; bar.bar = ctl + CW_BAR; bar.x = 0; bar.st = nullptr;
    const int lo = p.ph_lo, hi = p.ph_hi;
    const bool multi = ALL || (hi - lo) > 1;
    if (multi) bar = xcd_barrier_post(ctl + CW_BAR, (volatile LAS unsigned*)(F.lds + LDS_MISC));
#define IN(k) (ALL || (lo <= (k) && (k) < hi))
#define EN(b) ((PMASK >> (b)) & 1u)
#define SEAM(k) do { if (IN(k) && IN((k) + 1)) xcd_barrier(bar); } while (0)

    if (EN(11) && IN(PH_MOD)) { const Frame F = make_frame(); phase_mod(F, p); phase_rope_table(F); phase_gabw(F); }
    SEAM(PH_MOD);
    LAYER(0);
    LAYER(1);
    if (EN(12) && IN(PH_FINAL)) { const Frame F = make_frame(); phase_norm<2>(F, p, 0, !DBG_NOMOE); }
#undef IN
#undef SEAM
}

typedef void (*KernelFn)(Params);
static int phase_bit(int ph) { if (ph == PH_MOD) return 11; if (ph == PH_FINAL) return 12; return (ph - PH_L0) % PH_PER_LAYER; }
extern "C" void kernel_launch(void* const* d_in, const int* in_sizes, int n_in, void* d_out, int out_size, void* d_ws, size_t ws_size, hipStream_t stream) {
    static int grid = 0;
#if ONE_LAUNCH
    static KernelFn fns[1] = { fwd<0x1FFFu, true> };
    constexpr int NFN = 1;
#else
    static KernelFn fns[13] = { fwd<0x001u, false>, fwd<0x002u, false>, fwd<0x004u, false>, fwd<0x008u, false>, fwd<0x010u, false>, fwd<0x020u, false>, fwd<0x040u, false>, fwd<0x080u, false>, fwd<0x100u, false>, fwd<0x200u, false>, fwd<0x400u, false>, fwd<0x800u, false>, fwd<0x1000u, false> };
    constexpr int NFN = 13;
#endif
    if (grid == 0) {
        if (n_in != 29 || out_size != S_ * D_ || ws_size < WS_END) { fprintf(stderr, "kernel_launch: unexpected shapes (n_in %d out %d ws %zu)\n", n_in, out_size, ws_size); grid = -1; return; }
        int dev = 0, cus = 0, per_cu = 0;
        if (hipGetDevice(&dev) != hipSuccess || hipDeviceGetAttribute(&cus, hipDeviceAttributeMultiprocessorCount, dev) != hipSuccess) { grid = -1; return; }
        for (int i = 0; i < NFN; ++i) {
            if (hipFuncSetAttribute((const void*)fns[i], hipFuncAttributeMaxDynamicSharedMemorySize, LDS_BYTES) != hipSuccess) { fprintf(stderr, "kernel_launch: hipFuncSetAttribute failed\n"); grid = -1; return; }
            if (hipOccupancyMaxActiveBlocksPerMultiprocessor(&per_cu, (const void*)fns[i], NTHR, LDS_BYTES) != hipSuccess || per_cu < 1) fprintf(stderr, "kernel_launch: occupancy query says %d for fn %d\n", per_cu, i);
        }
        (void)hipGetLastError();
        grid = cus > 0 ? cus : 256;
    }
    if (grid < 0) return;
    (void)hipMemsetAsync((char*)d_ws + WS_CTL, 0, CTL_BYTES, stream);
    Params p{};
    for (int i = 0; i < 29; ++i) p.in[i] = (const float*)d_in[i];
    p.out = (float*)d_out; p.ws = (unsigned char*)d_ws;
#if ONE_LAUNCH
    p.ph_lo = 0; p.ph_hi = NPH;
    { void* args[] = {&p}; (void)hipLaunchKernel((const void*)fns[0], dim3(grid), dim3(NTHR), args, LDS_BYTES, stream); }
#else
    for (int ph = 0; ph < NPH; ++ph) { p.ph_lo = ph; p.ph_hi = ph + 1; void* args[] = {&p}; (void)hipLaunchKernel((const void*)fns[phase_bit(ph)], dim3(grid), dim3(NTHR), args, LDS_BYTES, stream); }
#endif
}
```

```cpp
#include <hip/hip_runtime.h>
#include <cstdio>
#include <cstdint>

#ifndef ONE_LAUNCH
#define ONE_LAUNCH 1
#endif
#ifndef DBG_NOSEQ
#define DBG_NOSEQ 0
#endif
#ifndef DBG_NOMOE
#define DBG_NOMOE 0
#endif
#ifndef DBG_NOMIX
#define DBG_NOMIX 0
#endif
#ifndef DBG_MOE_SCALE
#define DBG_MOE_SCALE 1.0f
#endif
#ifndef DBG_M
#define DBG_M 0
#endif
#ifndef DBG_ZERO_BR
#define DBG_ZERO_BR 0
#endif

#define LAS __attribute__((address_space(3)))
typedef unsigned short bf16_t;
typedef short bf16x8 __attribute__((ext_vector_type(8)));
typedef float f32x4 __attribute__((ext_vector_type(4)));
typedef float f32x2 __attribute__((ext_vector_type(2)));
typedef unsigned u32x4 __attribute__((ext_vector_type(4)));
typedef unsigned u32x2 __attribute__((ext_vector_type(2)));

constexpr int S_ = 16384, D_ = 2048, NL = 2;
constexpr int NZ = 16384;
constexpr int NZP = 16640;
constexpr int INC = 16400;
constexpr int NWAVES = 8, NTHR = 512;
constexpr float EPS = 1e-6f;
constexpr int ZC_RQ = 0, ZC_RK = 1024, ZC_RV = 2048, ZC_RG = 3072, ZC_LX = 4096, ZC_LG = 5120, ZC_GQ = 6144, ZC_GK = 7168, ZC_GV = 8192, ZC_GZ = 9216, ZC_BR = 10240;
constexpr int MO_SH1 = 0, MO_SC1 = 2048, MO_GT1 = 4096, MO_SH2 = 6144, MO_SC2 = 8192, MO_GT2 = 10240;

constexpr size_t MiB = 1u << 20;
constexpr size_t WS_CTL = 0, CTL_BYTES = 1 * MiB;
constexpr size_t WS_MODV = 1 * MiB;
constexpr size_t WS_RTW = 2 * MiB;
constexpr size_t WS_GAB = 3 * MiB;
constexpr size_t WS_GABW = 2 * MiB + 512 * 1024;
constexpr size_t WS_ROWINFO = 4 * MiB;
constexpr size_t WS_TOK = 5 * MiB;
constexpr size_t WS_WIN = 8 * MiB;
constexpr size_t WS_BP = 73 * MiB;
constexpr size_t WS_WO = 85 * MiB;
constexpr size_t WS_W13 = 93 * MiB;
constexpr size_t WS_W2 = 221 * MiB;
constexpr size_t WS_H = 285 * MiB;
constexpr size_t WS_Y = 349 * MiB;
constexpr size_t WS_MF = 445 * MiB;
constexpr size_t WS_Z = 573 * MiB;
constexpr size_t WS_XB = WS_Z;
constexpr size_t WS_HID = WS_Z + 160 * MiB;
constexpr size_t WS_SLOT = WS_Z + 200 * MiB;
constexpr size_t WS_LWT = 1085 * MiB;
constexpr size_t WS_LPH = 1086 * MiB;
constexpr size_t WS_LCARRY = 1088 * MiB;
constexpr size_t WS_ROPE_C = 1089 * MiB;
constexpr size_t WS_ROPE_S = 1093 * MiB;
constexpr size_t WS_KV = 1100 * MiB;
constexpr size_t WS_GP2 = 1164 * MiB;
constexpr size_t WS_GPO = WS_GP2 + 64 * MiB;
constexpr size_t WS_GSV = 445 * MiB;
constexpr size_t WS_GUP = 1276 * MiB;
constexpr size_t WS_GGL = 1340 * MiB;
constexpr size_t WS_GO = 1341 * MiB;
constexpr size_t WS_END = 1373 * MiB;
constexpr int CW_BAR = 4096;
constexpr int CW_CNT = 16384;
constexpr int CW_SUB = 17408;
constexpr int CW_MOEQ = 65536;

constexpr int LDS_STAGE = 131072;
constexpr int LDS_BYTES = 163840;
constexpr int LDS_MISC = LDS_BYTES - 1024;
constexpr int MAXTILES = 160;

constexpr int PH_MOD = 0, PH_L0 = 1, PH_PER_LAYER = 11, PH_FINAL = 23, NPH = 24;

struct Params { const float* in[29]; float* out; unsigned char* ws; int ph_lo, ph_hi; };


#define CAS __attribute__((address_space(4)))
__device__ __forceinline__ const CAS char* karg_base() { const CAS char* ka = (const CAS char*)__builtin_amdgcn_kernarg_segment_ptr(); asm volatile("" : "+s"(ka)); return ka; }
__device__ __forceinline__ const float* KIN(int i) { return *(const float* const CAS*)(karg_base() + 8 * i); }
__device__ __forceinline__ float* KOUT() { return *(float* const CAS*)(karg_base() + 232); }
__device__ __forceinline__ unsigned char* KWS() { return *(unsigned char* const CAS*)(karg_base() + 240); }

typedef __bf16 bf16x2_n __attribute__((ext_vector_type(2)));
__device__ __forceinline__ unsigned pk2(float lo, float hi) { const f32x2 f = {lo, hi}; const bf16x2_n b = __builtin_convertvector(f, bf16x2_n); return __builtin_bit_cast(unsigned, b); }
__device__ __forceinline__ unsigned f2bf(float f) { return pk2(f, 0.f) & 0xffffu; }
__device__ __forceinline__ float bf2f(unsigned short b) { return __builtin_bit_cast(float, ((unsigned)b) << 16); }
__device__ __forceinline__ float bflo(unsigned w) { return __builtin_bit_cast(float, w << 16); }
__device__ __forceinline__ float bfhi(unsigned w) { return __builtin_bit_cast(float, w & 0xffff0000u); }
__device__ __forceinline__ float wave_sum(float v) {
#pragma unroll
    for (int o = 1; o < 64; o <<= 1) v += __shfl_xor(v, o);
    return v;
}
__device__ __forceinline__ float sigm(float x) { return 1.0f / (1.0f + expf(-x)); }
__device__ __forceinline__ float fexp(float x) { return __builtin_amdgcn_exp2f(x * 1.4426950408889634f); }
__device__ __forceinline__ float fsigm(float x) { return __builtin_amdgcn_rcpf(1.0f + __builtin_amdgcn_exp2f(-x * 1.4426950408889634f)); }
__device__ __forceinline__ float fsilu(float x) { return x * fsigm(x); }
__device__ __forceinline__ float siluf(float x) { return x * sigm(x); }
__device__ __forceinline__ float softplusf(float x) { return fmaxf(x, 0.f) + log1pf(expf(-fabsf(x))); }
__device__ __forceinline__ void unpack8(const u32x4 a, float (&o)[8]) { o[0] = bflo(a.x); o[1] = bfhi(a.x); o[2] = bflo(a.y); o[3] = bfhi(a.y); o[4] = bflo(a.z); o[5] = bfhi(a.z); o[6] = bflo(a.w); o[7] = bfhi(a.w); }
__device__ __forceinline__ float gelu_tanh(float x) { return 0.5f * x * (1.0f + tanhf(0.7978845608028654f * (x + 0.044715f * x * x * x))); }

#define XB_TMO      128
#define XB_XCNT(j)  (256  + 64 * (j))
#define XB_XSUB(j)  (1280 + 64 * (j))
#define XB_XGEN(j)  (2304 + 64 * (j))
#define XB_TOP      3328
#define XB_TOPGEN   3392
#define XCD_BAR_WORDS 3456
#define XB_SPIN_CAP (1u << 24)
__device__ __forceinline__ unsigned xb_ld(unsigned* p)              { return __hip_atomic_load(p, __ATOMIC_RELAXED, __HIP_MEMORY_SCOPE_AGENT); }
__device__ __forceinline__ unsigned xb_add(unsigned* p, unsigned v) { return __hip_atomic_fetch_add(p, v, __ATOMIC_RELAXED, __HIP_MEMORY_SCOPE_AGENT); }
__device__ __forceinline__ unsigned xb_xcc_id() { return (unsigned)__builtin_amdgcn_s_getreg((3 << 11) | 20) & 0xFu; }
#define XB_SPIN(cond, bar) do { unsigned _sp = 0; while (cond) { __builtin_amdgcn_s_sleep(1); \
    if ((++_sp & 255u) == 0u) { if (xb_ld(&(bar)[XB_TMO])) break; if (_sp > XB_SPIN_CAP) { atomicAdd(&(bar)[XB_TMO], 1u); break; } } } } while (0)
struct XcdBarrier { unsigned* bar; unsigned x; volatile LAS unsigned* st; };
__device__ __forceinline__ XcdBarrier xcd_barrier_post(unsigned* bar, volatile LAS unsigned* st) {
    XcdBarrier b; b.bar = bar; b.x = xb_xcc_id(); b.st = st;
    if (threadIdx.x == 0) (void)xb_add(&bar[XB_XCNT(b.x)], 1u);
    return b;
}
__device__ __forceinline__ void xcd_barrier_complete(unsigned* bar, unsigned x, unsigned& nloc, unsigned& nx) {
    const unsigned G = gridDim.x * gridDim.y * gridDim.z;
    unsigned sum, cnt, mine, sp = 0u;
    for (;;) {
        sum = 0u; cnt = 0u; mine = 0u;
#pragma unroll 1
        for (unsigned j = 0; j < 16; ++j) { const unsigned c = xb_ld(&bar[XB_XCNT(j)]); sum += c; cnt += (c > 0u) ? 1u : 0u; mine = (j == x) ? c : mine; }
        if (sum == G) break;
        __builtin_amdgcn_s_sleep(1);
        if ((++sp & 255u) == 0u) { if (xb_ld(&bar[XB_TMO])) break; if (sp > XB_SPIN_CAP) { atomicAdd(&bar[XB_TMO], 1u); break; } }
    }
    nloc = mine > 0u ? mine : 1u; nx = cnt > 0u ? cnt : 1u;
}
__device__ __forceinline__ void xcd_barrier(const XcdBarrier& b) {
    asm volatile("s_waitcnt vmcnt(0)" ::: "memory");
    __syncthreads();
    if (threadIdx.x == 0) {
        unsigned* bar = b.bar;
        __builtin_amdgcn_s_waitcnt(0);
        unsigned nloc = b.st[0], nx = b.st[1];
        if (nloc == 0u) { xcd_barrier_complete(bar, b.x, nloc, nx); b.st[0] = nloc; b.st[1] = nx; }
        const unsigned old = xb_add(&bar[XB_XSUB(b.x)], 1u);
        const unsigned gen = old / nloc;
        if (old + 1u == (gen + 1u) * nloc) {
            __builtin_amdgcn_fence(__ATOMIC_RELEASE, "agent");
            asm volatile("s_waitcnt vmcnt(0)" ::: "memory");
            const unsigned og = xb_add(&bar[XB_TOP], 1u);
            const unsigned tg = og / nx;
            if (og + 1u == (tg + 1u) * nx) xb_add(&bar[XB_TOPGEN], 1u);
            else XB_SPIN(xb_ld(&bar[XB_TOPGEN]) == tg, bar);
            __builtin_amdgcn_fence(__ATOMIC_ACQUIRE, "agent");
            xb_add(&bar[XB_XGEN(b.x)], 1u);
            asm volatile("s_waitcnt vmcnt(0)" ::: "memory");
        } else {
            XB_SPIN(xb_ld(&bar[XB_XGEN(b.x)]) == gen, bar);
            __builtin_amdgcn_fence(__ATOMIC_ACQUIRE, "agent");
            asm volatile("s_waitcnt vmcnt(0)" ::: "memory");
        }
    }
    __syncthreads();
}


__device__ __forceinline__ void sub_barrier(unsigned* cnt, unsigned target, unsigned* tmo) {
    asm volatile("s_waitcnt vmcnt(0)" ::: "memory");
    __syncthreads();
    if (threadIdx.x == 0) {
        __builtin_amdgcn_fence(__ATOMIC_RELEASE, "agent");
        asm volatile("s_waitcnt vmcnt(0)" ::: "memory");
        (void)xb_add(cnt, 1u);
        unsigned sp = 0u;
        while (xb_ld(cnt) < target) { __builtin_amdgcn_s_sleep(1); if ((++sp & 255u) == 0u) { if (xb_ld(tmo)) break; if (sp > XB_SPIN_CAP) { atomicAdd(tmo, 1u); break; } } }
        __builtin_amdgcn_fence(__ATOMIC_ACQUIRE, "agent");
        asm volatile("s_waitcnt vmcnt(0)" ::: "memory");
    }
    __syncthreads();
}

namespace pg8 {
constexpr int BM = 256, BK = 64, HALF = 128, HTB = HALF * BK * 2, STAGE_BYTES = 8 * HTB, NXCD = 8, WGM = 8;
__device__ __forceinline__ int lds_byte(int r, int c) { const int st = (r >> 4) * 2 + (c >> 5), rr = r & 15, cc = c & 31, ob = rr * 64 + cc * 2; return st * 1024 + (ob ^ (((ob >> 9) & 1) << 5)); }
__device__ __forceinline__ void stage_rc(int b, int& R, int& C) { const int st = b / 1024, sb = b % 1024, swz = sb ^ (((sb >> 9) & 1) << 5); R = (st >> 1) * 16 + swz / 64; C = (st & 1) * 32 + (swz % 64) / 2; }
__device__ __forceinline__ int perm32(int rho) { const int n = rho >> 4, i = rho & 15; return 8 * (i >> 2) + 4 * n + (i & 3); }
struct Unit { int pm, pn, aoff; };
struct Gemm { const bf16_t* A; const bf16_t* Bt; int lda, ldb, K; };
__device__ __forceinline__ bool static_tile(int L, int nM, int nN, int& pm, int& pn) {
    const int nwg = nM * nN; if (L >= nwg) return false;
    int wgid = L; { const int q = nwg / NXCD, r = nwg % NXCD, xcd = wgid % NXCD, off = wgid / NXCD; wgid = (xcd < r ? xcd * (q + 1) : r * (q + 1) + (xcd - r) * q) + off; }
    const int nig = WGM * nN, gid = wgid / nig, fm = gid * WGM, gsz = (nM - fm) < WGM ? (nM - fm) : WGM;
    pm = fm + ((wgid % nig) % gsz); pn = (wgid % nig) / gsz; return true;
}
__device__ __forceinline__ unsigned cvt_pk_bf16(float lo, float hi) { return pk2(lo, hi); }

template <class E, class = void> struct epi_early { static constexpr bool value = false; };
template <class E> struct epi_early<E, decltype((void)E::EARLY)> { static constexpr bool value = E::EARLY; };
template <class Epi, class Sched>
__device__ __forceinline__ void gemm_phase(LAS unsigned char* lds, const Gemm g, const Sched& S, const Epi& E) {
    int tid = threadIdx.x; asm volatile("" : "+v"(tid)); const int wid = __builtin_amdgcn_readfirstlane(tid >> 6), lane = tid & 63, wr = wid >> 2, wc = wid & 3, fr = lane & 15, fq = lane >> 4;
    int K = g.K; asm volatile("" : "+s"(K)); const int nt = K / BK; int lda_ = g.lda, ldb_ = g.ldb; asm volatile("" : "+s"(lda_), "+s"(ldb_));
    unsigned voffA[2], voffB[2];
#pragma unroll
    for (int i = 0; i < 2; ++i) { int R, C; stage_rc(tid * 16 + i * 8192, R, C); const int Rb = Epi::PERM ? ((R & ~31) + perm32(R & 31)) : R;
        voffA[i] = (unsigned)(R * lda_ + C) * 2u; voffB[i] = (unsigned)(Rb * ldb_ + C) * 2u; }
    const size_t kstep = (size_t)(BK * 2);
    const int* rtab = S.row_table();
    const size_t hstepA = Sched::GATHER ? (size_t)0 : (size_t)HALF * lda_ * 2, hstepB = (size_t)HALF * ldb_ * 2;
    const size_t tstepA = 2 * hstepA, tstepB = 2 * hstepB;
    unsigned vc0[2], vc1[2], vn0[2], vn1[2];
#define PG8_ROWS(pm_, o0, o1) do { _Pragma("unroll") for (int _i = 0; _i < 2; ++_i) { int _R, _C; stage_rc(tid * 16 + _i * 8192, _R, _C); \
        if (Sched::GATHER) { o0[_i] = (unsigned)(rtab[(pm_) * 256 + _R] * lda_ + _C) * 2u; o1[_i] = (unsigned)(rtab[(pm_) * 256 + 128 + _R] * lda_ + _C) * 2u; } else { o0[_i] = voffA[_i]; o1[_i] = voffA[_i]; } } } while (0)
    const unsigned ldsw = (unsigned)wid * 1024u;
    const int aoff = lds_byte(wr * 64 + fr, fq * 8), boff = lds_byte(wc * 32 + fr, fq * 8);
#define PG8_SA(b, h) (((b) * 2 + (h)) * HTB)
#define PG8_SB(b, h) ((4 + (b) * 2 + (h)) * HTB)
#define PG8_STAGE(bufoff, gbase, voff) do { _Pragma("unroll") for (int _i = 0; _i < 2; ++_i) \
        __builtin_amdgcn_global_load_lds((const unsigned*)((const char*)(gbase) + (voff)[_i]), (LAS unsigned*)(lds + (bufoff) + ldsw + _i * 8192), 16, 0, 0); } while (0)
#define PG8_LDA(dst, b, h) do { _Pragma("unroll") for (int m = 0; m < 4; ++m) _Pragma("unroll") for (int k = 0; k < 2; ++k) dst[m][k] = *(const LAS bf16x8*)(lds + PG8_SA(b, h) + aoff + m * 2048 + k * 1024); } while (0)
#define PG8_LDB(dst, b, h) do { _Pragma("unroll") for (int n = 0; n < 2; ++n) _Pragma("unroll") for (int k = 0; k < 2; ++k) dst[n][k] = *(const LAS bf16x8*)(lds + PG8_SB(b, h) + boff + n * 2048 + k * 1024); } while (0)
#define PG8_MMA(ai, bj, At, Bt) do { __builtin_amdgcn_s_setprio(1); _Pragma("unroll") for (int m = 0; m < 4; ++m) _Pragma("unroll") for (int n = 0; n < 2; ++n) _Pragma("unroll") for (int k = 0; k < 2; ++k) \
        acc[ai][bj][m][n] = __builtin_amdgcn_mfma_f32_16x16x32_bf16(Bt[n][k], At[m][k], acc[ai][bj][m][n], 0, 0, 0); __builtin_amdgcn_s_setprio(0); } while (0)
#define PG8_WAIT_V(n) asm volatile("s_waitcnt vmcnt(" #n ")" ::: "memory")
#define PG8_WAIT_L(n) asm volatile("s_waitcnt lgkmcnt(" #n ")" ::: "memory")
#define PG8_BAR __builtin_amdgcn_s_barrier()
#define PG8_SCHED __builtin_amdgcn_sched_barrier(0)
    Unit cur, nxt; int ui = 0;
    if (!S.next(0, cur)) return;
    f32x4 acc[2][2][4][2];
#pragma unroll
    for (int a = 0; a < 2; ++a)
#pragma unroll
        for (int b = 0; b < 2; ++b)
#pragma unroll
            for (int m = 0; m < 4; ++m)
#pragma unroll
                for (int n = 0; n < 2; ++n) acc[a][b][m][n] = (f32x4){0.f, 0.f, 0.f, 0.f};
    bf16x8 At[4][2], B0[2][2], B1[2][2];
    const char* cA = (const char*)g.A + (size_t)cur.pm * tstepA + (size_t)cur.aoff; const char* cB = (const char*)g.Bt + (size_t)cur.pn * tstepB;
    PG8_ROWS(cur.pm, vc0, vc1);
#define PG8_PROLOGUE_A(cA_, cB_, v0_, v1_) do { PG8_STAGE(PG8_SB(0, 0), cB_, voffB); PG8_STAGE(PG8_SA(0, 0), cA_, v0_); PG8_STAGE(PG8_SB(0, 1), (cB_) + hstepB, voffB); PG8_STAGE(PG8_SA(0, 1), (cA_) + hstepA, v1_); } while (0)
#define PG8_PROLOGUE_B() do { if (wr == 1) PG8_BAR; PG8_WAIT_V(4); PG8_BAR; \
        PG8_STAGE(PG8_SB(1, 0), cB + kstep, voffB); PG8_STAGE(PG8_SA(1, 0), cA + kstep, vc0); PG8_STAGE(PG8_SB(1, 1), cB + hstepB + kstep, voffB); \
        PG8_WAIT_V(6); PG8_BAR; } while (0)
#define PG8_PROLOGUE() do { PG8_PROLOGUE_A(cA, cB, vc0, vc1); PG8_PROLOGUE_B(); } while (0)
    if (!Epi::LDS_EPI) PG8_PROLOGUE();
    for (;;) {
        const bool has_next = S.next(ui + 1, nxt);
        if (Epi::LDS_EPI) { S.ready(cur); if (!(epi_early<Epi>::value && ui > 0)) PG8_PROLOGUE_A(cA, cB, vc0, vc1); PG8_PROLOGUE_B(); }
        const bool chain = has_next && !Epi::LDS_EPI;
        const char* nA = chain ? (const char*)g.A + (size_t)nxt.pm * tstepA + (size_t)nxt.aoff : cA; const char* nB = chain ? (const char*)g.Bt + (size_t)nxt.pn * tstepB : cB;
        if (chain) PG8_ROWS(nxt.pm, vn0, vn1); else { vn0[0] = vc0[0]; vn0[1] = vc0[1]; vn1[0] = vc1[0]; vn1[1] = vc1[1]; }
        for (int t = 0; t < nt; t += 2) {
            const bool last = (t == nt - 2);
            const char* a1 = cA + (size_t)(t + 1) * kstep;
            const char* a2 = last ? nA : cA + (size_t)(t + 2) * kstep; const char* b2 = last ? nB : cB + (size_t)(t + 2) * kstep;
            const char* a3 = a2 + kstep; const char* b3 = b2 + kstep;
            unsigned x0[2], x1[2]; x0[0] = last ? vn0[0] : vc0[0]; x0[1] = last ? vn0[1] : vc0[1]; x1[0] = last ? vn1[0] : vc1[0]; x1[1] = last ? vn1[1] : vc1[1];
            PG8_LDB(B0, 0, 0); PG8_SCHED; PG8_LDA(At, 0, 0); PG8_STAGE(PG8_SA(1, 1), a1 + hstepA, vc1);
            PG8_WAIT_L(8); PG8_BAR; PG8_WAIT_L(0); PG8_MMA(0, 0, At, B0); PG8_BAR; PG8_SCHED;
            PG8_LDB(B1, 0, 1); PG8_STAGE(PG8_SB(0, 0), b2, voffB);
            PG8_BAR; PG8_WAIT_L(0); PG8_MMA(0, 1, At, B1); PG8_BAR;
            PG8_LDA(At, 0, 1); PG8_STAGE(PG8_SA(0, 0), a2, x0);
            PG8_BAR; PG8_WAIT_L(0); PG8_MMA(1, 0, At, B0); PG8_BAR; PG8_SCHED;
            PG8_STAGE(PG8_SB(0, 1), b2 + hstepB, voffB);
            PG8_WAIT_V(6); PG8_BAR; PG8_MMA(1, 1, At, B1); PG8_BAR;
            PG8_LDB(B0, 1, 0); PG8_SCHED; PG8_LDA(At, 1, 0); PG8_STAGE(PG8_SA(0, 1), a2 + hstepA, x1);
            PG8_WAIT_L(8); PG8_BAR; PG8_WAIT_L(0); PG8_MMA(0, 0, At, B0); PG8_BAR; PG8_SCHED;
            PG8_LDB(B1, 1, 1); PG8_STAGE(PG8_SB(1, 0), b3, voffB);
            PG8_BAR; PG8_WAIT_L(0); PG8_MMA(0, 1, At, B1); PG8_BAR;
            PG8_LDA(At, 1, 1); PG8_STAGE(PG8_SA(1, 0), a3, x0);
            PG8_BAR; PG8_WAIT_L(0); PG8_MMA(1, 0, At, B0); PG8_BAR; PG8_SCHED;
            PG8_STAGE(PG8_SB(1, 1), b3 + hstepB, voffB);
            PG8_WAIT_V(6); PG8_BAR; PG8_MMA(1, 1, At, B1); PG8_BAR;
        }
        if (Epi::LDS_EPI) { PG8_WAIT_V(0); if (wr == 0) PG8_BAR; PG8_BAR;
            if constexpr (epi_early<Epi>::value) { static_assert(!Sched::GATHER, "early prologue: plain row tiles only");
                E.run_a(acc, cur, wr, wc, lds, tid);
                if (has_next) { const char* eA = (const char*)g.A + (size_t)nxt.pm * tstepA + (size_t)nxt.aoff; const char* eB = (const char*)g.Bt + (size_t)nxt.pn * tstepB; PG8_PROLOGUE_A(eA, eB, voffA, voffA); }
                E.run_b(cur, lds, tid); }
            else E.run(acc, cur, wr, wc, fr, fq, lds, tid); }
        else E(acc, cur, wr, wc, fr, fq);
        if (!has_next) break;
        if (!E.keep(cur))
#pragma unroll
        for (int a = 0; a < 2; ++a)
#pragma unroll
            for (int b = 0; b < 2; ++b)
#pragma unroll
                for (int m = 0; m < 4; ++m)
#pragma unroll
                    for (int n = 0; n < 2; ++n) acc[a][b][m][n] = (f32x4){0.f, 0.f, 0.f, 0.f};
        if (Epi::LDS_EPI) { cur = nxt; cA = (const char*)g.A + (size_t)cur.pm * tstepA + (size_t)cur.aoff; cB = (const char*)g.Bt + (size_t)cur.pn * tstepB; ++ui; PG8_ROWS(cur.pm, vc0, vc1); }
        else { cur = nxt; cA = nA; cB = nB; ++ui; vc0[0] = vn0[0]; vc0[1] = vn0[1]; vc1[0] = vn1[0]; vc1[1] = vn1[1]; }
    }
    if (!Epi::LDS_EPI) { PG8_WAIT_V(0); if (wr == 0) PG8_BAR; PG8_BAR; }
#undef PG8_ROWS
#undef PG8_PROLOGUE
#undef PG8_PROLOGUE_A
#undef PG8_PROLOGUE_B
#undef PG8_SA
#undef PG8_SB
#undef PG8_STAGE
#undef PG8_LDA
#undef PG8_LDB
#undef PG8_MMA
#undef PG8_WAIT_V
#undef PG8_WAIT_L
#undef PG8_BAR
#undef PG8_SCHED
}
}
using pg8::Unit;

struct SchedStatic { static constexpr bool GATHER = false; __device__ __forceinline__ const int* row_table() const { return nullptr; } __device__ __forceinline__ void ready(const Unit&) const {} int nM, nN, G, c;
    __device__ __forceinline__ bool next(int i, Unit& u) const { int pm, pn; if (!pg8::static_tile(i * G + c, nM, nN, pm, pn)) return false; u.pm = pm; u.pn = pn; u.aoff = 0; return true; } };
struct SchedMerge { static constexpr bool GATHER = false; __device__ __forceinline__ const int* row_table() const { return nullptr; } __device__ __forceinline__ void ready(const Unit&) const {} int G, c;
    __device__ __forceinline__ bool next(int i, Unit& u) const { const int ti = i / 3, b = i - 3 * ti; int pm, pn; if (!pg8::static_tile(ti * G + c, 64, 8, pm, pn)) return false;
        u.pm = pm; u.pn = b * 8 + pn; u.aoff = b * 1024 * 2; return true; } };
template <bool GATH>
struct SchedMoe { static constexpr bool GATHER = GATH; const int* rtab; __device__ __forceinline__ const int* row_table() const { return rtab; } __device__ __forceinline__ void ready(const Unit&) const {} int G, c, nN; const LAS int* tbl;
    __device__ __forceinline__ bool next(int i, Unit& u) const { const int L = i * G + c; const int ntl = __builtin_amdgcn_readfirstlane(tbl[224]); if (L >= ntl * nN) return false;
        const int pm = L / nN; u.pm = pm; u.pn = __builtin_amdgcn_readfirstlane(tbl[pm]) * nN + (L - pm * nN); u.aoff = 0; return true; } };
struct SchedMoeDyn { static constexpr bool GATHER = false; __device__ __forceinline__ const int* row_table() const { return nullptr; } int nN; const LAS int* tbl; volatile LAS int* slot; unsigned* done; unsigned* tmo;
    __device__ __forceinline__ bool next(int i, Unit& u) const { const int L = __builtin_amdgcn_readfirstlane(slot[i & 1]); const int ntl = __builtin_amdgcn_readfirstlane(tbl[224]); if (L >= ntl * nN) return false;
        const int pm = L / nN; u.pm = pm; u.pn = __builtin_amdgcn_readfirstlane(tbl[pm]) * nN + (L - pm * nN); u.aoff = 0; return true; }
    __device__ __forceinline__ void ready(const Unit& u) const {
        if (threadIdx.x == 0) { if (slot[4] == 0) { unsigned* d = done + 64 * (u.pm + 1); unsigned sp = 0u;
                while (xb_ld(d) < 32u) { __builtin_amdgcn_s_sleep(1); if ((++sp & 255u) == 0u) { if (xb_ld(tmo)) break; if (sp > XB_SPIN_CAP) { atomicAdd(tmo, 1u); break; } } } }
            slot[4] = 0; __builtin_amdgcn_fence(__ATOMIC_ACQUIRE, "agent"); asm volatile("s_waitcnt vmcnt(0)" ::: "memory"); }
        asm volatile("s_waitcnt lgkmcnt(0)" ::: "memory"); __builtin_amdgcn_s_barrier(); asm volatile("" ::: "memory"); } };

struct EpiZ { static constexpr bool LDS_EPI = false; template <class A_> __device__ __forceinline__ void run(A_&, const Unit&, int, int, int, int, LAS unsigned char*, int) const {} __device__ __forceinline__ bool keep(const Unit&) const { return false; } static constexpr bool PERM = true; bf16_t* Z; float* GAB;
    __device__ __forceinline__ void operator()(const f32x4 (&acc)[2][2][4][2], const Unit& u, int wr, int wc, int fr, int fq) const {
        const int row0 = u.pm * 256 + wr * 64 + fr;
        if (u.pn < 64) {
            const int col0 = u.pn * 256 + wc * 32 + 8 * fq;
#pragma unroll
            for (int ai = 0; ai < 2; ++ai)
#pragma unroll
                for (int m = 0; m < 4; ++m) { bf16_t* rowp = Z + (size_t)(row0 + ai * 128 + m * 16) * NZ + col0;
#pragma unroll
                    for (int bj = 0; bj < 2; ++bj) { const f32x4 v0 = acc[ai][bj][m][0], v1 = acc[ai][bj][m][1]; u32x4 w;
                        w.x = pg8::cvt_pk_bf16(v0[0], v0[1]); w.y = pg8::cvt_pk_bf16(v0[2], v0[3]); w.z = pg8::cvt_pk_bf16(v1[0], v1[1]); w.w = pg8::cvt_pk_bf16(v1[2], v1[3]);
                        *(u32x4*)(rowp + bj * 128) = w; } }
        } else if (wc == 0 && fq < 2) {
#pragma unroll
            for (int ai = 0; ai < 2; ++ai)
#pragma unroll
                for (int m = 0; m < 4; ++m) { float* gp = GAB + (size_t)(row0 + ai * 128 + m * 16) * 16 + 8 * fq;
                    *(f32x4*)gp = acc[ai][0][m][0]; *(f32x4*)(gp + 4) = acc[ai][0][m][1]; }
        }
    } };
struct EpiZL { static constexpr bool LDS_EPI = true, PERM = true, EARLY = true; bf16_t* Z;
    __device__ __forceinline__ bool keep(const Unit&) const { return false; }
    __device__ __forceinline__ void operator()(const f32x4 (&)[2][2][4][2], const Unit&, int, int, int, int) const {}
    template <class A_> __device__ __forceinline__ void run(A_&, const Unit&, int, int, int, int, LAS unsigned char*, int) const {}
    __device__ __forceinline__ void rows_out(const Unit& u, LAS unsigned char* lds, int tid, int i) const { const int c = tid & 31; const int row = (tid >> 5) + 16 * i;
        const u32x4 w = *(const LAS u32x4*)(lds + row * 512 + ((c ^ (row & 31)) << 4)); __builtin_nontemporal_store(w, (u32x4*)(Z + (size_t)(u.pm * 256 + row) * NZ + u.pn * 256 + c * 8)); }
    __device__ __forceinline__ void run_a(const f32x4 (&acc)[2][2][4][2], const Unit& u, int wr, int wc, LAS unsigned char* lds, int tid_) const {
        int tid = tid_; asm volatile("" : "+v"(tid));
        const int fr = tid & 15, fq = (tid >> 4) & 3;
#pragma unroll
        for (int ai = 0; ai < 2; ++ai)
#pragma unroll
            for (int m = 0; m < 4; ++m) { const int r = ai * 128 + wr * 64 + m * 16 + fr;
#pragma unroll
                for (int bj = 0; bj < 2; ++bj) { const int c16 = 16 * bj + 4 * wc + fq; const f32x4 v0 = acc[ai][bj][m][0], v1 = acc[ai][bj][m][1]; u32x4 w;
                    w.x = pk2(v0[0], v0[1]); w.y = pk2(v0[2], v0[3]); w.z = pk2(v1[0], v1[1]); w.w = pk2(v1[2], v1[3]);
                    *(LAS u32x4*)(lds + r * 512 + ((c16 ^ (r & 31)) << 4)) = w; }
                asm volatile("" ::: "memory"); }
        __syncthreads();
#pragma unroll
        for (int i = 0; i < 4; ++i) rows_out(u, lds, tid, i);
        asm volatile("" ::: "memory");
#pragma unroll
        for (int i = 8; i < 12; ++i) rows_out(u, lds, tid, i);
        asm volatile("s_waitcnt lgkmcnt(0)" ::: "memory"); __builtin_amdgcn_s_barrier(); asm volatile("" ::: "memory");
    }
    __device__ __forceinline__ void run_b(const Unit& u, LAS unsigned char* lds, int tid_) const {
        int tid = tid_; asm volatile("" : "+v"(tid));
#pragma unroll
        for (int i = 4; i < 8; ++i) rows_out(u, lds, tid, i);
        asm volatile("" ::: "memory");
#pragma unroll
        for (int i = 12; i < 16; ++i) rows_out(u, lds, tid, i);
        asm volatile("s_waitcnt lgkmcnt(0)" ::: "memory"); __builtin_amdgcn_s_barrier(); asm volatile("" ::: "memory");
    } };
struct EpiMerge { static constexpr bool LDS_EPI = false; template <class A_> __device__ __forceinline__ void run(A_&, const Unit&, int, int, int, int, LAS unsigned char*, int) const {} static constexpr bool PERM = true; const bf16_t* Z; bf16_t* OUT;
    __device__ __forceinline__ bool keep(const Unit& u) const { return (u.pn >> 3) < 2; }
    __device__ __forceinline__ void operator()(f32x4 (&acc)[2][2][4][2], const Unit& u, int wr, int wc, int fr, int fq) const {
        const int b = u.pn >> 3, pnl = u.pn & 7; const int row0 = u.pm * 256 + wr * 64 + fr, col0 = pnl * 256 + wc * 32 + 8 * fq;
        const bf16_t* zb = Z + ZC_BR + b * 2048 + col0;
        u32x4 gb[2][2][2], gn[2][2][2];
#define EM_LOAD(slot, aim_) do { const int ai_ = (aim_) >> 1, mh_ = (aim_) & 1; _Pragma("unroll") for (int mm = 0; mm < 2; ++mm) _Pragma("unroll") for (int bj = 0; bj < 2; ++bj) { \
            const bf16_t* zp = zb + (size_t)(row0 + ai_ * 128 + (2 * mh_ + mm) * 16) * NZ + bj * 128; gb[slot][mm][bj] = *(const u32x4*)zp; gn[slot][mm][bj] = (b < 2) ? *(const u32x4*)(zp + 2048) : (u32x4){0u, 0u, 0u, 0u}; } } while (0)
        EM_LOAD(0, 0);
#pragma unroll
        for (int aim = 0; aim < 4; ++aim) { const int ai = aim >> 1, mh = aim & 1, sl = aim & 1;
            if (aim + 1 < 4) EM_LOAD((aim + 1) & 1, aim + 1);
#pragma unroll
            for (int mm = 0; mm < 2; ++mm) { const int m = 2 * mh + mm;
#pragma unroll
                for (int bj = 0; bj < 2; ++bj) { float eb[8]; { float x[8]; unpack8(gb[sl][mm][bj], x);
#pragma unroll
                        for (int i = 0; i < 8; ++i) eb[i] = __builtin_amdgcn_rcpf(1.0f + fexp(-fmaxf(fminf(x[i], 30.f), -30.f))); }
                    if (b < 2) { float x[8]; unpack8(gn[sl][mm][bj], x);
#pragma unroll
                        for (int i = 0; i < 8; ++i) eb[i] *= 1.0f + fexp(-fmaxf(fminf(x[i], 30.f), -30.f)); }
                    f32x4& v0 = acc[ai][bj][m][0]; f32x4& v1 = acc[ai][bj][m][1];
                    v0[0] *= eb[0]; v0[1] *= eb[1]; v0[2] *= eb[2]; v0[3] *= eb[3]; v1[0] *= eb[4]; v1[1] *= eb[5]; v1[2] *= eb[6]; v1[3] *= eb[7];
                    if (b == 2) { u32x4 w; w.x = pg8::cvt_pk_bf16(v0[0], v0[1]); w.y = pg8::cvt_pk_bf16(v0[2], v0[3]); w.z = pg8::cvt_pk_bf16(v1[0], v1[1]); w.w = pg8::cvt_pk_bf16(v1[2], v1[3]);
                        *(u32x4*)(OUT + (size_t)(row0 + ai * 128 + m * 16) * 2048 + col0 + bj * 128) = w; } } }
        }
#undef EM_LOAD
    } };
struct EpiWout { static constexpr bool LDS_EPI = false; template <class A_> __device__ __forceinline__ void run(A_&, const Unit&, int, int, int, int, LAS unsigned char*, int) const {} __device__ __forceinline__ bool keep(const Unit&) const { return false; } static constexpr bool PERM = false; const float* xsrc; float* xdst; const float* gt;
    __device__ __forceinline__ void operator()(const f32x4 (&acc)[2][2][4][2], const Unit& u, int wr, int wc, int fr, int fq) const {
        const int row0 = u.pm * 256 + wr * 64 + fr, col0 = u.pn * 256 + wc * 32 + 4 * fq;
        f32x4 gv[2][2];
#pragma unroll
        for (int bj = 0; bj < 2; ++bj)
#pragma unroll
            for (int n = 0; n < 2; ++n) gv[bj][n] = *(const f32x4*)(gt + col0 + bj * 128 + n * 16);
        f32x4 xo[2][2][2][2];
#define EW_LOAD(slot, q_) do { const int ai_ = (q_) >> 1, mh_ = (q_) & 1; _Pragma("unroll") for (int mm = 0; mm < 2; ++mm) { const size_t off_ = (size_t)(row0 + ai_ * 128 + (2 * mh_ + mm) * 16) * 2048 + col0; \
            _Pragma("unroll") for (int bj = 0; bj < 2; ++bj) _Pragma("unroll") for (int n = 0; n < 2; ++n) xo[slot][mm][bj][n] = *(const f32x4*)(xsrc + off_ + bj * 128 + n * 16); } } while (0)
        EW_LOAD(0, 0);
#pragma unroll
        for (int q = 0; q < 4; ++q) { const int ai = q >> 1, mh = q & 1, sl = q & 1;
            if (q + 1 < 4) EW_LOAD((q + 1) & 1, q + 1);
#pragma unroll
            for (int mm = 0; mm < 2; ++mm) { const int m = 2 * mh + mm; const size_t off = (size_t)(row0 + ai * 128 + m * 16) * 2048 + col0;
#pragma unroll
                for (int bj = 0; bj < 2; ++bj)
#pragma unroll
                    for (int n = 0; n < 2; ++n) *(f32x4*)(xdst + off + bj * 128 + n * 16) = xo[sl][mm][bj][n] + gv[bj][n] * acc[ai][bj][m][n]; } }
#undef EW_LOAD
    } };
struct EpiW13 { static constexpr bool LDS_EPI = false; template <class A_> __device__ __forceinline__ void run(A_&, const Unit&, int, int, int, int, LAS unsigned char*, int) const {} __device__ __forceinline__ bool keep(const Unit&) const { return false; } static constexpr bool PERM = true; bf16_t* HID; unsigned* done;
    __device__ __forceinline__ void operator()(const f32x4 (&acc)[2][2][4][2], const Unit& u, int wr, int wc, int fr, int fq) const {
        const int pnl = u.pn & 3; const int row0 = u.pm * 256 + wr * 64 + fr, col0 = pnl * 128 + wc * 32 + 8 * fq;
        const __amdgpu_buffer_rsrc_t rs = __builtin_amdgcn_make_buffer_rsrc(HID, 0, MAXTILES * 256 * 512 * 2, 0x00020000);
#pragma unroll
        for (int ai = 0; ai < 2; ++ai)
#pragma unroll
            for (int m = 0; m < 4; ++m) { float hv[8];
#pragma unroll
                for (int n = 0; n < 2; ++n)
#pragma unroll
                    for (int j = 0; j < 4; ++j) hv[n * 4 + j] = fsilu(acc[ai][0][m][n][j]) * acc[ai][1][m][n][j];
                u32x4 w; w.x = pg8::cvt_pk_bf16(hv[0], hv[1]); w.y = pg8::cvt_pk_bf16(hv[2], hv[3]); w.z = pg8::cvt_pk_bf16(hv[4], hv[5]); w.w = pg8::cvt_pk_bf16(hv[6], hv[7]);
                __builtin_amdgcn_raw_buffer_store_b128(w, rs, (unsigned)(((row0 + ai * 128 + m * 16) * 512 + col0) * 2), 0,   16); }
        asm volatile("s_waitcnt vmcnt(0)" ::: "memory");
        if (fr == 0 && fq == 0) (void)xb_add(done + 64 * (u.pm + 1), 1u);
    } };
struct EpiW2 { static constexpr bool LDS_EPI = false; template <class A_> __device__ __forceinline__ void run(A_&, const Unit&, int, int, int, int, LAS unsigned char*, int) const {} __device__ __forceinline__ bool keep(const Unit&) const { return false; } static constexpr bool PERM = true; bf16_t* SLOT; const u32x2* rowinfo; const LAS int* tbl;
    __device__ __forceinline__ void operator()(const f32x4 (&acc)[2][2][4][2], const Unit& u, int wr, int wc, int fr, int fq) const {
        const int e = u.pn >> 3, pnl = u.pn & 7; const int row0 = u.pm * 256 + wr * 64 + fr, col0 = pnl * 256 + wc * 32 + 8 * fq; const int rend = __builtin_amdgcn_readfirstlane(tbl[192 + e]);
        u32x2 inf[2][4];
#pragma unroll
        for (int ai = 0; ai < 2; ++ai)
#pragma unroll
            for (int m = 0; m < 4; ++m) inf[ai][m] = rowinfo[row0 + ai * 128 + m * 16];
#pragma unroll
        for (int ai = 0; ai < 2; ++ai)
#pragma unroll
            for (int m = 0; m < 4; ++m) { const int r = row0 + ai * 128 + m * 16;
                if (r < rend) { const unsigned wbits = inf[ai][m].y; const float w = __uint_as_float(wbits); const unsigned tx = inf[ai][m].x; const unsigned tok = tx >> 1, k = tx & 1u;
                    bf16_t* dst = SLOT + ((size_t)k * S_ + tok) * 2048 + col0;
#pragma unroll
                    for (int bj = 0; bj < 2; ++bj) { const f32x4 v0 = acc[ai][bj][m][0] * w, v1 = acc[ai][bj][m][1] * w; u32x4 o;
                        o.x = pg8::cvt_pk_bf16(v0[0], v0[1]); o.y = pg8::cvt_pk_bf16(v0[2], v0[3]); o.z = pg8::cvt_pk_bf16(v1[0], v1[1]); o.w = pg8::cvt_pk_bf16(v1[2], v1[3]);
                        *(u32x4*)(dst + bj * 128) = o; } } }
    } };

struct EpiW2L { static constexpr bool LDS_EPI = true, PERM = true; bf16_t* SLOT; const u32x2* rowinfo; const LAS int* tbl; unsigned* q; volatile LAS int* slot; unsigned* done;
    __device__ __forceinline__ bool keep(const Unit&) const { return false; }
    __device__ __forceinline__ void operator()(const f32x4 (&)[2][2][4][2], const Unit&, int, int, int, int) const {}
    __device__ __forceinline__ void run(const f32x4 (&acc)[2][2][4][2], const Unit& u, int wr, int wc, int fr_, int fq_, LAS unsigned char* lds, int tid_) const {
        int tid = tid_; asm volatile("" : "+v"(tid));
        int qn = 0; unsigned dn = 0u;
        if (tid == 0) { qn = (int)xb_add(q, 1u); const int Ln = slot[(slot[2] + 1) & 1]; if (Ln < tbl[224] * 8) dn = xb_ld(done + 64 * ((Ln >> 3) + 1)); }
        const int fr = tid & 15, fq = (tid >> 4) & 3; const int e = u.pn >> 3, pnl = u.pn & 7; const int rend = __builtin_amdgcn_readfirstlane(tbl[192 + e]);
        LAS unsigned* rowx = (LAS unsigned*)(lds + 131072);
        u32x2 inf[2][4];
#pragma unroll
        for (int ai = 0; ai < 2; ++ai)
#pragma unroll
            for (int m = 0; m < 4; ++m) inf[ai][m] = rowinfo[u.pm * 256 + ai * 128 + wr * 64 + m * 16 + fr];
#pragma unroll
        for (int ai = 0; ai < 2; ++ai)
#pragma unroll
            for (int m = 0; m < 4; ++m) { const int r = ai * 128 + wr * 64 + m * 16 + fr; const bool valid = (u.pm * 256 + r) < rend; const float w = valid ? __uint_as_float(inf[ai][m].y) : 0.f;
                if (wc == 0 && fq == 0) rowx[r] = valid ? inf[ai][m].x : 0xffffffffu;
#pragma unroll
                for (int bj = 0; bj < 2; ++bj) { const int c16 = 16 * bj + 4 * wc + fq; const f32x4 v0 = acc[ai][bj][m][0] * w, v1 = acc[ai][bj][m][1] * w; u32x4 o;
                    o.x = pk2(v0[0], v0[1]); o.y = pk2(v0[2], v0[3]); o.z = pk2(v1[0], v1[1]); o.w = pk2(v1[2], v1[3]);
                    *(LAS u32x4*)(lds + r * 512 + ((c16 ^ (r & 31)) << 4)) = o; }
                asm volatile("" ::: "memory"); }
        __syncthreads();
        const int c = tid & 31;
#pragma unroll
        for (int i = 0; i < 16; ++i) { const int row = (tid >> 5) + 16 * i; const unsigned tx = rowx[row];
            if (tx != 0xffffffffu) { const u32x4 o = *(const LAS u32x4*)(lds + row * 512 + ((c ^ (row & 31)) << 4));
                *(u32x4*)(SLOT + ((size_t)(tx & 1u) * S_ + (tx >> 1)) * 2048 + pnl * 256 + c * 8) = o; }
            if ((i & 3) == 3) asm volatile("" ::: "memory"); }
        if (tid == 0) { const int n = slot[2]; slot[n & 1] = qn; slot[2] = n + 1; slot[4] = dn >= 32u ? 1 : 0; }
        asm volatile("s_waitcnt lgkmcnt(0)" ::: "memory"); __builtin_amdgcn_s_barrier(); asm volatile("" ::: "memory");
    } };

struct Frame { LAS unsigned char* lds; unsigned char* ldsg; int tid, lane, wave, G, bx; };
extern __shared__ __attribute__((aligned(16))) unsigned char lds_raw[];
__device__ __forceinline__ Frame make_frame() { Frame F; int tz = threadIdx.x; asm volatile("" : "+v"(tz)); F.lds = (LAS unsigned char*)lds_raw; F.ldsg = lds_raw; F.tid = tz; F.lane = tz & 63;
    F.wave = __builtin_amdgcn_readfirstlane(tz >> 6); F.G = gridDim.x; F.bx = blockIdx.x; return F; }

struct TItem { const float* W; bf16_t* WT; int ldw, srccol, k0, ldk, dstrow; };
__device__ __forceinline__ void titem_load(const TItem& t, f32x4 (&x)[8], int lane) {
    const int n4 = (lane & 7) * 4, kr = lane >> 3;
#pragma unroll
    for (int i = 0; i < 8; ++i) x[i] = __builtin_nontemporal_load((const f32x4*)(t.W + (size_t)(t.k0 + kr + 8 * i) * t.ldw + t.srccol + n4));
}
__device__ __forceinline__ void titem_store(const TItem& t, const f32x4 (&x)[8], float* scr, int lane) {
    const int n4 = (lane & 7) * 4, kr = lane >> 3;
#pragma unroll
    for (int i = 0; i < 8; ++i) { float* s = scr + (kr + 8 * i) * 33 + n4; s[0] = x[i][0]; s[1] = x[i][1]; s[2] = x[i][2]; s[3] = x[i][3]; }
    asm volatile("s_waitcnt lgkmcnt(0)" ::: "memory");
    const int c = lane & 7;
#pragma unroll
    for (int j = 0; j < 4; ++j) { const int n = (lane >> 3) + 8 * j; const float* s = scr + (8 * c) * 33 + n;
        u32x4 o; o.x = pk2(s[0 * 33], s[1 * 33]); o.y = pk2(s[2 * 33], s[3 * 33]); o.z = pk2(s[4 * 33], s[5 * 33]); o.w = pk2(s[6 * 33], s[7 * 33]);
        *(u32x4*)(t.WT + (size_t)(t.dstrow + n) * t.ldk + t.k0 + 8 * c) = o; }
    asm volatile("s_waitcnt lgkmcnt(0)" ::: "memory");
}

__device__ __forceinline__ void phase_mod(const Frame& F, const Params& p) {
    const float* cvec = KIN(1); const float* ada_w = KIN(3); const float* ada_b = KIN(4);
    float* modv = (float*)(KWS() + WS_MODV);
    float* sc = (float*)F.ldsg;
    f32x2* red = (f32x2*)(sc + 2048);
    for (int k = F.tid; k < 2048; k += NTHR) sc[k] = siluf(cvec[k]);
    __syncthreads();
    for (int u = F.bx; u < 2 * 96; u += F.G) {
        const int l = u / 96, cb = u % 96, col = cb * 128 + 2 * F.lane;
        const float* wp = ada_w + ((size_t)l * 2048 + F.wave * 256) * 12288 + col; const float* sp = sc + F.wave * 256;
        f32x2 acc = (f32x2){0.f, 0.f};
#pragma unroll 16
        for (int k = 0; k < 256; ++k) { const f32x2 w = __builtin_nontemporal_load((const f32x2*)(wp + (size_t)k * 12288)); const float s = sp[k]; acc[0] += s * w[0]; acc[1] += s * w[1]; }
        red[F.wave * 64 + F.lane] = acc;
        __syncthreads();
        if (F.wave == 0) { f32x2 s = *(const f32x2*)(ada_b + l * 12288 + col);
#pragma unroll
            for (int w = 0; w < 8; ++w) s += red[w * 64 + F.lane];
            *(f32x2*)(modv + l * 12288 + col) = s; }
        __syncthreads();
    }
}

__device__ __forceinline__ void phase_convert(const Frame& F, const Params& p, int l) {
    float* scr = (float*)(F.ldsg + F.wave * 8448);
    const int gw = F.bx * NWAVES + F.wave, NGW = F.G * NWAVES;
    bf16_t* WIN = (bf16_t*)(KWS() + WS_WIN); bf16_t* BP = (bf16_t*)(KWS() + WS_BP); bf16_t* WO = (bf16_t*)(KWS() + WS_WO); bf16_t* W13 = (bf16_t*)(KWS() + WS_W13); bf16_t* W2 = (bf16_t*)(KWS() + WS_W2);
    const float* w_in = KIN(7) + (size_t)l * 2048 * INC;
    const float* bp = KIN(19) + (size_t)l * 3 * 1024 * 2048;
    const float* wo = KIN(20) + (size_t)l * 2048 * 2048;
    const float* w1 = KIN(25) + (size_t)l * 32 * 2048 * 512; const float* w3 = KIN(26) + (size_t)l * 32 * 2048 * 512; const float* w2 = KIN(27) + (size_t)l * 32 * 512 * 2048;
    const float* lwa = KIN(10) + (size_t)l * 8 * 16384; const float* lwx = KIN(12) + (size_t)l * 8 * 16384; bf16_t* LWT = (bf16_t*)(KWS() + WS_LWT);
    constexpr int I_IN = 512 * 32, I_BP = 3 * 16 * 64, I_WO = 32 * 64, I_W13 = 32 * 2 * 512, I_W2 = 32 * 512, I_LRU = 8 * 2 * 8;
    constexpr int NITEMS = I_IN + I_BP + I_WO + I_W13 + I_W2 + I_LRU;
    auto decode = [&](int it) -> TItem { TItem t; int r = it;
        if (r < I_IN) { const int nb = r % 512, kb = r / 512; t.W = w_in; t.ldw = INC; t.srccol = (nb < 320) ? 32 * nb : 10256 + 32 * (nb - 320); t.k0 = 64 * kb; t.WT = WIN; t.ldk = 2048; t.dstrow = 32 * nb; return t; }
        r -= I_IN;
        if (r < I_BP) { const int b = r / 1024, q = r % 1024, nb = q % 64, kb = q / 64; t.W = bp + (size_t)b * 1024 * 2048; t.ldw = 2048; t.srccol = 32 * nb; t.k0 = 64 * kb; t.WT = BP + (size_t)b * 2048 * 1024; t.ldk = 1024; t.dstrow = 32 * nb; return t; }
        r -= I_BP;
        if (r < I_WO) { const int nb = r % 64, kb = r / 64; t.W = wo; t.ldw = 2048; t.srccol = 32 * nb; t.k0 = 64 * kb; t.WT = WO; t.ldk = 2048; t.dstrow = 32 * nb; return t; }
        r -= I_WO;
        if (r < I_W13) { const int e = r / 1024, q = r % 1024, which = q / 512, q2 = q % 512, nb = q2 % 16, kb = q2 / 16; const int pn = nb >> 2, j = nb & 3;
            t.W = (which ? w3 : w1) + (size_t)e * 2048 * 512; t.ldw = 512; t.srccol = 32 * nb; t.k0 = 64 * kb; t.WT = W13 + (size_t)e * 1024 * 2048; t.ldk = 2048; t.dstrow = pn * 256 + which * 128 + 32 * j; return t; }
        r -= I_W13;
        if (r < I_W2) { const int e = r / 512, q = r % 512, nb = q % 64, kb = q / 64; t.W = w2 + (size_t)e * 512 * 2048; t.ldw = 2048; t.srccol = 32 * nb; t.k0 = 64 * kb; t.WT = W2 + (size_t)e * 2048 * 512; t.ldk = 512; t.dstrow = 32 * nb; return t; }
        r -= I_W2;
        { const int n = r / 16, q = r % 16, which = q / 8, q2 = q % 8, nb = q2 % 4, kb = q2 / 4; t.W = (which ? lwx : lwa) + (size_t)n * 16384; t.ldw = 128; t.srccol = 32 * nb; t.k0 = 64 * kb; t.WT = LWT + (size_t)n * 256 * 128; t.ldk = 128; t.dstrow = which * 128 + 32 * nb; return t; } };
    if (gw < NITEMS) { TItem ta = decode(gw); f32x4 xa[8]; titem_load(ta, xa, F.lane);
        for (int it = gw; it < NITEMS; it += NGW) { const int nx = it + NGW; TItem tb = ta; f32x4 xb[8];
            if (nx < NITEMS) { tb = decode(nx); titem_load(tb, xb, F.lane); }
            titem_store(ta, xa, scr, F.lane);
            if (nx < NITEMS) { ta = tb;
#pragma unroll
                for (int i = 0; i < 8; ++i) xa[i] = xb[i]; } } }
    float* rtw = (float*)(KWS() + WS_RTW); const float* rgw = KIN(21) + (size_t)l * 2048 * 4; const float* rew = KIN(23) + (size_t)l * 2048 * 32;
    for (int idx = F.bx * NTHR + F.tid; idx < 36 * 2048; idx += F.G * NTHR) { const int j = idx >> 11, k = idx & 2047; rtw[idx] = (j < 32) ? rew[k * 32 + j] : rgw[k * 4 + (j - 32)]; }
}

template <int MODE>
__device__ __forceinline__ void phase_norm(const Frame& F, const Params& p, int l, bool fold) {
    float* tA = (float*)(F.ldsg + 98304);
    float* tB = tA + 2048;
    float* tG = tB + 2048;
    const float* modv = (const float*)(KWS() + WS_MODV);
    const float* xin = (MODE == 0 && l == 0) ? KIN(0) : KOUT();
    float* xio = KOUT();
    bf16_t* H = (bf16_t*)(KWS() + WS_H);
    const bf16_t* SL = (const bf16_t*)(KWS() + WS_SLOT);
    for (int c = F.tid; c < 2048; c += NTHR) {
        if (MODE == 0) { tA[c] = KIN(5)[l * 2048 + c] * (1.f + modv[l * 12288 + MO_SC1 + c]); tB[c] = modv[l * 12288 + MO_SH1 + c]; }
        if (MODE == 1) { tA[c] = KIN(6)[l * 2048 + c] * (1.f + modv[l * 12288 + MO_SC2 + c]); tB[c] = modv[l * 12288 + MO_SH2 + c]; }
        if (MODE == 2) { tA[c] = KIN(28)[c]; tB[c] = 0.f; }
        tG[c] = fold ? DBG_MOE_SCALE * modv[(MODE == 2 ? 1 : l - 1) * 12288 + MO_GT2 + c] : 0.f;
    }
    __syncthreads();
    const int gw = F.bx * NWAVES + F.wave, NGW = F.G * NWAVES;
    const float* rtw = (const float*)(KWS() + WS_RTW);
    for (int row = gw; row < S_; row += NGW) {
        f32x4 v[8]; float ss = 0.f;
#pragma unroll
        for (int j = 0; j < 8; ++j) { const int c = 4 * F.lane + 256 * j; v[j] = *(const f32x4*)(xin + (size_t)row * 2048 + c);
            if (fold) { const u32x2 a = *(const u32x2*)(SL + (size_t)row * 2048 + c), b = *(const u32x2*)(SL + ((size_t)S_ + row) * 2048 + c); const f32x4 g = *(const f32x4*)(tG + c);
#if DBG_M == 1
                v[j][0] += g[0]; v[j][1] += g[1]; v[j][2] += g[2]; v[j][3] += g[3];
#else
                v[j][0] += g[0] * (bflo(a.x) + bflo(b.x)); v[j][1] += g[1] * (bfhi(a.x) + bfhi(b.x)); v[j][2] += g[2] * (bflo(a.y) + bflo(b.y)); v[j][3] += g[3] * (bfhi(a.y) + bfhi(b.y));
#endif
                if (MODE != 2) *(f32x4*)(xio + (size_t)row * 2048 + c) = v[j]; }
            ss += (v[j][0] * v[j][0] + v[j][1] * v[j][1]) + (v[j][2] * v[j][2] + v[j][3] * v[j][3]); }
        const float rstd = 1.0f / sqrtf(wave_sum(ss) * (1.0f / 2048.0f) + EPS);
#pragma unroll
        for (int j = 0; j < 8; ++j) { const int c = 4 * F.lane + 256 * j; const f32x4 a = *(const f32x4*)(tA + c), b = *(const f32x4*)(tB + c);
            v[j] = v[j] * rstd * a + b;
            if (MODE == 2) *(f32x4*)(xio + (size_t)row * 2048 + c) = v[j];
            else { u32x2 w; w.x = pk2(v[j][0], v[j][1]); w.y = pk2(v[j][2], v[j][3]); *(u32x2*)(H + (size_t)row * 2048 + c) = w; } }
        if (MODE == 1) {
            float mine = 0.f;
#pragma unroll 2
            for (int jo = 0; jo < 36; ++jo) { float d = 0.f;
#pragma unroll
                for (int j = 0; j < 8; ++j) { const f32x4 w = *(const f32x4*)(rtw + (size_t)jo * 2048 + 4 * F.lane + 256 * j); d += (v[j][0] * w[0] + v[j][1] * w[1]) + (v[j][2] * w[2] + v[j][3] * w[3]); }
                d = wave_sum(d); mine = (F.lane == jo) ? d : mine; }
            if (F.lane < 32) mine += KIN(24)[l * 32 + F.lane]; else if (F.lane < 36) mine += KIN(22)[l * 4 + (F.lane - 32)];
            const float g0 = __shfl(mine, 32), g1 = __shfl(mine, 33), g2 = __shfl(mine, 34), g3 = __shfl(mine, 35);
            int gs = 0; float gm = g0; if (g1 > gm) { gm = g1; gs = 1; } if (g2 > gm) { gm = g2; gs = 2; } if (g3 > gm) { gm = g3; gs = 3; }
            const float pg = 1.0f / (expf(g0 - gm) + expf(g1 - gm) + expf(g2 - gm) + expf(g3 - gm));
            float ev[8];
#pragma unroll
            for (int i = 0; i < 8; ++i) ev[i] = __shfl(mine, gs * 8 + i);
            int i0 = 0; float v0 = ev[0];
#pragma unroll
            for (int i = 1; i < 8; ++i) if (ev[i] > v0) { v0 = ev[i]; i0 = i; }
            int i1 = -1; float v1 = -3.0e38f;
#pragma unroll
            for (int i = 0; i < 8; ++i) if (i != i0 && ev[i] > v1) { v1 = ev[i]; i1 = i; }
            const float e1 = expf(v1 - v0);
#if DBG_M == 6
            const float w0 = 0.3f, w1 = 0.2f;
#elif DBG_M == 7
            const float w0 = pg, w1 = 0.f;
#elif DBG_M == 8
            const float w0 = 1.0f / (1.0f + e1), w1 = 0.f;
#else
            const float w0 = pg / (1.0f + e1), w1 = pg * e1 / (1.0f + e1);
#endif
            if (F.lane == 0) { unsigned* cnt = (unsigned*)(KWS() + WS_CTL) + CW_CNT + l * 32; const int ex0 = gs * 8 + i0, ex1 = gs * 8 + i1;
                const unsigned p0 = atomicAdd(cnt + ex0, 1u), p1 = atomicAdd(cnt + ex1, 1u);
                unsigned* tk = (unsigned*)(KWS() + WS_TOK) + (size_t)row * 8;
                tk[0] = (unsigned)ex0; tk[1] = p0; tk[2] = __builtin_bit_cast(unsigned, w0); tk[3] = 0u; tk[4] = (unsigned)ex1; tk[5] = p1; tk[6] = __builtin_bit_cast(unsigned, w1); tk[7] = 0u; }
        }
    }
}

__device__ __forceinline__ void phase_norm1_gab(const Frame& F, const Params& p, int l, bool fold) {
    float* tA = (float*)(F.ldsg + 98304); float* tB = tA + 2048; float* tG = tB + 2048;
    bf16_t* Wl = (bf16_t*)F.ldsg;
    const float* modv = (const float*)(KWS() + WS_MODV); const float* xin = (l == 0) ? KIN(0) : KOUT(); float* xio = KOUT(); bf16_t* H = (bf16_t*)(KWS() + WS_H);
    const bf16_t* SL = (const bf16_t*)(KWS() + WS_SLOT); float* GAB = (float*)(KWS() + WS_GAB);
    __syncthreads();
    for (int c = F.tid; c < 2048; c += NTHR) { tA[c] = KIN(5)[l * 2048 + c] * (1.f + modv[l * 12288 + MO_SC1 + c]); tB[c] = modv[l * 12288 + MO_SH1 + c]; tG[c] = fold ? modv[(l - 1) * 12288 + MO_GT2 + c] : 0.f; }
    { const float* gabw = (const float*)(KWS() + WS_GABW) + (size_t)l * 16 * 2048;
        for (int i = F.tid; i < 16 * 2048 / 4; i += NTHR) { const f32x4 v = *(const f32x4*)(gabw + 4 * i); u32x2 o; o.x = pk2(v[0], v[1]); o.y = pk2(v[2], v[3]); *(u32x2*)(Wl + 4 * i) = o; } }
    __syncthreads();
    const int gw = F.bx * NWAVES + F.wave, NGW = F.G * NWAVES;
    for (int rb = gw * 2; rb < S_; rb += NGW * 2) {
        f32x4 v[2][8];
#pragma unroll
        for (int r = 0; r < 2; ++r) { const size_t row = (size_t)(rb + r); float ss = 0.f;
#pragma unroll
            for (int j = 0; j < 8; ++j) { const int c = 4 * F.lane + 256 * j; v[r][j] = *(const f32x4*)(xin + row * 2048 + c);
                if (fold) { const u32x2 a = *(const u32x2*)(SL + row * 2048 + c), b = *(const u32x2*)(SL + ((size_t)S_ + row) * 2048 + c); const f32x4 g = *(const f32x4*)(tG + c);
                    v[r][j][0] += g[0] * (bflo(a.x) + bflo(b.x)); v[r][j][1] += g[1] * (bfhi(a.x) + bfhi(b.x)); v[r][j][2] += g[2] * (bflo(a.y) + bflo(b.y)); v[r][j][3] += g[3] * (bfhi(a.y) + bfhi(b.y));
                    *(f32x4*)(xio + row * 2048 + c) = v[r][j]; }
                ss += (v[r][j][0] * v[r][j][0] + v[r][j][1] * v[r][j][1]) + (v[r][j][2] * v[r][j][2] + v[r][j][3] * v[r][j][3]); }
            const float rstd = 1.0f / sqrtf(wave_sum(ss) * (1.0f / 2048.0f) + EPS);
#pragma unroll
            for (int j = 0; j < 8; ++j) { const int c = 4 * F.lane + 256 * j; const f32x4 a = *(const f32x4*)(tA + c), b = *(const f32x4*)(tB + c); v[r][j] = v[r][j] * rstd * a + b;
                u32x2 w; w.x = pk2(v[r][j][0], v[r][j][1]); w.y = pk2(v[r][j][2], v[r][j][3]); *(u32x2*)(H + row * 2048 + c) = w; }
            asm volatile("" ::: "memory"); }
        float mine[2] = {0.f, 0.f};
#pragma unroll 1
        for (int jo = 0; jo < 16; ++jo) { float d[2] = {0.f, 0.f};
#pragma unroll
            for (int j = 0; j < 8; ++j) { const u32x2 wq = *(const u32x2*)(Wl + jo * 2048 + 4 * F.lane + 256 * j); const float w0 = bflo(wq.x), w1 = bfhi(wq.x), w2 = bflo(wq.y), w3 = bfhi(wq.y);
#pragma unroll
                for (int r = 0; r < 2; ++r) { d[r] = __builtin_fmaf(v[r][j][0], w0, d[r]); d[r] = __builtin_fmaf(v[r][j][1], w1, d[r]); d[r] = __builtin_fmaf(v[r][j][2], w2, d[r]); d[r] = __builtin_fmaf(v[r][j][3], w3, d[r]); } }
#pragma unroll
            for (int r = 0; r < 2; ++r) { const float s = wave_sum(d[r]); mine[r] = (F.lane == jo) ? s : mine[r]; } }
        if (F.lane < 16) {
#pragma unroll
            for (int r = 0; r < 2; ++r) GAB[(size_t)(rb + r) * 16 + F.lane] = mine[r]; }
    }
}

__device__ __forceinline__ void phase_norm2_router(const Frame& F, const Params& p, int l) {
    float* tA = (float*)(F.ldsg + 98304); float* tB = tA + 2048;
    const float* modv = (const float*)(KWS() + WS_MODV); const float* xin = KOUT(); bf16_t* H = (bf16_t*)(KWS() + WS_H);
    for (int c = F.tid; c < 2048; c += NTHR) { tA[c] = KIN(6)[l * 2048 + c] * (1.f + modv[l * 12288 + MO_SC2 + c]); tB[c] = modv[l * 12288 + MO_SH2 + c]; }
    __syncthreads();
    const int gw = F.bx * NWAVES + F.wave, NGW = F.G * NWAVES; const float* rtw = (const float*)(KWS() + WS_RTW);
    const float be = (F.lane < 32) ? KIN(24)[l * 32 + F.lane] : ((F.lane < 36) ? KIN(22)[l * 4 + (F.lane - 32)] : 0.f);
    for (int rb = gw * 4; rb < S_; rb += NGW * 4) {
        f32x4 v[4][8];
#pragma unroll
        for (int r = 0; r < 4; ++r) { const size_t row = (size_t)(rb + r); float ss = 0.f;
#pragma unroll
            for (int j = 0; j < 8; ++j) { v[r][j] = *(const f32x4*)(xin + row * 2048 + 4 * F.lane + 256 * j); ss += (v[r][j][0] * v[r][j][0] + v[r][j][1] * v[r][j][1]) + (v[r][j][2] * v[r][j][2] + v[r][j][3] * v[r][j][3]); }
            const float rstd = 1.0f / sqrtf(wave_sum(ss) * (1.0f / 2048.0f) + EPS);
#pragma unroll
            for (int j = 0; j < 8; ++j) { const int c = 4 * F.lane + 256 * j; const f32x4 a = *(const f32x4*)(tA + c), b = *(const f32x4*)(tB + c); v[r][j] = v[r][j] * rstd * a + b;
                u32x2 w; w.x = pk2(v[r][j][0], v[r][j][1]); w.y = pk2(v[r][j][2], v[r][j][3]); *(u32x2*)(H + row * 2048 + c) = w; } }
        float mine[4] = {0.f, 0.f, 0.f, 0.f};
#pragma unroll 2
        for (int jo = 0; jo < 36; ++jo) { f32x4 wv[8];
#pragma unroll
            for (int j = 0; j < 8; ++j) wv[j] = *(const f32x4*)(rtw + (size_t)jo * 2048 + 4 * F.lane + 256 * j);
#pragma unroll
            for (int r = 0; r < 4; ++r) { float d = 0.f;
#pragma unroll
                for (int j = 0; j < 8; ++j) { d = __builtin_fmaf(v[r][j][0], wv[j][0], d); d = __builtin_fmaf(v[r][j][1], wv[j][1], d); d = __builtin_fmaf(v[r][j][2], wv[j][2], d); d = __builtin_fmaf(v[r][j][3], wv[j][3], d); }
                d = wave_sum(d); mine[r] = (F.lane == jo) ? d : mine[r]; } }
#pragma unroll
        for (int r = 0; r < 4; ++r) { const float lg = mine[r] + be; const int row = rb + r;
            const float g0 = __shfl(lg, 32), g1 = __shfl(lg, 33), g2 = __shfl(lg, 34), g3 = __shfl(lg, 35);
            int gs = 0; float gm = g0; if (g1 > gm) { gm = g1; gs = 1; } if (g2 > gm) { gm = g2; gs = 2; } if (g3 > gm) { gm = g3; gs = 3; }
            const float pg = 1.0f / (expf(g0 - gm) + expf(g1 - gm) + expf(g2 - gm) + expf(g3 - gm));
            float ev[8];
#pragma unroll
            for (int i = 0; i < 8; ++i) ev[i] = __shfl(lg, gs * 8 + i);
            int i0 = 0; float v0 = ev[0];
#pragma unroll
            for (int i = 1; i < 8; ++i) if (ev[i] > v0) { v0 = ev[i]; i0 = i; }
            int i1 = -1; float v1 = -3.0e38f;
#pragma unroll
            for (int i = 0; i < 8; ++i) if (i != i0 && ev[i] > v1) { v1 = ev[i]; i1 = i; }
            const float e1 = expf(v1 - v0); const float w0 = pg / (1.0f + e1), w1 = pg * e1 / (1.0f + e1);
            if (F.lane == 0) { unsigned* cnt = (unsigned*)(KWS() + WS_CTL) + CW_CNT + l * 32; const int ex0 = gs * 8 + i0, ex1 = gs * 8 + i1;
                const unsigned p0 = atomicAdd(cnt + ex0, 1u), p1 = atomicAdd(cnt + ex1, 1u);
                unsigned* tk = (unsigned*)(KWS() + WS_TOK) + (size_t)row * 8;
                tk[0] = (unsigned)ex0; tk[1] = p0; tk[2] = __float_as_uint(w0); tk[3] = 0u; tk[4] = (unsigned)ex1; tk[5] = p1; tk[6] = __float_as_uint(w1); tk[7] = 0u; } }
    }
}

__device__ __forceinline__ void phase_norm2_router_lds(const Frame& F, const Params& p, int l) {
    float* tA = (float*)(F.ldsg + 131072); float* tB = tA + 2048;
    const float* modv = (const float*)(KWS() + WS_MODV); const float* xin = KOUT(); bf16_t* H = (bf16_t*)(KWS() + WS_H);
    for (int c = F.tid; c < 2048; c += NTHR) { tA[c] = KIN(6)[l * 2048 + c] * (1.f + modv[l * 12288 + MO_SC2 + c]); tB[c] = modv[l * 12288 + MO_SH2 + c]; }
    const int gw = F.bx * NWAVES + F.wave, NGW = F.G * NWAVES, ng = S_ / (NGW * 4), w = F.wave, lane = F.lane;
    const unsigned char* rtwb = (const unsigned char*)(KWS() + WS_RTW);
    const float be = (lane < 32) ? KIN(24)[l * 32 + lane] : ((lane < 36) ? KIN(22)[l * 4 + (lane - 32)] : 0.f);
#pragma unroll
    for (int k = 0; k < 8; ++k) __builtin_amdgcn_global_load_lds((const unsigned*)(rtwb + (size_t)(w + 8 * k) * 1024 + lane * 16), (LAS unsigned*)(F.lds + (w + 8 * k) * 1024), 16, 0, 0);
    __syncthreads();
    int s = 0;
#pragma unroll 1
    for (int g = 0; g < ng; ++g) { const int rb = gw * 4 + g * NGW * 4;
        f32x4 v[4][8]; float mine[4] = {0.f, 0.f, 0.f, 0.f};
        { float rstd[4];
#pragma unroll
        for (int r = 0; r < 4; ++r) { const size_t row = (size_t)(rb + r); float ss = 0.f;
#pragma unroll
            for (int j = 0; j < 8; ++j) { v[r][j] = *(const f32x4*)(xin + row * 2048 + 4 * lane + 256 * j); ss += (v[r][j][0] * v[r][j][0] + v[r][j][1] * v[r][j][1]) + (v[r][j][2] * v[r][j][2] + v[r][j][3] * v[r][j][3]); }
            rstd[r] = 1.0f / sqrtf(wave_sum(ss) * (1.0f / 2048.0f) + EPS); }
#pragma unroll
        for (int j = 0; j < 8; ++j) { const int c = 4 * lane + 256 * j; const f32x4 a = *(const f32x4*)(tA + c), b = *(const f32x4*)(tB + c);
#pragma unroll
            for (int r = 0; r < 4; ++r) { v[r][j] = v[r][j] * rstd[r] * a + b;
                u32x2 wq; wq.x = pk2(v[r][j][0], v[r][j][1]); wq.y = pk2(v[r][j][2], v[r][j][3]); *(u32x2*)(H + (size_t)(rb + r) * 2048 + c) = wq; }
            asm volatile("" ::: "memory"); } }
        f32x2 vp[2][8][4];
#pragma unroll
        for (int rp = 0; rp < 2; ++rp)
#pragma unroll
            for (int j = 0; j < 8; ++j)
#pragma unroll
                for (int i = 0; i < 4; ++i) vp[rp][j][i] = (f32x2){v[2 * rp][j][i], v[2 * rp + 1][j][i]};
#pragma unroll 1
        for (int blk = 0; blk < 5; ++blk, ++s) {
            asm volatile("s_waitcnt vmcnt(0)" ::: "memory");
            __syncthreads();
            if (blk < 4 || g + 1 < ng) { const int nb = (blk + 1) % 5; const int nld = (nb == 4) ? 4 : 8; int lz = lane * 16; asm volatile("" : "+v"(lz));
                const unsigned char* src = rtwb + (size_t)nb * 65536 + lz; LAS unsigned char* dst = F.lds + ((s + 1) & 1) * 65536;
#pragma unroll
                for (int k = 0; k < 8; ++k) if (k < nld) __builtin_amdgcn_global_load_lds((const unsigned*)(src + (size_t)(w + 8 * k) * 1024), (LAS unsigned*)(dst + (w + 8 * k) * 1024), 16, 0, 0); }
            { int l4 = 4 * lane; asm volatile("" : "+v"(l4)); const LAS float* wb = (const LAS float*)(F.lds + (s & 1) * 65536) + l4; const int nout = (blk == 4) ? 4 : 8;
#pragma unroll 1
                for (int q = 0; q < nout; ++q) { f32x2 dp[2] = {(f32x2){0.f, 0.f}, (f32x2){0.f, 0.f}};
#pragma unroll
                    for (int j = 0; j < 8; ++j) { const f32x4 wv = *(const LAS f32x4*)(wb + q * 2048 + 256 * j);
#pragma unroll
                        for (int rp = 0; rp < 2; ++rp)
#pragma unroll
                            for (int i = 0; i < 4; ++i) dp[rp] = __builtin_elementwise_fma(vp[rp][j][i], (f32x2){wv[i], wv[i]}, dp[rp]);
                        if ((j & 1) == 1) asm volatile("" ::: "memory"); }
                    const float d[4] = {dp[0][0], dp[0][1], dp[1][0], dp[1][1]};
                    const int jo = blk * 8 + q;
#pragma unroll
                    for (int r = 0; r < 4; ++r) { const float sm = wave_sum(d[r]); mine[r] = (lane == jo) ? sm : mine[r]; } } }
        }
#pragma unroll
        for (int r = 0; r < 4; ++r) { const float lg = mine[r] + be; const int row = rb + r;
            const float g0 = __shfl(lg, 32), g1 = __shfl(lg, 33), g2 = __shfl(lg, 34), g3 = __shfl(lg, 35);
            int gs = 0; float gm = g0; if (g1 > gm) { gm = g1; gs = 1; } if (g2 > gm) { gm = g2; gs = 2; } if (g3 > gm) { gm = g3; gs = 3; }
            const float pg = 1.0f / (expf(g0 - gm) + expf(g1 - gm) + expf(g2 - gm) + expf(g3 - gm));
            float ev[8];
#pragma unroll
            for (int i = 0; i < 8; ++i) ev[i] = __shfl(lg, gs * 8 + i);
            int i0 = 0; float v0 = ev[0];
#pragma unroll
            for (int i = 1; i < 8; ++i) if (ev[i] > v0) { v0 = ev[i]; i0 = i; }
            int i1 = -1; float v1 = -3.0e38f;
#pragma unroll
            for (int i = 0; i < 8; ++i) if (i != i0 && ev[i] > v1) { v1 = ev[i]; i1 = i; }
            const float e1 = expf(v1 - v0); const float w0 = pg / (1.0f + e1), w1 = pg * e1 / (1.0f + e1);
            if (lane == 0) { unsigned* cnt = (unsigned*)(KWS() + WS_CTL) + CW_CNT + l * 32; const int ex0 = gs * 8 + i0, ex1 = gs * 8 + i1;
                const unsigned p0 = atomicAdd(cnt + ex0, 1u), p1 = atomicAdd(cnt + ex1, 1u);
                unsigned* tk = (unsigned*)(KWS() + WS_TOK) + (size_t)row * 8;
                tk[0] = (unsigned)ex0; tk[1] = p0; tk[2] = __float_as_uint(w0); tk[3] = 0u; tk[4] = (unsigned)ex1; tk[5] = p1; tk[6] = __float_as_uint(w1); tk[7] = 0u; } }
    }
}


__device__ __forceinline__ void moe_tables(const Frame& F, const Params& p, int l) {
    LAS int* tbl = (LAS int*)(F.lds + LDS_MISC + 64);
    int* gtbl = (int*)(KWS() + WS_ROWINFO + 512 * 1024);
    if (F.wave == 0) { const unsigned* cnt = (const unsigned*)(KWS() + WS_CTL) + CW_CNT + l * 32; const int e = F.lane;
        const int c = (e < 32) ? (int)__hip_atomic_load(cnt + e, __ATOMIC_RELAXED, __HIP_MEMORY_SCOPE_AGENT) : 0; const int t = (c + 255) >> 8;
        int incl = t;
#pragma unroll
        for (int o = 1; o < 32; o <<= 1) { const int v = __shfl_up(incl, o); if (e >= o) incl += v; }
        const int start = incl - t; const int total = __shfl(incl, 31);
        if (e < 32) { tbl[160 + e] = start; tbl[192 + e] = start * 256 + c; for (int k = 0; k < t && start + k < MAXTILES; ++k) tbl[start + k] = e; }
        const int nt = total < MAXTILES ? total : MAXTILES;
        for (int k = nt + e; k < MAXTILES; k += 64) tbl[k] = 0;
        if (e == 0) tbl[224] = nt; }
    __syncthreads();
    if (F.bx == 0 && F.tid < 225) gtbl[F.tid] = tbl[F.tid];
}
__device__ __forceinline__ void moe_tables_load(const Frame& F, const Params& p) {
    LAS int* tbl = (LAS int*)(F.lds + LDS_MISC + 64);
    const int* gtbl = (const int*)(KWS() + WS_ROWINFO + 512 * 1024);
    if (F.tid < 225) tbl[F.tid] = gtbl[F.tid];
    __syncthreads();
}
__device__ __forceinline__ void phase_gather(const Frame& F, const Params& p, int l) {
    moe_tables(F, p, l);
    const LAS int* tbl = (const LAS int*)(F.lds + LDS_MISC + 64);
    u32x2* rowinfo = (u32x2*)(KWS() + WS_ROWINFO); int* rowtok = (int*)(KWS() + WS_TOK + 512 * 1024);
    for (int a = F.bx * NTHR + F.tid; a < 2 * S_; a += F.G * NTHR) { const int t = a >> 1, k = a & 1; const unsigned* tk = (const unsigned*)(KWS() + WS_TOK) + (size_t)t * 8 + 4 * k;
        const int e = (int)tk[0], pos = (int)tk[1]; const int dest = tbl[160 + e] * 256 + pos; u32x2 inf; inf.x = (unsigned)a; inf.y = tk[2]; rowinfo[dest] = inf; rowtok[dest] = t; }
    if (F.bx < 32) { const int e = F.bx; const int r0 = tbl[192 + e]; const int tend = (e < 31 ? tbl[160 + e + 1] : tbl[224]) * 256;
        for (int r = r0 + F.tid; r < tend; r += NTHR) rowtok[r] = 0; }
}

__device__ __forceinline__ void phase_lru_gates(const Frame& F, const Params& p, int l) {
    float* U = (float*)F.ldsg;
    const bf16_t* Z = (const bf16_t*)(KWS() + WS_Z); float* LA = (float*)(KWS() + WS_MF); float* LB = LA + (size_t)S_ * 1024;
    const float* cw = KIN(8) + l * 4 * 1024; const float* cb = KIN(9) + l * 1024; const float* wa = KIN(10) + (size_t)l * 8 * 128 * 128; const float* ba = KIN(11) + l * 1024;
    const float* wx = KIN(12) + (size_t)l * 8 * 128 * 128; const float* bx = KIN(13) + l * 1024; const float* lam = KIN(14) + l * 1024;
    for (int u = F.bx; u < 4096; u += F.G) {
        const int tt = u >> 1, half = u & 1, t0 = tt * 8, ch = half * 512 + F.tid, n = ch >> 7, j = ch & 127;
        float xr[11];
#pragma unroll
        for (int i = 0; i < 11; ++i) { const int t = t0 - 3 + i; xr[i] = (t >= 0) ? bf2f(Z[(size_t)t * NZ + ZC_LX + ch]) : 0.f; }
        const float c0 = cw[ch], c1 = cw[1024 + ch], c2 = cw[2048 + ch], c3 = cw[3072 + ch], cbv = cb[ch];
        float uo[8];
#pragma unroll
        for (int i = 0; i < 8; ++i) { uo[i] = c0 * xr[i] + c1 * xr[i + 1] + c2 * xr[i + 2] + c3 * xr[i + 3] + cbv; U[i * 512 + F.tid] = uo[i]; }
        __syncthreads();
        float ar[8], ai[8];
#pragma unroll
        for (int i = 0; i < 8; ++i) { ar[i] = 0.f; ai[i] = 0.f; }
        const float* wap = wa + (size_t)n * 16384 + j; const float* wxp = wx + (size_t)n * 16384 + j; const float* up = U + (F.tid & ~127);
        for (int i = 0; i < 128; ++i) { const float a = wap[i * 128], x = wxp[i * 128];
#pragma unroll
            for (int tk = 0; tk < 8; ++tk) { const float uu = up[tk * 512 + i]; ar[tk] += uu * a; ai[tk] += uu * x; } }
        const float bav = ba[ch], bxv = bx[ch], spl = softplusf(-lam[ch]);
#pragma unroll
        for (int tk = 0; tk < 8; ++tk) { const float r = sigm(ar[tk] + bav), ii = sigm(ai[tk] + bxv); const float la = -8.0f * r * spl;
            LA[(size_t)(t0 + tk) * 1024 + ch] = expf(la); LB[(size_t)(t0 + tk) * 1024 + ch] = sqrtf(-expm1f(2.0f * la)) * (ii * uo[tk]); }
        __syncthreads();
    }
}


constexpr int LRU_UF_PITCH = 132, LRU_UB_PITCH = 136;
template <bool FINAL>
__device__ __forceinline__ void lru_units(const Frame& F, const Params& p, int l, int first, int stride) {
    float* Uf = (float*)F.ldsg;
    float* Al = Uf + 64 * LRU_UF_PITCH;
    bf16_t* Ub = (bf16_t*)(Al + 64 * LRU_UF_PITCH);
    float* Cw = (float*)(Ub + 64 * LRU_UB_PITCH);
    const bf16_t* Z = (const bf16_t*)(KWS() + WS_Z); const bf16_t* LWT = (const bf16_t*)(KWS() + WS_LWT);
    float* PHb = (float*)(KWS() + WS_LPH); const float* CAR = (const float*)(KWS() + WS_LCARRY); bf16_t* Y = (bf16_t*)(KWS() + WS_Y);
    const float* cw = KIN(8) + l * 4 * 1024; const float* cb = KIN(9) + l * 1024; const float* ba = KIN(11) + l * 1024; const float* bx = KIN(13) + l * 1024; const float* lam = KIN(14) + l * 1024;
    const int w = F.wave, lane = F.lane, fr = lane & 15, fg = lane >> 4;
    int cur_n = -1; bf16x8 Bf[2][4]; float bav = 0.f, bxv = 0.f, spl = 0.f;
    u32x4 raw[4][2];
#define LRU_RAW(u_) do { const int n_ = (u_) & 7, t0_ = ((u_) >> 3) * 64, tt_ = F.tid >> 3, cg_ = F.tid & 7; _Pragma("unroll") for (int k = 0; k < 4; ++k) { const int t = t0_ + tt_ - 3 + k; \
        if (t >= 0) { const bf16_t* zp = Z + (size_t)t * NZ + ZC_LX + n_ * 128 + 16 * cg_; raw[k][0] = *(const u32x4*)zp; raw[k][1] = *(const u32x4*)(zp + 8); } \
        else { raw[k][0] = (u32x4){0u, 0u, 0u, 0u}; raw[k][1] = raw[k][0]; } } } while (0)
    if (first < 2048) LRU_RAW(first);
    for (int u = first; u < 2048; u += stride) {
        const int n = u & 7, ci = u >> 3, t0 = ci * 64;
        if (n != cur_n) {
            cur_n = n;
#pragma unroll
            for (int q = 0; q < 2; ++q)
#pragma unroll
                for (int ks = 0; ks < 4; ++ks) Bf[q][ks] = *(const bf16x8*)(LWT + ((size_t)n * 256 + q * 128 + 16 * w + fr) * 128 + 32 * ks + 8 * fg);
            const int ch = n * 128 + 16 * w + fr; bav = ba[ch]; bxv = bx[ch]; spl = softplusf(-lam[ch]);
            __syncthreads();
            for (int i = F.tid; i < 640; i += NTHR) { const int k = i >> 7, c = i & 127; Cw[i] = (k < 4) ? cw[k * 1024 + n * 128 + c] : cb[n * 128 + c]; }
            __syncthreads();
        }
        { const int tt = F.tid >> 3, cg = F.tid & 7; float xr[4][16];
#pragma unroll
            for (int k = 0; k < 4; ++k) { const u32x4 a = raw[k][0], b = raw[k][1];
                xr[k][0] = bflo(a.x); xr[k][1] = bfhi(a.x); xr[k][2] = bflo(a.y); xr[k][3] = bfhi(a.y); xr[k][4] = bflo(a.z); xr[k][5] = bfhi(a.z); xr[k][6] = bflo(a.w); xr[k][7] = bfhi(a.w);
                xr[k][8] = bflo(b.x); xr[k][9] = bfhi(b.x); xr[k][10] = bflo(b.y); xr[k][11] = bfhi(b.y); xr[k][12] = bflo(b.z); xr[k][13] = bfhi(b.z); xr[k][14] = bflo(b.w); xr[k][15] = bfhi(b.w); }
            if (u + stride < 2048) LRU_RAW(u + stride);
            float uo[16];
#pragma unroll
            for (int i = 0; i < 16; ++i) { const int c = 16 * cg + i; uo[i] = Cw[c] * xr[0][i] + Cw[128 + c] * xr[1][i] + Cw[256 + c] * xr[2][i] + Cw[384 + c] * xr[3][i] + Cw[512 + c]; }
#pragma unroll
            for (int i = 0; i < 4; ++i) *(f32x4*)(Uf + tt * LRU_UF_PITCH + 16 * cg + 4 * i) = (f32x4){uo[4 * i], uo[4 * i + 1], uo[4 * i + 2], uo[4 * i + 3]};
            u32x4 o0, o1; o0.x = pk2(uo[0], uo[1]); o0.y = pk2(uo[2], uo[3]); o0.z = pk2(uo[4], uo[5]); o0.w = pk2(uo[6], uo[7]); o1.x = pk2(uo[8], uo[9]); o1.y = pk2(uo[10], uo[11]); o1.z = pk2(uo[12], uo[13]); o1.w = pk2(uo[14], uo[15]);
            *(u32x4*)(Ub + tt * LRU_UB_PITCH + 16 * cg) = o0; *(u32x4*)(Ub + tt * LRU_UB_PITCH + 16 * cg + 8) = o1; }
        __syncthreads();
        f32x4 acc[4][2];
#pragma unroll
        for (int mt = 0; mt < 4; ++mt) { acc[mt][0] = (f32x4){0.f, 0.f, 0.f, 0.f}; acc[mt][1] = acc[mt][0]; }
#pragma unroll
        for (int mt = 0; mt < 4; ++mt)
#pragma unroll
            for (int ks = 0; ks < 4; ++ks) { const bf16x8 af = *(const bf16x8*)(Ub + (16 * mt + fr) * LRU_UB_PITCH + 32 * ks + 8 * fg);
                acc[mt][0] = __builtin_amdgcn_mfma_f32_16x16x32_bf16(af, Bf[0][ks], acc[mt][0], 0, 0, 0);
                acc[mt][1] = __builtin_amdgcn_mfma_f32_16x16x32_bf16(af, Bf[1][ks], acc[mt][1], 0, 0, 0); }
#pragma unroll
        for (int mt = 0; mt < 4; ++mt)
#pragma unroll
            for (int r = 0; r < 4; ++r) { const int tk = 16 * mt + 4 * fg + r, cc = 16 * w + fr;
                const float rr = fsigm(acc[mt][0][r] + bav), ii = fsigm(acc[mt][1][r] + bxv), la = -8.0f * rr * spl;
                const float uu = Uf[tk * LRU_UF_PITCH + cc]; const float av = fexp(la);
                Al[tk * LRU_UF_PITCH + cc] = av; Uf[tk * LRU_UF_PITCH + cc] = __builtin_amdgcn_sqrtf(fmaxf(1.0f - av * av, 0.f)) * (ii * uu); }
        __syncthreads();
        { const int chl = F.tid & 127, seg = F.tid >> 7, ch = n * 128 + chl; float* SP = (float*)(Cw + 640); float* SH = SP + 512;
            unsigned short gq[16];
            if (FINAL) {
#pragma unroll
                for (int t = 0; t < 16; ++t) gq[t] = Z[(size_t)(t0 + 16 * seg + t) * NZ + ZC_LG + ch]; }
            float h = 0.f, P = 1.f;
#pragma unroll
            for (int t = 0; t < 16; ++t) { const float a = Al[(16 * seg + t) * LRU_UF_PITCH + chl], bb = Uf[(16 * seg + t) * LRU_UF_PITCH + chl]; h = a * h + bb; P *= a; }
            SP[seg * 128 + chl] = P; SH[seg * 128 + chl] = h;
            __syncthreads();
            float hin = FINAL ? CAR[(size_t)ci * 1024 + ch] : 0.f;
            if (FINAL) {
                for (int s = 0; s < seg; ++s) hin = SP[s * 128 + chl] * hin + SH[s * 128 + chl];
                h = hin;
#pragma unroll
                for (int t = 0; t < 16; ++t) { const float a = Al[(16 * seg + t) * LRU_UF_PITCH + chl], bb = Uf[(16 * seg + t) * LRU_UF_PITCH + chl]; h = a * h + bb;
                    const float g = bf2f(gq[t]); const float gl = g * fsigm(1.5957691216057308f * (g + 0.044715f * g * g * g));
                    Y[(size_t)(t0 + 16 * seg + t) * 3072 + 1024 + ch] = (bf16_t)f2bf(h * gl); }
            } else if (seg == 0) { float Pt = 1.f, Ht = 0.f;
#pragma unroll
                for (int s = 0; s < 4; ++s) { Ht = SP[s * 128 + chl] * Ht + SH[s * 128 + chl]; Pt *= SP[s * 128 + chl]; }
                *(f32x2*)(PHb + ((size_t)ci * 1024 + ch) * 2) = (f32x2){Pt, Ht}; } }
        __syncthreads();
    }
}
#undef LRU_RAW
__device__ __forceinline__ void lru_carry(const Frame& F, int part) {
    const float* PHb = (const float*)(KWS() + WS_LPH); float* CAR = (float*)(KWS() + WS_LCARRY);
    const int ch = part * 512 + F.tid; float h = 0.f;
    for (int c0 = 0; c0 < 256; c0 += 32) { f32x2 v[32];
#pragma unroll
        for (int i = 0; i < 32; ++i) v[i] = *(const f32x2*)(PHb + ((size_t)(c0 + i) * 1024 + ch) * 2);
#pragma unroll
        for (int i = 0; i < 32; ++i) { CAR[(size_t)(c0 + i) * 1024 + ch] = h; h = v[i][0] * h + v[i][1]; } }
}


constexpr int RT_PITCH = 136;
__device__ __forceinline__ float ret_log2g(int h) { return log2f(1.0f - exp2f(-5.0f - (float)h)); }
__device__ __forceinline__ void phase_gabw(const Frame& F) {
    float* gabw = (float*)(KWS() + WS_GABW); const float* w_in = KIN(7);
    for (int idx = F.bx * NTHR + F.tid; idx < 2 * 16 * 2048; idx += F.G * NTHR) { const int j = idx & 15, lk = idx >> 4, l = lk >> 11, k = lk & 2047; gabw[(l * 16 + j) * 2048 + k] = w_in[(size_t)lk * INC + 10240 + j]; }
}
__device__ __forceinline__ void phase_rope_table(const Frame& F) {
    float* RC = (float*)(KWS() + WS_ROPE_C); float* RS = (float*)(KWS() + WS_ROPE_S); const int* pos = (const int*)KIN(2);
    for (int idx = F.bx * NTHR + F.tid; idx < S_ * 64; idx += F.G * NTHR) { const int t = idx >> 6, i = idx & 63;
        const float invf = (float)exp2(-(double)i * (13.287712379549449 / 64.0)); const float angf = (float)pos[t] * invf;
        const double rev = (double)angf * 0.15915494309189535; const float fr = (float)(rev - rint(rev));
        RC[idx] = __builtin_amdgcn_cosf(fr); RS[idx] = __builtin_amdgcn_sinf(fr); }
}
template <bool ROPE>
__device__ __forceinline__ void stage_transposed(const Frame& F, const bf16_t* src  , int t0, bf16_t* T, float mul0, float mul1) {
    const int p = F.lane, c = F.wave; const float* RC = (const float*)(KWS() + WS_ROPE_C); const float* RS = (const float*)(KWS() + WS_ROPE_S);
    float a[2][8], b[2][8];
#pragma unroll
    for (int q = 0; q < 2; ++q) { const bf16_t* rp = src + (size_t)(2 * p + q) * NZ; unpack8(*(const u32x4*)(rp + 8 * c), a[q]); unpack8(*(const u32x4*)(rp + 64 + 8 * c), b[q]);
        if (ROPE) { const size_t ro = (size_t)(t0 + 2 * p + q) * 64 + 8 * c; const f32x4 c0 = *(const f32x4*)(RC + ro), c1 = *(const f32x4*)(RC + ro + 4), s0 = *(const f32x4*)(RS + ro), s1 = *(const f32x4*)(RS + ro + 4);
#pragma unroll
            for (int i = 0; i < 8; ++i) { const float cs = i < 4 ? c0[i & 3] : c1[i & 3], sn = i < 4 ? s0[i & 3] : s1[i & 3]; const float x1 = a[q][i], x2 = b[q][i]; a[q][i] = x1 * cs - x2 * sn; b[q][i] = x2 * cs + x1 * sn; } }
        const float m = q ? mul1 : mul0;
#pragma unroll
        for (int i = 0; i < 8; ++i) { a[q][i] *= m; b[q][i] *= m; } }
#pragma unroll
    for (int i = 0; i < 8; ++i) { *(unsigned*)(T + (8 * c + i) * RT_PITCH + 2 * p) = pk2(a[0][i], a[1][i]); *(unsigned*)(T + (64 + 8 * c + i) * RT_PITCH + 2 * p) = pk2(b[0][i], b[1][i]); }
}
__device__ __forceinline__ void stage_natural_rope(const Frame& F, const bf16_t* src, int t0, bf16_t* N, float mul) {
    const float* RC = (const float*)(KWS() + WS_ROPE_C); const float* RS = (const float*)(KWS() + WS_ROPE_S);
#pragma unroll
    for (int rep = 0; rep < 2; ++rep) { const int c = F.tid & 7, tok = (F.tid >> 3) + 64 * rep; const bf16_t* rp = src + (size_t)tok * NZ; float a[8], b[8];
        unpack8(*(const u32x4*)(rp + 8 * c), a); unpack8(*(const u32x4*)(rp + 64 + 8 * c), b);
        const size_t ro = (size_t)(t0 + tok) * 64 + 8 * c; const f32x4 c0 = *(const f32x4*)(RC + ro), c1 = *(const f32x4*)(RC + ro + 4), s0 = *(const f32x4*)(RS + ro), s1 = *(const f32x4*)(RS + ro + 4);
        float y1[8], y2[8];
#pragma unroll
        for (int i = 0; i < 8; ++i) { const float cs = i < 4 ? c0[i & 3] : c1[i & 3], sn = i < 4 ? s0[i & 3] : s1[i & 3]; y1[i] = (a[i] * cs - b[i] * sn) * mul; y2[i] = (b[i] * cs + a[i] * sn) * mul; }
        u32x4 o1, o2; o1.x = pk2(y1[0], y1[1]); o1.y = pk2(y1[2], y1[3]); o1.z = pk2(y1[4], y1[5]); o1.w = pk2(y1[6], y1[7]); o2.x = pk2(y2[0], y2[1]); o2.y = pk2(y2[2], y2[3]); o2.z = pk2(y2[4], y2[5]); o2.w = pk2(y2[6], y2[7]);
        *(u32x4*)(N + tok * RT_PITCH + 8 * c) = o1; *(u32x4*)(N + tok * RT_PITCH + 64 + 8 * c) = o2; }
}

struct RopeCS { f32x4 c0, c1, s0, s1; };
__device__ __forceinline__ void rope_store_natural(bf16_t* N, int tok, int c, const u32x4 xa, const u32x4 xb, const RopeCS& cs, float mul) {
    float a[8], b[8]; unpack8(xa, a); unpack8(xb, b); float y1[8], y2[8];
#pragma unroll
    for (int i = 0; i < 8; ++i) { const float co = i < 4 ? cs.c0[i & 3] : cs.c1[i & 3], sn = i < 4 ? cs.s0[i & 3] : cs.s1[i & 3]; y1[i] = (a[i] * co - b[i] * sn) * mul; y2[i] = (b[i] * co + a[i] * sn) * mul; }
    u32x4 o1, o2; o1.x = pk2(y1[0], y1[1]); o1.y = pk2(y1[2], y1[3]); o1.z = pk2(y1[4], y1[5]); o1.w = pk2(y1[6], y1[7]); o2.x = pk2(y2[0], y2[1]); o2.y = pk2(y2[2], y2[3]); o2.z = pk2(y2[4], y2[5]); o2.w = pk2(y2[6], y2[7]);
    *(u32x4*)(N + tok * RT_PITCH + 8 * c) = o1; *(u32x4*)(N + tok * RT_PITCH + 64 + 8 * c) = o2;
}
template <bool ROPE>
__device__ __forceinline__ void store_transposed(bf16_t* T, int p, int c, const u32x4 (&xa)[2], const u32x4 (&xb)[2], const RopeCS (&cs)[2], float mul0, float mul1) {
    float a[2][8], b[2][8];
#pragma unroll
    for (int q = 0; q < 2; ++q) { unpack8(xa[q], a[q]); unpack8(xb[q], b[q]);
        if (ROPE) {
#pragma unroll
            for (int i = 0; i < 8; ++i) { const float co = i < 4 ? cs[q].c0[i & 3] : cs[q].c1[i & 3], sn = i < 4 ? cs[q].s0[i & 3] : cs[q].s1[i & 3]; const float x1 = a[q][i], x2 = b[q][i]; a[q][i] = x1 * co - x2 * sn; b[q][i] = x2 * co + x1 * sn; } }
        const float m = q ? mul1 : mul0;
#pragma unroll
        for (int i = 0; i < 8; ++i) { a[q][i] *= m; b[q][i] *= m; } }
#pragma unroll
    for (int i = 0; i < 8; ++i) { *(unsigned*)(T + (8 * c + i) * RT_PITCH + 2 * p) = pk2(a[0][i], a[1][i]); *(unsigned*)(T + (64 + 8 * c + i) * RT_PITCH + 2 * p) = pk2(b[0][i], b[1][i]); }
}
__device__ __forceinline__ RopeCS load_cs(int tok_global, int c) { const float* RC = (const float*)(KWS() + WS_ROPE_C); const float* RS = (const float*)(KWS() + WS_ROPE_S); const size_t ro = (size_t)tok_global * 64 + 8 * c;
    RopeCS r; r.c0 = *(const f32x4*)(RC + ro); r.c1 = *(const f32x4*)(RC + ro + 4); r.s0 = *(const f32x4*)(RS + ro); r.s1 = *(const f32x4*)(RS + ro + 4); return r; }
__device__ __forceinline__ void ret_units_a(const Frame& F, int first, int stride) {
    bf16_t* Kt = (bf16_t*)F.ldsg; bf16_t* Vt = Kt + 128 * RT_PITCH;
    const bf16_t* Z = (const bf16_t*)(KWS() + WS_Z); float* KV = (float*)(KWS() + WS_KV);
    const int w = F.wave, lane = F.lane, fr = lane & 15, fg = lane >> 4, pp = F.lane, cw = F.wave;
    u32x4 ka[2], kb[2], va[2], vb[2]; RopeCS cs[2];
#define RETA_RAW(u_) do { const int h_ = (u_) & 7, t0_ = ((u_) >> 3) * 128; const bf16_t* zk = Z + (size_t)t0_ * NZ + ZC_RK + h_ * 128; const bf16_t* zv = Z + (size_t)t0_ * NZ + ZC_RV + h_ * 128; \
        _Pragma("unroll") for (int q = 0; q < 2; ++q) { const size_t ro = (size_t)(2 * pp + q) * NZ; ka[q] = *(const u32x4*)(zk + ro + 8 * cw); kb[q] = *(const u32x4*)(zk + ro + 64 + 8 * cw); \
            va[q] = *(const u32x4*)(zv + ro + 8 * cw); vb[q] = *(const u32x4*)(zv + ro + 64 + 8 * cw); cs[q] = load_cs(t0_ + 2 * pp + q, cw); } } while (0)
    if (first < 1024) RETA_RAW(first);
    for (int u = first; u < 1024; u += stride) {
        const int h = u & 7, n = u >> 3; const float l2g = ret_log2g(h);
        const float m0 = 0.08838834764831845f * exp2f((float)(127 - 2 * lane) * l2g), m1 = 0.08838834764831845f * exp2f((float)(126 - 2 * lane) * l2g);
        store_transposed<true>(Kt, pp, cw, ka, kb, cs, m0, m1); store_transposed<false>(Vt, pp, cw, va, vb, cs, 1.0f, 1.0f);
        if (u + stride < 1024) RETA_RAW(u + stride);
        __syncthreads();
        f32x4 acc[8];
#pragma unroll
        for (int nt = 0; nt < 8; ++nt) acc[nt] = (f32x4){0.f, 0.f, 0.f, 0.f};
#pragma unroll
        for (int ks = 0; ks < 4; ++ks) { const bf16x8 af = *(const bf16x8*)(Kt + (16 * w + fr) * RT_PITCH + 32 * ks + 8 * fg);
#pragma unroll
            for (int nt = 0; nt < 8; ++nt) { const bf16x8 bfr = *(const bf16x8*)(Vt + (16 * nt + fr) * RT_PITCH + 32 * ks + 8 * fg); acc[nt] = __builtin_amdgcn_mfma_f32_16x16x32_bf16(af, bfr, acc[nt], 0, 0, 0); } }
        float* kvp = KV + ((size_t)(n * 8 + h) * 128) * 128;
#pragma unroll
        for (int nt = 0; nt < 8; ++nt) *(f32x4*)(kvp + (size_t)(16 * nt + fr) * 128 + 16 * w + 4 * fg) = acc[nt];
        __syncthreads();
    }
#undef RETA_RAW
}
__device__ __forceinline__ void ret_scan(const Frame& F, int wg, int nwg) {
    float* KV = (float*)(KWS() + WS_KV);
    for (int idx = wg * NTHR + F.tid; idx < 8 * 8192; idx += nwg * NTHR) { const int h = idx >> 13, ed = (idx & 8191) * 2; const float cd = exp2f(128.0f * ret_log2g(h)); f32x2 R = (f32x2){0.f, 0.f};
        for (int n0 = 0; n0 < 128; n0 += 16) { f32x2 v[16];
#pragma unroll
            for (int i = 0; i < 16; ++i) v[i] = *(const f32x2*)(KV + ((size_t)((n0 + i) * 8 + h) << 14) + ed);
#pragma unroll
            for (int i = 0; i < 16; ++i) { *(f32x2*)(KV + ((size_t)((n0 + i) * 8 + h) << 14) + ed) = R; R[0] = cd * R[0] + v[i][0]; R[1] = cd * R[1] + v[i][1]; } } }
}
__device__ __forceinline__ void ret_units_c(const Frame& F, int first, int stride) {
    bf16_t* Qs = (bf16_t*)F.ldsg; bf16_t* Ks = Qs + 128 * RT_PITCH; bf16_t* Vt = Ks + 128 * RT_PITCH; bf16_t* Rt = Vt + 128 * RT_PITCH;
    const bf16_t* Z = (const bf16_t*)(KWS() + WS_Z); const float* KV = (const float*)(KWS() + WS_KV); bf16_t* Y = (bf16_t*)(KWS() + WS_Y);
    const int w = F.wave, lane = F.lane, fr = lane & 15, fg = lane >> 4;
    for (int u = first; u < 1024; u += stride) {
        const int h = u & 7, n = u >> 3, t0 = n * 128; const float l2g = ret_log2g(h);
        { const int pp = F.lane, cw = F.wave, cn = F.tid & 7; const bf16_t* zq = Z + (size_t)t0 * NZ + ZC_RQ + h * 128; const bf16_t* zk = Z + (size_t)t0 * NZ + ZC_RK + h * 128; const bf16_t* zv = Z + (size_t)t0 * NZ + ZC_RV + h * 128;
            const float* kvp = KV + ((size_t)(n * 8 + h) << 14);
            u32x4 qa[2], qb[2], ka[2], kb[2], va[2], vb[2]; RopeCS cs[2]; f32x4 rv[8];
#pragma unroll
            for (int rep = 0; rep < 2; ++rep) { const int tok = (F.tid >> 3) + 64 * rep; const size_t ro = (size_t)tok * NZ; qa[rep] = *(const u32x4*)(zq + ro + 8 * cn); qb[rep] = *(const u32x4*)(zq + ro + 64 + 8 * cn);
                ka[rep] = *(const u32x4*)(zk + ro + 8 * cn); kb[rep] = *(const u32x4*)(zk + ro + 64 + 8 * cn); cs[rep] = load_cs(t0 + tok, cn); }
#pragma unroll
            for (int q = 0; q < 2; ++q) { const size_t ro = (size_t)(2 * pp + q) * NZ; va[q] = *(const u32x4*)(zv + ro + 8 * cw); vb[q] = *(const u32x4*)(zv + ro + 64 + 8 * cw); }
#pragma unroll
            for (int i = 0; i < 8; ++i) { const int i4 = F.tid + NTHR * i; rv[i] = *(const f32x4*)(kvp + (i4 >> 5) * 128 + (i4 & 31) * 4); }
#pragma unroll
            for (int rep = 0; rep < 2; ++rep) { const int tok = (F.tid >> 3) + 64 * rep; rope_store_natural(Qs, tok, cn, qa[rep], qb[rep], cs[rep], 1.0f); rope_store_natural(Ks, tok, cn, ka[rep], kb[rep], cs[rep], 0.08838834764831845f); }
            store_transposed<false>(Vt, pp, cw, va, vb, cs, 1.0f, 1.0f);
#pragma unroll
            for (int i = 0; i < 8; ++i) { const int i4 = F.tid + NTHR * i, e = i4 >> 5, d4 = (i4 & 31) * 4; u32x2 o; o.x = pk2(rv[i][0], rv[i][1]); o.y = pk2(rv[i][2], rv[i][3]); *(u32x2*)(Rt + e * RT_PITCH + d4) = o; } }
        __syncthreads();
#pragma unroll 1
        for (int half = 0; half < 2; ++half) {
            const int T = half ? 7 - w : w;
            u32x2 gpre[8]; { const size_t tgp = (size_t)(t0 + 16 * T + fr);
#pragma unroll
                for (int mt = 0; mt < 8; ++mt) gpre[mt] = *(const u32x2*)(Z + tgp * NZ + ZC_RG + h * 128 + 16 * mt + 4 * fg); }
            bf16x8 qf[4];
#pragma unroll
            for (int ks = 0; ks < 4; ++ks) qf[ks] = *(const bf16x8*)(Qs + (16 * T + fr) * RT_PITCH + 32 * ks + 8 * fg);
            f32x4 ao[8], ar[8];
#pragma unroll
            for (int mt = 0; mt < 8; ++mt) { ao[mt] = (f32x4){0.f, 0.f, 0.f, 0.f}; ar[mt] = ao[mt]; }
#pragma unroll
            for (int mt = 0; mt < 8; ++mt)
#pragma unroll
                for (int ks = 0; ks < 4; ++ks) { const bf16x8 af = *(const bf16x8*)(Rt + (16 * mt + fr) * RT_PITCH + 32 * ks + 8 * fg); ar[mt] = __builtin_amdgcn_mfma_f32_16x16x32_bf16(af, qf[ks], ar[mt], 0, 0, 0);
                    if (ks == 3 && (mt & 3) == 3) asm volatile("" ::: "memory"); }
            const int il = 16 * T + fr;
            for (int kp = 0; kp <= (T >> 1); ++kp) {
                u32x2 pt[2];
#pragma unroll
                for (int q = 0; q < 2; ++q) { const int jt = 2 * kp + q; f32x4 s = (f32x4){0.f, 0.f, 0.f, 0.f};
                    if (jt <= T) {
#pragma unroll
                        for (int ks = 0; ks < 4; ++ks) { const bf16x8 kf = *(const bf16x8*)(Ks + (16 * jt + fr) * RT_PITCH + 32 * ks + 8 * fg); s = __builtin_amdgcn_mfma_f32_16x16x32_bf16(kf, qf[ks], s, 0, 0, 0); }
#pragma unroll
                        for (int r = 0; r < 4; ++r) { const int jl = 16 * jt + 4 * fg + r; s[r] = (il >= jl) ? s[r] * __builtin_amdgcn_exp2f((float)(il - jl) * l2g) : 0.f; }
                        asm volatile("" ::: "memory"); }
                    pt[q].x = pk2(s[0], s[1]); pt[q].y = pk2(s[2], s[3]); }
                bf16x8 pf; { u32x4 t4; t4.x = pt[0].x; t4.y = pt[0].y; t4.z = pt[1].x; t4.w = pt[1].y; pf = __builtin_bit_cast(bf16x8, t4); }
#pragma unroll
                for (int mt = 0; mt < 8; ++mt) { const u32x2 v0 = *(const u32x2*)(Vt + (16 * mt + fr) * RT_PITCH + 32 * kp + 4 * fg), v1 = *(const u32x2*)(Vt + (16 * mt + fr) * RT_PITCH + 32 * kp + 16 + 4 * fg);
                    u32x4 t4; t4.x = v0.x; t4.y = v0.y; t4.z = v1.x; t4.w = v1.y; const bf16x8 vf = __builtin_bit_cast(bf16x8, t4);
                    ao[mt] = __builtin_amdgcn_mfma_f32_16x16x32_bf16(vf, pf, ao[mt], 0, 0, 0); if (mt == 7) asm volatile("" ::: "memory"); } }
            const float qd = exp2f((float)(il + 1) * l2g); float ss = 0.f;
#pragma unroll
            for (int mt = 0; mt < 8; ++mt) { ao[mt] = ao[mt] + ar[mt] * qd; ss += (ao[mt][0] * ao[mt][0] + ao[mt][1] * ao[mt][1]) + (ao[mt][2] * ao[mt][2] + ao[mt][3] * ao[mt][3]); }
            ss += __shfl_xor(ss, 16); ss += __shfl_xor(ss, 32);
            const float rstd = 1.0f / sqrtf(ss * (1.0f / 128.0f) + EPS); const size_t tg = (size_t)(t0 + il);
#pragma unroll
            for (int mt = 0; mt < 8; ++mt) { const int e0 = h * 128 + 16 * mt + 4 * fg; const u32x2 gw = gpre[mt];
                u32x2 o; o.x = pk2(ao[mt][0] * rstd * fsilu(bflo(gw.x)), ao[mt][1] * rstd * fsilu(bfhi(gw.x))); o.y = pk2(ao[mt][2] * rstd * fsilu(bflo(gw.y)), ao[mt][3] * rstd * fsilu(bfhi(gw.y)));
                *(u32x2*)(Y + tg * 3072 + e0) = o; }
        }
        __syncthreads();
    }
}


constexpr int GP = 136;
constexpr int GMP = 68;
constexpr int GS_FRAGS = 32, GS_PACK_BYTES = GS_FRAGS * 1024, GO_FRAGS = 24, GO_PACK_BYTES = GO_FRAGS * 1024;
__device__ __forceinline__ bf16x8 mk_frag(u32x2 lo, u32x2 hi) { u32x4 t; t.x = lo.x; t.y = lo.y; t.z = hi.x; t.w = hi.y; return __builtin_bit_cast(bf16x8, t); }
__device__ __forceinline__ bf16x8 pack_acc2(const f32x4 a, const f32x4 b) { u32x4 t; t.x = pk2(a[0], a[1]); t.y = pk2(a[2], a[3]); t.z = pk2(b[0], b[1]); t.w = pk2(b[2], b[3]); return __builtin_bit_cast(bf16x8, t); }
__device__ __forceinline__ u32x4 tile_frag_scaled(const bf16_t* T, int mt, int ks, int fr, int fg, float sc) {
    const u32x2 lo = *(const u32x2*)(T + (16 * mt + fr) * GP + 32 * ks + 4 * fg), hi = *(const u32x2*)(T + (16 * mt + fr) * GP + 32 * ks + 16 + 4 * fg);
    u32x4 o; o.x = pk2(bflo(lo.x) * sc, bfhi(lo.x) * sc); o.y = pk2(bflo(lo.y) * sc, bfhi(lo.y) * sc); o.z = pk2(bflo(hi.x) * sc, bfhi(hi.x) * sc); o.w = pk2(bflo(hi.y) * sc, bfhi(hi.y) * sc); return o;
}
__device__ __forceinline__ void gdn_units_a(const Frame& F, const Params& p, int l) {
    bf16_t* Qn = (bf16_t*)F.ldsg; bf16_t* Kn = Qn + 64 * GP; bf16_t* Vn = Kn + 64 * GP; bf16_t* Wl = Vn + 64 * GP;
    float* Mm = (float*)(Wl + 64 * GP);
    float* gcv = Mm + 64 * GMP; float* bet = gcv + 64; float* beg = bet + 64; float* ekd = beg + 64; float* egc = ekd + 64;
    float* cwl = egc + 64;
    const bf16_t* Z = (const bf16_t*)(KWS() + WS_Z); const float* GAB = (const float*)(KWS() + WS_GAB);
    unsigned char* P2 = KWS() + WS_GP2; float* UP = (float*)(KWS() + WS_GUP); float* GL = (float*)(KWS() + WS_GGL);
    const float* cw = KIN(15) + (size_t)l * 4 * 3072;
    const int w = F.wave, lane = F.lane, fr = lane & 15, fg = lane >> 4;
    int cur_h = -1; float Aexp = 0.f, dtb = 0.f;
    for (int u = F.bx; u < 2048; u += F.G) {
        const int h = u & 7, n = u >> 3, t0 = n * 64;
        if (h != cur_h) { cur_h = h; Aexp = expf(KIN(16)[l * 8 + h]); dtb = KIN(17)[l * 8 + h];
            __syncthreads();
            for (int i = F.tid; i < 1536; i += NTHR) { const int ten = i >> 9, k = (i >> 7) & 3, c = i & 127; cwl[i] = cw[k * 3072 + ten * 1024 + h * 128 + c]; }
            __syncthreads(); }
        { const int tt = F.tid >> 3, cg = F.tid & 7;
#pragma unroll
            for (int ten = 0; ten < 3; ++ten) { float y[16];
#pragma unroll
                for (int i = 0; i < 16; ++i) y[i] = 0.f;
#pragma unroll
                for (int k = 0; k < 4; ++k) { const int t = t0 + tt - 3 + k;
                    if (t >= 0) { const bf16_t* zp = Z + (size_t)t * NZ + ZC_GQ + ten * 1024 + h * 128 + 16 * cg; float x[16]; float x8a[8], x8b[8]; unpack8(*(const u32x4*)zp, x8a); unpack8(*(const u32x4*)(zp + 8), x8b);
#pragma unroll
                        for (int i = 0; i < 8; ++i) { x[i] = x8a[i]; x[8 + i] = x8b[i]; }
#pragma unroll
                        for (int i = 0; i < 16; ++i) y[i] += cwl[(ten * 4 + k) * 128 + 16 * cg + i] * x[i]; } }
                float ss = 0.f;
#pragma unroll
                for (int i = 0; i < 16; ++i) { y[i] = fsilu(y[i]); ss += y[i] * y[i]; }
                float mul = 1.0f;
                if (ten < 2) { ss += __shfl_xor(ss, 1); ss += __shfl_xor(ss, 2); ss += __shfl_xor(ss, 4); mul = (1.0f / sqrtf(ss + EPS)) * (ten == 0 ? 0.08838834764831845f : 1.0f); }
                bf16_t* dst = (ten == 0 ? Qn : (ten == 1 ? Kn : Vn)) + tt * GP + 16 * cg; u32x4 o0, o1;
                o0.x = pk2(y[0] * mul, y[1] * mul); o0.y = pk2(y[2] * mul, y[3] * mul); o0.z = pk2(y[4] * mul, y[5] * mul); o0.w = pk2(y[6] * mul, y[7] * mul);
                o1.x = pk2(y[8] * mul, y[9] * mul); o1.y = pk2(y[10] * mul, y[11] * mul); o1.z = pk2(y[12] * mul, y[13] * mul); o1.w = pk2(y[14] * mul, y[15] * mul);
                *(u32x4*)dst = o0; *(u32x4*)(dst + 8) = o1;
                asm volatile("" ::: "memory"); } }
        if (w == 0) { const size_t gi = (size_t)(t0 + lane) * 16; const float g = -Aexp * softplusf(GAB[gi + h] + dtb); const float beta = sigm(GAB[gi + 8 + h]);
            float gc = g;
#pragma unroll
            for (int o = 1; o < 64; o <<= 1) { const float t = __shfl_up(gc, o); if (lane >= o) gc += t; }
            const float gl = __shfl(gc, 63);
            gcv[lane] = gc; bet[lane] = beta; { const float eg = expf(gc); egc[lane] = eg; beg[lane] = beta * eg; } ekd[lane] = expf(gl - gc);
            if (lane == 0) GL[u] = expf(gl); }
        __syncthreads();
        unsigned char* pk = P2 + (size_t)u * GS_PACK_BYTES; unsigned char* pko = KWS() + WS_GPO + (size_t)u * GO_PACK_BYTES;
        { const int mt = w >> 1;
#pragma unroll
            for (int q = 0; q < 2; ++q) { const int nt = 2 * (w & 1) + q;
                if (nt <= mt) { f32x4 s = (f32x4){0.f, 0.f, 0.f, 0.f};
#pragma unroll
                    for (int ks = 0; ks < 4; ++ks) { const bf16x8 af = *(const bf16x8*)(Kn + (16 * mt + fr) * GP + 32 * ks + 8 * fg), bf_ = *(const bf16x8*)(Kn + (16 * nt + fr) * GP + 32 * ks + 8 * fg); s = __builtin_amdgcn_mfma_f32_16x16x32_bf16(af, bf_, s, 0, 0, 0); }
                    const int j = 16 * nt + fr; const float gj = gcv[j];
#pragma unroll
                    for (int r = 0; r < 4; ++r) { const int i = 16 * mt + 4 * fg + r; Mm[i * GMP + j] = (i > j) ? bet[i] * s[r] * fexp(gcv[i] - gj) : 0.f; } } } }
        { const int it = w >> 1, ksA = w & 1; f32x4 s2[2];
#pragma unroll
            for (int q = 0; q < 2; ++q) { const int jt = 2 * ksA + q; s2[q] = (f32x4){0.f, 0.f, 0.f, 0.f};
                if (jt <= it) {
#pragma unroll
                    for (int ks = 0; ks < 4; ++ks) { const bf16x8 af = *(const bf16x8*)(Kn + (16 * jt + fr) * GP + 32 * ks + 8 * fg), bf_ = *(const bf16x8*)(Qn + (16 * it + fr) * GP + 32 * ks + 8 * fg); s2[q] = __builtin_amdgcn_mfma_f32_16x16x32_bf16(af, bf_, s2[q], 0, 0, 0); }
                    const int i = 16 * it + fr; const float gi = gcv[i];
#pragma unroll
                    for (int r = 0; r < 4; ++r) { const int j = 16 * jt + 4 * fg + r; s2[q][r] = (i >= j) ? s2[q][r] * fexp(gi - gcv[j]) : 0.f; } } }
            *(bf16x8*)(pko + (size_t)(16 + it * 2 + ksA) * 1024 + lane * 16) = pack_acc2(s2[0], s2[1]); }
        __syncthreads();
        if (w < 4) { const int c = F.tid; float sol[64];
#pragma unroll
            for (int i = 0; i < 64; ++i) sol[i] = 0.f;
            LAS const bf16_t* colp = (LAS const bf16_t*)(F.lds) + ((c < 128) ? (2 * 64 * GP + c) : (64 * GP + (c - 128))); asm volatile("" : "+v"(colp));
            LAS const float* mm = (LAS const float*)(F.lds + 4 * 64 * GP * 2); asm volatile("" : "+v"(mm));
            LAS const float* tb = mm + 64 * GMP + ((c < 128) ? 64 : 128); asm volatile("" : "+v"(tb));
#pragma unroll
            for (int i = 0; i < 64; ++i) { float a = bf2f(colp[i * GP]) * tb[i];
#pragma unroll
                for (int jb = 0; jb < (i + 3) / 4; ++jb) { const f32x4 m4 = *(LAS const f32x4*)(mm + i * GMP + 4 * jb);
                    a -= m4[0] * sol[4 * jb]; a -= m4[1] * sol[4 * jb + 1]; a -= m4[2] * sol[4 * jb + 2]; a -= m4[3] * sol[4 * jb + 3];
                    if ((jb & 3) == 3) asm volatile("" ::: "memory"); }
                sol[i] = a; asm volatile("" ::: "memory"); }
            if (c < 128) { float* up = UP + (size_t)u * 8192 + (size_t)(c >> 4) * 1024;
#pragma unroll
                for (int t = 0; t < 4; ++t)
#pragma unroll
                    for (int G = 0; G < 4; ++G) *(f32x4*)(up + (t * 64 + (c & 15) + 16 * G) * 4) = (f32x4){sol[16 * t + 4 * G], sol[16 * t + 4 * G + 1], sol[16 * t + 4 * G + 2], sol[16 * t + 4 * G + 3]}; }
            else { const int d = c - 128;
#pragma unroll
                for (int i = 0; i < 64; ++i) Wl[i * GP + d] = (bf16_t)f2bf(-sol[i]); }
        } else { const int w4 = w - 4;
#pragma unroll
            for (int q = 0; q < 4; ++q) { const int f = w4 * 4 + q, mt = f >> 2, ks = f & 3;
                *(u32x4*)(pko + (size_t)f * 1024 + lane * 16) = tile_frag_scaled(Qn, mt, ks, fr, fg, egc[16 * mt + fr]); }
#pragma unroll
            for (int q = 0; q < 4; ++q) { const int f = w4 * 4 + q, mt = f >> 1, ks = f & 1;
                float v[8];
#pragma unroll
                for (int jj = 0; jj < 8; ++jj) { const int tk = 32 * ks + 16 * (jj >> 2) + 4 * fg + (jj & 3); v[jj] = bf2f(Kn[tk * GP + 16 * mt + fr]) * ekd[tk]; }
                u32x4 o; o.x = pk2(v[0], v[1]); o.y = pk2(v[2], v[3]); o.z = pk2(v[4], v[5]); o.w = pk2(v[6], v[7]);
                *(u32x4*)(pk + (size_t)(16 + f) * 1024 + lane * 16) = o; } }
        __syncthreads();
#pragma unroll
        for (int q = 0; q < 2; ++q) { const int f = w * 2 + q, mt = f >> 2, ks = f & 3; *(u32x4*)(pk + (size_t)f * 1024 + lane * 16) = tile_frag_scaled(Wl, mt, ks, fr, fg, 1.0f); }
        __syncthreads();
    }
}

constexpr int GA_SET = 3 * 64 * GP * 2 + 5 * 64 * 4, GA_WL = 2 * GA_SET, GA_MM = GA_WL + 64 * GP * 2, GA_CW = GA_MM + 64 * GMP * 4, GA_END = GA_CW + 1536 * 4;
static_assert(GA_END <= LDS_MISC, "gdn prep LDS map");
__device__ __forceinline__ void gdn_stage_unit(const Frame& F, const Params& p, int l, int u, int h, float Aexp, float dtb, unsigned char* setb, const float* cwl) {
    bf16_t* Qn = (bf16_t*)setb; bf16_t* Kn = Qn + 64 * GP; bf16_t* Vn = Kn + 64 * GP; float* gcv = (float*)(Vn + 64 * GP); float* bet = gcv + 64; float* beg = bet + 64; float* ekd = beg + 64; float* egc = ekd + 64;
    const bf16_t* Z = (const bf16_t*)(KWS() + WS_Z); const float* GAB = (const float*)(KWS() + WS_GAB); float* GL = (float*)(KWS() + WS_GGL);
    const int n = u >> 3, t0 = n * 64, lane = F.lane;
    float ga_pre = 0.f, gb_pre = 0.f; if (F.wave == 4) { const size_t gi = (size_t)(t0 + lane) * 16; ga_pre = GAB[gi + h]; gb_pre = GAB[gi + 8 + h]; }
#pragma unroll 1
    for (int rep = 0; rep < 2; ++rep) { const int it = (F.tid - 256) + 256 * rep, tt = it >> 3, cg = it & 7;
        u32x4 raw[3][4][2];
#pragma unroll
        for (int ten = 0; ten < 3; ++ten)
#pragma unroll
            for (int k = 0; k < 4; ++k) { const int t = t0 + tt - 3 + k;
                if (t >= 0) { const bf16_t* zp = Z + (size_t)t * NZ + ZC_GQ + ten * 1024 + h * 128 + 16 * cg; raw[ten][k][0] = *(const u32x4*)zp; raw[ten][k][1] = *(const u32x4*)(zp + 8); }
                else { raw[ten][k][0] = (u32x4){0u, 0u, 0u, 0u}; raw[ten][k][1] = raw[ten][k][0]; } }
#pragma unroll
        for (int ten = 0; ten < 3; ++ten) { float y[16];
#pragma unroll
            for (int i = 0; i < 16; ++i) y[i] = 0.f;
#pragma unroll
            for (int k = 0; k < 4; ++k) { float x8a[8], x8b[8]; unpack8(raw[ten][k][0], x8a); unpack8(raw[ten][k][1], x8b);
#pragma unroll
                for (int i = 0; i < 8; ++i) { y[i] += cwl[(ten * 4 + k) * 128 + 16 * cg + i] * x8a[i]; y[8 + i] += cwl[(ten * 4 + k) * 128 + 16 * cg + 8 + i] * x8b[i]; } }
            float ss = 0.f;
#pragma unroll
            for (int i = 0; i < 16; ++i) { y[i] = fsilu(y[i]); ss += y[i] * y[i]; }
            float mul = 1.0f;
            if (ten < 2) { ss += __shfl_xor(ss, 1); ss += __shfl_xor(ss, 2); ss += __shfl_xor(ss, 4); mul = (1.0f / sqrtf(ss + EPS)) * (ten == 0 ? 0.08838834764831845f : 1.0f); }
            bf16_t* dst = (ten == 0 ? Qn : (ten == 1 ? Kn : Vn)) + tt * GP + 16 * cg; u32x4 o0, o1;
            o0.x = pk2(y[0] * mul, y[1] * mul); o0.y = pk2(y[2] * mul, y[3] * mul); o0.z = pk2(y[4] * mul, y[5] * mul); o0.w = pk2(y[6] * mul, y[7] * mul);
            o1.x = pk2(y[8] * mul, y[9] * mul); o1.y = pk2(y[10] * mul, y[11] * mul); o1.z = pk2(y[12] * mul, y[13] * mul); o1.w = pk2(y[14] * mul, y[15] * mul);
            *(u32x4*)dst = o0; *(u32x4*)(dst + 8) = o1; }
        asm volatile("" ::: "memory"); }
    if (F.wave == 4) { const float g = -Aexp * softplusf(ga_pre + dtb); const float beta = sigm(gb_pre);
        float gc = g;
#pragma unroll
        for (int o = 1; o < 64; o <<= 1) { const float t = __shfl_up(gc, o); if (lane >= o) gc += t; }
        const float gl = __shfl(gc, 63);
        gcv[lane] = gc; bet[lane] = beta; { const float eg = expf(gc); egc[lane] = eg; beg[lane] = beta * eg; } ekd[lane] = expf(gl - gc);
        if (lane == 0) GL[u] = expf(gl); }
}
__device__ __forceinline__ void gdn_units_a_pipe(const Frame& F, const Params& p, int l) {
    unsigned char* L = F.ldsg; bf16_t* Wl = (bf16_t*)(L + GA_WL); float* Mm = (float*)(L + GA_MM); float* cwl = (float*)(L + GA_CW);
    unsigned char* P2 = KWS() + WS_GP2; float* UP = (float*)(KWS() + WS_GUP);
    const float* cw = KIN(15) + (size_t)l * 4 * 3072;
    const int w = F.wave, lane = F.lane, fr = lane & 15, fg = lane >> 4, h = F.bx & 7;
    const float Aexp = expf(KIN(16)[l * 8 + h]), dtb = KIN(17)[l * 8 + h];
    for (int i = F.tid; i < 1536; i += NTHR) { const int ten = i >> 9, k = (i >> 7) & 3, c = i & 127; cwl[i] = cw[k * 3072 + ten * 1024 + h * 128 + c]; }
    __syncthreads();
    if (w >= 4 && F.bx < 2048) gdn_stage_unit(F, p, l, F.bx, h, Aexp, dtb, L, cwl);
    __syncthreads();
    int prev_u = -1, it = 0;
    for (int u = F.bx; u < 2048; u += F.G, ++it) {
        unsigned char* setb = L + (it & 1) * GA_SET; unsigned char* setn = L + ((it + 1) & 1) * GA_SET;
        const bf16_t* Qn = (const bf16_t*)setb; const bf16_t* Kn = Qn + 64 * GP; const float* gcv = (const float*)(Kn + 2 * 64 * GP); const float* bet = gcv + 64; const float* ekd = gcv + 192; const float* egc = gcv + 256;
        unsigned char* pk = P2 + (size_t)u * GS_PACK_BYTES; unsigned char* pko = KWS() + WS_GPO + (size_t)u * GO_PACK_BYTES;
        if (prev_u >= 0) { unsigned char* pkp = P2 + (size_t)prev_u * GS_PACK_BYTES;
#pragma unroll
            for (int q = 0; q < 2; ++q) { const int f = w * 2 + q, mt = f >> 2, ks = f & 3; *(u32x4*)(pkp + (size_t)f * 1024 + lane * 16) = tile_frag_scaled(Wl, mt, ks, fr, fg, 1.0f); } }
        { const int mt = w >> 1;
#pragma unroll
            for (int q = 0; q < 2; ++q) { const int nt = 2 * (w & 1) + q;
                if (nt <= mt) { f32x4 s = (f32x4){0.f, 0.f, 0.f, 0.f};
#pragma unroll
                    for (int ks = 0; ks < 4; ++ks) { const bf16x8 af = *(const bf16x8*)(Kn + (16 * mt + fr) * GP + 32 * ks + 8 * fg), bf_ = *(const bf16x8*)(Kn + (16 * nt + fr) * GP + 32 * ks + 8 * fg); s = __builtin_amdgcn_mfma_f32_16x16x32_bf16(af, bf_, s, 0, 0, 0); }
                    const int j = 16 * nt + fr; const float gj = gcv[j];
#pragma unroll
                    for (int r = 0; r < 4; ++r) { const int i = 16 * mt + 4 * fg + r; Mm[i * GMP + j] = (i > j) ? bet[i] * s[r] * fexp(gcv[i] - gj) : 0.f; } } } }
        { const int itl = w >> 1, ksA = w & 1; f32x4 s2[2];
#pragma unroll
            for (int q = 0; q < 2; ++q) { const int jt = 2 * ksA + q; s2[q] = (f32x4){0.f, 0.f, 0.f, 0.f};
                if (jt <= itl) {
#pragma unroll
                    for (int ks = 0; ks < 4; ++ks) { const bf16x8 af = *(const bf16x8*)(Kn + (16 * jt + fr) * GP + 32 * ks + 8 * fg), bf_ = *(const bf16x8*)(Qn + (16 * itl + fr) * GP + 32 * ks + 8 * fg); s2[q] = __builtin_amdgcn_mfma_f32_16x16x32_bf16(af, bf_, s2[q], 0, 0, 0); }
                    const int i = 16 * itl + fr; const float gi = gcv[i];
#pragma unroll
                    for (int r = 0; r < 4; ++r) { const int j = 16 * jt + 4 * fg + r; s2[q][r] = (i >= j) ? s2[q][r] * fexp(gi - gcv[j]) : 0.f; } } }
            *(bf16x8*)(pko + (size_t)(16 + itl * 2 + ksA) * 1024 + lane * 16) = pack_acc2(s2[0], s2[1]); }
#pragma unroll
        for (int q = 0; q < 2; ++q) { const int f = w * 2 + q, mt = f >> 2, ks = f & 3;
            *(u32x4*)(pko + (size_t)f * 1024 + lane * 16) = tile_frag_scaled(Qn, mt, ks, fr, fg, egc[16 * mt + fr]); }
#pragma unroll
        for (int q = 0; q < 2; ++q) { const int f = w * 2 + q, mt = f >> 1, ks = f & 1; float v[8];
#pragma unroll
            for (int jj = 0; jj < 8; ++jj) { const int tk = 32 * ks + 16 * (jj >> 2) + 4 * fg + (jj & 3); v[jj] = bf2f(Kn[tk * GP + 16 * mt + fr]) * ekd[tk]; }
            u32x4 o; o.x = pk2(v[0], v[1]); o.y = pk2(v[2], v[3]); o.z = pk2(v[4], v[5]); o.w = pk2(v[6], v[7]);
            *(u32x4*)(pk + (size_t)(16 + f) * 1024 + lane * 16) = o; }
        __syncthreads();
        if (w < 4) { const int c = F.tid; float sol[64];
#pragma unroll
            for (int i = 0; i < 64; ++i) sol[i] = 0.f;
            LAS const bf16_t* colp = (LAS const bf16_t*)(F.lds + (it & 1) * GA_SET) + ((c < 128) ? (2 * 64 * GP + c) : (64 * GP + (c - 128))); asm volatile("" : "+v"(colp));
            LAS const float* mm = (LAS const float*)(F.lds + GA_MM); asm volatile("" : "+v"(mm));
            LAS const float* tb = (LAS const float*)(F.lds + (it & 1) * GA_SET + 3 * 64 * GP * 2) + ((c < 128) ? 64 : 128); asm volatile("" : "+v"(tb));
#pragma unroll
            for (int i = 0; i < 64; ++i) { float a = bf2f(colp[i * GP]) * tb[i];
#pragma unroll
                for (int jb = 0; jb < (i + 3) / 4; ++jb) { const f32x4 m4 = *(LAS const f32x4*)(mm + i * GMP + 4 * jb);
                    a -= m4[0] * sol[4 * jb]; a -= m4[1] * sol[4 * jb + 1]; a -= m4[2] * sol[4 * jb + 2]; a -= m4[3] * sol[4 * jb + 3];
                    if ((jb & 3) == 3) asm volatile("" ::: "memory"); }
                sol[i] = a; asm volatile("" ::: "memory"); }
            if (c < 128) { float* up = UP + (size_t)u * 8192 + (size_t)(c >> 4) * 1024;
#pragma unroll
                for (int t = 0; t < 4; ++t)
#pragma unroll
                    for (int G = 0; G < 4; ++G) *(f32x4*)(up + (t * 64 + (c & 15) + 16 * G) * 4) = (f32x4){sol[16 * t + 4 * G], sol[16 * t + 4 * G + 1], sol[16 * t + 4 * G + 2], sol[16 * t + 4 * G + 3]}; }
            else { const int d = c - 128;
#pragma unroll
                for (int i = 0; i < 64; ++i) Wl[i * GP + d] = (bf16_t)f2bf(-sol[i]); }
        } else if (u + F.G < 2048) gdn_stage_unit(F, p, l, u + F.G, h, Aexp, dtb, setn, cwl);
        __syncthreads();
        prev_u = u;
    }
    if (prev_u >= 0) { unsigned char* pkp = P2 + (size_t)prev_u * GS_PACK_BYTES;
#pragma unroll
        for (int q = 0; q < 2; ++q) { const int f = w * 2 + q, mt = f >> 2, ks = f & 3; *(u32x4*)(pkp + (size_t)f * 1024 + lane * 16) = tile_frag_scaled(Wl, mt, ks, fr, fg, 1.0f); } }
    __syncthreads();
}

constexpr int GS_HALF = 16384;
__device__ __forceinline__ void gdn_scan(const Frame& F, int b) {
    const int h = b >> 1, w = F.wave, lane = F.lane; const int slice = (b & 1) * 4 + (w & 3); const bool comp = w < 4;
    const unsigned char* P2 = KWS() + WS_GP2; const float* UP = (const float*)(KWS() + WS_GUP); const float* GL = (const float*)(KWS() + WS_GGL); unsigned char* SV = KWS() + WS_GSV;
    f32x4 S[8];
#pragma unroll
    for (int i = 0; i < 8; ++i) S[i] = (f32x4){0.f, 0.f, 0.f, 0.f};
    if (!comp) {
#pragma unroll
        for (int hf = 0; hf < 7; ++hf) { const unsigned char* src = P2 + (size_t)((hf >> 1) * 8 + h) * GS_PACK_BYTES + (hf & 1) * GS_HALF;
#pragma unroll
            for (int i = 0; i < 4; ++i) { const int f = (w - 4) + 4 * i; __builtin_amdgcn_global_load_lds((const unsigned*)(src + f * 1024 + lane * 16), (LAS unsigned*)(F.lds + hf * GS_HALF + f * 1024), 16, 0, 0); } }
        asm volatile("s_waitcnt vmcnt(20)" ::: "memory"); }
    f32x4 ua[4], ub[4]; float gla = 0.f, glb = 0.f;
#pragma unroll
    for (int t = 0; t < 4; ++t) { ua[t] = (f32x4){0.f, 0.f, 0.f, 0.f}; ub[t] = ua[t]; }
    if (comp) {
#pragma unroll
        for (int t = 0; t < 4; ++t) { ua[t] = *(const f32x4*)(UP + (size_t)h * 8192 + slice * 1024 + (t * 64 + lane) * 4); ub[t] = *(const f32x4*)(UP + (size_t)(8 + h) * 8192 + slice * 1024 + (t * 64 + lane) * 4); }
        gla = GL[h]; glb = GL[8 + h]; }
    __syncthreads();
    int hw = 0;
    for (int n = 0; n < 256; ++n) {
        const int unit = n * 8 + h; const int hk = (hw + 1 >= 9) ? hw + 1 - 9 : hw + 1;
        const LAS unsigned char* bufW = F.lds + hw * GS_HALF; const LAS unsigned char* bufK = F.lds + hk * GS_HALF;
        if (!comp) {
            if (n + 3 < 256) { const int e7 = (hw + 7 >= 9) ? hw + 7 - 9 : hw + 7; const unsigned char* src = P2 + (size_t)(unit + 24) * GS_PACK_BYTES + GS_HALF;
#pragma unroll
                for (int i = 0; i < 4; ++i) { const int f = (w - 4) + 4 * i; __builtin_amdgcn_global_load_lds((const unsigned*)(src + f * 1024 + lane * 16), (LAS unsigned*)(F.lds + e7 * GS_HALF + f * 1024), 16, 0, 0); } }
            if (n + 4 < 256) { const int e8 = (hw + 8 >= 9) ? hw + 8 - 9 : hw + 8; const unsigned char* src = P2 + (size_t)(unit + 32) * GS_PACK_BYTES;
#pragma unroll
                for (int i = 0; i < 4; ++i) { const int f = (w - 4) + 4 * i; __builtin_amdgcn_global_load_lds((const unsigned*)(src + f * 1024 + lane * 16), (LAS unsigned*)(F.lds + e8 * GS_HALF + f * 1024), 16, 0, 0); }
                asm volatile("s_waitcnt vmcnt(20)" ::: "memory"); }
            else asm volatile("s_waitcnt vmcnt(0)" ::: "memory");
        } else {
            f32x4 vn[4];
#pragma unroll
            for (int t = 0; t < 4; ++t) { vn[t] = ua[t]; ua[t] = ub[t]; }
            const float gl = gla; gla = glb;
            if (n + 2 < 256) {
#pragma unroll
                for (int t = 0; t < 4; ++t) ub[t] = *(const f32x4*)(UP + (size_t)(unit + 16) * 8192 + slice * 1024 + (t * 64 + lane) * 4);
                glb = GL[unit + 16]; }
            bf16x8* svp = (bf16x8*)(SV + ((size_t)(unit * 8 + slice) * 6) * 1024 + lane * 16);
            bf16x8 Sb[4];
#pragma unroll
            for (int ks = 0; ks < 4; ++ks) { Sb[ks] = pack_acc2(S[2 * ks], S[2 * ks + 1]); svp[ks * 64] = Sb[ks]; }
#pragma unroll
            for (int t = 0; t < 4; ++t)
#pragma unroll
                for (int ks = 0; ks < 4; ++ks) vn[t] = __builtin_amdgcn_mfma_f32_16x16x32_bf16(*(const LAS bf16x8*)(bufW + (t * 4 + ks) * 1024 + lane * 16), Sb[ks], vn[t], 0, 0, 0);
            bf16x8 vb[2];
#pragma unroll
            for (int ks = 0; ks < 2; ++ks) { vb[ks] = pack_acc2(vn[2 * ks], vn[2 * ks + 1]); svp[(4 + ks) * 64] = vb[ks]; }
#pragma unroll
            for (int dt = 0; dt < 8; ++dt) { S[dt] = S[dt] * gl;
#pragma unroll
                for (int ks = 0; ks < 2; ++ks) S[dt] = __builtin_amdgcn_mfma_f32_16x16x32_bf16(*(const LAS bf16x8*)(bufK + (dt * 2 + ks) * 1024 + lane * 16), vb[ks], S[dt], 0, 0, 0); }
        }
        __syncthreads();
        hw += 2; if (hw >= 9) hw -= 9;
    }
}
constexpr int GO_PITCH = 132;
__device__ __forceinline__ void gdn_output(const Frame& F, const Params& p, int l) {
    float* Ot = (float*)F.ldsg;
    const unsigned char* PO = KWS() + WS_GPO; const unsigned char* SV = KWS() + WS_GSV; const bf16_t* Z = (const bf16_t*)(KWS() + WS_Z); bf16_t* Y = (bf16_t*)(KWS() + WS_Y); const float* ng = KIN(18) + l * 128;
    const int w = F.wave, lane = F.lane, fr = lane & 15, fg = lane >> 4;
    const int tt = F.tid >> 3, cg = F.tid & 7; float gn[16];
#pragma unroll
    for (int i = 0; i < 16; ++i) gn[i] = ng[16 * cg + i];
    for (int u = F.bx; u < 2048; u += F.G) {
        const int h = u & 7, n = u >> 3;
        const bf16x8* svp = (const bf16x8*)(SV + ((size_t)(u * 8 + w) * 6) * 1024 + lane * 16); const bf16x8* pop = (const bf16x8*)(PO + (size_t)u * GO_PACK_BYTES + lane * 16);
        const u32x4 gzp0 = *(const u32x4*)(Z + (size_t)(n * 64 + tt) * NZ + ZC_GZ + h * 128 + 16 * cg), gzp1 = *(const u32x4*)(Z + (size_t)(n * 64 + tt) * NZ + ZC_GZ + h * 128 + 16 * cg + 8);
        bf16x8 Sb[4], vb[2];
#pragma unroll
        for (int ks = 0; ks < 4; ++ks) Sb[ks] = svp[ks * 64];
#pragma unroll
        for (int ks = 0; ks < 2; ++ks) vb[ks] = svp[(4 + ks) * 64];
#pragma unroll
        for (int t = 0; t < 4; ++t) { f32x4 o = (f32x4){0.f, 0.f, 0.f, 0.f};
#pragma unroll
            for (int ks = 0; ks < 4; ++ks) o = __builtin_amdgcn_mfma_f32_16x16x32_bf16(pop[(t * 4 + ks) * 64], Sb[ks], o, 0, 0, 0);
#pragma unroll
            for (int ks = 0; ks < 2; ++ks) o = __builtin_amdgcn_mfma_f32_16x16x32_bf16(pop[(16 + t * 2 + ks) * 64], vb[ks], o, 0, 0, 0);
#pragma unroll
            for (int r = 0; r < 4; ++r) Ot[(16 * t + 4 * fg + r) * GO_PITCH + 16 * w + fr] = o[r]; }
        __syncthreads();
        { const size_t tg = (size_t)(n * 64 + tt); float o[16], g[8], g2[8]; float ss = 0.f;
#pragma unroll
            for (int i = 0; i < 4; ++i) { const f32x4 v = *(const f32x4*)(Ot + tt * GO_PITCH + 16 * cg + 4 * i); o[4 * i] = v[0]; o[4 * i + 1] = v[1]; o[4 * i + 2] = v[2]; o[4 * i + 3] = v[3]; }
#pragma unroll
            for (int i = 0; i < 16; ++i) ss += o[i] * o[i];
            ss += __shfl_xor(ss, 1); ss += __shfl_xor(ss, 2); ss += __shfl_xor(ss, 4);
            const float rstd = 1.0f / sqrtf(ss * (1.0f / 128.0f) + EPS);
            unpack8(gzp0, g); unpack8(gzp1, g2);
            float y[16];
#pragma unroll
            for (int i = 0; i < 8; ++i) { y[i] = o[i] * rstd * gn[i] * fsilu(g[i]); y[8 + i] = o[8 + i] * rstd * gn[8 + i] * fsilu(g2[i]); }
            u32x4 o0, o1; o0.x = pk2(y[0], y[1]); o0.y = pk2(y[2], y[3]); o0.z = pk2(y[4], y[5]); o0.w = pk2(y[6], y[7]); o1.x = pk2(y[8], y[9]); o1.y = pk2(y[10], y[11]); o1.z = pk2(y[12], y[13]); o1.w = pk2(y[14], y[15]);
            bf16_t* yp = Y + tg * 3072 + 2048 + h * 128 + 16 * cg; *(u32x4*)yp = o0; *(u32x4*)(yp + 8) = o1; }
        __syncthreads();
    }
}

__device__ __forceinline__ void seq_retention(const Frame& F, const Params& p, int h) {
    float* sq = (float*)F.ldsg; float* sk = sq + 128; float* red = sk + 128;
    const bf16_t* Z = (const bf16_t*)(KWS() + WS_Z); bf16_t* Y = (bf16_t*)(KWS() + WS_Y); const int* pos = (const int*)KIN(2);
    const int c = F.tid & 127; const bool act = F.tid < 128, rot = F.tid < 64;
    float R[128];
#pragma unroll
    for (int d = 0; d < 128; ++d) R[d] = 0.f;
    const float gamma = 1.0f - exp2f(-5.0f - (float)h);
    const float invf = (float)exp2(-(double)(F.tid & 63) * (13.287712379549449 / 64.0));
    unsigned short nq1 = 0, nq2 = 0, nk1 = 0, nk2 = 0, nv = 0, ng = 0; int npos = 0;
    if (rot) { nq1 = Z[ZC_RQ + h * 128 + F.tid]; nq2 = Z[ZC_RQ + h * 128 + 64 + F.tid]; nk1 = Z[ZC_RK + h * 128 + F.tid]; nk2 = Z[ZC_RK + h * 128 + 64 + F.tid]; npos = pos[0]; }
    if (act) { nv = Z[ZC_RV + h * 128 + c]; ng = Z[ZC_RG + h * 128 + c]; }
    for (int t = 0; t < S_; ++t) {
        const unsigned short q1 = nq1, q2 = nq2, k1 = nk1, k2 = nk2, vv = nv, gg = ng; const int ps = npos;
        if (t + 1 < S_) { const size_t zo = (size_t)(t + 1) * NZ;
            if (rot) { nq1 = Z[zo + ZC_RQ + h * 128 + F.tid]; nq2 = Z[zo + ZC_RQ + h * 128 + 64 + F.tid]; nk1 = Z[zo + ZC_RK + h * 128 + F.tid]; nk2 = Z[zo + ZC_RK + h * 128 + 64 + F.tid]; npos = pos[t + 1]; }
            if (act) { nv = Z[zo + ZC_RV + h * 128 + c]; ng = Z[zo + ZC_RG + h * 128 + c]; } }
        if (rot) { const float angf = (float)ps * invf; const double ad = (double)angf; const double nn = rint(ad * 0.15915494309189535); const float rr = (float)(ad - nn * 6.283185307179586);
            const float cs = cosf(rr), sn = sinf(rr); const float a1 = bf2f(q1), a2 = bf2f(q2), b1 = bf2f(k1), b2 = bf2f(k2);
            sq[F.tid] = a1 * cs - a2 * sn; sq[F.tid + 64] = a2 * cs + a1 * sn;
            sk[F.tid] = (b1 * cs - b2 * sn) * 0.08838834764831845f; sk[F.tid + 64] = (b2 * cs + b1 * sn) * 0.08838834764831845f; }
        __syncthreads();
        float o = 0.f;
        if (act) { const float v = bf2f(vv);
#pragma unroll
            for (int d0 = 0; d0 < 128; d0 += 16) {
#pragma unroll
                for (int d = d0; d < d0 + 16; ++d) { R[d] = gamma * R[d] + sk[d] * v; o += sq[d] * R[d]; }
                asm volatile("" ::: "memory"); }
            const float ss = wave_sum(o * o); if (F.lane == 0) red[F.wave] = ss; }
        __syncthreads();
        if (act) { const float ms = (red[0] + red[1]) * (1.0f / 128.0f); const float y = o * (1.0f / sqrtf(ms + EPS)) * siluf(bf2f(gg)); Y[(size_t)t * 3072 + h * 128 + c] = (bf16_t)f2bf(y); }
    }
}
__device__ __forceinline__ void seq_gdn(const Frame& F, const Params& p, int l, int h) {
    float* sq = (float*)F.ldsg; float* sk = sq + 128; float* red = sk + 128; float* red2 = red + 8;
    const bf16_t* Z = (const bf16_t*)(KWS() + WS_Z); bf16_t* Y = (bf16_t*)(KWS() + WS_Y); const float* GAB = (const float*)(KWS() + WS_GAB);
    const int c = F.tid & 127; const bool act = F.tid < 128;
    float St[128];
#pragma unroll
    for (int d = 0; d < 128; ++d) St[d] = 0.f;
    const float* cw = KIN(15) + (size_t)l * 4 * 3072;
    float wq[4], wk[4], wv[4];
#pragma unroll
    for (int k = 0; k < 4; ++k) { wq[k] = cw[k * 3072 + h * 128 + c]; wk[k] = cw[k * 3072 + 1024 + h * 128 + c]; wv[k] = cw[k * 3072 + 2048 + h * 128 + c]; }
    const float Aexp = expf(KIN(16)[l * 8 + h]), dtb = KIN(17)[l * 8 + h], ngain = KIN(18)[l * 128 + c];
    float xq1 = 0, xq2 = 0, xq3 = 0, xk1 = 0, xk2 = 0, xk3 = 0, xv1 = 0, xv2 = 0, xv3 = 0;
    unsigned short nq = 0, nk = 0, nv = 0, nz = 0; float nga = 0.f, ngb = 0.f;
    if (act) { nq = Z[ZC_GQ + h * 128 + c]; nk = Z[ZC_GK + h * 128 + c]; nv = Z[ZC_GV + h * 128 + c]; nz = Z[ZC_GZ + h * 128 + c]; nga = GAB[h]; ngb = GAB[8 + h]; }
    for (int t = 0; t < S_; ++t) {
        const float rq = bf2f(nq), rk = bf2f(nk), rv = bf2f(nv), gz = bf2f(nz), ga = nga, gb = ngb;
        if (act && t + 1 < S_) { const size_t zo = (size_t)(t + 1) * NZ; nq = Z[zo + ZC_GQ + h * 128 + c]; nk = Z[zo + ZC_GK + h * 128 + c]; nv = Z[zo + ZC_GV + h * 128 + c]; nz = Z[zo + ZC_GZ + h * 128 + c];
            nga = GAB[(size_t)(t + 1) * 16 + h]; ngb = GAB[(size_t)(t + 1) * 16 + 8 + h]; }
        float q = 0.f, k = 0.f, v = 0.f;
        if (act) { const float cq = wq[0] * xq3 + wq[1] * xq2 + wq[2] * xq1 + wq[3] * rq, ck = wk[0] * xk3 + wk[1] * xk2 + wk[2] * xk1 + wk[3] * rk, cv = wv[0] * xv3 + wv[1] * xv2 + wv[2] * xv1 + wv[3] * rv;
            xq3 = xq2; xq2 = xq1; xq1 = rq; xk3 = xk2; xk2 = xk1; xk1 = rk; xv3 = xv2; xv2 = xv1; xv1 = rv;
            q = siluf(cq); k = siluf(ck); v = siluf(cv);
            const float s1 = wave_sum(q * q), s2 = wave_sum(k * k); if (F.lane == 0) { red[F.wave] = s1; red[2 + F.wave] = s2; } }
        __syncthreads();
        if (act) { sq[c] = q * (1.0f / sqrtf(red[0] + red[1] + EPS)) * 0.08838834764831845f; sk[c] = k * (1.0f / sqrtf(red[2] + red[3] + EPS)); }
        __syncthreads();
        float o = 0.f;
        if (act) { const float g = -Aexp * softplusf(ga + dtb), e = expf(g), beta = sigm(gb);
            float dot = 0.f;
#pragma unroll
            for (int d0 = 0; d0 < 128; d0 += 16) {
#pragma unroll
                for (int d = d0; d < d0 + 16; ++d) dot += sk[d] * St[d];
                asm volatile("" ::: "memory"); }
            const float coef = beta * (v - e * dot);
#pragma unroll
            for (int d0 = 0; d0 < 128; d0 += 16) {
#pragma unroll
                for (int d = d0; d < d0 + 16; ++d) { St[d] = e * St[d] + sk[d] * coef; o += sq[d] * St[d]; }
                asm volatile("" ::: "memory"); }
            const float ss = wave_sum(o * o); if (F.lane == 0) red2[F.wave] = ss; }
        __syncthreads();
        if (act) { const float ms = (red2[0] + red2[1]) * (1.0f / 128.0f); const float y = o * (1.0f / sqrtf(ms + EPS)) * ngain * siluf(gz); Y[(size_t)t * 3072 + 2048 + h * 128 + c] = (bf16_t)f2bf(y); }
    }
}
__device__ __forceinline__ void seq_lru(const Frame& F, const Params& p, int part) {
    const bf16_t* Z = (const bf16_t*)(KWS() + WS_Z); bf16_t* Y = (bf16_t*)(KWS() + WS_Y); const float* LA = (const float*)(KWS() + WS_MF); const float* LB = LA + (size_t)S_ * 1024;
    const int ch = part * 512 + F.tid; float h = 0.f;
    for (int t0 = 0; t0 < S_; t0 += 8) { float a[8], b[8]; unsigned short g[8];
#pragma unroll
        for (int i = 0; i < 8; ++i) { a[i] = LA[(size_t)(t0 + i) * 1024 + ch]; b[i] = LB[(size_t)(t0 + i) * 1024 + ch]; g[i] = Z[(size_t)(t0 + i) * NZ + ZC_LG + ch]; }
#pragma unroll
        for (int i = 0; i < 8; ++i) { h = a[i] * h + b[i]; Y[(size_t)(t0 + i) * 3072 + 1024 + ch] = (bf16_t)f2bf(h * gelu_tanh(bf2f(g[i]))); } }
}

__device__ __forceinline__ void phase_seq(const Frame& F, const Params& p, int l) {
#if DBG_NOSEQ
    { u32x4* yy = (u32x4*)(KWS() + WS_Y); for (size_t i = (size_t)F.bx * NTHR + F.tid; i < (size_t)S_ * 3072 / 8; i += (size_t)F.G * NTHR) yy[i] = (u32x4){0u, 0u, 0u, 0u}; }
#else
    if (F.bx < 16) { gdn_scan(F, ((F.bx & 7) << 1) | (F.bx >> 3)); return; }
    const int wg = F.bx - 16, nwg = F.G - 16; unsigned* ctl = (unsigned*)(KWS() + WS_CTL); unsigned* cnt = ctl + CW_SUB + 64 * l; unsigned* tmo = ctl + CW_BAR + XB_TMO;
    const int rwg = (wg + nwg - (2048 % nwg)) % nwg;
    lru_units<false>(F, p, l, wg, nwg); __syncthreads(); ret_units_a(F, rwg, nwg);
    sub_barrier(cnt, (unsigned)nwg, tmo);
    if (wg < 2) lru_carry(F, wg); else ret_scan(F, wg - 2, nwg - 2);
    sub_barrier(cnt, 2u * (unsigned)nwg, tmo);
    lru_units<true>(F, p, l, wg, nwg); __syncthreads(); ret_units_c(F, rwg, nwg);
#endif
}

#define LAYER(l) do { \
const int pb = PH_L0 + l * PH_PER_LAYER; \
        if (EN(0) && IN(pb + 0)) { const Frame F = make_frame(); phase_convert(F, p, l); phase_norm1_gab(F, p, l, l > 0 && !DBG_NOMOE); __syncthreads(); } \
        SEAM(pb + 0); \
        if (EN(1) && IN(pb + 1)) { const Frame F = make_frame(); pg8::Gemm g{(const bf16_t*)(KWS() + WS_H), (const bf16_t*)(KWS() + WS_WIN), 2048, 2048, 2048}; SchedStatic sc{64, 64, F.G, F.bx}; \
            EpiZL E{(bf16_t*)(KWS() + WS_Z)}; pg8::gemm_phase(F.lds, g, sc, E); } \
        SEAM(pb + 1); \
        if (EN(2) && IN(pb + 2)) { const Frame F = make_frame(); if ((F.G & 7) == 0) gdn_units_a_pipe(F, p, l); else gdn_units_a(F, p, l); } \
        SEAM(pb + 2); \
        if (EN(3) && IN(pb + 3)) { const Frame F = make_frame(); \
            phase_seq(F, p, l); \
        } \
        SEAM(pb + 3); \
        if (EN(4) && IN(pb + 4)) { const Frame F = make_frame(); gdn_output(F, p, l); } \
        SEAM(pb + 4); \
        if (EN(5) && IN(pb + 5)) { const Frame F = make_frame(); pg8::Gemm g{(const bf16_t*)(KWS() + WS_Y), (const bf16_t*)(KWS() + WS_BP), 3072, 1024, 1024}; SchedMerge sc{F.G, F.bx}; \
            EpiMerge E{(const bf16_t*)(KWS() + WS_Z), (bf16_t*)(KWS() + WS_H)}; pg8::gemm_phase(F.lds, g, sc, E); } \
        SEAM(pb + 5); \
        if (EN(6) && IN(pb + 6)) { const Frame F = make_frame(); pg8::Gemm g{(const bf16_t*)(KWS() + WS_H), (const bf16_t*)(KWS() + WS_WO), 2048, 2048, 2048}; SchedStatic sc{64, 8, F.G, F.bx}; \
            EpiWout E{l == 0 ? KIN(0) : KOUT(), KOUT(), (const float*)(KWS() + WS_MODV) + l * 12288 + MO_GT1}; pg8::gemm_phase(F.lds, g, sc, E); } \
        SEAM(pb + 6); \
        if (!DBG_NOMOE && EN(7) && IN(pb + 7)) { const Frame F = make_frame(); if ((S_ % (F.G * NWAVES * 4)) == 0) phase_norm2_router_lds(F, p, l); else phase_norm2_router(F, p, l); __syncthreads(); } \
        SEAM(pb + 7); \
        if (!DBG_NOMOE && EN(8) && IN(pb + 8)) { const Frame F = make_frame(); phase_gather(F, p, l); } \
        SEAM(pb + 8); \
        if (!DBG_NOMOE && EN(9) && IN(pb + 9)) { const Frame F = make_frame(); moe_tables_load(F, p); unsigned* mq = (unsigned*)(KWS() + WS_CTL) + CW_MOEQ + l * 16384; \
            { pg8::Gemm g{(const bf16_t*)(KWS() + WS_H), (const bf16_t*)(KWS() + WS_W13), 2048, 2048, 2048}; SchedMoe<true> sc{(const int*)(KWS() + WS_TOK + 512 * 1024), F.G, F.bx, 4, (const LAS int*)(F.lds + LDS_MISC + 64)}; \
              EpiW13 E{(bf16_t*)(KWS() + WS_HID), mq}; pg8::gemm_phase(F.lds, g, sc, E); } \
            { volatile LAS int* slot = (volatile LAS int*)(F.lds + LDS_MISC + 32); \
              if (F.tid == 0) { const int q0 = (int)xb_add(mq, 1u), q1 = (int)xb_add(mq, 1u); slot[0] = q0; slot[1] = q1; slot[2] = 2; slot[4] = 0; } __syncthreads(); \
              pg8::Gemm g{(const bf16_t*)(KWS() + WS_HID), (const bf16_t*)(KWS() + WS_W2), 512, 512, 512}; SchedMoeDyn sc{8, (const LAS int*)(F.lds + LDS_MISC + 64), slot, mq, (unsigned*)(KWS() + WS_CTL) + CW_BAR + XB_TMO}; \
              EpiW2L E{(bf16_t*)(KWS() + WS_SLOT), (const u32x2*)(KWS() + WS_ROWINFO), (const LAS int*)(F.lds + LDS_MISC + 64), mq, slot, mq}; pg8::gemm_phase(F.lds, g, sc, E); } } \
        SEAM(pb + 10); \
    } while (0)
template <unsigned PMASK, bool ALL>
__global__ void __launch_bounds__(NTHR, 2) fwd(Params p) {
    Frame F = make_frame();
    if (F.tid < 4) ((LAS unsigned*)(F.lds + LDS_MISC))[F.tid] = 0u;
    __syncthreads();
    unsigned* ctl = (unsigned*)(KWS() + WS_CTL);
    XcdBarrier bar; bar.bar = ctl + CW_BAR; bar.x = 0; bar.st = nullptr;
    const int lo = p.ph_lo, hi = p.ph_hi;
    const bool multi = ALL || (hi - lo) > 1;
    if (multi) bar = xcd_barrier_post(ctl + CW_BAR, (volatile LAS unsigned*)(F.lds + LDS_MISC));
#define IN(k) (ALL || (lo <= (k) && (k) < hi))
#define EN(b) ((PMASK >> (b)) & 1u)
#define SEAM(k) do { if (IN(k) && IN((k) + 1)) xcd_barrier(bar); } while (0)

    if (EN(11) && IN(PH_MOD)) { const Frame F = make_frame(); phase_mod(F, p); phase_rope_table(F); phase_gabw(F); }
    SEAM(PH_MOD);
    LAYER(0);
    LAYER(1);
    if (EN(12) && IN(PH_FINAL)) { const Frame F = make_frame(); phase_norm<2>(F, p, 0, !DBG_NOMOE); }
#undef IN
#undef SEAM
}

typedef void (*KernelFn)(Params);
static int phase_bit(int ph) { if (ph == PH_MOD) return 11; if (ph == PH_FINAL) return 12; return (ph - PH_L0) % PH_PER_LAYER; }
extern "C" void kernel_launch(void* const* d_in, const int* in_sizes, int n_in, void* d_out, int out_size, void* d_ws, size_t ws_size, hipStream_t stream) {
    static int grid = 0;
#if ONE_LAUNCH
    static KernelFn fns[1] = { fwd<0x1FFFu, true> };
    constexpr int NFN = 1;
#else
    static KernelFn fns[13] = { fwd<0x001u, false>, fwd<0x002u, false>, fwd<0x004u, false>, fwd<0x008u, false>, fwd<0x010u, false>, fwd<0x020u, false>, fwd<0x040u, false>, fwd<0x080u, false>, fwd<0x100u, false>, fwd<0x200u, false>, fwd<0x400u, false>, fwd<0x800u, false>, fwd<0x1000u, false> };
    constexpr int NFN = 13;
#endif
    if (grid == 0) {
        if (n_in != 29 || out_size != S_ * D_ || ws_size < WS_END) { fprintf(stderr, "kernel_launch: unexpected shapes (n_in %d out %d ws %zu)\n", n_in, out_size, ws_size); grid = -1; return; }
        int dev = 0, cus = 0, per_cu = 0;
        if (hipGetDevice(&dev) != hipSuccess || hipDeviceGetAttribute(&cus, hipDeviceAttributeMultiprocessorCount, dev) != hipSuccess) { grid = -1; return; }
        for (int i = 0; i < NFN; ++i) {
            if (hipFuncSetAttribute((const void*)fns[i], hipFuncAttributeMaxDynamicSharedMemorySize, LDS_BYTES) != hipSuccess) { fprintf(stderr, "kernel_launch: hipFuncSetAttribute failed\n"); grid = -1; return; }
            if (hipOccupancyMaxActiveBlocksPerMultiprocessor(&per_cu, (const void*)fns[i], NTHR, LDS_BYTES) != hipSuccess || per_cu < 1) fprintf(stderr, "kernel_launch: occupancy query says %d for fn %d\n", per_cu, i);
        }
        (void)hipGetLastError();
        grid = cus > 0 ? cus : 256;
    }
    if (grid < 0) return;
    (void)hipMemsetAsync((char*)d_ws + WS_CTL, 0, CTL_BYTES, stream);
    Params p{};
    for (int i = 0; i < 29; ++i) p.in[i] = (const float*)d_in[i];
    p.out = (float*)d_out; p.ws = (unsigned char*)d_ws;
#if ONE_LAUNCH
    p.ph_lo = 0; p.ph_hi = NPH;
    { void* args[] = {&p}; (void)hipLaunchKernel((const void*)fns[0], dim3(grid), dim3(NTHR), args, LDS_BYTES, stream); }
#else
    for (int ph = 0; ph < NPH; ++ph) { p.ph_lo = ph; p.ph_hi = ph + 1; void* args[] = {&p}; (void)hipLaunchKernel((const void*)fns[phase_bit(ph)], dim3(grid), dim3(NTHR), args, LDS_BYTES, stream); }
#endif
}
```

```cpp
#include <hip/hip_runtime.h>
#include <cstdio>
#include <cstdint>

#ifndef ONE_LAUNCH
#define ONE_LAUNCH 1
#endif
#ifndef DBG_NOSEQ
#define DBG_NOSEQ 0
#endif
#ifndef DBG_NOMOE
#define DBG_NOMOE 0
#endif
#ifndef DBG_NOMIX
#define DBG_NOMIX 0
#endif
#ifndef DBG_MOE_SCALE
#define DBG_MOE_SCALE 1.0f
#endif
#ifndef DBG_M
#define DBG_M 0
#endif
#ifndef DBG_ZERO_BR
#define DBG_ZERO_BR 0
#endif

#define LAS __attribute__((address_space(3)))
typedef unsigned short bf16_t;
typedef short bf16x8 __attribute__((ext_vector_type(8)));
typedef float f32x4 __attribute__((ext_vector_type(4)));
typedef float f32x2 __attribute__((ext_vector_type(2)));
typedef unsigned u32x4 __attribute__((ext_vector_type(4)));
typedef unsigned u32x2 __attribute__((ext_vector_type(2)));

constexpr int S_ = 16384, D_ = 2048, NL = 2;
constexpr int NZ = 16384;
constexpr int NZP = 16640;
constexpr int INC = 16400;
constexpr int NWAVES = 8, NTHR = 512;
constexpr float EPS = 1e-6f;
constexpr int ZC_RQ = 0, ZC_RK = 1024, ZC_RV = 2048, ZC_RG = 3072, ZC_LX = 4096, ZC_LG = 5120, ZC_GQ = 6144, ZC_GK = 7168, ZC_GV = 8192, ZC_GZ = 9216, ZC_BR = 10240;
constexpr int MO_SH1 = 0, MO_SC1 = 2048, MO_GT1 = 4096, MO_SH2 = 6144, MO_SC2 = 8192, MO_GT2 = 10240;

constexpr size_t MiB = 1u << 20;
constexpr size_t WS_CTL = 0, CTL_BYTES = 1 * MiB;
constexpr size_t WS_MODV = 1 * MiB;
constexpr size_t WS_RTW = 2 * MiB;
constexpr size_t WS_GAB = 3 * MiB;
constexpr size_t WS_GABW = 2 * MiB + 512 * 1024;
constexpr size_t WS_ROWINFO = 4 * MiB;
constexpr size_t WS_TOK = 5 * MiB;
constexpr size_t WS_WIN = 8 * MiB;
constexpr size_t WS_BP = 73 * MiB;
constexpr size_t WS_WO = 85 * MiB;
constexpr size_t WS_W13 = 93 * MiB;
constexpr size_t WS_W2 = 221 * MiB;
constexpr size_t WS_H = 285 * MiB;
constexpr size_t WS_Y = 349 * MiB;
constexpr size_t WS_MF = 445 * MiB;
constexpr size_t WS_Z = 573 * MiB;
constexpr size_t WS_XB = WS_Z;
constexpr size_t WS_HID = WS_Z + 160 * MiB;
constexpr size_t WS_SLOT = WS_Z + 200 * MiB;
constexpr size_t WS_LWT = 1085 * MiB;
constexpr size_t WS_LPH = 1086 * MiB;
constexpr size_t WS_LCARRY = 1088 * MiB;
constexpr size_t WS_ROPE_C = 1089 * MiB;
constexpr size_t WS_ROPE_S = 1093 * MiB;
constexpr size_t WS_KV = 1100 * MiB;
constexpr size_t WS_GP2 = 1164 * MiB;
constexpr size_t WS_GPO = WS_GP2 + 64 * MiB;
constexpr size_t WS_GSV = 445 * MiB;
constexpr size_t WS_GUP = 1276 * MiB;
constexpr size_t WS_GGL = 1340 * MiB;
constexpr size_t WS_GO = 1341 * MiB;
constexpr size_t WS_END = 1373 * MiB;
constexpr int CW_BAR = 4096;
constexpr int CW_CNT = 16384;
constexpr int CW_SUB = 17408;
constexpr int CW_MOEQ = 65536;

constexpr int LDS_STAGE = 131072;
constexpr int LDS_BYTES = 163840;
constexpr int LDS_MISC = LDS_BYTES - 1024;
constexpr int MAXTILES = 160;

constexpr int PH_MOD = 0, PH_L0 = 1, PH_PER_LAYER = 11, PH_FINAL = 23, NPH = 24;

struct Params { const float* in[29]; float* out; unsigned char* ws; int ph_lo, ph_hi; };


#define CAS __attribute__((address_space(4)))
__device__ __forceinline__ const CAS char* karg_base() { const CAS char* ka = (const CAS char*)__builtin_amdgcn_kernarg_segment_ptr(); asm volatile("" : "+s"(ka)); return ka; }
__device__ __forceinline__ const float* KIN(int i) { return *(const float* const CAS*)(karg_base() + 8 * i); }
__device__ __forceinline__ float* KOUT() { return *(float* const CAS*)(karg_base() + 232); }
__device__ __forceinline__ unsigned char* KWS() { return *(unsigned char* const CAS*)(karg_base() + 240); }

typedef __bf16 bf16x2_n __attribute__((ext_vector_type(2)));
__device__ __forceinline__ unsigned pk2(float lo, float hi) { const f32x2 f = {lo, hi}; const bf16x2_n b = __builtin_convertvector(f, bf16x2_n); return __builtin_bit_cast(unsigned, b); }
__device__ __forceinline__ unsigned f2bf(float f) { return pk2(f, 0.f) & 0xffffu; }
__device__ __forceinline__ float bf2f(unsigned short b) { return __builtin_bit_cast(float, ((unsigned)b) << 16); }
__device__ __forceinline__ float bflo(unsigned w) { return __builtin_bit_cast(float, w << 16); }
__device__ __forceinline__ float bfhi(unsigned w) { return __builtin_bit_cast(float, w & 0xffff0000u); }
__device__ __forceinline__ float wave_sum(float v) {
#pragma unroll
    for (int o = 1; o < 64; o <<= 1) v += __shfl_xor(v, o);
    return v;
}
__device__ __forceinline__ float sigm(float x) { return 1.0f / (1.0f + expf(-x)); }
__device__ __forceinline__ float fexp(float x) { return __builtin_amdgcn_exp2f(x * 1.4426950408889634f); }
__device__ __forceinline__ float fsigm(float x) { return __builtin_amdgcn_rcpf(1.0f + __builtin_amdgcn_exp2f(-x * 1.4426950408889634f)); }
__device__ __forceinline__ float fsilu(float x) { return x * fsigm(x); }
__device__ __forceinline__ float siluf(float x) { return x * sigm(x); }
__device__ __forceinline__ float softplusf(float x) { return fmaxf(x, 0.f) + log1pf(expf(-fabsf(x))); }
__device__ __forceinline__ void unpack8(const u32x4 a, float (&o)[8]) { o[0] = bflo(a.x); o[1] = bfhi(a.x); o[2] = bflo(a.y); o[3] = bfhi(a.y); o[4] = bflo(a.z); o[5] = bfhi(a.z); o[6] = bflo(a.w); o[7] = bfhi(a.w); }
__device__ __forceinline__ float gelu_tanh(float x) { return 0.5f * x * (1.0f + tanhf(0.7978845608028654f * (x + 0.044715f * x * x * x))); }

#define XB_TMO      128
#define XB_XCNT(j)  (256  + 64 * (j))
#define XB_XSUB(j)  (1280 + 64 * (j))
#define XB_XGEN(j)  (2304 + 64 * (j))
#define XB_TOP      3328
#define XB_TOPGEN   3392
#define XCD_BAR_WORDS 3456
#define XB_SPIN_CAP (1u << 24)
__device__ __forceinline__ unsigned xb_ld(unsigned* p)              { return __hip_atomic_load(p, __ATOMIC_RELAXED, __HIP_MEMORY_SCOPE_AGENT); }
__device__ __forceinline__ unsigned xb_add(unsigned* p, unsigned v) { return __hip_atomic_fetch_add(p, v, __ATOMIC_RELAXED, __HIP_MEMORY_SCOPE_AGENT); }
__device__ __forceinline__ unsigned xb_xcc_id() { return (unsigned)__builtin_amdgcn_s_getreg((3 << 11) | 20) & 0xFu; }
#define XB_SPIN(cond, bar) do { unsigned _sp = 0; while (cond) { __builtin_amdgcn_s_sleep(1); \
    if ((++_sp & 255u) == 0u) { if (xb_ld(&(bar)[XB_TMO])) break; if (_sp > XB_SPIN_CAP) { atomicAdd(&(bar)[XB_TMO], 1u); break; } } } } while (0)
struct XcdBarrier { unsigned* bar; unsigned x; volatile LAS unsigned* st; };
__device__ __forceinline__ XcdBarrier xcd_barrier_post(unsigned* bar, volatile LAS unsigned* st) {
    XcdBarrier b; b.bar = bar; b.x = xb_xcc_id(); b.st = st;
    if (threadIdx.x == 0) (void)xb_add(&bar[XB_XCNT(b.x)], 1u);
    return b;
}
__device__ __forceinline__ void xcd_barrier_complete(unsigned* bar, unsigned x, unsigned& nloc, unsigned& nx) {
    const unsigned G = gridDim.x * gridDim.y * gridDim.z;
    unsigned sum, cnt, mine, sp = 0u;
    for (;;) {
        sum = 0u; cnt = 0u; mine = 0u;
#pragma unroll 1
        for (unsigned j = 0; j < 16; ++j) { const unsigned c = xb_ld(&bar[XB_XCNT(j)]); sum += c; cnt += (c > 0u) ? 1u : 0u; mine = (j == x) ? c : mine; }
        if (sum == G) break;
        __builtin_amdgcn_s_sleep(1);
        if ((++sp & 255u) == 0u) { if (xb_ld(&bar[XB_TMO])) break; if (sp > XB_SPIN_CAP) { atomicAdd(&bar[XB_TMO], 1u); break; } }
    }
    nloc = mine > 0u ? mine : 1u; nx = cnt > 0u ? cnt : 1u;
}
__device__ __forceinline__ void xcd_barrier(const XcdBarrier& b) {
    asm volatile("s_waitcnt vmcnt(0)" ::: "memory");
    __syncthreads();
    if (threadIdx.x == 0) {
        unsigned* bar = b.bar;
        __builtin_amdgcn_s_waitcnt(0);
        unsigned nloc = b.st[0], nx = b.st[1];
        if (nloc == 0u) { xcd_barrier_complete(bar, b.x, nloc, nx); b.st[0] = nloc; b.st[1] = nx; }
        const unsigned old = xb_add(&bar[XB_XSUB(b.x)], 1u);
        const unsigned gen = old / nloc;
        if (old + 1u == (gen + 1u) * nloc) {
            __builtin_amdgcn_fence(__ATOMIC_RELEASE, "agent");
            asm volatile("s_waitcnt vmcnt(0)" ::: "memory");
            const unsigned og = xb_add(&bar[XB_TOP], 1u);
            const unsigned tg = og / nx;
            if (og + 1u == (tg + 1u) * nx) xb_add(&bar[XB_TOPGEN], 1u);
            else XB_SPIN(xb_ld(&bar[XB_TOPGEN]) == tg, bar);
            __builtin_amdgcn_fence(__ATOMIC_ACQUIRE, "agent");
            xb_add(&bar[XB_XGEN(b.x)], 1u);
            asm volatile("s_waitcnt vmcnt(0)" ::: "memory");
        } else {
            XB_SPIN(xb_ld(&bar[XB_XGEN(b.x)]) == gen, bar);
            __builtin_amdgcn_fence(__ATOMIC_ACQUIRE, "agent");
            asm volatile("s_waitcnt vmcnt(0)" ::: "memory");
        }
    }
    __syncthreads();
}


__device__ __forceinline__ void sub_barrier(unsigned* cnt, unsigned target, unsigned* tmo) {
    asm volatile("s_waitcnt vmcnt(0)" ::: "memory");
    __syncthreads();
    if (threadIdx.x == 0) {
        __builtin_amdgcn_fence(__ATOMIC_RELEASE, "agent");
        asm volatile("s_waitcnt vmcnt(0)" ::: "memory");
        (void)xb_add(cnt, 1u);
        unsigned sp = 0u;
        while (xb_ld(cnt) < target) { __builtin_amdgcn_s_sleep(1); if ((++sp & 255u) == 0u) { if (xb_ld(tmo)) break; if (sp > XB_SPIN_CAP) { atomicAdd(tmo, 1u); break; } } }
        __builtin_amdgcn_fence(__ATOMIC_ACQUIRE, "agent");
        asm volatile("s_waitcnt vmcnt(0)" ::: "memory");
    }
    __syncthreads();
}

namespace pg8 {
constexpr int BM = 256, BK = 64, HALF = 128, HTB = HALF * BK * 2, STAGE_BYTES = 8 * HTB, NXCD = 8, WGM = 8;
__device__ __forceinline__ int lds_byte(int r, int c) { const int st = (r >> 4) * 2 + (c >> 5), rr = r & 15, cc = c & 31, ob = rr * 64 + cc * 2; return st * 1024 + (ob ^ (((ob >> 9) & 1) << 5)); }
__device__ __forceinline__ void stage_rc(int b, int& R, int& C) { const int st = b / 1024, sb = b % 1024, swz = sb ^ (((sb >> 9) & 1) << 5); R = (st >> 1) * 16 + swz / 64; C = (st & 1) * 32 + (swz % 64) / 2; }
__device__ __forceinline__ int perm32(int rho) { const int n = rho >> 4, i = rho & 15; return 8 * (i >> 2) + 4 * n + (i & 3); }
struct Unit { int pm, pn, aoff; };
struct Gemm { const bf16_t* A; const bf16_t* Bt; int lda, ldb, K; };
__device__ __forceinline__ bool static_tile(int L, int nM, int nN, int& pm, int& pn) {
    const int nwg = nM * nN; if (L >= nwg) return false;
    int wgid = L; { const int q = nwg / NXCD, r = nwg % NXCD, xcd = wgid % NXCD, off = wgid / NXCD; wgid = (xcd < r ? xcd * (q + 1) : r * (q + 1) + (xcd - r) * q) + off; }
    const int nig = WGM * nN, gid = wgid / nig, fm = gid * WGM, gsz = (nM - fm) < WGM ? (nM - fm) : WGM;
    pm = fm + ((wgid % nig) % gsz); pn = (wgid % nig) / gsz; return true;
}
__device__ __forceinline__ unsigned cvt_pk_bf16(float lo, float hi) { return pk2(lo, hi); }

template <class E, class = void> struct epi_early { static constexpr bool value = false; };
template <class E> struct epi_early<E, decltype((void)E::EARLY)> { static constexpr bool value = E::EARLY; };
template <class Epi, class Sched>
__device__ __forceinline__ void gemm_phase(LAS unsigned char* lds, const Gemm g, const Sched& S, const Epi& E) {
    int tid = threadIdx.x; asm volatile("" : "+v"(tid)); const int wid = __builtin_amdgcn_readfirstlane(tid >> 6), lane = tid & 63, wr = wid >> 2, wc = wid & 3, fr = lane & 15, fq = lane >> 4;
    int K = g.K; asm volatile("" : "+s"(K)); const int nt = K / BK; int lda_ = g.lda, ldb_ = g.ldb; asm volatile("" : "+s"(lda_), "+s"(ldb_));
    unsigned voffA[2], voffB[2];
#pragma unroll
    for (int i = 0; i < 2; ++i) { int R, C; stage_rc(tid * 16 + i * 8192, R, C); const int Rb = Epi::PERM ? ((R & ~31) + perm32(R & 31)) : R;
        voffA[i] = (unsigned)(R * lda_ + C) * 2u; voffB[i] = (unsigned)(Rb * ldb_ + C) * 2u; }
    const size_t kstep = (size_t)(BK * 2);
    const int* rtab = S.row_table();
    const size_t hstepA = Sched::GATHER ? (size_t)0 : (size_t)HALF * lda_ * 2, hstepB = (size_t)HALF * ldb_ * 2;
    const size_t tstepA = 2 * hstepA, tstepB = 2 * hstepB;
    unsigned vc0[2], vc1[2], vn0[2], vn1[2];
#define PG8_ROWS(pm_, o0, o1) do { _Pragma("unroll") for (int _i = 0; _i < 2; ++_i) { int _R, _C; stage_rc(tid * 16 + _i * 8192, _R, _C); \
        if (Sched::GATHER) { o0[_i] = (unsigned)(rtab[(pm_) * 256 + _R] * lda_ + _C) * 2u; o1[_i] = (unsigned)(rtab[(pm_) * 256 + 128 + _R] * lda_ + _C) * 2u; } else { o0[_i] = voffA[_i]; o1[_i] = voffA[_i]; } } } while (0)
    const unsigned ldsw = (unsigned)wid * 1024u;
    const int aoff = lds_byte(wr * 64 + fr, fq * 8), boff = lds_byte(wc * 32 + fr, fq * 8);
#define PG8_SA(b, h) (((b) * 2 + (h)) * HTB)
#define PG8_SB(b, h) ((4 + (b) * 2 + (h)) * HTB)
#define PG8_STAGE(bufoff, gbase, voff) do { _Pragma("unroll") for (int _i = 0; _i < 2; ++_i) \
        __builtin_amdgcn_global_load_lds((const unsigned*)((const char*)(gbase) + (voff)[_i]), (LAS unsigned*)(lds + (bufoff) + ldsw + _i * 8192), 16, 0, 0); } while (0)
#define PG8_LDA(dst, b, h) do { _Pragma("unroll") for (int m = 0; m < 4; ++m) _Pragma("unroll") for (int k = 0; k < 2; ++k) dst[m][k] = *(const LAS bf16x8*)(lds + PG8_SA(b, h) + aoff + m * 2048 + k * 1024); } while (0)
#define PG8_LDB(dst, b, h) do { _Pragma("unroll") for (int n = 0; n < 2; ++n) _Pragma("unroll") for (int k = 0; k < 2; ++k) dst[n][k] = *(const LAS bf16x8*)(lds + PG8_SB(b, h) + boff + n * 2048 + k * 1024); } while (0)
#define PG8_MMA(ai, bj, At, Bt) do { __builtin_amdgcn_s_setprio(1); _Pragma("unroll") for (int m = 0; m < 4; ++m) _Pragma("unroll") for (int n = 0; n < 2; ++n) _Pragma("unroll") for (int k = 0; k < 2; ++k) \
        acc[ai][bj][m][n] = __builtin_amdgcn_mfma_f32_16x16x32_bf16(Bt[n][k], At[m][k], acc[ai][bj][m][n], 0, 0, 0); __builtin_amdgcn_s_setprio(0); } while (0)
#define PG8_WAIT_V(n) asm volatile("s_waitcnt vmcnt(" #n ")" ::: "memory")
#define PG8_WAIT_L(n) asm volatile("s_waitcnt lgkmcnt(" #n ")" ::: "memory")
#define PG8_BAR __builtin_amdgcn_s_barrier()
#define PG8_SCHED __builtin_amdgcn_sched_barrier(0)
    Unit cur, nxt; int ui = 0;
    if (!S.next(0, cur)) return;
    f32x4 acc[2][2][4][2];
#pragma unroll
    for (int a = 0; a < 2; ++a)
#pragma unroll
        for (int b = 0; b < 2; ++b)
#pragma unroll
            for (int m = 0; m < 4; ++m)
#pragma unroll
                for (int n = 0; n < 2; ++n) acc[a][b][m][n] = (f32x4){0.f, 0.f, 0.f, 0.f};
    bf16x8 At[4][2], B0[2][2], B1[2][2];
    const char* cA = (const char*)g.A + (size_t)cur.pm * tstepA + (size_t)cur.aoff; const char* cB = (const char*)g.Bt + (size_t)cur.pn * tstepB;
    PG8_ROWS(cur.pm, vc0, vc1);
#define PG8_PROLOGUE_A(cA_, cB_, v0_, v1_) do { PG8_STAGE(PG8_SB(0, 0), cB_, voffB); PG8_STAGE(PG8_SA(0, 0), cA_, v0_); PG8_STAGE(PG8_SB(0, 1), (cB_) + hstepB, voffB); PG8_STAGE(PG8_SA(0, 1), (cA_) + hstepA, v1_); } while (0)
#define PG8_PROLOGUE_B() do { if (wr == 1) PG8_BAR; PG8_WAIT_V(4); PG8_BAR; \
        PG8_STAGE(PG8_SB(1, 0), cB + kstep, voffB); PG8_STAGE(PG8_SA(1, 0), cA + kstep, vc0); PG8_STAGE(PG8_SB(1, 1), cB + hstepB + kstep, voffB); \
        PG8_WAIT_V(6); PG8_BAR; } while (0)
#define PG8_PROLOGUE() do { PG8_PROLOGUE_A(cA, cB, vc0, vc1); PG8_PROLOGUE_B(); } while (0)
    if (!Epi::LDS_EPI) PG8_PROLOGUE();
    for (;;) {
        const bool has_next = S.next(ui + 1, nxt);
        if (Epi::LDS_EPI) { S.ready(cur); if (!(epi_early<Epi>::value && ui > 0)) PG8_PROLOGUE_A(cA, cB, vc0, vc1); PG8_PROLOGUE_B(); }
        const bool chain = has_next && !Epi::LDS_EPI;
        const char* nA = chain ? (const char*)g.A + (size_t)nxt.pm * tstepA + (size_t)nxt.aoff : cA; const char* nB = chain ? (const char*)g.Bt + (size_t)nxt.pn * tstepB : cB;
        if (chain) PG8_ROWS(nxt.pm, vn0, vn1); else { vn0[0] = vc0[0]; vn0[1] = vc0[1]; vn1[0] = vc1[0]; vn1[1] = vc1[1]; }
        for (int t = 0; t < nt; t += 2) {
            const bool last = (t == nt - 2);
            const char* a1 = cA + (size_t)(t + 1) * kstep;
            const char* a2 = last ? nA : cA + (size_t)(t + 2) * kstep; const char* b2 = last ? nB : cB + (size_t)(t + 2) * kstep;
            const char* a3 = a2 + kstep; const char* b3 = b2 + kstep;
            unsigned x0[2], x1[2]; x0[0] = last ? vn0[0] : vc0[0]; x0[1] = last ? vn0[1] : vc0[1]; x1[0] = last ? vn1[0] : vc1[0]; x1[1] = last ? vn1[1] : vc1[1];
            PG8_LDB(B0, 0, 0); PG8_SCHED; PG8_LDA(At, 0, 0); PG8_STAGE(PG8_SA(1, 1), a1 + hstepA, vc1);
            PG8_WAIT_L(8); PG8_BAR; PG8_WAIT_L(0); PG8_MMA(0, 0, At, B0); PG8_BAR; PG8_SCHED;
            PG8_LDB(B1, 0, 1); PG8_STAGE(PG8_SB(0, 0), b2, voffB);
            PG8_BAR; PG8_WAIT_L(0); PG8_MMA(0, 1, At, B1); PG8_BAR;
            PG8_LDA(At, 0, 1); PG8_STAGE(PG8_SA(0, 0), a2, x0);
            PG8_BAR; PG8_WAIT_L(0); PG8_MMA(1, 0, At, B0); PG8_BAR; PG8_SCHED;
            PG8_STAGE(PG8_SB(0, 1), b2 + hstepB, voffB);
            PG8_WAIT_V(6); PG8_BAR; PG8_MMA(1, 1, At, B1); PG8_BAR;
            PG8_LDB(B0, 1, 0); PG8_SCHED; PG8_LDA(At, 1, 0); PG8_STAGE(PG8_SA(0, 1), a2 + hstepA, x1);
            PG8_WAIT_L(8); PG8_BAR; PG8_WAIT_L(0); PG8_MMA(0, 0, At, B0); PG8_BAR; PG8_SCHED;
            PG8_LDB(B1, 1, 1); PG8_STAGE(PG8_SB(1, 0), b3, voffB);
            PG8_BAR; PG8_WAIT_L(0); PG8_MMA(0, 1, At, B1); PG8_BAR;
            PG8_LDA(At, 1, 1); PG8_STAGE(PG8_SA(1, 0), a3, x0);
            PG8_BAR; PG8_WAIT_L(0); PG8_MMA(1, 0, At, B0); PG8_BAR; PG8_SCHED;
            PG8_STAGE(PG8_SB(1, 1), b3 + hstepB, voffB);
            PG8_WAIT_V(6); PG8_BAR; PG8_MMA(1, 1, At, B1); PG8_BAR;
        }
        if (Epi::LDS_EPI) { PG8_WAIT_V(0); if (wr == 0) PG8_BAR; PG8_BAR;
            if constexpr (epi_early<Epi>::value) { static_assert(!Sched::GATHER, "early prologue: plain row tiles only");
                E.run_a(acc, cur, wr, wc, lds, tid);
                if (has_next) { const char* eA = (const char*)g.A + (size_t)nxt.pm * tstepA + (size_t)nxt.aoff; const char* eB = (const char*)g.Bt + (size_t)nxt.pn * tstepB; PG8_PROLOGUE_A(eA, eB, voffA, voffA); }
                E.run_b(cur, lds, tid); }
            else E.run(acc, cur, wr, wc, fr, fq, lds, tid); }
        else E(acc, cur, wr, wc, fr, fq);
        if (!has_next) break;
        if (!E.keep(cur))
#pragma unroll
        for (int a = 0; a < 2; ++a)
#pragma unroll
            for (int b = 0; b < 2; ++b)
#pragma unroll
                for (int m = 0; m < 4; ++m)
#pragma unroll
                    for (int n = 0; n < 2; ++n) acc[a][b][m][n] = (f32x4){0.f, 0.f, 0.f, 0.f};
        if (Epi::LDS_EPI) { cur = nxt; cA = (const char*)g.A + (size_t)cur.pm * tstepA + (size_t)cur.aoff; cB = (const char*)g.Bt + (size_t)cur.pn * tstepB; ++ui; PG8_ROWS(cur.pm, vc0, vc1); }
        else { cur = nxt; cA = nA; cB = nB; ++ui; vc0[0] = vn0[0]; vc0[1] = vn0[1]; vc1[0] = vn1[0]; vc1[1] = vn1[1]; }
    }
    if (!Epi::LDS_EPI) { PG8_WAIT_V(0); if (wr == 0) PG8_BAR; PG8_BAR; }
#undef PG8_ROWS
#undef PG8_PROLOGUE
#undef PG8_PROLOGUE_A
#undef PG8_PROLOGUE_B
#undef PG8_SA
#undef PG8_SB
#undef PG8_STAGE
#undef PG8_LDA
#undef PG8_LDB
#undef PG8_MMA
#undef PG8_WAIT_V
#undef PG8_WAIT_L
#undef PG8_BAR
#undef PG8_SCHED
}
}
using pg8::Unit;

struct SchedStatic { static constexpr bool GATHER = false; __device__ __forceinline__ const int* row_table() const { return nullptr; } __device__ __forceinline__ void ready(const Unit&) const {} int nM, nN, G, c;
    __device__ __forceinline__ bool next(int i, Unit& u) const { int pm, pn; if (!pg8::static_tile(i * G + c, nM, nN, pm, pn)) return false; u.pm = pm; u.pn = pn; u.aoff = 0; return true; } };
struct SchedMerge { static constexpr bool GATHER = false; __device__ __forceinline__ const int* row_table() const { return nullptr; } __device__ __forceinline__ void ready(const Unit&) const {} int G, c;
    __device__ __forceinline__ bool next(int i, Unit& u) const { const int ti = i / 3, b = i - 3 * ti; int pm, pn; if (!pg8::static_tile(ti * G + c, 64, 8, pm, pn)) return false;
        u.pm = pm; u.pn = b * 8 + pn; u.aoff = b * 1024 * 2; return true; } };
template <bool GATH>
struct SchedMoe { static constexpr bool GATHER = GATH; const int* rtab; __device__ __forceinline__ const int* row_table() const { return rtab; } __device__ __forceinline__ void ready(const Unit&) const {} int G, c, nN; const LAS int* tbl;
    __device__ __forceinline__ bool next(int i, Unit& u) const { const int L = i * G + c; const int ntl = __builtin_amdgcn_readfirstlane(tbl[224]); if (L >= ntl * nN) return false;
        const int pm = L / nN; u.pm = pm; u.pn = __builtin_amdgcn_readfirstlane(tbl[pm]) * nN + (L - pm * nN); u.aoff = 0; return true; } };
struct SchedMoeDyn { static constexpr bool GATHER = false; __device__ __forceinline__ const int* row_table() const { return nullptr; } int nN; const LAS int* tbl; volatile LAS int* slot; unsigned* done; unsigned* tmo;
    __device__ __forceinline__ bool next(int i, Unit& u) const { const int L = __builtin_amdgcn_readfirstlane(slot[i & 1]); const int ntl = __builtin_amdgcn_readfirstlane(tbl[224]); if (L >= ntl * nN) return false;
        const int pm = L / nN; u.pm = pm; u.pn = __builtin_amdgcn_readfirstlane(tbl[pm]) * nN + (L - pm * nN); u.aoff = 0; return true; }
    __device__ __forceinline__ void ready(const Unit& u) const {
        if (threadIdx.x == 0) { if (slot[4] == 0) { unsigned* d = done + 64 * (u.pm + 1); unsigned sp = 0u;
                while (xb_ld(d) < 32u) { __builtin_amdgcn_s_sleep(1); if ((++sp & 255u) == 0u) { if (xb_ld(tmo)) break; if (sp > XB_SPIN_CAP) { atomicAdd(tmo, 1u); break; } } } }
            slot[4] = 0; __builtin_amdgcn_fence(__ATOMIC_ACQUIRE, "agent"); asm volatile("s_waitcnt vmcnt(0)" ::: "memory"); }
        asm volatile("s_waitcnt lgkmcnt(0)" ::: "memory"); __builtin_amdgcn_s_barrier(); asm volatile("" ::: "memory"); } };

struct EpiZ { static constexpr bool LDS_EPI = false; template <class A_> __device__ __forceinline__ void run(A_&, const Unit&, int, int, int, int, LAS unsigned char*, int) const {} __device__ __forceinline__ bool keep(const Unit&) const { return false; } static constexpr bool PERM = true; bf16_t* Z; float* GAB;
    __device__ __forceinline__ void operator()(const f32x4 (&acc)[2][2][4][2], const Unit& u, int wr, int wc, int fr, int fq) const {
        const int row0 = u.pm * 256 + wr * 64 + fr;
        if (u.pn < 64) {
            const int col0 = u.pn * 256 + wc * 32 + 8 * fq;
#pragma unroll
            for (int ai = 0; ai < 2; ++ai)
#pragma unroll
                for (int m = 0; m < 4; ++m) { bf16_t* rowp = Z + (size_t)(row0 + ai * 128 + m * 16) * NZ + col0;
#pragma unroll
                    for (int bj = 0; bj < 2; ++bj) { const f32x4 v0 = acc[ai][bj][m][0], v1 = acc[ai][bj][m][1]; u32x4 w;
                        w.x = pg8::cvt_pk_bf16(v0[0], v0[1]); w.y = pg8::cvt_pk_bf16(v0[2], v0[3]); w.z = pg8::cvt_pk_bf16(v1[0], v1[1]); w.w = pg8::cvt_pk_bf16(v1[2], v1[3]);
                        *(u32x4*)(rowp + bj * 128) = w; } }
        } else if (wc == 0 && fq < 2) {
#pragma unroll
            for (int ai = 0; ai < 2; ++ai)
#pragma unroll
                for (int m = 0; m < 4; ++m) { float* gp = GAB + (size_t)(row0 + ai * 128 + m * 16) * 16 + 8 * fq;
                    *(f32x4*)gp = acc[ai][0][m][0]; *(f32x4*)(gp + 4) = acc[ai][0][m][1]; }
        }
    } };
struct EpiZL { static constexpr bool LDS_EPI = true, PERM = true, EARLY = true; bf16_t* Z;
    __device__ __forceinline__ bool keep(const Unit&) const { return false; }
    __device__ __forceinline__ void operator()(const f32x4 (&)[2][2][4][2], const Unit&, int, int, int, int) const {}
    template <class A_> __device__ __forceinline__ void run(A_&, const Unit&, int, int, int, int, LAS unsigned char*, int) const {}
    __device__ __forceinline__ void rows_out(const Unit& u, LAS unsigned char* lds, int tid, int i) const { const int c = tid & 31; const int row = (tid >> 5) + 16 * i;
        const u32x4 w = *(const LAS u32x4*)(lds + row * 512 + ((c ^ (row & 31)) << 4)); __builtin_nontemporal_store(w, (u32x4*)(Z + (size_t)(u.pm * 256 + row) * NZ + u.pn * 256 + c * 8)); }
    __device__ __forceinline__ void run_a(const f32x4 (&acc)[2][2][4][2], const Unit& u, int wr, int wc, LAS unsigned char* lds, int tid_) const {
        int tid = tid_; asm volatile("" : "+v"(tid));
        const int fr = tid & 15, fq = (tid >> 4) & 3;
#pragma unroll
        for (int ai = 0; ai < 2; ++ai)
#pragma unroll
            for (int m = 0; m < 4; ++m) { const int r = ai * 128 + wr * 64 + m * 16 + fr;
#pragma unroll
                for (int bj = 0; bj < 2; ++bj) { const int c16 = 16 * bj + 4 * wc + fq; const f32x4 v0 = acc[ai][bj][m][0], v1 = acc[ai][bj][m][1]; u32x4 w;
                    w.x = pk2(v0[0], v0[1]); w.y = pk2(v0[2], v0[3]); w.z = pk2(v1[0], v1[1]); w.w = pk2(v1[2], v1[3]);
                    *(LAS u32x4*)(lds + r * 512 + ((c16 ^ (r & 31)) << 4)) = w; }
                asm volatile("" ::: "memory"); }
        __syncthreads();
#pragma unroll
        for (int i = 0; i < 4; ++i) rows_out(u, lds, tid, i);
        asm volatile("" ::: "memory");
#pragma unroll
        for (int i = 8; i < 12; ++i) rows_out(u, lds, tid, i);
        asm volatile("s_waitcnt lgkmcnt(0)" ::: "memory"); __builtin_amdgcn_s_barrier(); asm volatile("" ::: "memory");
    }
    __device__ __forceinline__ void run_b(const Unit& u, LAS unsigned char* lds, int tid_) const {
        int tid = tid_; asm volatile("" : "+v"(tid));
#pragma unroll
        for (int i = 4; i < 8; ++i) rows_out(u, lds, tid, i);
        asm volatile("" ::: "memory");
#pragma unroll
        for (int i = 12; i < 16; ++i) rows_out(u, lds, tid, i);
        asm volatile("s_waitcnt lgkmcnt(0)" ::: "memory"); __builtin_amdgcn_s_barrier(); asm volatile("" ::: "memory");
    } };
struct EpiMerge { static constexpr bool LDS_EPI = false; template <class A_> __device__ __forceinline__ void run(A_&, const Unit&, int, int, int, int, LAS unsigned char*, int) const {} static constexpr bool PERM = true; const bf16_t* Z; bf16_t* OUT;
    __device__ __forceinline__ bool keep(const Unit& u) const { return (u.pn >> 3) < 2; }
    __device__ __forceinline__ void operator()(f32x4 (&acc)[2][2][4][2], const Unit& u, int wr, int wc, int fr, int fq) const {
        const int b = u.pn >> 3, pnl = u.pn & 7; const int row0 = u.pm * 256 + wr * 64 + fr, col0 = pnl * 256 + wc * 32 + 8 * fq;
        const bf16_t* zb = Z + ZC_BR + b * 2048 + col0;
        u32x4 gb[2][2][2], gn[2][2][2];
#define EM_LOAD(slot, aim_) do { const int ai_ = (aim_) >> 1, mh_ = (aim_) & 1; _Pragma("unroll") for (int mm = 0; mm < 2; ++mm) _Pragma("unroll") for (int bj = 0; bj < 2; ++bj) { \
            const bf16_t* zp = zb + (size_t)(row0 + ai_ * 128 + (2 * mh_ + mm) * 16) * NZ + bj * 128; gb[slot][mm][bj] = *(const u32x4*)zp; gn[slot][mm][bj] = (b < 2) ? *(const u32x4*)(zp + 2048) : (u32x4){0u, 0u, 0u, 0u}; } } while (0)
        EM_LOAD(0, 0);
#pragma unroll
        for (int aim = 0; aim < 4; ++aim) { const int ai = aim >> 1, mh = aim & 1, sl = aim & 1;
            if (aim + 1 < 4) EM_LOAD((aim + 1) & 1, aim + 1);
#pragma unroll
            for (int mm = 0; mm < 2; ++mm) { const int m = 2 * mh + mm;
#pragma unroll
                for (int bj = 0; bj < 2; ++bj) { float eb[8]; { float x[8]; unpack8(gb[sl][mm][bj], x);
#pragma unroll
                        for (int i = 0; i < 8; ++i) eb[i] = __builtin_amdgcn_rcpf(1.0f + fexp(-fmaxf(fminf(x[i], 30.f), -30.f))); }
                    if (b < 2) { float x[8]; unpack8(gn[sl][mm][bj], x);
#pragma unroll
                        for (int i = 0; i < 8; ++i) eb[i] *= 1.0f + fexp(-fmaxf(fminf(x[i], 30.f), -30.f)); }
                    f32x4& v0 = acc[ai][bj][m][0]; f32x4& v1 = acc[ai][bj][m][1];
                    v0[0] *= eb[0]; v0[1] *= eb[1]; v0[2] *= eb[2]; v0[3] *= eb[3]; v1[0] *= eb[4]; v1[1] *= eb[5]; v1[2] *= eb[6]; v1[3] *= eb[7];
                    if (b == 2) { u32x4 w; w.x = pg8::cvt_pk_bf16(v0[0], v0[1]); w.y = pg8::cvt_pk_bf16(v0[2], v0[3]); w.z = pg8::cvt_pk_bf16(v1[0], v1[1]); w.w = pg8::cvt_pk_bf16(v1[2], v1[3]);
                        *(u32x4*)(OUT + (size_t)(row0 + ai * 128 + m * 16) * 2048 + col0 + bj * 128) = w; } } }
        }
#undef EM_LOAD
    } };
struct EpiWout { static constexpr bool LDS_EPI = false; template <class A_> __device__ __forceinline__ void run(A_&, const Unit&, int, int, int, int, LAS unsigned char*, int) const {} __device__ __forceinline__ bool keep(const Unit&) const { return false; } static constexpr bool PERM = false; const float* xsrc; float* xdst; const float* gt;
    __device__ __forceinline__ void operator()(const f32x4 (&acc)[2][2][4][2], const Unit& u, int wr, int wc, int fr, int fq) const {
        const int row0 = u.pm * 256 + wr * 64 + fr, col0 = u.pn * 256 + wc * 32 + 4 * fq;
        f32x4 gv[2][2];
#pragma unroll
        for (int bj = 0; bj < 2; ++bj)
#pragma unroll
            for (int n = 0; n < 2; ++n) gv[bj][n] = *(const f32x4*)(gt + col0 + bj * 128 + n * 16);
        f32x4 xo[2][2][2][2];
#define EW_LOAD(slot, q_) do { const int ai_ = (q_) >> 1, mh_ = (q_) & 1; _Pragma("unroll") for (int mm = 0; mm < 2; ++mm) { const size_t off_ = (size_t)(row0 + ai_ * 128 + (2 * mh_ + mm) * 16) * 2048 + col0; \
            _Pragma("unroll") for (int bj = 0; bj < 2; ++bj) _Pragma("unroll") for (int n = 0; n < 2; ++n) xo[slot][mm][bj][n] = *(const f32x4*)(xsrc + off_ + bj * 128 + n * 16); } } while (0)
        EW_LOAD(0, 0);
#pragma unroll
        for (int q = 0; q < 4; ++q) { const int ai = q >> 1, mh = q & 1, sl = q & 1;
            if (q + 1 < 4) EW_LOAD((q + 1) & 1, q + 1);
#pragma unroll
            for (int mm = 0; mm < 2; ++mm) { const int m = 2 * mh + mm; const size_t off = (size_t)(row0 + ai * 128 + m * 16) * 2048 + col0;
#pragma unroll
                for (int bj = 0; bj < 2; ++bj)
#pragma unroll
                    for (int n = 0; n < 2; ++n) *(f32x4*)(xdst + off + bj * 128 + n * 16) = xo[sl][mm][bj][n] + gv[bj][n] * acc[ai][bj][m][n]; } }
#undef EW_LOAD
    } };
struct EpiW13 { static constexpr bool LDS_EPI = false; template <class A_> __device__ __forceinline__ void run(A_&, const Unit&, int, int, int, int, LAS unsigned char*, int) const {} __device__ __forceinline__ bool keep(const Unit&) const { return false; } static constexpr bool PERM = true; bf16_t* HID; unsigned* done;
    __device__ __forceinline__ void operator()(const f32x4 (&acc)[2][2][4][2], const Unit& u, int wr, int wc, int fr, int fq) const {
        const int pnl = u.pn & 3; const int row0 = u.pm * 256 + wr * 64 + fr, col0 = pnl * 128 + wc * 32 + 8 * fq;
        const __amdgpu_buffer_rsrc_t rs = __builtin_amdgcn_make_buffer_rsrc(HID, 0, MAXTILES * 256 * 512 * 2, 0x00020000);
#pragma unroll
        for (int ai = 0; ai < 2; ++ai)
#pragma unroll
            for (int m = 0; m < 4; ++m) { float hv[8];
#pragma unroll
                for (int n = 0; n < 2; ++n)
#pragma unroll
                    for (int j = 0; j < 4; ++j) hv[n * 4 + j] = fsilu(acc[ai][0][m][n][j]) * acc[ai][1][m][n][j];
                u32x4 w; w.x = pg8::cvt_pk_bf16(hv[0], hv[1]); w.y = pg8::cvt_pk_bf16(hv[2], hv[3]); w.z = pg8::cvt_pk_bf16(hv[4], hv[5]); w.w = pg8::cvt_pk_bf16(hv[6], hv[7]);
                __builtin_amdgcn_raw_buffer_store_b128(w, rs, (unsigned)(((row0 + ai * 128 + m * 16) * 512 + col0) * 2), 0,   16); }
        asm volatile("s_waitcnt vmcnt(0)" ::: "memory");
        if (fr == 0 && fq == 0) (void)xb_add(done + 64 * (u.pm + 1), 1u);
    } };
struct EpiW2 { static constexpr bool LDS_EPI = false; template <class A_> __device__ __forceinline__ void run(A_&, const Unit&, int, int, int, int, LAS unsigned char*, int) const {} __device__ __forceinline__ bool keep(const Unit&) const { return false; } static constexpr bool PERM = true; bf16_t* SLOT; const u32x2* rowinfo; const LAS int* tbl;
    __device__ __forceinline__ void operator()(const f32x4 (&acc)[2][2][4][2], const Unit& u, int wr, int wc, int fr, int fq) const {
        const int e = u.pn >> 3, pnl = u.pn & 7; const int row0 = u.pm * 256 + wr * 64 + fr, col0 = pnl * 256 + wc * 32 + 8 * fq; const int rend = __builtin_amdgcn_readfirstlane(tbl[192 + e]);
        u32x2 inf[2][4];
#pragma unroll
        for (int ai = 0; ai < 2; ++ai)
#pragma unroll
            for (int m = 0; m < 4; ++m) inf[ai][m] = rowinfo[row0 + ai * 128 + m * 16];
#pragma unroll
        for (int ai = 0; ai < 2; ++ai)
#pragma unroll
            for (int m = 0; m < 4; ++m) { const int r = row0 + ai * 128 + m * 16;
                if (r < rend) { const unsigned wbits = inf[ai][m].y; const float w = __uint_as_float(wbits); const unsigned tx = inf[ai][m].x; const unsigned tok = tx >> 1, k = tx & 1u;
                    bf16_t* dst = SLOT + ((size_t)k * S_ + tok) * 2048 + col0;
#pragma unroll
                    for (int bj = 0; bj < 2; ++bj) { const f32x4 v0 = acc[ai][bj][m][0] * w, v1 = acc[ai][bj][m][1] * w; u32x4 o;
                        o.x = pg8::cvt_pk_bf16(v0[0], v0[1]); o.y = pg8::cvt_pk_bf16(v0[2], v0[3]); o.z = pg8::cvt_pk_bf16(v1[0], v1[1]); o.w = pg8::cvt_pk_bf16(v1[2], v1[3]);
                        *(u32x4*)(dst + bj * 128) = o; } } }
    } };

struct EpiW2L { static constexpr bool LDS_EPI = true, PERM = true; bf16_t* SLOT; const u32x2* rowinfo; const LAS int* tbl; unsigned* q; volatile LAS int* slot; unsigned* done;
    __device__ __forceinline__ bool keep(const Unit&) const { return false; }
    __device__ __forceinline__ void operator()(const f32x4 (&)[2][2][4][2], const Unit&, int, int, int, int) const {}
    __device__ __forceinline__ void run(const f32x4 (&acc)[2][2][4][2], const Unit& u, int wr, int wc, int fr_, int fq_, LAS unsigned char* lds, int tid_) const {
        int tid = tid_; asm volatile("" : "+v"(tid));
        int qn = 0; unsigned dn = 0u;
        if (tid == 0) { qn = (int)xb_add(q, 1u); const int Ln = slot[(slot[2] + 1) & 1]; if (Ln < tbl[224] * 8) dn = xb_ld(done + 64 * ((Ln >> 3) + 1)); }
        const int fr = tid & 15, fq = (tid >> 4) & 3; const int e = u.pn >> 3, pnl = u.pn & 7; const int rend = __builtin_amdgcn_readfirstlane(tbl[192 + e]);
        LAS unsigned* rowx = (LAS unsigned*)(lds + 131072);
        u32x2 inf[2][4];
#pragma unroll
        for (int ai = 0; ai < 2; ++ai)
#pragma unroll
            for (int m = 0; m < 4; ++m) inf[ai][m] = rowinfo[u.pm * 256 + ai * 128 + wr * 64 + m * 16 + fr];
#pragma unroll
        for (int ai = 0; ai < 2; ++ai)
#pragma unroll
            for (int m = 0; m < 4; ++m) { const int r = ai * 128 + wr * 64 + m * 16 + fr; const bool valid = (u.pm * 256 + r) < rend; const float w = valid ? __uint_as_float(inf[ai][m].y) : 0.f;
                if (wc == 0 && fq == 0) rowx[r] = valid ? inf[ai][m].x : 0xffffffffu;
#pragma unroll
                for (int bj = 0; bj < 2; ++bj) { const int c16 = 16 * bj + 4 * wc + fq; const f32x4 v0 = acc[ai][bj][m][0] * w, v1 = acc[ai][bj][m][1] * w; u32x4 o;
                    o.x = pk2(v0[0], v0[1]); o.y = pk2(v0[2], v0[3]); o.z = pk2(v1[0], v1[1]); o.w = pk2(v1[2], v1[3]);
                    *(LAS u32x4*)(lds + r * 512 + ((c16 ^ (r & 31)) << 4)) = o; }
                asm volatile("" ::: "memory"); }
        __syncthreads();
        const int c = tid & 31;
#pragma unroll
        for (int i = 0; i < 16; ++i) { const int row = (tid >> 5) + 16 * i; const unsigned tx = rowx[row];
            if (tx != 0xffffffffu) { const u32x4 o = *(const LAS u32x4*)(lds + row * 512 + ((c ^ (row & 31)) << 4));
                *(u32x4*)(SLOT + ((size_t)(tx & 1u) * S_ + (tx >> 1)) * 2048 + pnl * 256 + c * 8) = o; }
            if ((i & 3) == 3) asm volatile("" ::: "memory"); }
        if (tid == 0) { const int n = slot[2]; slot[n & 1] = qn; slot[2] = n + 1; slot[4] = dn >= 32u ? 1 : 0; }
        asm volatile("s_waitcnt lgkmcnt(0)" ::: "memory"); __builtin_amdgcn_s_barrier(); asm volatile("" ::: "memory");
    } };

struct Frame { LAS unsigned char* lds; unsigned char* ldsg; int tid, lane, wave, G, bx; };
extern __shared__ __attribute__((aligned(16))) unsigned char lds_raw[];
__device__ __forceinline__ Frame make_frame() { Frame F; int tz = threadIdx.x; asm volatile("" : "+v"(tz)); F.lds = (LAS unsigned char*)lds_raw; F.ldsg = lds_raw; F.tid = tz; F.lane = tz & 63;
    F.wave = __builtin_amdgcn_readfirstlane(tz >> 6); F.G = gridDim.x; F.bx = blockIdx.x; return F; }

struct TItem { const float* W; bf16_t* WT; int ldw, srccol, k0, ldk, dstrow; };
__device__ __forceinline__ void titem_load(const TItem& t, f32x4 (&x)[8], int lane) {
    const int n4 = (lane & 7) * 4, kr = lane >> 3;
#pragma unroll
    for (int i = 0; i < 8; ++i) x[i] = __builtin_nontemporal_load((const f32x4*)(t.W + (size_t)(t.k0 + kr + 8 * i) * t.ldw + t.srccol + n4));
}
__device__ __forceinline__ void titem_store(const TItem& t, const f32x4 (&x)[8], float* scr, int lane) {
    const int n4 = (lane & 7) * 4, kr = lane >> 3;
#pragma unroll
    for (int i = 0; i < 8; ++i) { float* s = scr + (kr + 8 * i) * 33 + n4; s[0] = x[i][0]; s[1] = x[i][1]; s[2] = x[i][2]; s[3] = x[i][3]; }
    asm volatile("s_waitcnt lgkmcnt(0)" ::: "memory");
    const int c = lane & 7;
#pragma unroll
    for (int j = 0; j < 4; ++j) { const int n = (lane >> 3) + 8 * j; const float* s = scr + (8 * c) * 33 + n;
        u32x4 o; o.x = pk2(s[0 * 33], s[1 * 33]); o.y = pk2(s[2 * 33], s[3 * 33]); o.z = pk2(s[4 * 33], s[5 * 33]); o.w = pk2(s[6 * 33], s[7 * 33]);
        *(u32x4*)(t.WT + (size_t)(t.dstrow + n) * t.ldk + t.k0 + 8 * c) = o; }
    asm volatile("s_waitcnt lgkmcnt(0)" ::: "memory");
}

__device__ __forceinline__ void phase_mod(const Frame& F, const Params& p) {
    const float* cvec = KIN(1); const float* ada_w = KIN(3); const float* ada_b = KIN(4);
    float* modv = (float*)(KWS() + WS_MODV);
    float* sc = (float*)F.ldsg;
    f32x2* red = (f32x2*)(sc + 2048);
    for (int k = F.tid; k < 2048; k += NTHR) sc[k] = siluf(cvec[k]);
    __syncthreads();
    for (int u = F.bx; u < 2 * 96; u += F.G) {
        const int l = u / 96, cb = u % 96, col = cb * 128 + 2 * F.lane;
        const float* wp = ada_w + ((size_t)l * 2048 + F.wave * 256) * 12288 + col; const float* sp = sc + F.wave * 256;
        f32x2 acc = (f32x2){0.f, 0.f};
#pragma unroll 16
        for (int k = 0; k < 256; ++k) { const f32x2 w = __builtin_nontemporal_load((const f32x2*)(wp + (size_t)k * 12288)); const float s = sp[k]; acc[0] += s * w[0]; acc[1] += s * w[1]; }
        red[F.wave * 64 + F.lane] = acc;
        __syncthreads();
        if (F.wave == 0) { f32x2 s = *(const f32x2*)(ada_b + l * 12288 + col);
#pragma unroll
            for (int w = 0; w < 8; ++w) s += red[w * 64 + F.lane];
            *(f32x2*)(modv + l * 12288 + col) = s; }
        __syncthreads();
    }
}

__device__ __forceinline__ void phase_convert(const Frame& F, const Params& p, int l) {
    float* scr = (float*)(F.ldsg + F.wave * 8448);
    const int gw = F.bx * NWAVES + F.wave, NGW = F.G * NWAVES;
    bf16_t* WIN = (bf16_t*)(KWS() + WS_WIN); bf16_t* BP = (bf16_t*)(KWS() + WS_BP); bf16_t* WO = (bf16_t*)(KWS() + WS_WO); bf16_t* W13 = (bf16_t*)(KWS() + WS_W13); bf16_t* W2 = (bf16_t*)(KWS() + WS_W2);
    const float* w_in = KIN(7) + (size_t)l * 2048 * INC;
    const float* bp = KIN(19) + (size_t)l * 3 * 1024 * 2048;
    const float* wo = KIN(20) + (size_t)l * 2048 * 2048;
    const float* w1 = KIN(25) + (size_t)l * 32 * 2048 * 512; const float* w3 = KIN(26) + (size_t)l * 32 * 2048 * 512; const float* w2 = KIN(27) + (size_t)l * 32 * 512 * 2048;
    const float* lwa = KIN(10) + (size_t)l * 8 * 16384; const float* lwx = KIN(12) + (size_t)l * 8 * 16384; bf16_t* LWT = (bf16_t*)(KWS() + WS_LWT);
    constexpr int I_IN = 512 * 32, I_BP = 3 * 16 * 64, I_WO = 32 * 64, I_W13 = 32 * 2 * 512, I_W2 = 32 * 512, I_LRU = 8 * 2 * 8;
    constexpr int NITEMS = I_IN + I_BP + I_WO + I_W13 + I_W2 + I_LRU;
    auto decode = [&](int it) -> TItem { TItem t; int r = it;
        if (r < I_IN) { const int nb = r % 512, kb = r / 512; t.W = w_in; t.ldw = INC; t.srccol = (nb < 320) ? 32 * nb : 10256 + 32 * (nb - 320); t.k0 = 64 * kb; t.WT = WIN; t.ldk = 2048; t.dstrow = 32 * nb; return t; }
        r -= I_IN;
        if (r < I_BP) { const int b = r / 1024, q = r % 1024, nb = q % 64, kb = q / 64; t.W = bp + (size_t)b * 1024 * 2048; t.ldw = 2048; t.srccol = 32 * nb; t.k0 = 64 * kb; t.WT = BP + (size_t)b * 2048 * 1024; t.ldk = 1024; t.dstrow = 32 * nb; return t; }
        r -= I_BP;
        if (r < I_WO) { const int nb = r % 64, kb = r / 64; t.W = wo; t.ldw = 2048; t.srccol = 32 * nb; t.k0 = 64 * kb; t.WT = WO; t.ldk = 2048; t.dstrow = 32 * nb; return t; }
        r -= I_WO;
        if (r < I_W13) { const int e = r / 1024, q = r % 1024, which = q / 512, q2 = q % 512, nb = q2 % 16, kb = q2 / 16; const int pn = nb >> 2, j = nb & 3;
            t.W = (which ? w3 : w1) + (size_t)e * 2048 * 512; t.ldw = 512; t.srccol = 32 * nb; t.k0 = 64 * kb; t.WT = W13 + (size_t)e * 1024 * 2048; t.ldk = 2048; t.dstrow = pn * 256 + which * 128 + 32 * j; return t; }
        r -= I_W13;
        if (r < I_W2) { const int e = r / 512, q = r % 512, nb = q % 64, kb = q / 64; t.W = w2 + (size_t)e * 512 * 2048; t.ldw = 2048; t.srccol = 32 * nb; t.k0 = 64 * kb; t.WT = W2 + (size_t)e * 2048 * 512; t.ldk = 512; t.dstrow = 32 * nb; return t; }
        r -= I_W2;
        { const int n = r / 16, q = r % 16, which = q / 8, q2 = q % 8, nb = q2 % 4, kb = q2 / 4; t.W = (which ? lwx : lwa) + (size_t)n * 16384; t.ldw = 128; t.srccol = 32 * nb; t.k0 = 64 * kb; t.WT = LWT + (size_t)n * 256 * 128; t.ldk = 128; t.dstrow = which * 128 + 32 * nb; return t; } };
    if (gw < NITEMS) { TItem ta = decode(gw); f32x4 xa[8]; titem_load(ta, xa, F.lane);
        for (int it = gw; it < NITEMS; it += NGW) { const int nx = it + NGW; TItem tb = ta; f32x4 xb[8];
            if (nx < NITEMS) { tb = decode(nx); titem_load(tb, xb, F.lane); }
            titem_store(ta, xa, scr, F.lane);
            if (nx < NITEMS) { ta = tb;
#pragma unroll
                for (int i = 0; i < 8; ++i) xa[i] = xb[i]; } } }
    float* rtw = (float*)(KWS() + WS_RTW); const float* rgw = KIN(21) + (size_t)l * 2048 * 4; const float* rew = KIN(23) + (size_t)l * 2048 * 32;
    for (int idx = F.bx * NTHR + F.tid; idx < 36 * 2048; idx += F.G * NTHR) { const int j = idx >> 11, k = idx & 2047; rtw[idx] = (j < 32) ? rew[k * 32 + j] : rgw[k * 4 + (j - 32)]; }
}

template <int MODE>
__device__ __forceinline__ void phase_norm(const Frame& F, const Params& p, int l, bool fold) {
    float* tA = (float*)(F.ldsg + 98304);
    float* tB = tA + 2048;
    float* tG = tB + 2048;
    const float* modv = (const float*)(KWS() + WS_MODV);
    const float* xin = (MODE == 0 && l == 0) ? KIN(0) : KOUT();
    float* xio = KOUT();
    bf16_t* H = (bf16_t*)(KWS() + WS_H);
    const bf16_t* SL = (const bf16_t*)(KWS() + WS_SLOT);
    for (int c = F.tid; c < 2048; c += NTHR) {
        if (MODE == 0) { tA[c] = KIN(5)[l * 2048 + c] * (1.f + modv[l * 12288 + MO_SC1 + c]); tB[c] = modv[l * 12288 + MO_SH1 + c]; }
        if (MODE == 1) { tA[c] = KIN(6)[l * 2048 + c] * (1.f + modv[l * 12288 + MO_SC2 + c]); tB[c] = modv[l * 12288 + MO_SH2 + c]; }
        if (MODE == 2) { tA[c] = KIN(28)[c]; tB[c] = 0.f; }
        tG[c] = fold ? DBG_MOE_SCALE * modv[(MODE == 2 ? 1 : l - 1) * 12288 + MO_GT2 + c] : 0.f;
    }
    __syncthreads();
    const int gw = F.bx * NWAVES + F.wave, NGW = F.G * NWAVES;
    const float* rtw = (const float*)(KWS() + WS_RTW);
    for (int row = gw; row < S_; row += NGW) {
        f32x4 v[8]; float ss = 0.f;
#pragma unroll
        for (int j = 0; j < 8; ++j) { const int c = 4 * F.lane + 256 * j; v[j] = *(const f32x4*)(xin + (size_t)row * 2048 + c);
            if (fold) { const u32x2 a = *(const u32x2*)(SL + (size_t)row * 2048 + c), b = *(const u32x2*)(SL + ((size_t)S_ + row) * 2048 + c); const f32x4 g = *(const f32x4*)(tG + c);
#if DBG_M == 1
                v[j][0] += g[0]; v[j][1] += g[1]; v[j][2] += g[2]; v[j][3] += g[3];
#else
                v[j][0] += g[0] * (bflo(a.x) + bflo(b.x)); v[j][1] += g[1] * (bfhi(a.x) + bfhi(b.x)); v[j][2] += g[2] * (bflo(a.y) + bflo(b.y)); v[j][3] += g[3] * (bfhi(a.y) + bfhi(b.y));
#endif
                if (MODE != 2) *(f32x4*)(xio + (size_t)row * 2048 + c) = v[j]; }
            ss += (v[j][0] * v[j][0] + v[j][1] * v[j][1]) + (v[j][2] * v[j][2] + v[j][3] * v[j][3]); }
        const float rstd = 1.0f / sqrtf(wave_sum(ss) * (1.0f / 2048.0f) + EPS);
#pragma unroll
        for (int j = 0; j < 8; ++j) { const int c = 4 * F.lane + 256 * j; const f32x4 a = *(const f32x4*)(tA + c), b = *(const f32x4*)(tB + c);
            v[j] = v[j] * rstd * a + b;
            if (MODE == 2) *(f32x4*)(xio + (size_t)row * 2048 + c) = v[j];
            else { u32x2 w; w.x = pk2(v[j][0], v[j][1]); w.y = pk2(v[j][2], v[j][3]); *(u32x2*)(H + (size_t)row * 2048 + c) = w; } }
        if (MODE == 1) {
            float mine = 0.f;
#pragma unroll 2
            for (int jo = 0; jo < 36; ++jo) { float d = 0.f;
#pragma unroll
                for (int j = 0; j < 8; ++j) { const f32x4 w = *(const f32x4*)(rtw + (size_t)jo * 2048 + 4 * F.lane + 256 * j); d += (v[j][0] * w[0] + v[j][1] * w[1]) + (v[j][2] * w[2] + v[j][3] * w[3]); }
                d = wave_sum(d); mine = (F.lane == jo) ? d : mine; }
            if (F.lane < 32) mine += KIN(24)[l * 32 + F.lane]; else if (F.lane < 36) mine += KIN(22)[l * 4 + (F.lane - 32)];
            const float g0 = __shfl(mine, 32), g1 = __shfl(mine, 33), g2 = __shfl(mine, 34), g3 = __shfl(mine, 35);
            int gs = 0; float gm = g0; if (g1 > gm) { gm = g1; gs = 1; } if (g2 > gm) { gm = g2; gs = 2; } if (g3 > gm) { gm = g3; gs = 3; }
            const float pg = 1.0f / (expf(g0 - gm) + expf(g1 - gm) + expf(g2 - gm) + expf(g3 - gm));
            float ev[8];
#pragma unroll
            for (int i = 0; i < 8; ++i) ev[i] = __shfl(mine, gs * 8 + i);
            int i0 = 0; float v0 = ev[0];
#pragma unroll
            for (int i = 1; i < 8; ++i) if (ev[i] > v0) { v0 = ev[i]; i0 = i; }
            int i1 = -1; float v1 = -3.0e38f;
#pragma unroll
            for (int i = 0; i < 8; ++i) if (i != i0 && ev[i] > v1) { v1 = ev[i]; i1 = i; }
            const float e1 = expf(v1 - v0);
#if DBG_M == 6
            const float w0 = 0.3f, w1 = 0.2f;
#elif DBG_M == 7
            const float w0 = pg, w1 = 0.f;
#elif DBG_M == 8
            const float w0 = 1.0f / (1.0f + e1), w1 = 0.f;
#else
            const float w0 = pg / (1.0f + e1), w1 = pg * e1 / (1.0f + e1);
#endif
            if (F.lane == 0) { unsigned* cnt = (unsigned*)(KWS() + WS_CTL) + CW_CNT + l * 32; const int ex0 = gs * 8 + i0, ex1 = gs * 8 + i1;
                const unsigned p0 = atomicAdd(cnt + ex0, 1u), p1 = atomicAdd(cnt + ex1, 1u);
                unsigned* tk = (unsigned*)(KWS() + WS_TOK) + (size_t)row * 8;
                tk[0] = (unsigned)ex0; tk[1] = p0; tk[2] = __builtin_bit_cast(unsigned, w0); tk[3] = 0u; tk[4] = (unsigned)ex1; tk[5] = p1; tk[6] = __builtin_bit_cast(unsigned, w1); tk[7] = 0u; }
        }
    }
}

__device__ __forceinline__ void phase_norm1_gab(const Frame& F, const Params& p, int l, bool fold) {
    float* tA = (float*)(F.ldsg + 98304); float* tB = tA + 2048; float* tG = tB + 2048;
    bf16_t* Wl = (bf16_t*)F.ldsg;
    const float* modv = (const float*)(KWS() + WS_MODV); const float* xin = (l == 0) ? KIN(0) : KOUT(); float* xio = KOUT(); bf16_t* H = (bf16_t*)(KWS() + WS_H);
    const bf16_t* SL = (const bf16_t*)(KWS() + WS_SLOT); float* GAB = (float*)(KWS() + WS_GAB);
    __syncthreads();
    for (int c = F.tid; c < 2048; c += NTHR) { tA[c] = KIN(5)[l * 2048 + c] * (1.f + modv[l * 12288 + MO_SC1 + c]); tB[c] = modv[l * 12288 + MO_SH1 + c]; tG[c] = fold ? modv[(l - 1) * 12288 + MO_GT2 + c] : 0.f; }
    { const float* gabw = (const float*)(KWS() + WS_GABW) + (size_t)l * 16 * 2048;
        for (int i = F.tid; i < 16 * 2048 / 4; i += NTHR) { const f32x4 v = *(const f32x4*)(gabw + 4 * i); u32x2 o; o.x = pk2(v[0], v[1]); o.y = pk2(v[2], v[3]); *(u32x2*)(Wl + 4 * i) = o; } }
    __syncthreads();
    const int gw = F.bx * NWAVES + F.wave, NGW = F.G * NWAVES;
    for (int rb = gw * 2; rb < S_; rb += NGW * 2) {
        f32x4 v[2][8];
#pragma unroll
        for (int r = 0; r < 2; ++r) { const size_t row = (size_t)(rb + r); float ss = 0.f;
#pragma unroll
            for (int j = 0; j < 8; ++j) { const int c = 4 * F.lane + 256 * j; v[r][j] = *(const f32x4*)(xin + row * 2048 + c);
                if (fold) { const u32x2 a = *(const u32x2*)(SL + row * 2048 + c), b = *(const u32x2*)(SL + ((size_t)S_ + row) * 2048 + c); const f32x4 g = *(const f32x4*)(tG + c);
                    v[r][j][0] += g[0] * (bflo(a.x) + bflo(b.x)); v[r][j][1] += g[1] * (bfhi(a.x) + bfhi(b.x)); v[r][j][2] += g[2] * (bflo(a.y) + bflo(b.y)); v[r][j][3] += g[3] * (bfhi(a.y) + bfhi(b.y));
                    *(f32x4*)(xio + row * 2048 + c) = v[r][j]; }
                ss += (v[r][j][0] * v[r][j][0] + v[r][j][1] * v[r][j][1]) + (v[r][j][2] * v[r][j][2] + v[r][j][3] * v[r][j][3]); }
            const float rstd = 1.0f / sqrtf(wave_sum(ss) * (1.0f / 2048.0f) + EPS);
#pragma unroll
            for (int j = 0; j < 8; ++j) { const int c = 4 * F.lane + 256 * j; const f32x4 a = *(const f32x4*)(tA + c), b = *(const f32x4*)(tB + c); v[r][j] = v[r][j] * rstd * a + b;
                u32x2 w; w.x = pk2(v[r][j][0], v[r][j][1]); w.y = pk2(v[r][j][2], v[r][j][3]); *(u32x2*)(H + row * 2048 + c) = w; }
            asm volatile("" ::: "memory"); }
        float mine[2] = {0.f, 0.f};
#pragma unroll 1
        for (int jo = 0; jo < 16; ++jo) { float d[2] = {0.f, 0.f};
#pragma unroll
            for (int j = 0; j < 8; ++j) { const u32x2 wq = *(const u32x2*)(Wl + jo * 2048 + 4 * F.lane + 256 * j); const float w0 = bflo(wq.x), w1 = bfhi(wq.x), w2 = bflo(wq.y), w3 = bfhi(wq.y);
#pragma unroll
                for (int r = 0; r < 2; ++r) { d[r] = __builtin_fmaf(v[r][j][0], w0, d[r]); d[r] = __builtin_fmaf(v[r][j][1], w1, d[r]); d[r] = __builtin_fmaf(v[r][j][2], w2, d[r]); d[r] = __builtin_fmaf(v[r][j][3], w3, d[r]); } }
#pragma unroll
            for (int r = 0; r < 2; ++r) { const float s = wave_sum(d[r]); mine[r] = (F.lane == jo) ? s : mine[r]; } }
        if (F.lane < 16) {
#pragma unroll
            for (int r = 0; r < 2; ++r) GAB[(size_t)(rb + r) * 16 + F.lane] = mine[r]; }
    }
}

__device__ __forceinline__ void phase_norm2_router(const Frame& F, const Params& p, int l) {
    float* tA = (float*)(F.ldsg + 98304); float* tB = tA + 2048;
    const float* modv = (const float*)(KWS() + WS_MODV); const float* xin = KOUT(); bf16_t* H = (bf16_t*)(KWS() + WS_H);
    for (int c = F.tid; c < 2048; c += NTHR) { tA[c] = KIN(6)[l * 2048 + c] * (1.f + modv[l * 12288 + MO_SC2 + c]); tB[c] = modv[l * 12288 + MO_SH2 + c]; }
    __syncthreads();
    const int gw = F.bx * NWAVES + F.wave, NGW = F.G * NWAVES; const float* rtw = (const float*)(KWS() + WS_RTW);
    const float be = (F.lane < 32) ? KIN(24)[l * 32 + F.lane] : ((F.lane < 36) ? KIN(22)[l * 4 + (F.lane - 32)] : 0.f);
    for (int rb = gw * 4; rb < S_; rb += NGW * 4) {
        f32x4 v[4][8];
#pragma unroll
        for (int r = 0; r < 4; ++r) { const size_t row = (size_t)(rb + r); float ss = 0.f;
#pragma unroll
            for (int j = 0; j < 8; ++j) { v[r][j] = *(const f32x4*)(xin + row * 2048 + 4 * F.lane + 256 * j); ss += (v[r][j][0] * v[r][j][0] + v[r][j][1] * v[r][j][1]) + (v[r][j][2] * v[r][j][2] + v[r][j][3] * v[r][j][3]); }
            const float rstd = 1.0f / sqrtf(wave_sum(ss) * (1.0f / 2048.0f) + EPS);
#pragma unroll
            for (int j = 0; j < 8; ++j) { const int c = 4 * F.lane + 256 * j; const f32x4 a = *(const f32x4*)(tA + c), b = *(const f32x4*)(tB + c); v[r][j] = v[r][j] * rstd * a + b;
                u32x2 w; w.x = pk2(v[r][j][0], v[r][j][1]); w.y = pk2(v[r][j][2], v[r][j][3]); *(u32x2*)(H + row * 2048 + c) = w; } }
        float mine[4] = {0.f, 0.f, 0.f, 0.f};
#pragma unroll 2
        for (int jo = 0; jo < 36; ++jo) { f32x4 wv[8];
#pragma unroll
            for (int j = 0; j < 8; ++j) wv[j] = *(const f32x4*)(rtw + (size_t)jo * 2048 + 4 * F.lane + 256 * j);
#pragma unroll
            for (int r = 0; r < 4; ++r) { float d = 0.f;
#pragma unroll
                for (int j = 0; j < 8; ++j) { d = __builtin_fmaf(v[r][j][0], wv[j][0], d); d = __builtin_fmaf(v[r][j][1], wv[j][1], d); d = __builtin_fmaf(v[r][j][2], wv[j][2], d); d = __builtin_fmaf(v[r][j][3], wv[j][3], d); }
                d = wave_sum(d); mine[r] = (F.lane == jo) ? d : mine[r]; } }
#pragma unroll
        for (int r = 0; r < 4; ++r) { const float lg = mine[r] + be; const int row = rb + r;
            const float g0 = __shfl(lg, 32), g1 = __shfl(lg, 33), g2 = __shfl(lg, 34), g3 = __shfl(lg, 35);
            int gs = 0; float gm = g0; if (g1 > gm) { gm = g1; gs = 1; } if (g2 > gm) { gm = g2; gs = 2; } if (g3 > gm) { gm = g3; gs = 3; }
            const float pg = 1.0f / (expf(g0 - gm) + expf(g1 - gm) + expf(g2 - gm) + expf(g3 - gm));
            float ev[8];
#pragma unroll
            for (int i = 0; i < 8; ++i) ev[i] = __shfl(lg, gs * 8 + i);
            int i0 = 0; float v0 = ev[0];
#pragma unroll
            for (int i = 1; i < 8; ++i) if (ev[i] > v0) { v0 = ev[i]; i0 = i; }
            int i1 = -1; float v1 = -3.0e38f;
#pragma unroll
            for (int i = 0; i < 8; ++i) if (i != i0 && ev[i] > v1) { v1 = ev[i]; i1 = i; }
            const float e1 = expf(v1 - v0); const float w0 = pg / (1.0f + e1), w1 = pg * e1 / (1.0f + e1);
            if (F.lane == 0) { unsigned* cnt = (unsigned*)(KWS() + WS_CTL) + CW_CNT + l * 32; const int ex0 = gs * 8 + i0, ex1 = gs * 8 + i1;
                const unsigned p0 = atomicAdd(cnt + ex0, 1u), p1 = atomicAdd(cnt + ex1, 1u);
                unsigned* tk = (unsigned*)(KWS() + WS_TOK) + (size_t)row * 8;
                tk[0] = (unsigned)ex0; tk[1] = p0; tk[2] = __float_as_uint(w0); tk[3] = 0u; tk[4] = (unsigned)ex1; tk[5] = p1; tk[6] = __float_as_uint(w1); tk[7] = 0u; } }
    }
}

__device__ __forceinline__ void phase_norm2_router_lds(const Frame& F, const Params& p, int l) {
    float* tA = (float*)(F.ldsg + 131072); float* tB = tA + 2048;
    const float* modv = (const float*)(KWS() + WS_MODV); const float* xin = KOUT(); bf16_t* H = (bf16_t*)(KWS() + WS_H);
    for (int c = F.tid; c < 2048; c += NTHR) { tA[c] = KIN(6)[l * 2048 + c] * (1.f + modv[l * 12288 + MO_SC2 + c]); tB[c] = modv[l * 12288 + MO_SH2 + c]; }
    const int gw = F.bx * NWAVES + F.wave, NGW = F.G * NWAVES, ng = S_ / (NGW * 4), w = F.wave, lane = F.lane;
    const unsigned char* rtwb = (const unsigned char*)(KWS() + WS_RTW);
    const float be = (lane < 32) ? KIN(24)[l * 32 + lane] : ((lane < 36) ? KIN(22)[l * 4 + (lane - 32)] : 0.f);
#pragma unroll
    for (int k = 0; k < 8; ++k) __builtin_amdgcn_global_load_lds((const unsigned*)(rtwb + (size_t)(w + 8 * k) * 1024 + lane * 16), (LAS unsigned*)(F.lds + (w + 8 * k) * 1024), 16, 0, 0);
    __syncthreads();
    int s = 0;
#pragma unroll 1
    for (int g = 0; g < ng; ++g) { const int rb = gw * 4 + g * NGW * 4;
        f32x4 v[4][8]; float mine[4] = {0.f, 0.f, 0.f, 0.f};
        { float rstd[4];
#pragma unroll
        for (int r = 0; r < 4; ++r) { const size_t row = (size_t)(rb + r); float ss = 0.f;
#pragma unroll
            for (int j = 0; j < 8; ++j) { v[r][j] = *(const f32x4*)(xin + row * 2048 + 4 * lane + 256 * j); ss += (v[r][j][0] * v[r][j][0] + v[r][j][1] * v[r][j][1]) + (v[r][j][2] * v[r][j][2] + v[r][j][3] * v[r][j][3]); }
            rstd[r] = 1.0f / sqrtf(wave_sum(ss) * (1.0f / 2048.0f) + EPS); }
#pragma unroll
        for (int j = 0; j < 8; ++j) { const int c = 4 * lane + 256 * j; const f32x4 a = *(const f32x4*)(tA + c), b = *(const f32x4*)(tB + c);
#pragma unroll
            for (int r = 0; r < 4; ++r) { v[r][j] = v[r][j] * rstd[r] * a + b;
                u32x2 wq; wq.x = pk2(v[r][j][0], v[r][j][1]); wq.y = pk2(v[r][j][2], v[r][j][3]); *(u32x2*)(H + (size_t)(rb + r) * 2048 + c) = wq; }
            asm volatile("" ::: "memory"); } }
        f32x2 vp[2][8][4];
#pragma unroll
        for (int rp = 0; rp < 2; ++rp)
#pragma unroll
            for (int j = 0; j < 8; ++j)
#pragma unroll
                for (int i = 0; i < 4; ++i) vp[rp][j][i] = (f32x2){v[2 * rp][j][i], v[2 * rp + 1][j][i]};
#pragma unroll 1
        for (int blk = 0; blk < 5; ++blk, ++s) {
            asm volatile("s_waitcnt vmcnt(0)" ::: "memory");
            __syncthreads();
            if (blk < 4 || g + 1 < ng) { const int nb = (blk + 1) % 5; const int nld = (nb == 4) ? 4 : 8; int lz = lane * 16; asm volatile("" : "+v"(lz));
                const unsigned char* src = rtwb + (size_t)nb * 65536 + lz; LAS unsigned char* dst = F.lds + ((s + 1) & 1) * 65536;
#pragma unroll
                for (int k = 0; k < 8; ++k) if (k < nld) __builtin_amdgcn_global_load_lds((const unsigned*)(src + (size_t)(w + 8 * k) * 1024), (LAS unsigned*)(dst + (w + 8 * k) * 1024), 16, 0, 0); }
            { int l4 = 4 * lane; asm volatile("" : "+v"(l4)); const LAS float* wb = (const LAS float*)(F.lds + (s & 1) * 65536) + l4; const int nout = (blk == 4) ? 4 : 8;
#pragma unroll 1
                for (int q = 0; q < nout; ++q) { f32x2 dp[2] = {(f32x2){0.f, 0.f}, (f32x2){0.f, 0.f}};
#pragma unroll
                    for (int j = 0; j < 8; ++j) { const f32x4 wv = *(const LAS f32x4*)(wb + q * 2048 + 256 * j);
#pragma unroll
                        for (int rp = 0; rp < 2; ++rp)
#pragma unroll
                            for (int i = 0; i < 4; ++i) dp[rp] = __builtin_elementwise_fma(vp[rp][j][i], (f32x2){wv[i], wv[i]}, dp[rp]);
                        if ((j & 1) == 1) asm volatile("" ::: "memory"); }
                    const float d[4] = {dp[0][0], dp[0][1], dp[1][0], dp[1][1]};
                    const int jo = blk * 8 + q;
#pragma unroll
                    for (int r = 0; r < 4; ++r) { const float sm = wave_sum(d[r]); mine[r] = (lane == jo) ? sm : mine[r]; } } }
        }
#pragma unroll
        for (int r = 0; r < 4; ++r) { const float lg = mine[r] + be; const int row = rb + r;
            const float g0 = __shfl(lg, 32), g1 = __shfl(lg, 33), g2 = __shfl(lg, 34), g3 = __shfl(lg, 35);
            int gs = 0; float gm = g0; if (g1 > gm) { gm = g1; gs = 1; } if (g2 > gm) { gm = g2; gs = 2; } if (g3 > gm) { gm = g3; gs = 3; }
            const float pg = 1.0f / (expf(g0 - gm) + expf(g1 - gm) + expf(g2 - gm) + expf(g3 - gm));
            float ev[8];
#pragma unroll
            for (int i = 0; i < 8; ++i) ev[i] = __shfl(lg, gs * 8 + i);
            int i0 = 0; float v0 = ev[0];
#pragma unroll
            for (int i = 1; i < 8; ++i) if (ev[i] > v0) { v0 = ev[i]; i0 = i; }
            int i1 = -1; float v1 = -3.0e38f;
#pragma unroll
            for (int i = 0; i < 8; ++i) if (i != i0 && ev[i] > v1) { v1 = ev[i]; i1 = i; }
            const float e1 = expf(v1 - v0); const float w0 = pg / (1.0f + e1), w1 = pg * e1 / (1.0f + e1);
            if (lane == 0) { unsigned* cnt = (unsigned*)(KWS() + WS_CTL) + CW_CNT + l * 32; const int ex0 = gs * 8 + i0, ex1 = gs * 8 + i1;
                const unsigned p0 = atomicAdd(cnt + ex0, 1u), p1 = atomicAdd(cnt + ex1, 1u);
                unsigned* tk = (unsigned*)(KWS() + WS_TOK) + (size_t)row * 8;
                tk[0] = (unsigned)ex0; tk[1] = p0; tk[2] = __float_as_uint(w0); tk[3] = 0u; tk[4] = (unsigned)ex1; tk[5] = p1; tk[6] = __float_as_uint(w1); tk[7] = 0u; } }
    }
}


__device__ __forceinline__ void moe_tables(const Frame& F, const Params& p, int l) {
    LAS int* tbl = (LAS int*)(F.lds + LDS_MISC + 64);
    int* gtbl = (int*)(KWS() + WS_ROWINFO + 512 * 1024);
    if (F.wave == 0) { const unsigned* cnt = (const unsigned*)(KWS() + WS_CTL) + CW_CNT + l * 32; const int e = F.lane;
        const int c = (e < 32) ? (int)__hip_atomic_load(cnt + e, __ATOMIC_RELAXED, __HIP_MEMORY_SCOPE_AGENT) : 0; const int t = (c + 255) >> 8;
        int incl = t;
#pragma unroll
        for (int o = 1; o < 32; o <<= 1) { const int v = __shfl_up(incl, o); if (e >= o) incl += v; }
        const int start = incl - t; const int total = __shfl(incl, 31);
        if (e < 32) { tbl[160 + e] = start; tbl[192 + e] = start * 256 + c; for (int k = 0; k < t && start + k < MAXTILES; ++k) tbl[start + k] = e; }
        const int nt = total < MAXTILES ? total : MAXTILES;
        for (int k = nt + e; k < MAXTILES; k += 64) tbl[k] = 0;
        if (e == 0) tbl[224] = nt; }
    __syncthreads();
    if (F.bx == 0 && F.tid < 225) gtbl[F.tid] = tbl[F.tid];
}
__device__ __forceinline__ void moe_tables_load(const Frame& F, const Params& p) {
    LAS int* tbl = (LAS int*)(F.lds + LDS_MISC + 64);
    const int* gtbl = (const int*)(KWS() + WS_ROWINFO + 512 * 1024);
    if (F.tid < 225) tbl[F.tid] = gtbl[F.tid];
    __syncthreads();
}
__device__ __forceinline__ void phase_gather(const Frame& F, const Params& p, int l) {
    moe_tables(F, p, l);
    const LAS int* tbl = (const LAS int*)(F.lds + LDS_MISC + 64);
    u32x2* rowinfo = (u32x2*)(KWS() + WS_ROWINFO); int* rowtok = (int*)(KWS() + WS_TOK + 512 * 1024);
    for (int a = F.bx * NTHR + F.tid; a < 2 * S_; a += F.G * NTHR) { const int t = a >> 1, k = a & 1; const unsigned* tk = (const unsigned*)(KWS() + WS_TOK) + (size_t)t * 8 + 4 * k;
        const int e = (int)tk[0], pos = (int)tk[1]; const int dest = tbl[160 + e] * 256 + pos; u32x2 inf; inf.x = (unsigned)a; inf.y = tk[2]; rowinfo[dest] = inf; rowtok[dest] = t; }
    if (F.bx < 32) { const int e = F.bx; const int r0 = tbl[192 + e]; const int tend = (e < 31 ? tbl[160 + e + 1] : tbl[224]) * 256;
        for (int r = r0 + F.tid; r < tend; r += NTHR) rowtok[r] = 0; }
}

__device__ __forceinline__ void phase_lru_gates(const Frame& F, const Params& p, int l) {
    float* U = (float*)F.ldsg;
    const bf16_t* Z = (const bf16_t*)(KWS() + WS_Z); float* LA = (float*)(KWS() + WS_MF); float* LB = LA + (size_t)S_ * 1024;
    const float* cw = KIN(8) + l * 4 * 1024; const float* cb = KIN(9) + l * 1024; const float* wa = KIN(10) + (size_t)l * 8 * 128 * 128; const float* ba = KIN(11) + l * 1024;
    const float* wx = KIN(12) + (size_t)l * 8 * 128 * 128; const float* bx = KIN(13) + l * 1024; const float* lam = KIN(14) + l * 1024;
    for (int u = F.bx; u < 4096; u += F.G) {
        const int tt = u >> 1, half = u & 1, t0 = tt * 8, ch = half * 512 + F.tid, n = ch >> 7, j = ch & 127;
        float xr[11];
#pragma unroll
        for (int i = 0; i < 11; ++i) { const int t = t0 - 3 + i; xr[i] = (t >= 0) ? bf2f(Z[(size_t)t * NZ + ZC_LX + ch]) : 0.f; }
        const float c0 = cw[ch], c1 = cw[1024 + ch], c2 = cw[2048 + ch], c3 = cw[3072 + ch], cbv = cb[ch];
        float uo[8];
#pragma unroll
        for (int i = 0; i < 8; ++i) { uo[i] = c0 * xr[i] + c1 * xr[i + 1] + c2 * xr[i + 2] + c3 * xr[i + 3] + cbv; U[i * 512 + F.tid] = uo[i]; }
        __syncthreads();
        float ar[8], ai[8];
#pragma unroll
        for (int i = 0; i < 8; ++i) { ar[i] = 0.f; ai[i] = 0.f; }
        const float* wap = wa + (size_t)n * 16384 + j; const float* wxp = wx + (size_t)n * 16384 + j; const float* up = U + (F.tid & ~127);
        for (int i = 0; i < 128; ++i) { const float a = wap[i * 128], x = wxp[i * 128];
#pragma unroll
            for (int tk = 0; tk < 8; ++tk) { const float uu = up[tk * 512 + i]; ar[tk] += uu * a; ai[tk] += uu * x; } }
        const float bav = ba[ch], bxv = bx[ch], spl = softplusf(-lam[ch]);
#pragma unroll
        for (int tk = 0; tk < 8; ++tk) { const float r = sigm(ar[tk] + bav), ii = sigm(ai[tk] + bxv); const float la = -8.0f * r * spl;
            LA[(size_t)(t0 + tk) * 1024 + ch] = expf(la); LB[(size_t)(t0 + tk) * 1024 + ch] = sqrtf(-expm1f(2.0f * la)) * (ii * uo[tk]); }
        __syncthreads();
    }
}


constexpr int LRU_UF_PITCH = 132, LRU_UB_PITCH = 136;
template <bool FINAL>
__device__ __forceinline__ void lru_units(const Frame& F, const Params& p, int l, int first, int stride) {
    float* Uf = (float*)F.ldsg;
    float* Al = Uf + 64 * LRU_UF_PITCH;
    bf16_t* Ub = (bf16_t*)(Al + 64 * LRU_UF_PITCH);
    float* Cw = (float*)(Ub + 64 * LRU_UB_PITCH);
    const bf16_t* Z = (const bf16_t*)(KWS() + WS_Z); const bf16_t* LWT = (const bf16_t*)(KWS() + WS_LWT);
    float* PHb = (float*)(KWS() + WS_LPH); const float* CAR = (const float*)(KWS() + WS_LCARRY); bf16_t* Y = (bf16_t*)(KWS() + WS_Y);
    const float* cw = KIN(8) + l * 4 * 1024; const float* cb = KIN(9) + l * 1024; const float* ba = KIN(11) + l * 1024; const float* bx = KIN(13) + l * 1024; const float* lam = KIN(14) + l * 1024;
    const int w = F.wave, lane = F.lane, fr = lane & 15, fg = lane >> 4;
    int cur_n = -1; bf16x8 Bf[2][4]; float bav = 0.f, bxv = 0.f, spl = 0.f;
    u32x4 raw[4][2];
#define LRU_RAW(u_) do { const int n_ = (u_) & 7, t0_ = ((u_) >> 3) * 64, tt_ = F.tid >> 3, cg_ = F.tid & 7; _Pragma("unroll") for (int k = 0; k < 4; ++k) { const int t = t0_ + tt_ - 3 + k; \
        if (t >= 0) { const bf16_t* zp = Z + (size_t)t * NZ + ZC_LX + n_ * 128 + 16 * cg_; raw[k][0] = *(const u32x4*)zp; raw[k][1] = *(const u32x4*)(zp + 8); } \
        else { raw[k][0] = (u32x4){0u, 0u, 0u, 0u}; raw[k][1] = raw[k][0]; } } } while (0)
    if (first < 2048) LRU_RAW(first);
    for (int u = first; u < 2048; u += stride) {
        const int n = u & 7, ci = u >> 3, t0 = ci * 64;
        if (n != cur_n) {
            cur_n = n;
#pragma unroll
            for (int q = 0; q < 2; ++q)
#pragma unroll
                for (int ks = 0; ks < 4; ++ks) Bf[q][ks] = *(const bf16x8*)(LWT + ((size_t)n * 256 + q * 128 + 16 * w + fr) * 128 + 32 * ks + 8 * fg);
            const int ch = n * 128 + 16 * w + fr; bav = ba[ch]; bxv = bx[ch]; spl = softplusf(-lam[ch]);
            __syncthreads();
            for (int i = F.tid; i < 640; i += NTHR) { const int k = i >> 7, c = i & 127; Cw[i] = (k < 4) ? cw[k * 1024 + n * 128 + c] : cb[n * 128 + c]; }
            __syncthreads();
        }
        { const int tt = F.tid >> 3, cg = F.tid & 7; float xr[4][16];
#pragma unroll
            for (int k = 0; k < 4; ++k) { const u32x4 a = raw[k][0], b = raw[k][1];
                xr[k][0] = bflo(a.x); xr[k][1] = bfhi(a.x); xr[k][2] = bflo(a.y); xr[k][3] = bfhi(a.y); xr[k][4] = bflo(a.z); xr[k][5] = bfhi(a.z); xr[k][6] = bflo(a.w); xr[k][7] = bfhi(a.w);
                xr[k][8] = bflo(b.x); xr[k][9] = bfhi(b.x); xr[k][10] = bflo(b.y); xr[k][11] = bfhi(b.y); xr[k][12] = bflo(b.z); xr[k][13] = bfhi(b.z); xr[k][14] = bflo(b.w); xr[k][15] = bfhi(b.w); }
            if (u + stride < 2048) LRU_RAW(u + stride);
            float uo[16];
#pragma unroll
            for (int i = 0; i < 16; ++i) { const int c = 16 * cg + i; uo[i] = Cw[c] * xr[0][i] + Cw[128 + c] * xr[1][i] + Cw[256 + c] * xr[2][i] + Cw[384 + c] * xr[3][i] + Cw[512 + c]; }
#pragma unroll
            for (int i = 0; i < 4; ++i) *(f32x4*)(Uf + tt * LRU_UF_PITCH + 16 * cg + 4 * i) = (f32x4){uo[4 * i], uo[4 * i + 1], uo[4 * i + 2], uo[4 * i + 3]};
            u32x4 o0, o1; o0.x = pk2(uo[0], uo[1]); o0.y = pk2(uo[2], uo[3]); o0.z = pk2(uo[4], uo[5]); o0.w = pk2(uo[6], uo[7]); o1.x = pk2(uo[8], uo[9]); o1.y = pk2(uo[10], uo[11]); o1.z = pk2(uo[12], uo[13]); o1.w = pk2(uo[14], uo[15]);
            *(u32x4*)(Ub + tt * LRU_UB_PITCH + 16 * cg) = o0; *(u32x4*)(Ub + tt * LRU_UB_PITCH + 16 * cg + 8) = o1; }
        __syncthreads();
        f32x4 acc[4][2];
#pragma unroll
        for (int mt = 0; mt < 4; ++mt) { acc[mt][0] = (f32x4){0.f, 0.f, 0.f, 0.f}; acc[mt][1] = acc[mt][0]; }
#pragma unroll
        for (int mt = 0; mt < 4; ++mt)
#pragma unroll
            for (int ks = 0; ks < 4; ++ks) { const bf16x8 af = *(const bf16x8*)(Ub + (16 * mt + fr) * LRU_UB_PITCH + 32 * ks + 8 * fg);
                acc[mt][0] = __builtin_amdgcn_mfma_f32_16x16x32_bf16(af, Bf[0][ks], acc[mt][0], 0, 0, 0);
                acc[mt][1] = __builtin_amdgcn_mfma_f32_16x16x32_bf16(af, Bf[1][ks], acc[mt][1], 0, 0, 0); }
#pragma unroll
        for (int mt = 0; mt < 4; ++mt)
#pragma unroll
            for (int r = 0; r < 4; ++r) { const int tk = 16 * mt + 4 * fg + r, cc = 16 * w + fr;
                const float rr = fsigm(acc[mt][0][r] + bav), ii = fsigm(acc[mt][1][r] + bxv), la = -8.0f * rr * spl;
                const float uu = Uf[tk * LRU_UF_PITCH + cc]; const float av = fexp(la);
                Al[tk * LRU_UF_PITCH + cc] = av; Uf[tk * LRU_UF_PITCH + cc] = __builtin_amdgcn_sqrtf(fmaxf(1.0f - av * av, 0.f)) * (ii * uu); }
        __syncthreads();
        { const int chl = F.tid & 127, seg = F.tid >> 7, ch = n * 128 + chl; float* SP = (float*)(Cw + 640); float* SH = SP + 512;
            unsigned short gq[16];
            if (FINAL) {
#pragma unroll
                for (int t = 0; t < 16; ++t) gq[t] = Z[(size_t)(t0 + 16 * seg + t) * NZ + ZC_LG + ch]; }
            float h = 0.f, P = 1.f;
#pragma unroll
            for (int t = 0; t < 16; ++t) { const float a = Al[(16 * seg + t) * LRU_UF_PITCH + chl], bb = Uf[(16 * seg + t) * LRU_UF_PITCH + chl]; h = a * h + bb; P *= a; }
            SP[seg * 128 + chl] = P; SH[seg * 128 + chl] = h;
            __syncthreads();
            float hin = FINAL ? CAR[(size_t)ci * 1024 + ch] : 0.f;
            if (FINAL) {
                for (int s = 0; s < seg; ++s) hin = SP[s * 128 + chl] * hin + SH[s * 128 + chl];
                h = hin;
#pragma unroll
                for (int t = 0; t < 16; ++t) { const float a = Al[(16 * seg + t) * LRU_UF_PITCH + chl], bb = Uf[(16 * seg + t) * LRU_UF_PITCH + chl]; h = a * h + bb;
                    const float g = bf2f(gq[t]); const float gl = g * fsigm(1.5957691216057308f * (g + 0.044715f * g * g * g));
                    Y[(size_t)(t0 + 16 * seg + t) * 3072 + 1024 + ch] = (bf16_t)f2bf(h * gl); }
            } else if (seg == 0) { float Pt = 1.f, Ht = 0.f;
#pragma unroll
                for (int s = 0; s < 4; ++s) { Ht = SP[s * 128 + chl] * Ht + SH[s * 128 + chl]; Pt *= SP[s * 128 + chl]; }
                *(f32x2*)(PHb + ((size_t)ci * 1024 + ch) * 2) = (f32x2){Pt, Ht}; } }
        __syncthreads();
    }
}
#undef LRU_RAW
__device__ __forceinline__ void lru_carry(const Frame& F, int part) {
    const float* PHb = (const float*)(KWS() + WS_LPH); float* CAR = (float*)(KWS() + WS_LCARRY);
    const int ch = part * 512 + F.tid; float h = 0.f;
    for (int c0 = 0; c0 < 256; c0 += 32) { f32x2 v[32];
#pragma unroll
        for (int i = 0; i < 32; ++i) v[i] = *(const f32x2*)(PHb + ((size_t)(c0 + i) * 1024 + ch) * 2);
#pragma unroll
        for (int i = 0; i < 32; ++i) { CAR[(size_t)(c0 + i) * 1024 + ch] = h; h = v[i][0] * h + v[i][1]; } }
}


constexpr int RT_PITCH = 136;
__device__ __forceinline__ float ret_log2g(int h) { return log2f(1.0f - exp2f(-5.0f - (float)h)); }
__device__ __forceinline__ void phase_gabw(const Frame& F) {
    float* gabw = (float*)(KWS() + WS_GABW); const float* w_in = KIN(7);
    for (int idx = F.bx * NTHR + F.tid; idx < 2 * 16 * 2048; idx += F.G * NTHR) { const int j = idx & 15, lk = idx >> 4, l = lk >> 11, k = lk & 2047; gabw[(l * 16 + j) * 2048 + k] = w_in[(size_t)lk * INC + 10240 + j]; }
}
__device__ __forceinline__ void phase_rope_table(const Frame& F) {
    float* RC = (float*)(KWS() + WS_ROPE_C); float* RS = (float*)(KWS() + WS_ROPE_S); const int* pos = (const int*)KIN(2);
    for (int idx = F.bx * NTHR + F.tid; idx < S_ * 64; idx += F.G * NTHR) { const int t = idx >> 6, i = idx & 63;
        const float invf = (float)exp2(-(double)i * (13.287712379549449 / 64.0)); const float angf = (float)pos[t] * invf;
        const double rev = (double)angf * 0.15915494309189535; const float fr = (float)(rev - rint(rev));
        RC[idx] = __builtin_amdgcn_cosf(fr); RS[idx] = __builtin_amdgcn_sinf(fr); }
}
template <bool ROPE>
__device__ __forceinline__ void stage_transposed(const Frame& F, const bf16_t* src  , int t0, bf16_t* T, float mul0, float mul1) {
    const int p = F.lane, c = F.wave; const float* RC = (const float*)(KWS() + WS_ROPE_C); const float* RS = (const float*)(KWS() + WS_ROPE_S);
    float a[2][8], b[2][8];
#pragma unroll
    for (int q = 0; q < 2; ++q) { const bf16_t* rp = src + (size_t)(2 * p + q) * NZ; unpack8(*(const u32x4*)(rp + 8 * c), a[q]); unpack8(*(const u32x4*)(rp + 64 + 8 * c), b[q]);
        if (ROPE) { const size_t ro = (size_t)(t0 + 2 * p + q) * 64 + 8 * c; const f32x4 c0 = *(const f32x4*)(RC + ro), c1 = *(const f32x4*)(RC + ro + 4), s0 = *(const f32x4*)(RS + ro), s1 = *(const f32x4*)(RS + ro + 4);
#pragma unroll
            for (int i = 0; i < 8; ++i) { const float cs = i < 4 ? c0[i & 3] : c1[i & 3], sn = i < 4 ? s0[i & 3] : s1[i & 3]; const float x1 = a[q][i], x2 = b[q][i]; a[q][i] = x1 * cs - x2 * sn; b[q][i] = x2 * cs + x1 * sn; } }
        const float m = q ? mul1 : mul0;
#pragma unroll
        for (int i = 0; i < 8; ++i) { a[q][i] *= m; b[q][i] *= m; } }
#pragma unroll
    for (int i = 0; i < 8; ++i) { *(unsigned*)(T + (8 * c + i) * RT_PITCH + 2 * p) = pk2(a[0][i], a[1][i]); *(unsigned*)(T + (64 + 8 * c + i) * RT_PITCH + 2 * p) = pk2(b[0][i], b[1][i]); }
}
__device__ __forceinline__ void stage_natural_rope(const Frame& F, const bf16_t* src, int t0, bf16_t* N, float mul) {
    const float* RC = (const float*)(KWS() + WS_ROPE_C); const float* RS = (const float*)(KWS() + WS_ROPE_S);
#pragma unroll
    for (int rep = 0; rep < 2; ++rep) { const int c = F.tid & 7, tok = (F.tid >> 3) + 64 * rep; const bf16_t* rp = src + (size_t)tok * NZ; float a[8], b[8];
        unpack8(*(const u32x4*)(rp + 8 * c), a); unpack8(*(const u32x4*)(rp + 64 + 8 * c), b);
        const size_t ro = (size_t)(t0 + tok) * 64 + 8 * c; const f32x4 c0 = *(const f32x4*)(RC + ro), c1 = *(const f32x4*)(RC + ro + 4), s0 = *(const f32x4*)(RS + ro), s1 = *(const f32x4*)(RS + ro + 4);
        float y1[8], y2[8];
#pragma unroll
        for (int i = 0; i < 8; ++i) { const float cs = i < 4 ? c0[i & 3] : c1[i & 3], sn = i < 4 ? s0[i & 3] : s1[i & 3]; y1[i] = (a[i] * cs - b[i] * sn) * mul; y2[i] = (b[i] * cs + a[i] * sn) * mul; }
        u32x4 o1, o2; o1.x = pk2(y1[0], y1[1]); o1.y = pk2(y1[2], y1[3]); o1.z = pk2(y1[4], y1[5]); o1.w = pk2(y1[6], y1[7]); o2.x = pk2(y2[0], y2[1]); o2.y = pk2(y2[2], y2[3]); o2.z = pk2(y2[4], y2[5]); o2.w = pk2(y2[6], y2[7]);
        *(u32x4*)(N + tok * RT_PITCH + 8 * c) = o1; *(u32x4*)(N + tok * RT_PITCH + 64 + 8 * c) = o2; }
}

struct RopeCS { f32x4 c0, c1, s0, s1; };
__device__ __forceinline__ void rope_store_natural(bf16_t* N, int tok, int c, const u32x4 xa, const u32x4 xb, const RopeCS& cs, float mul) {
    float a[8], b[8]; unpack8(xa, a); unpack8(xb, b); float y1[8], y2[8];
#pragma unroll
    for (int i = 0; i < 8; ++i) { const float co = i < 4 ? cs.c0[i & 3] : cs.c1[i & 3], sn = i < 4 ? cs.s0[i & 3] : cs.s1[i & 3]; y1[i] = (a[i] * co - b[i] * sn) * mul; y2[i] = (b[i] * co + a[i] * sn) * mul; }
    u32x4 o1, o2; o1.x = pk2(y1[0], y1[1]); o1.y = pk2(y1[2], y1[3]); o1.z = pk2(y1[4], y1[5]); o1.w = pk2(y1[6], y1[7]); o2.x = pk2(y2[0], y2[1]); o2.y = pk2(y2[2], y2[3]); o2.z = pk2(y2[4], y2[5]); o2.w = pk2(y2[6], y2[7]);
    *(u32x4*)(N + tok * RT_PITCH + 8 * c) = o1; *(u32x4*)(N + tok * RT_PITCH + 64 + 8 * c) = o2;
}
template <bool ROPE>
__device__ __forceinline__ void store_transposed(bf16_t* T, int p, int c, const u32x4 (&xa)[2], const u32x4 (&xb)[2], const RopeCS (&cs)[2], float mul0, float mul1) {
    float a[2][8], b[2][8];
#pragma unroll
    for (int q = 0; q < 2; ++q) { unpack8(xa[q], a[q]); unpack8(xb[q], b[q]);
        if (ROPE) {
#pragma unroll
            for (int i = 0; i < 8; ++i) { const float co = i < 4 ? cs[q].c0[i & 3] : cs[q].c1[i & 3], sn = i < 4 ? cs[q].s0[i & 3] : cs[q].s1[i & 3]; const float x1 = a[q][i], x2 = b[q][i]; a[q][i] = x1 * co - x2 * sn; b[q][i] = x2 * co + x1 * sn; } }
        const float m = q ? mul1 : mul0;
#pragma unroll
        for (int i = 0; i < 8; ++i) { a[q][i] *= m; b[q][i] *= m; } }
#pragma unroll
    for (int i = 0; i < 8; ++i) { *(unsigned*)(T + (8 * c + i) * RT_PITCH + 2 * p) = pk2(a[0][i], a[1][i]); *(unsigned*)(T + (64 + 8 * c + i) * RT_PITCH + 2 * p) = pk2(b[0][i], b[1][i]); }
}
__device__ __forceinline__ RopeCS load_cs(int tok_global, int c) { const float* RC = (const float*)(KWS() + WS_ROPE_C); const float* RS = (const float*)(KWS() + WS_ROPE_S); const size_t ro = (size_t)tok_global * 64 + 8 * c;
    RopeCS r; r.c0 = *(const f32x4*)(RC + ro); r.c1 = *(const f32x4*)(RC + ro + 4); r.s0 = *(const f32x4*)(RS + ro); r.s1 = *(const f32x4*)(RS + ro + 4); return r; }
__device__ __forceinline__ void ret_units_a(const Frame& F, int first, int stride) {
    bf16_t* Kt = (bf16_t*)F.ldsg; bf16_t* Vt = Kt + 128 * RT_PITCH;
    const bf16_t* Z = (const bf16_t*)(KWS() + WS_Z); float* KV = (float*)(KWS() + WS_KV);
    const int w = F.wave, lane = F.lane, fr = lane & 15, fg = lane >> 4, pp = F.lane, cw = F.wave;
    u32x4 ka[2], kb[2], va[2], vb[2]; RopeCS cs[2];
#define RETA_RAW(u_) do { const int h_ = (u_) & 7, t0_ = ((u_) >> 3) * 128; const bf16_t* zk = Z + (size_t)t0_ * NZ + ZC_RK + h_ * 128; const bf16_t* zv = Z + (size_t)t0_ * NZ + ZC_RV + h_ * 128; \
        _Pragma("unroll") for (int q = 0; q < 2; ++q) { const size_t ro = (size_t)(2 * pp + q) * NZ; ka[q] = *(const u32x4*)(zk + ro + 8 * cw); kb[q] = *(const u32x4*)(zk + ro + 64 + 8 * cw); \
            va[q] = *(const u32x4*)(zv + ro + 8 * cw); vb[q] = *(const u32x4*)(zv + ro + 64 + 8 * cw); cs[q] = load_cs(t0_ + 2 * pp + q, cw); } } while (0)
    if (first < 1024) RETA_RAW(first);
    for (int u = first; u < 1024; u += stride) {
        const int h = u & 7, n = u >> 3; const float l2g = ret_log2g(h);
        const float m0 = 0.08838834764831845f * exp2f((float)(127 - 2 * lane) * l2g), m1 = 0.08838834764831845f * exp2f((float)(126 - 2 * lane) * l2g);
        store_transposed<true>(Kt, pp, cw, ka, kb, cs, m0, m1); store_transposed<false>(Vt, pp, cw, va, vb, cs, 1.0f, 1.0f);
        if (u + stride < 1024) RETA_RAW(u + stride);
        __syncthreads();
        f32x4 acc[8];
#pragma unroll
        for (int nt = 0; nt < 8; ++nt) acc[nt] = (f32x4){0.f, 0.f, 0.f, 0.f};
#pragma unroll
        for (int ks = 0; ks < 4; ++ks) { const bf16x8 af = *(const bf16x8*)(Kt + (16 * w + fr) * RT_PITCH + 32 * ks + 8 * fg);
#pragma unroll
            for (int nt = 0; nt < 8; ++nt) { const bf16x8 bfr = *(const bf16x8*)(Vt + (16 * nt + fr) * RT_PITCH + 32 * ks + 8 * fg); acc[nt] = __builtin_amdgcn_mfma_f32_16x16x32_bf16(af, bfr, acc[nt], 0, 0, 0); } }
        float* kvp = KV + ((size_t)(n * 8 + h) * 128) * 128;
#pragma unroll
        for (int nt = 0; nt < 8; ++nt) *(f32x4*)(kvp + (size_t)(16 * nt + fr) * 128 + 16 * w + 4 * fg) = acc[nt];
        __syncthreads();
    }
#undef RETA_RAW
}
__device__ __forceinline__ void ret_scan(const Frame& F, int wg, int nwg) {
    float* KV = (float*)(KWS() + WS_KV);
    for (int idx = wg * NTHR + F.tid; idx < 8 * 8192; idx += nwg * NTHR) { const int h = idx >> 13, ed = (idx & 8191) * 2; const float cd = exp2f(128.0f * ret_log2g(h)); f32x2 R = (f32x2){0.f, 0.f};
        for (int n0 = 0; n0 < 128; n0 += 16) { f32x2 v[16];
#pragma unroll
            for (int i = 0; i < 16; ++i) v[i] = *(const f32x2*)(KV + ((size_t)((n0 + i) * 8 + h) << 14) + ed);
#pragma unroll
            for (int i = 0; i < 16; ++i) { *(f32x2*)(KV + ((size_t)((n0 + i) * 8 + h) << 14) + ed) = R; R[0] = cd * R[0] + v[i][0]; R[1] = cd * R[1] + v[i][1]; } } }
}
__device__ __forceinline__ void ret_units_c(const Frame& F, int first, int stride) {
    bf16_t* Qs = (bf16_t*)F.ldsg; bf16_t* Ks = Qs + 128 * RT_PITCH; bf16_t* Vt = Ks + 128 * RT_PITCH; bf16_t* Rt = Vt + 128 * RT_PITCH;
    const bf16_t* Z = (const bf16_t*)(KWS() + WS_Z); const float* KV = (const float*)(KWS() + WS_KV); bf16_t* Y = (bf16_t*)(KWS() + WS_Y);
    const int w = F.wave, lane = F.lane, fr = lane & 15, fg = lane >> 4;
    for (int u = first; u < 1024; u += stride) {
        const int h = u & 7, n = u >> 3, t0 = n * 128; const float l2g = ret_log2g(h);
        { const int pp = F.lane, cw = F.wave, cn = F.tid & 7; const bf16_t* zq = Z + (size_t)t0 * NZ + ZC_RQ + h * 128; const bf16_t* zk = Z + (size_t)t0 * NZ + ZC_RK + h * 128; const bf16_t* zv = Z + (size_t)t0 * NZ + ZC_RV + h * 128;
            const float* kvp = KV + ((size_t)(n * 8 + h) << 14);
            u32x4 qa[2], qb[2], ka[2], kb[2], va[2], vb[2]; RopeCS cs[2]; f32x4 rv[8];
#pragma unroll
            for (int rep = 0; rep < 2; ++rep) { const int tok = (F.tid >> 3) + 64 * rep; const size_t ro = (size_t)tok * NZ; qa[rep] = *(const u32x4*)(zq + ro + 8 * cn); qb[rep] = *(const u32x4*)(zq + ro + 64 + 8 * cn);
                ka[rep] = *(const u32x4*)(zk + ro + 8 * cn); kb[rep] = *(const u32x4*)(zk + ro + 64 + 8 * cn); cs[rep] = load_cs(t0 + tok, cn); }
#pragma unroll
            for (int q = 0; q < 2; ++q) { const size_t ro = (size_t)(2 * pp + q) * NZ; va[q] = *(const u32x4*)(zv + ro + 8 * cw); vb[q] = *(const u32x4*)(zv + ro + 64 + 8 * cw); }
#pragma unroll
            for (int i = 0; i < 8; ++i) { const int i4 = F.tid + NTHR * i; rv[i] = *(const f32x4*)(kvp + (i4 >> 5) * 128 + (i4 & 31) * 4); }
#pragma unroll
            for (int rep = 0; rep < 2; ++rep) { const int tok = (F.tid >> 3) + 64 * rep; rope_store_natural(Qs, tok, cn, qa[rep], qb[rep], cs[rep], 1.0f); rope_store_natural(Ks, tok, cn, ka[rep], kb[rep], cs[rep], 0.08838834764831845f); }
            store_transposed<false>(Vt, pp, cw, va, vb, cs, 1.0f, 1.0f);
#pragma unroll
            for (int i = 0; i < 8; ++i) { const int i4 = F.tid + NTHR * i, e = i4 >> 5, d4 = (i4 & 31) * 4; u32x2 o; o.x = pk2(rv[i][0], rv[i][1]); o.y = pk2(rv[i][2], rv[i][3]); *(u32x2*)(Rt + e * RT_PITCH + d4) = o; } }
        __syncthreads();
#pragma unroll 1
        for (int half = 0; half < 2; ++half) {
            const int T = half ? 7 - w : w;
            u32x2 gpre[8]; { const size_t tgp = (size_t)(t0 + 16 * T + fr);
#pragma unroll
                for (int mt = 0; mt < 8; ++mt) gpre[mt] = *(const u32x2*)(Z + tgp * NZ + ZC_RG + h * 128 + 16 * mt + 4 * fg); }
            bf16x8 qf[4];
#pragma unroll
            for (int ks = 0; ks < 4; ++ks) qf[ks] = *(const bf16x8*)(Qs + (16 * T + fr) * RT_PITCH + 32 * ks + 8 * fg);
            f32x4 ao[8], ar[8];
#pragma unroll
            for (int mt = 0; mt < 8; ++mt) { ao[mt] = (f32x4){0.f, 0.f, 0.f, 0.f}; ar[mt] = ao[mt]; }
#pragma unroll
            for (int mt = 0; mt < 8; ++mt)
#pragma unroll
                for (int ks = 0; ks < 4; ++ks) { const bf16x8 af = *(const bf16x8*)(Rt + (16 * mt + fr) * RT_PITCH + 32 * ks + 8 * fg); ar[mt] = __builtin_amdgcn_mfma_f32_16x16x32_bf16(af, qf[ks], ar[mt], 0, 0, 0);
                    if (ks == 3 && (mt & 3) == 3) asm volatile("" ::: "memory"); }
            const int il = 16 * T + fr;
            for (int kp = 0; kp <= (T >> 1); ++kp) {
                u32x2 pt[2];
#pragma unroll
                for (int q = 0; q < 2; ++q) { const int jt = 2 * kp + q; f32x4 s = (f32x4){0.f, 0.f, 0.f, 0.f};
                    if (jt <= T) {
#pragma unroll
                        for (int ks = 0; ks < 4; ++ks) { const bf16x8 kf = *(const bf16x8*)(Ks + (16 * jt + fr) * RT_PITCH + 32 * ks + 8 * fg); s = __builtin_amdgcn_mfma_f32_16x16x32_bf16(kf, qf[ks], s, 0, 0, 0); }
#pragma unroll
                        for (int r = 0; r < 4; ++r) { const int jl = 16 * jt + 4 * fg + r; s[r] = (il >= jl) ? s[r] * __builtin_amdgcn_exp2f((float)(il - jl) * l2g) : 0.f; }
                        asm volatile("" ::: "memory"); }
                    pt[q].x = pk2(s[0], s[1]); pt[q].y = pk2(s[2], s[3]); }
                bf16x8 pf; { u32x4 t4; t4.x = pt[0].x; t4.y = pt[0].y; t4.z = pt[1].x; t4.w = pt[1].y; pf = __builtin_bit_cast(bf16x8, t4); }
#pragma unroll
                for (int mt = 0; mt < 8; ++mt) { const u32x2 v0 = *(const u32x2*)(Vt + (16 * mt + fr) * RT_PITCH + 32 * kp + 4 * fg), v1 = *(const u32x2*)(Vt + (16 * mt + fr) * RT_PITCH + 32 * kp + 16 + 4 * fg);
                    u32x4 t4; t4.x = v0.x; t4.y = v0.y; t4.z = v1.x; t4.w = v1.y; const bf16x8 vf = __builtin_bit_cast(bf16x8, t4);
                    ao[mt] = __builtin_amdgcn_mfma_f32_16x16x32_bf16(vf, pf, ao[mt], 0, 0, 0); if (mt == 7) asm volatile("" ::: "memory"); } }
            const float qd = exp2f((float)(il + 1) * l2g); float ss = 0.f;
#pragma unroll
            for (int mt = 0; mt < 8; ++mt) { ao[mt] = ao[mt] + ar[mt] * qd; ss += (ao[mt][0] * ao[mt][0] + ao[mt][1] * ao[mt][1]) + (ao[mt][2] * ao[mt][2] + ao[mt][3] * ao[mt][3]); }
            ss += __shfl_xor(ss, 16); ss += __shfl_xor(ss, 32);
            const float rstd = 1.0f / sqrtf(ss * (1.0f / 128.0f) + EPS); const size_t tg = (size_t)(t0 + il);
#pragma unroll
            for (int mt = 0; mt < 8; ++mt) { const int e0 = h * 128 + 16 * mt + 4 * fg; const u32x2 gw = gpre[mt];
                u32x2 o; o.x = pk2(ao[mt][0] * rstd * fsilu(bflo(gw.x)), ao[mt][1] * rstd * fsilu(bfhi(gw.x))); o.y = pk2(ao[mt][2] * rstd * fsilu(bflo(gw.y)), ao[mt][3] * rstd * fsilu(bfhi(gw.y)));
                *(u32x2*)(Y + tg * 3072 + e0) = o; }
        }
        __syncthreads();
    }
}


constexpr int GP = 136;
constexpr int GMP = 68;
constexpr int GS_FRAGS = 32, GS_PACK_BYTES = GS_FRAGS * 1024, GO_FRAGS = 24, GO_PACK_BYTES = GO_FRAGS * 1024;
__device__ __forceinline__ bf16x8 mk_frag(u32x2 lo, u32x2 hi) { u32x4 t; t.x = lo.x; t.y = lo.y; t.z = hi.x; t.w = hi.y; return __builtin_bit_cast(bf16x8, t); }
__device__ __forceinline__ bf16x8 pack_acc2(const f32x4 a, const f32x4 b) { u32x4 t; t.x = pk2(a[0], a[1]); t.y = pk2(a[2], a[3]); t.z = pk2(b[0], b[1]); t.w = pk2(b[2], b[3]); return __builtin_bit_cast(bf16x8, t); }
__device__ __forceinline__ u32x4 tile_frag_scaled(const bf16_t* T, int mt, int ks, int fr, int fg, float sc) {
    const u32x2 lo = *(const u32x2*)(T + (16 * mt + fr) * GP + 32 * ks + 4 * fg), hi = *(const u32x2*)(T + (16 * mt + fr) * GP + 32 * ks + 16 + 4 * fg);
    u32x4 o; o.x = pk2(bflo(lo.x) * sc, bfhi(lo.x) * sc); o.y = pk2(bflo(lo.y) * sc, bfhi(lo.y) * sc); o.z = pk2(bflo(hi.x) * sc, bfhi(hi.x) * sc); o.w = pk2(bflo(hi.y) * sc, bfhi(hi.y) * sc); return o;
}
__device__ __forceinline__ void gdn_units_a(const Frame& F, const Params& p, int l) {
    bf16_t* Qn = (bf16_t*)F.ldsg; bf16_t* Kn = Qn + 64 * GP; bf16_t* Vn = Kn + 64 * GP; bf16_t* Wl = Vn + 64 * GP;
    float* Mm = (float*)(Wl + 64 * GP);
    float* gcv = Mm + 64 * GMP; float* bet = gcv + 64; float* beg = bet + 64; float* ekd = beg + 64; float* egc = ekd + 64;
    float* cwl = egc + 64;
    const bf16_t* Z = (const bf16_t*)(KWS() + WS_Z); const float* GAB = (const float*)(KWS() + WS_GAB);
    unsigned char* P2 = KWS() + WS_GP2; float* UP = (float*)(KWS() + WS_GUP); float* GL = (float*)(KWS() + WS_GGL);
    const float* cw = KIN(15) + (size_t)l * 4 * 3072;
    const int w = F.wave, lane = F.lane, fr = lane & 15, fg = lane >> 4;
    int cur_h = -1; float Aexp = 0.f, dtb = 0.f;
    for (int u = F.bx; u < 2048; u += F.G) {
        const int h = u & 7, n = u >> 3, t0 = n * 64;
        if (h != cur_h) { cur_h = h; Aexp = expf(KIN(16)[l * 8 + h]); dtb = KIN(17)[l * 8 + h];
            __syncthreads();
            for (int i = F.tid; i < 1536; i += NTHR) { const int ten = i >> 9, k = (i >> 7) & 3, c = i & 127; cwl[i] = cw[k * 3072 + ten * 1024 + h * 128 + c]; }
            __syncthreads(); }
        { const int tt = F.tid >> 3, cg = F.tid & 7;
#pragma unroll
            for (int ten = 0; ten < 3; ++ten) { float y[16];
#pragma unroll
                for (int i = 0; i < 16; ++i) y[i] = 0.f;
#pragma unroll
                for (int k = 0; k < 4; ++k) { const int t = t0 + tt - 3 + k;
                    if (t >= 0) { const bf16_t* zp = Z + (size_t)t * NZ + ZC_GQ + ten * 1024 + h * 128 + 16 * cg; float x[16]; float x8a[8], x8b[8]; unpack8(*(const u32x4*)zp, x8a); unpack8(*(const u32x4*)(zp + 8), x8b);
#pragma unroll
                        for (int i = 0; i < 8; ++i) { x[i] = x8a[i]; x[8 + i] = x8b[i]; }
#pragma unroll
                        for (int i = 0; i < 16; ++i) y[i] += cwl[(ten * 4 + k) * 128 + 16 * cg + i] * x[i]; } }
                float ss = 0.f;
#pragma unroll
                for (int i = 0; i < 16; ++i) { y[i] = fsilu(y[i]); ss += y[i] * y[i]; }
                float mul = 1.0f;
                if (ten < 2) { ss += __shfl_xor(ss, 1); ss += __shfl_xor(ss, 2); ss += __shfl_xor(ss, 4); mul = (1.0f / sqrtf(ss + EPS)) * (ten == 0 ? 0.08838834764831845f : 1.0f); }
                bf16_t* dst = (ten == 0 ? Qn : (ten == 1 ? Kn : Vn)) + tt * GP + 16 * cg; u32x4 o0, o1;
                o0.x = pk2(y[0] * mul, y[1] * mul); o0.y = pk2(y[2] * mul, y[3] * mul); o0.z = pk2(y[4] * mul, y[5] * mul); o0.w = pk2(y[6] * mul, y[7] * mul);
                o1.x = pk2(y[8] * mul, y[9] * mul); o1.y = pk2(y[10] * mul, y[11] * mul); o1.z = pk2(y[12] * mul, y[13] * mul); o1.w = pk2(y[14] * mul, y[15] * mul);
                *(u32x4*)dst = o0; *(u32x4*)(dst + 8) = o1;
                asm volatile("" ::: "memory"); } }
        if (w == 0) { const size_t gi = (size_t)(t0 + lane) * 16; const float g = -Aexp * softplusf(GAB[gi + h] + dtb); const float beta = sigm(GAB[gi + 8 + h]);
            float gc = g;
#pragma unroll
            for (int o = 1; o < 64; o <<= 1) { const float t = __shfl_up(gc, o); if (lane >= o) gc += t; }
            const float gl = __shfl(gc, 63);
            gcv[lane] = gc; bet[lane] = beta; { const float eg = expf(gc); egc[lane] = eg; beg[lane] = beta * eg; } ekd[lane] = expf(gl - gc);
            if (lane == 0) GL[u] = expf(gl); }
        __syncthreads();
        unsigned char* pk = P2 + (size_t)u * GS_PACK_BYTES; unsigned char* pko = KWS() + WS_GPO + (size_t)u * GO_PACK_BYTES;
        { const int mt = w >> 1;
#pragma unroll
            for (int q = 0; q < 2; ++q) { const int nt = 2 * (w & 1) + q;
                if (nt <= mt) { f32x4 s = (f32x4){0.f, 0.f, 0.f, 0.f};
#pragma unroll
                    for (int ks = 0; ks < 4; ++ks) { const bf16x8 af = *(const bf16x8*)(Kn + (16 * mt + fr) * GP + 32 * ks + 8 * fg), bf_ = *(const bf16x8*)(Kn + (16 * nt + fr) * GP + 32 * ks + 8 * fg); s = __builtin_amdgcn_mfma_f32_16x16x32_bf16(af, bf_, s, 0, 0, 0); }
                    const int j = 16 * nt + fr; const float gj = gcv[j];
#pragma unroll
                    for (int r = 0; r < 4; ++r) { const int i = 16 * mt + 4 * fg + r; Mm[i * GMP + j] = (i > j) ? bet[i] * s[r] * fexp(gcv[i] - gj) : 0.f; } } } }
        { const int it = w >> 1, ksA = w & 1; f32x4 s2[2];
#pragma unroll
            for (int q = 0; q < 2; ++q) { const int jt = 2 * ksA + q; s2[q] = (f32x4){0.f, 0.f, 0.f, 0.f};
                if (jt <= it) {
#pragma unroll
                    for (int ks = 0; ks < 4; ++ks) { const bf16x8 af = *(const bf16x8*)(Kn + (16 * jt + fr) * GP + 32 * ks + 8 * fg), bf_ = *(const bf16x8*)(Qn + (16 * it + fr) * GP + 32 * ks + 8 * fg); s2[q] = __builtin_amdgcn_mfma_f32_16x16x32_bf16(af, bf_, s2[q], 0, 0, 0); }
                    const int i = 16 * it + fr; const float gi = gcv[i];
#pragma unroll
                    for (int r = 0; r < 4; ++r) { const int j = 16 * jt + 4 * fg + r; s2[q][r] = (i >= j) ? s2[q][r] * fexp(gi - gcv[j]) : 0.f; } } }
            *(bf16x8*)(pko + (size_t)(16 + it * 2 + ksA) * 1024 + lane * 16) = pack_acc2(s2[0], s2[1]); }
        __syncthreads();
        if (w < 4) { const int c = F.tid; float sol[64];
#pragma unroll
            for (int i = 0; i < 64; ++i) sol[i] = 0.f;
            LAS const bf16_t* colp = (LAS const bf16_t*)(F.lds) + ((c < 128) ? (2 * 64 * GP + c) : (64 * GP + (c - 128))); asm volatile("" : "+v"(colp));
            LAS const float* mm = (LAS const float*)(F.lds + 4 * 64 * GP * 2); asm volatile("" : "+v"(mm));
            LAS const float* tb = mm + 64 * GMP + ((c < 128) ? 64 : 128); asm volatile("" : "+v"(tb));
#pragma unroll
            for (int i = 0; i < 64; ++i) { float a = bf2f(colp[i * GP]) * tb[i];
#pragma unroll
                for (int jb = 0; jb < (i + 3) / 4; ++jb) { const f32x4 m4 = *(LAS const f32x4*)(mm + i * GMP + 4 * jb);
                    a -= m4[0] * sol[4 * jb]; a -= m4[1] * sol[4 * jb + 1]; a -= m4[2] * sol[4 * jb + 2]; a -= m4[3] * sol[4 * jb + 3];
                    if ((jb & 3) == 3) asm volatile("" ::: "memory"); }
                sol[i] = a; asm volatile("" ::: "memory"); }
            if (c < 128) { float* up = UP + (size_t)u * 8192 + (size_t)(c >> 4) * 1024;
#pragma unroll
                for (int t = 0; t < 4; ++t)
#pragma unroll
                    for (int G = 0; G < 4; ++G) *(f32x4*)(up + (t * 64 + (c & 15) + 16 * G) * 4) = (f32x4){sol[16 * t + 4 * G], sol[16 * t + 4 * G + 1], sol[16 * t + 4 * G + 2], sol[16 * t + 4 * G + 3]}; }
            else { const int d = c - 128;
#pragma unroll
                for (int i = 0; i < 64; ++i) Wl[i * GP + d] = (bf16_t)f2bf(-sol[i]); }
        } else { const int w4 = w - 4;
#pragma unroll
            for (int q = 0; q < 4; ++q) { const int f = w4 * 4 + q, mt = f >> 2, ks = f & 3;
                *(u32x4*)(pko + (size_t)f * 1024 + lane * 16) = tile_frag_scaled(Qn, mt, ks, fr, fg, egc[16 * mt + fr]); }
#pragma unroll
            for (int q = 0; q < 4; ++q) { const int f = w4 * 4 + q, mt = f >> 1, ks = f & 1;
                float v[8];
#pragma unroll
                for (int jj = 0; jj < 8; ++jj) { const int tk = 32 * ks + 16 * (jj >> 2) + 4 * fg + (jj & 3); v[jj] = bf2f(Kn[tk * GP + 16 * mt + fr]) * ekd[tk]; }
                u32x4 o; o.x = pk2(v[0], v[1]); o.y = pk2(v[2], v[3]); o.z = pk2(v[4], v[5]); o.w = pk2(v[6], v[7]);
                *(u32x4*)(pk + (size_t)(16 + f) * 1024 + lane * 16) = o; } }
        __syncthreads();
#pragma unroll
        for (int q = 0; q < 2; ++q) { const int f = w * 2 + q, mt = f >> 2, ks = f & 3; *(u32x4*)(pk + (size_t)f * 1024 + lane * 16) = tile_frag_scaled(Wl, mt, ks, fr, fg, 1.0f); }
        __syncthreads();
    }
}

constexpr int GA_SET = 3 * 64 * GP * 2 + 5 * 64 * 4, GA_WL = 2 * GA_SET, GA_MM = GA_WL + 64 * GP * 2, GA_CW = GA_MM + 64 * GMP * 4, GA_END = GA_CW + 1536 * 4;
static_assert(GA_END <= LDS_MISC, "gdn prep LDS map");
__device__ __forceinline__ void gdn_stage_unit(const Frame& F, const Params& p, int l, int u, int h, float Aexp, float dtb, unsigned char* setb, const float* cwl) {
    bf16_t* Qn = (bf16_t*)setb; bf16_t* Kn = Qn + 64 * GP; bf16_t* Vn = Kn + 64 * GP; float* gcv = (float*)(Vn + 64 * GP); float* bet = gcv + 64; float* beg = bet + 64; float* ekd = beg + 64; float* egc = ekd + 64;
    const bf16_t* Z = (const bf16_t*)(KWS() + WS_Z); const float* GAB = (const float*)(KWS() + WS_GAB); float* GL = (float*)(KWS() + WS_GGL);
    const int n = u >> 3, t0 = n * 64, lane = F.lane;
    float ga_pre = 0.f, gb_pre = 0.f; if (F.wave == 4) { const size_t gi = (size_t)(t0 + lane) * 16; ga_pre = GAB[gi + h]; gb_pre = GAB[gi + 8 + h]; }
#pragma unroll 1
    for (int rep = 0; rep < 2; ++rep) { const int it = (F.tid - 256) + 256 * rep, tt = it >> 3, cg = it & 7;
        u32x4 raw[3][4][2];
#pragma unroll
        for (int ten = 0; ten < 3; ++ten)
#pragma unroll
            for (int k = 0; k < 4; ++k) { const int t = t0 + tt - 3 + k;
                if (t >= 0) { const bf16_t* zp = Z + (size_t)t * NZ + ZC_GQ + ten * 1024 + h * 128 + 16 * cg; raw[ten][k][0] = *(const u32x4*)zp; raw[ten][k][1] = *(const u32x4*)(zp + 8); }
                else { raw[ten][k][0] = (u32x4){0u, 0u, 0u, 0u}; raw[ten][k][1] = raw[ten][k][0]; } }
#pragma unroll
        for (int ten = 0; ten < 3; ++ten) { float y[16];
#pragma unroll
            for (int i = 0; i < 16; ++i) y[i] = 0.f;
#pragma unroll
            for (int k = 0; k < 4; ++k) { float x8a[8], x8b[8]; unpack8(raw[ten][k][0], x8a); unpack8(raw[ten][k][1], x8b);
#pragma unroll
                for (int i = 0; i < 8; ++i) { y[i] += cwl[(ten * 4 + k) * 128 + 16 * cg + i] * x8a[i]; y[8 + i] += cwl[(ten * 4 + k) * 128 + 16 * cg + 8 + i] * x8b[i]; } }
            float ss = 0.f;
#pragma unroll
            for (int i = 0; i < 16; ++i) { y[i] = fsilu(y[i]); ss += y[i] * y[i]; }
            float mul = 1.0f;
            if (ten < 2) { ss += __shfl_xor(ss, 1); ss += __shfl_xor(ss, 2); ss += __shfl_xor(ss, 4); mul = (1.0f / sqrtf(ss + EPS)) * (ten == 0 ? 0.08838834764831845f : 1.0f); }
            bf16_t* dst = (ten == 0 ? Qn : (ten == 1 ? Kn : Vn)) + tt * GP + 16 * cg; u32x4 o0, o1;
            o0.x = pk2(y[0] * mul, y[1] * mul); o0.y = pk2(y[2] * mul, y[3] * mul); o0.z = pk2(y[4] * mul, y[5] * mul); o0.w = pk2(y[6] * mul, y[7] * mul);
            o1.x = pk2(y[8] * mul, y[9] * mul); o1.y = pk2(y[10] * mul, y[11] * mul); o1.z = pk2(y[12] * mul, y[13] * mul); o1.w = pk2(y[14] * mul, y[15] * mul);
            *(u32x4*)dst = o0; *(u32x4*)(dst + 8) = o1; }
        asm volatile("" ::: "memory"); }
    if (F.wave == 4) { const float g = -Aexp * softplusf(ga_pre + dtb); const float beta = sigm(gb_pre);
        float gc = g;
#pragma unroll
        for (int o = 1; o < 64; o <<= 1) { const float t = __shfl_up(gc, o); if (lane >= o) gc += t; }
        const float gl = __shfl(gc, 63);
        gcv[lane] = gc; bet[lane] = beta; { const float eg = expf(gc); egc[lane] = eg; beg[lane] = beta * eg; } ekd[lane] = expf(gl - gc);
        if (lane == 0) GL[u] = expf(gl); }
}
__device__ __forceinline__ void gdn_units_a_pipe(const Frame& F, const Params& p, int l) {
    unsigned char* L = F.ldsg; bf16_t* Wl = (bf16_t*)(L + GA_WL); float* Mm = (float*)(L + GA_MM); float* cwl = (float*)(L + GA_CW);
    unsigned char* P2 = KWS() + WS_GP2; float* UP = (float*)(KWS() + WS_GUP);
    const float* cw = KIN(15) + (size_t)l * 4 * 3072;
    const int w = F.wave, lane = F.lane, fr = lane & 15, fg = lane >> 4, h = F.bx & 7;
    const float Aexp = expf(KIN(16)[l * 8 + h]), dtb = KIN(17)[l * 8 + h];
    for (int i = F.tid; i < 1536; i += NTHR) { const int ten = i >> 9, k = (i >> 7) & 3, c = i & 127; cwl[i] = cw[k * 3072 + ten * 1024 + h * 128 + c]; }
    __syncthreads();
    if (w >= 4 && F.bx < 2048) gdn_stage_unit(F, p, l, F.bx, h, Aexp, dtb, L, cwl);
    __syncthreads();
    int prev_u = -1, it = 0;
    for (int u = F.bx; u < 2048; u += F.G, ++it) {
        unsigned char* setb = L + (it & 1) * GA_SET; unsigned char* setn = L + ((it + 1) & 1) * GA_SET;
        const bf16_t* Qn = (const bf16_t*)setb; const bf16_t* Kn = Qn + 64 * GP; const float* gcv = (const float*)(Kn + 2 * 64 * GP); const float* bet = gcv + 64; const float* ekd = gcv + 192; const float* egc = gcv + 256;
        unsigned char* pk = P2 + (size_t)u * GS_PACK_BYTES; unsigned char* pko = KWS() + WS_GPO + (size_t)u * GO_PACK_BYTES;
        if (prev_u >= 0) { unsigned char* pkp = P2 + (size_t)prev_u * GS_PACK_BYTES;
#pragma unroll
            for (int q = 0; q < 2; ++q) { const int f = w * 2 + q, mt = f >> 2, ks = f & 3; *(u32x4*)(pkp + (size_t)f * 1024 + lane * 16) = tile_frag_scaled(Wl, mt, ks, fr, fg, 1.0f); } }
        { const int mt = w >> 1;
#pragma unroll
            for (int q = 0; q < 2; ++q) { const int nt = 2 * (w & 1) + q;
                if (nt <= mt) { f32x4 s = (f32x4){0.f, 0.f, 0.f, 0.f};
#pragma unroll
                    for (int ks = 0; ks < 4; ++ks) { const bf16x8 af = *(const bf16x8*)(Kn + (16 * mt + fr) * GP + 32 * ks + 8 * fg), bf_ = *(const bf16x8*)(Kn + (16 * nt + fr) * GP + 32 * ks + 8 * fg); s = __builtin_amdgcn_mfma_f32_16x16x32_bf16(af, bf_, s, 0, 0, 0); }
                    const int j = 16 * nt + fr; const float gj = gcv[j];
#pragma unroll
                    for (int r = 0; r < 4; ++r) { const int i = 16 * mt + 4 * fg + r; Mm[i * GMP + j] = (i > j) ? bet[i] * s[r] * fexp(gcv[i] - gj) : 0.f; } } } }
        { const int itl = w >> 1, ksA = w & 1; f32x4 s2[2];
#pragma unroll
            for (int q = 0; q < 2; ++q) { const int jt = 2 * ksA + q; s2[q] = (f32x4){0.f, 0.f, 0.f, 0.f};
                if (jt <= itl) {
#pragma unroll
                    for (int ks = 0; ks < 4; ++ks) { const bf16x8 af = *(const bf16x8*)(Kn + (16 * jt + fr) * GP + 32 * ks + 8 * fg), bf_ = *(const bf16x8*)(Qn + (16 * itl + fr) * GP + 32 * ks + 8 * fg); s2[q] = __builtin_amdgcn_mfma_f32_16x16x32_bf16(af, bf_, s2[q], 0, 0, 0); }
                    const int i = 16 * itl + fr; const float gi = gcv[i];
#pragma unroll
                    for (int r = 0; r < 4; ++r) { const int j = 16 * jt + 4 * fg + r; s2[q][r] = (i >= j) ? s2[q][r] * fexp(gi - gcv[j]) : 0.f; } } }
            *(bf16x8*)(pko + (size_t)(16 + itl * 2 + ksA) * 1024 + lane * 16) = pack_acc2(s2[0], s2[1]); }
#pragma unroll
        for (int q = 0; q < 2; ++q) { const int f = w * 2 + q, mt = f >> 2, ks = f & 3;
            *(u32x4*)(pko + (size_t)f * 1024 + lane * 16) = tile_frag_scaled(Qn, mt, ks, fr, fg, egc[16 * mt + fr]); }
#pragma unroll
        for (int q = 0; q < 2; ++q) { const int f = w * 2 + q, mt = f >> 1, ks = f & 1; float v[8];
#pragma unroll
            for (int jj = 0; jj < 8; ++jj) { const int tk = 32 * ks + 16 * (jj >> 2) + 4 * fg + (jj & 3); v[jj] = bf2f(Kn[tk * GP + 16 * mt + fr]) * ekd[tk]; }
            u32x4 o; o.x = pk2(v[0], v[1]); o.y = pk2(v[2], v[3]); o.z = pk2(v[4], v[5]); o.w = pk2(v[6], v[7]);
            *(u32x4*)(pk + (size_t)(16 + f) * 1024 + lane * 16) = o; }
        __syncthreads();
        if (w < 4) { const int c = F.tid; float sol[64];
#pragma unroll
            for (int i = 0; i < 64; ++i) sol[i] = 0.f;
            LAS const bf16_t* colp = (LAS const bf16_t*)(F.lds + (it & 1) * GA_SET) + ((c < 128) ? (2 * 64 * GP + c) : (64 * GP + (c - 128))); asm volatile("" : "+v"(colp));
            LAS const float* mm = (LAS const float*)(F.lds + GA_MM); asm volatile("" : "+v"(mm));
            LAS const float* tb = (LAS const float*)(F.lds + (it & 1) * GA_SET + 3 * 64 * GP * 2) + ((c < 128) ? 64 : 128); asm volatile("" : "+v"(tb));
#pragma unroll
            for (int i = 0; i < 64; ++i) { float a = bf2f(colp[i * GP]) * tb[i];
#pragma unroll
                for (int jb = 0; jb < (i + 3) / 4; ++jb) { const f32x4 m4 = *(LAS const f32x4*)(mm + i * GMP + 4 * jb);
                    a -= m4[0] * sol[4 * jb]; a -= m4[1] * sol[4 * jb + 1]; a -= m4[2] * sol[4 * jb + 2]; a -= m4[3] * sol[4 * jb + 3];
                    if ((jb & 3) == 3) asm volatile("" ::: "memory"); }
                sol[i] = a; asm volatile("" ::: "memory"); }
            if (c < 128) { float* up = UP + (size_t)u * 8192 + (size_t)(c >> 4) * 1024;
#pragma unroll
                for (int t = 0; t < 4; ++t)
#pragma unroll
                    for (int G = 0; G < 4; ++G) *(f32x4*)(up + (t * 64 + (c & 15) + 16 * G) * 4) = (f32x4){sol[16 * t + 4 * G], sol[16 * t + 4 * G + 1], sol[16 * t + 4 * G + 2], sol[16 * t + 4 * G + 3]}; }
            else { const int d = c - 128;
#pragma unroll
                for (int i = 0; i < 64; ++i) Wl[i * GP + d] = (bf16_t)f2bf(-sol[i]); }
        } else if (u + F.G < 2048) gdn_stage_unit(F, p, l, u + F.G, h, Aexp, dtb, setn, cwl);
        __syncthreads();
        prev_u = u;
    }
    if (prev_u >= 0) { unsigned char* pkp = P2 + (size_t)prev_u * GS_PACK_BYTES;
#pragma unroll
        for (int q = 0; q < 2; ++q) { const int f = w * 2 + q, mt = f >> 2, ks = f & 3; *(u32x4*)(pkp + (size_t)f * 1024 + lane * 16) = tile_frag_scaled(Wl, mt, ks, fr, fg, 1.0f); } }
    __syncthreads();
}

constexpr int GS_Q = 8192, GS_NQ = 19;
static_assert(GS_NQ * GS_Q <= LDS_MISC, "scan ring");
__device__ __forceinline__ void gdn_scan(const Frame& F, int b) {
    const int h = b >> 1, w = F.wave, lane = F.lane; const int slice = (b & 1) * 4 + (w & 3); const bool comp = w < 4;
    const unsigned char* P2 = KWS() + WS_GP2; const float* UP = (const float*)(KWS() + WS_GUP); const float* GL = (const float*)(KWS() + WS_GGL); unsigned char* SV = KWS() + WS_GSV;
    f32x4 S[8];
#pragma unroll
    for (int i = 0; i < 8; ++i) S[i] = (f32x4){0.f, 0.f, 0.f, 0.f};
    if (!comp) {
#pragma unroll
        for (int q = 0; q < 15; ++q) { const unsigned char* src = P2 + (size_t)((q >> 2) * 8 + h) * GS_PACK_BYTES + (q & 3) * GS_Q;
#pragma unroll
            for (int i = 0; i < 2; ++i) { const int f = (w - 4) + 4 * i; __builtin_amdgcn_global_load_lds((const unsigned*)(src + f * 1024 + lane * 16), (LAS unsigned*)(F.lds + q * GS_Q + f * 1024), 16, 0, 0); } }
        asm volatile("s_waitcnt vmcnt(22)" ::: "memory"); }
    f32x4 ua[4], ub[4]; float gla = 0.f, glb = 0.f;
#pragma unroll
    for (int t = 0; t < 4; ++t) { ua[t] = (f32x4){0.f, 0.f, 0.f, 0.f}; ub[t] = ua[t]; }
    if (comp) {
#pragma unroll
        for (int t = 0; t < 4; ++t) { ua[t] = *(const f32x4*)(UP + (size_t)h * 8192 + slice * 1024 + (t * 64 + lane) * 4); ub[t] = *(const f32x4*)(UP + (size_t)(8 + h) * 8192 + slice * 1024 + (t * 64 + lane) * 4); }
        gla = GL[h]; glb = GL[8 + h]; }
    __syncthreads();
    int hq = 0;
#define GS_WRAP(x) (((x) >= GS_NQ) ? (x) - GS_NQ : (x))
    for (int n = 0; n < 256; ++n) {
        const int unit = n * 8 + h; const int e1 = GS_WRAP(hq + 1), e2 = GS_WRAP(hq + 2), e3 = GS_WRAP(hq + 3);
        const LAS unsigned char* bW0 = F.lds + hq * GS_Q; const LAS unsigned char* bW1 = F.lds + e1 * GS_Q; const LAS unsigned char* bK0 = F.lds + e2 * GS_Q; const LAS unsigned char* bK1 = F.lds + e3 * GS_Q;
        if (!comp) {
            if (n + 3 < 256) { const int e = GS_WRAP(hq + 15); const unsigned char* src = P2 + (size_t)(unit + 24) * GS_PACK_BYTES + 3 * GS_Q;
#pragma unroll
                for (int i = 0; i < 2; ++i) { const int f = (w - 4) + 4 * i; __builtin_amdgcn_global_load_lds((const unsigned*)(src + f * 1024 + lane * 16), (LAS unsigned*)(F.lds + e * GS_Q + f * 1024), 16, 0, 0); } }
            if (n + 4 < 256) {
#pragma unroll
                for (int j = 0; j < 3; ++j) { const int e = GS_WRAP(hq + 16 + j); const unsigned char* src = P2 + (size_t)(unit + 32) * GS_PACK_BYTES + j * GS_Q;
#pragma unroll
                    for (int i = 0; i < 2; ++i) { const int f = (w - 4) + 4 * i; __builtin_amdgcn_global_load_lds((const unsigned*)(src + f * 1024 + lane * 16), (LAS unsigned*)(F.lds + e * GS_Q + f * 1024), 16, 0, 0); } }
                asm volatile("s_waitcnt vmcnt(22)" ::: "memory"); }
            else asm volatile("s_waitcnt vmcnt(0)" ::: "memory");
        } else {
            f32x4 vn[4];
#pragma unroll
            for (int t = 0; t < 4; ++t) { vn[t] = ua[t]; ua[t] = ub[t]; }
            const float gl = gla; gla = glb;
            if (n + 2 < 256) {
#pragma unroll
                for (int t = 0; t < 4; ++t) ub[t] = *(const f32x4*)(UP + (size_t)(unit + 16) * 8192 + slice * 1024 + (t * 64 + lane) * 4);
                glb = GL[unit + 16]; }
            bf16x8* svp = (bf16x8*)(SV + ((size_t)(unit * 8 + slice) * 6) * 1024 + lane * 16);
            bf16x8 Sb[4];
#pragma unroll
            for (int ks = 0; ks < 4; ++ks) { Sb[ks] = pack_acc2(S[2 * ks], S[2 * ks + 1]); svp[ks * 64] = Sb[ks]; }
#pragma unroll
            for (int t = 0; t < 4; ++t)
#pragma unroll
                for (int ks = 0; ks < 4; ++ks) vn[t] = __builtin_amdgcn_mfma_f32_16x16x32_bf16(*(const LAS bf16x8*)((t < 2 ? bW0 : bW1) + ((t & 1) * 4 + ks) * 1024 + lane * 16), Sb[ks], vn[t], 0, 0, 0);
            bf16x8 vb[2];
#pragma unroll
            for (int ks = 0; ks < 2; ++ks) { vb[ks] = pack_acc2(vn[2 * ks], vn[2 * ks + 1]); svp[(4 + ks) * 64] = vb[ks]; }
#pragma unroll
            for (int dt = 0; dt < 8; ++dt) { S[dt] = S[dt] * gl;
#pragma unroll
                for (int ks = 0; ks < 2; ++ks) S[dt] = __builtin_amdgcn_mfma_f32_16x16x32_bf16(*(const LAS bf16x8*)((dt < 4 ? bK0 : bK1) + ((dt & 3) * 2 + ks) * 1024 + lane * 16), vb[ks], S[dt], 0, 0, 0); }
        }
        __syncthreads();
        hq += 4; if (hq >= GS_NQ) hq -= GS_NQ;
    }
#undef GS_WRAP
}
constexpr int GO_PITCH = 132;
__device__ __forceinline__ void gdn_output(const Frame& F, const Params& p, int l) {
    float* Ot = (float*)F.ldsg;
    const unsigned char* PO = KWS() + WS_GPO; const unsigned char* SV = KWS() + WS_GSV; const bf16_t* Z = (const bf16_t*)(KWS() + WS_Z); bf16_t* Y = (bf16_t*)(KWS() + WS_Y); const float* ng = KIN(18) + l * 128;
    const int w = F.wave, lane = F.lane, fr = lane & 15, fg = lane >> 4;
    const int tt = F.tid >> 3, cg = F.tid & 7; float gn[16];
#pragma unroll
    for (int i = 0; i < 16; ++i) gn[i] = ng[16 * cg + i];
    for (int u = F.bx; u < 2048; u += F.G) {
        const int h = u & 7, n = u >> 3;
        const bf16x8* svp = (const bf16x8*)(SV + ((size_t)(u * 8 + w) * 6) * 1024 + lane * 16); const bf16x8* pop = (const bf16x8*)(PO + (size_t)u * GO_PACK_BYTES + lane * 16);
        const u32x4 gzp0 = *(const u32x4*)(Z + (size_t)(n * 64 + tt) * NZ + ZC_GZ + h * 128 + 16 * cg), gzp1 = *(const u32x4*)(Z + (size_t)(n * 64 + tt) * NZ + ZC_GZ + h * 128 + 16 * cg + 8);
        bf16x8 Sb[4], vb[2];
#pragma unroll
        for (int ks = 0; ks < 4; ++ks) Sb[ks] = svp[ks * 64];
#pragma unroll
        for (int ks = 0; ks < 2; ++ks) vb[ks] = svp[(4 + ks) * 64];
#pragma unroll
        for (int t = 0; t < 4; ++t) { f32x4 o = (f32x4){0.f, 0.f, 0.f, 0.f};
#pragma unroll
            for (int ks = 0; ks < 4; ++ks) o = __builtin_amdgcn_mfma_f32_16x16x32_bf16(pop[(t * 4 + ks) * 64], Sb[ks], o, 0, 0, 0);
#pragma unroll
            for (int ks = 0; ks < 2; ++ks) o = __builtin_amdgcn_mfma_f32_16x16x32_bf16(pop[(16 + t * 2 + ks) * 64], vb[ks], o, 0, 0, 0);
#pragma unroll
            for (int r = 0; r < 4; ++r) Ot[(16 * t + 4 * fg + r) * GO_PITCH + 16 * w + fr] = o[r]; }
        __syncthreads();
        { const size_t tg = (size_t)(n * 64 + tt); float o[16], g[8], g2[8]; float ss = 0.f;
#pragma unroll
            for (int i = 0; i < 4; ++i) { const f32x4 v = *(const f32x4*)(Ot + tt * GO_PITCH + 16 * cg + 4 * i); o[4 * i] = v[0]; o[4 * i + 1] = v[1]; o[4 * i + 2] = v[2]; o[4 * i + 3] = v[3]; }
#pragma unroll
            for (int i = 0; i < 16; ++i) ss += o[i] * o[i];
            ss += __shfl_xor(ss, 1); ss += __shfl_xor(ss, 2); ss += __shfl_xor(ss, 4);
            const float rstd = 1.0f / sqrtf(ss * (1.0f / 128.0f) + EPS);
            unpack8(gzp0, g); unpack8(gzp1, g2);
            float y[16];
#pragma unroll
            for (int i = 0; i < 8; ++i) { y[i] = o[i] * rstd * gn[i] * fsilu(g[i]); y[8 + i] = o[8 + i] * rstd * gn[8 + i] * fsilu(g2[i]); }
            u32x4 o0, o1; o0.x = pk2(y[0], y[1]); o0.y = pk2(y[2], y[3]); o0.z = pk2(y[4], y[5]); o0.w = pk2(y[6], y[7]); o1.x = pk2(y[8], y[9]); o1.y = pk2(y[10], y[11]); o1.z = pk2(y[12], y[13]); o1.w = pk2(y[14], y[15]);
            bf16_t* yp = Y + tg * 3072 + 2048 + h * 128 + 16 * cg; *(u32x4*)yp = o0; *(u32x4*)(yp + 8) = o1; }
        __syncthreads();
    }
}

__device__ __forceinline__ void seq_retention(const Frame& F, const Params& p, int h) {
    float* sq = (float*)F.ldsg; float* sk = sq + 128; float* red = sk + 128;
    const bf16_t* Z = (const bf16_t*)(KWS() + WS_Z); bf16_t* Y = (bf16_t*)(KWS() + WS_Y); const int* pos = (const int*)KIN(2);
    const int c = F.tid & 127; const bool act = F.tid < 128, rot = F.tid < 64;
    float R[128];
#pragma unroll
    for (int d = 0; d < 128; ++d) R[d] = 0.f;
    const float gamma = 1.0f - exp2f(-5.0f - (float)h);
    const float invf = (float)exp2(-(double)(F.tid & 63) * (13.287712379549449 / 64.0));
    unsigned short nq1 = 0, nq2 = 0, nk1 = 0, nk2 = 0, nv = 0, ng = 0; int npos = 0;
    if (rot) { nq1 = Z[ZC_RQ + h * 128 + F.tid]; nq2 = Z[ZC_RQ + h * 128 + 64 + F.tid]; nk1 = Z[ZC_RK + h * 128 + F.tid]; nk2 = Z[ZC_RK + h * 128 + 64 + F.tid]; npos = pos[0]; }
    if (act) { nv = Z[ZC_RV + h * 128 + c]; ng = Z[ZC_RG + h * 128 + c]; }
    for (int t = 0; t < S_; ++t) {
        const unsigned short q1 = nq1, q2 = nq2, k1 = nk1, k2 = nk2, vv = nv, gg = ng; const int ps = npos;
        if (t + 1 < S_) { const size_t zo = (size_t)(t + 1) * NZ;
            if (rot) { nq1 = Z[zo + ZC_RQ + h * 128 + F.tid]; nq2 = Z[zo + ZC_RQ + h * 128 + 64 + F.tid]; nk1 = Z[zo + ZC_RK + h * 128 + F.tid]; nk2 = Z[zo + ZC_RK + h * 128 + 64 + F.tid]; npos = pos[t + 1]; }
            if (act) { nv = Z[zo + ZC_RV + h * 128 + c]; ng = Z[zo + ZC_RG + h * 128 + c]; } }
        if (rot) { const float angf = (float)ps * invf; const double ad = (double)angf; const double nn = rint(ad * 0.15915494309189535); const float rr = (float)(ad - nn * 6.283185307179586);
            const float cs = cosf(rr), sn = sinf(rr); const float a1 = bf2f(q1), a2 = bf2f(q2), b1 = bf2f(k1), b2 = bf2f(k2);
            sq[F.tid] = a1 * cs - a2 * sn; sq[F.tid + 64] = a2 * cs + a1 * sn;
            sk[F.tid] = (b1 * cs - b2 * sn) * 0.08838834764831845f; sk[F.tid + 64] = (b2 * cs + b1 * sn) * 0.08838834764831845f; }
        __syncthreads();
        float o = 0.f;
        if (act) { const float v = bf2f(vv);
#pragma unroll
            for (int d0 = 0; d0 < 128; d0 += 16) {
#pragma unroll
                for (int d = d0; d < d0 + 16; ++d) { R[d] = gamma * R[d] + sk[d] * v; o += sq[d] * R[d]; }
                asm volatile("" ::: "memory"); }
            const float ss = wave_sum(o * o); if (F.lane == 0) red[F.wave] = ss; }
        __syncthreads();
        if (act) { const float ms = (red[0] + red[1]) * (1.0f / 128.0f); const float y = o * (1.0f / sqrtf(ms + EPS)) * siluf(bf2f(gg)); Y[(size_t)t * 3072 + h * 128 + c] = (bf16_t)f2bf(y); }
    }
}
__device__ __forceinline__ void seq_gdn(const Frame& F, const Params& p, int l, int h) {
    float* sq = (float*)F.ldsg; float* sk = sq + 128; float* red = sk + 128; float* red2 = red + 8;
    const bf16_t* Z = (const bf16_t*)(KWS() + WS_Z); bf16_t* Y = (bf16_t*)(KWS() + WS_Y); const float* GAB = (const float*)(KWS() + WS_GAB);
    const int c = F.tid & 127; const bool act = F.tid < 128;
    float St[128];
#pragma unroll
    for (int d = 0; d < 128; ++d) St[d] = 0.f;
    const float* cw = KIN(15) + (size_t)l * 4 * 3072;
    float wq[4], wk[4], wv[4];
#pragma unroll
    for (int k = 0; k < 4; ++k) { wq[k] = cw[k * 3072 + h * 128 + c]; wk[k] = cw[k * 3072 + 1024 + h * 128 + c]; wv[k] = cw[k * 3072 + 2048 + h * 128 + c]; }
    const float Aexp = expf(KIN(16)[l * 8 + h]), dtb = KIN(17)[l * 8 + h], ngain = KIN(18)[l * 128 + c];
    float xq1 = 0, xq2 = 0, xq3 = 0, xk1 = 0, xk2 = 0, xk3 = 0, xv1 = 0, xv2 = 0, xv3 = 0;
    unsigned short nq = 0, nk = 0, nv = 0, nz = 0; float nga = 0.f, ngb = 0.f;
    if (act) { nq = Z[ZC_GQ + h * 128 + c]; nk = Z[ZC_GK + h * 128 + c]; nv = Z[ZC_GV + h * 128 + c]; nz = Z[ZC_GZ + h * 128 + c]; nga = GAB[h]; ngb = GAB[8 + h]; }
    for (int t = 0; t < S_; ++t) {
        const float rq = bf2f(nq), rk = bf2f(nk), rv = bf2f(nv), gz = bf2f(nz), ga = nga, gb = ngb;
        if (act && t + 1 < S_) { const size_t zo = (size_t)(t + 1) * NZ; nq = Z[zo + ZC_GQ + h * 128 + c]; nk = Z[zo + ZC_GK + h * 128 + c]; nv = Z[zo + ZC_GV + h * 128 + c]; nz = Z[zo + ZC_GZ + h * 128 + c];
            nga = GAB[(size_t)(t + 1) * 16 + h]; ngb = GAB[(size_t)(t + 1) * 16 + 8 + h]; }
        float q = 0.f, k = 0.f, v = 0.f;
        if (act) { const float cq = wq[0] * xq3 + wq[1] * xq2 + wq[2] * xq1 + wq[3] * rq, ck = wk[0] * xk3 + wk[1] * xk2 + wk[2] * xk1 + wk[3] * rk, cv = wv[0] * xv3 + wv[1] * xv2 + wv[2] * xv1 + wv[3] * rv;
            xq3 = xq2; xq2 = xq1; xq1 = rq; xk3 = xk2; xk2 = xk1; xk1 = rk; xv3 = xv2; xv2 = xv1; xv1 = rv;
            q = siluf(cq); k = siluf(ck); v = siluf(cv);
            const float s1 = wave_sum(q * q), s2 = wave_sum(k * k); if (F.lane == 0) { red[F.wave] = s1; red[2 + F.wave] = s2; } }
        __syncthreads();
        if (act) { sq[c] = q * (1.0f / sqrtf(red[0] + red[1] + EPS)) * 0.08838834764831845f; sk[c] = k * (1.0f / sqrtf(red[2] + red[3] + EPS)); }
        __syncthreads();
        float o = 0.f;
        if (act) { const float g = -Aexp * softplusf(ga + dtb), e = expf(g), beta = sigm(gb);
            float dot = 0.f;
#pragma unroll
            for (int d0 = 0; d0 < 128; d0 += 16) {
#pragma unroll
                for (int d = d0; d < d0 + 16; ++d) dot += sk[d] * St[d];
                asm volatile("" ::: "memory"); }
            const float coef = beta * (v - e * dot);
#pragma unroll
            for (int d0 = 0; d0 < 128; d0 += 16) {
#pragma unroll
                for (int d = d0; d < d0 + 16; ++d) { St[d] = e * St[d] + sk[d] * coef; o += sq[d] * St[d]; }
                asm volatile("" ::: "memory"); }
            const float ss = wave_sum(o * o); if (F.lane == 0) red2[F.wave] = ss; }
        __syncthreads();
        if (act) { const float ms = (red2[0] + red2[1]) * (1.0f / 128.0f); const float y = o * (1.0f / sqrtf(ms + EPS)) * ngain * siluf(gz); Y[(size_t)t * 3072 + 2048 + h * 128 + c] = (bf16_t)f2bf(y); }
    }
}
__device__ __forceinline__ void seq_lru(const Frame& F, const Params& p, int part) {
    const bf16_t* Z = (const bf16_t*)(KWS() + WS_Z); bf16_t* Y = (bf16_t*)(KWS() + WS_Y); const float* LA = (const float*)(KWS() + WS_MF); const float* LB = LA + (size_t)S_ * 1024;
    const int ch = part * 512 + F.tid; float h = 0.f;
    for (int t0 = 0; t0 < S_; t0 += 8) { float a[8], b[8]; unsigned short g[8];
#pragma unroll
        for (int i = 0; i < 8; ++i) { a[i] = LA[(size_t)(t0 + i) * 1024 + ch]; b[i] = LB[(size_t)(t0 + i) * 1024 + ch]; g[i] = Z[(size_t)(t0 + i) * NZ + ZC_LG + ch]; }
#pragma unroll
        for (int i = 0; i < 8; ++i) { h = a[i] * h + b[i]; Y[(size_t)(t0 + i) * 3072 + 1024 + ch] = (bf16_t)f2bf(h * gelu_tanh(bf2f(g[i]))); } }
}

__device__ __forceinline__ void phase_seq(const Frame& F, const Params& p, int l) {
#if DBG_NOSEQ
    { u32x4* yy = (u32x4*)(KWS() + WS_Y); for (size_t i = (size_t)F.bx * NTHR + F.tid; i < (size_t)S_ * 3072 / 8; i += (size_t)F.G * NTHR) yy[i] = (u32x4){0u, 0u, 0u, 0u}; }
#else
    if (F.bx < 16) { gdn_scan(F, ((F.bx & 7) << 1) | (F.bx >> 3)); return; }
    const int wg = F.bx - 16, nwg = F.G - 16; unsigned* ctl = (unsigned*)(KWS() + WS_CTL); unsigned* cnt = ctl + CW_SUB + 64 * l; unsigned* tmo = ctl + CW_BAR + XB_TMO;
    const int rwg = (wg + nwg - (2048 % nwg)) % nwg;
    lru_units<false>(F, p, l, wg, nwg); __syncthreads(); ret_units_a(F, rwg, nwg);
    sub_barrier(cnt, (unsigned)nwg, tmo);
    if (wg < 2) lru_carry(F, wg); else ret_scan(F, wg - 2, nwg - 2);
    sub_barrier(cnt, 2u * (unsigned)nwg, tmo);
    lru_units<true>(F, p, l, wg, nwg); __syncthreads(); ret_units_c(F, rwg, nwg);
#endif
}

#define LAYER(l) do { \
const int pb = PH_L0 + l * PH_PER_LAYER; \
        if (EN(0) && IN(pb + 0)) { const Frame F = make_frame(); phase_convert(F, p, l); phase_norm1_gab(F, p, l, l > 0 && !DBG_NOMOE); __syncthreads(); } \
        SEAM(pb + 0); \
        if (EN(1) && IN(pb + 1)) { const Frame F = make_frame(); pg8::Gemm g{(const bf16_t*)(KWS() + WS_H), (const bf16_t*)(KWS() + WS_WIN), 2048, 2048, 2048}; SchedStatic sc{64, 64, F.G, F.bx}; \
            EpiZL E{(bf16_t*)(KWS() + WS_Z)}; pg8::gemm_phase(F.lds, g, sc, E); } \
        SEAM(pb + 1); \
        if (EN(2) && IN(pb + 2)) { const Frame F = make_frame(); if ((F.G & 7) == 0) gdn_units_a_pipe(F, p, l); else gdn_units_a(F, p, l); } \
        SEAM(pb + 2); \
        if (EN(3) && IN(pb + 3)) { const Frame F = make_frame(); \
            phase_seq(F, p, l); \
        } \
        SEAM(pb + 3); \
        if (EN(4) && IN(pb + 4)) { const Frame F = make_frame(); gdn_output(F, p, l); } \
        SEAM(pb + 4); \
        if (EN(5) && IN(pb + 5)) { const Frame F = make_frame(); pg8::Gemm g{(const bf16_t*)(KWS() + WS_Y), (const bf16_t*)(KWS() + WS_BP), 3072, 1024, 1024}; SchedMerge sc{F.G, F.bx}; \
            EpiMerge E{(const bf16_t*)(KWS() + WS_Z), (bf16_t*)(KWS() + WS_H)}; pg8::gemm_phase(F.lds, g, sc, E); } \
        SEAM(pb + 5); \
        if (EN(6) && IN(pb + 6)) { const Frame F = make_frame(); pg8::Gemm g{(const bf16_t*)(KWS() + WS_H), (const bf16_t*)(KWS() + WS_WO), 2048, 2048, 2048}; SchedStatic sc{64, 8, F.G, F.bx}; \
            EpiWout E{l == 0 ? KIN(0) : KOUT(), KOUT(), (const float*)(KWS() + WS_MODV) + l * 12288 + MO_GT1}; pg8::gemm_phase(F.lds, g, sc, E); } \
        SEAM(pb + 6); \
        if (!DBG_NOMOE && EN(7) && IN(pb + 7)) { const Frame F = make_frame(); if ((S_ % (F.G * NWAVES * 4)) == 0) phase_norm2_router_lds(F, p, l); else phase_norm2_router(F, p, l); __syncthreads(); } \
        SEAM(pb + 7); \
        if (!DBG_NOMOE && EN(8) && IN(pb + 8)) { const Frame F = make_frame(); phase_gather(F, p, l); } \
        SEAM(pb + 8); \
        if (!DBG_NOMOE && EN(9) && IN(pb + 9)) { const Frame F = make_frame(); moe_tables_load(F, p); unsigned* mq = (unsigned*)(KWS() + WS_CTL) + CW_MOEQ + l * 16384; \
            { pg8::Gemm g{(const bf16_t*)(KWS() + WS_H), (const bf16_t*)(KWS() + WS_W13), 2048, 2048, 2048}; SchedMoe<true> sc{(const int*)(KWS() + WS_TOK + 512 * 1024), F.G, F.bx, 4, (const LAS int*)(F.lds + LDS_MISC + 64)}; \
              EpiW13 E{(bf16_t*)(KWS() + WS_HID), mq}; pg8::gemm_phase(F.lds, g, sc, E); } \
            { volatile LAS int* slot = (volatile LAS int*)(F.lds + LDS_MISC + 32); \
              if (F.tid == 0) { const int q0 = (int)xb_add(mq, 1u), q1 = (int)xb_add(mq, 1u); slot[0] = q0; slot[1] = q1; slot[2] = 2; slot[4] = 0; } __syncthreads(); \
              pg8::Gemm g{(const bf16_t*)(KWS() + WS_HID), (const bf16_t*)(KWS() + WS_W2), 512, 512, 512}; SchedMoeDyn sc{8, (const LAS int*)(F.lds + LDS_MISC + 64), slot, mq, (unsigned*)(KWS() + WS_CTL) + CW_BAR + XB_TMO}; \
              EpiW2L E{(bf16_t*)(KWS() + WS_SLOT), (const u32x2*)(KWS() + WS_ROWINFO), (const LAS int*)(F.lds + LDS_MISC + 64), mq, slot, mq}; pg8::gemm_phase(F.lds, g, sc, E); } } \
        SEAM(pb + 10); \
    } while (0)
template <unsigned PMASK, bool ALL>
__global__ void __launch_bounds__(NTHR, 2) fwd(Params p) {
    Frame F = make_frame();
    if (F.tid < 4) ((LAS unsigned*)(F.lds + LDS_MISC))[F.tid] = 0u;
    __syncthreads();
    unsigned* ctl = (unsigned*)(KWS() + WS_CTL);
    XcdBarrier bar; bar.bar = ctl + CW_BAR; bar.x = 0; bar.st = nullptr;
    const int lo = p.ph_lo, hi = p.ph_hi;
    const bool multi = ALL || (hi - lo) > 1;
    if (multi) bar = xcd_barrier_post(ctl + CW_BAR, (volatile LAS unsigned*)(F.lds + LDS_MISC));
#define IN(k) (ALL || (lo <= (k) && (k) < hi))
#define EN(b) ((PMASK >> (b)) & 1u)
#define SEAM(k) do { if (IN(k) && IN((k) + 1)) xcd_barrier(bar); } while (0)

    if (EN(11) && IN(PH_MOD)) { const Frame F = make_frame(); phase_mod(F, p); phase_rope_table(F); phase_gabw(F); }
    SEAM(PH_MOD);
    LAYER(0);
    LAYER(1);
    if (EN(12) && IN(PH_FINAL)) { const Frame F = make_frame(); phase_norm<2>(F, p, 0, !DBG_NOMOE); }
#undef IN
#undef SEAM
}

typedef void (*KernelFn)(Params);
static int phase_bit(int ph) { if (ph == PH_MOD) return 11; if (ph == PH_FINAL) return 12; return (ph - PH_L0) % PH_PER_LAYER; }
extern "C" void kernel_launch(void* const* d_in, const int* in_sizes, int n_in, void* d_out, int out_size, void* d_ws, size_t ws_size, hipStream_t stream) {
    static int grid = 0;
#if ONE_LAUNCH
    static KernelFn fns[1] = { fwd<0x1FFFu, true> };
    constexpr int NFN = 1;
#else
    static KernelFn fns[13] = { fwd<0x001u, false>, fwd<0x002u, false>, fwd<0x004u, false>, fwd<0x008u, false>, fwd<0x010u, false>, fwd<0x020u, false>, fwd<0x040u, false>, fwd<0x080u, false>, fwd<0x100u, false>, fwd<0x200u, false>, fwd<0x400u, false>, fwd<0x800u, false>, fwd<0x1000u, false> };
    constexpr int NFN = 13;
#endif
    if (grid == 0) {
        if (n_in != 29 || out_size != S_ * D_ || ws_size < WS_END) { fprintf(stderr, "kernel_launch: unexpected shapes (n_in %d out %d ws %zu)\n", n_in, out_size, ws_size); grid = -1; return; }
        int dev = 0, cus = 0, per_cu = 0;
        if (hipGetDevice(&dev) != hipSuccess || hipDeviceGetAttribute(&cus, hipDeviceAttributeMultiprocessorCount, dev) != hipSuccess) { grid = -1; return; }
        for (int i = 0; i < NFN; ++i) {
            if (hipFuncSetAttribute((const void*)fns[i], hipFuncAttributeMaxDynamicSharedMemorySize, LDS_BYTES) != hipSuccess) { fprintf(stderr, "kernel_launch: hipFuncSetAttribute failed\n"); grid = -1; return; }
            if (hipOccupancyMaxActiveBlocksPerMultiprocessor(&per_cu, (const void*)fns[i], NTHR, LDS_BYTES) != hipSuccess || per_cu < 1) fprintf(stderr, "kernel_launch: occupancy query says %d for fn %d\n", per_cu, i);
        }
        (void)hipGetLastError();
        grid = cus > 0 ? cus : 256;
    }
    if (grid < 0) return;
    (void)hipMemsetAsync((char*)d_ws + WS_CTL, 0, CTL_BYTES, stream);
    Params p{};
    for (int i = 0; i < 29; ++i) p.in[i] = (const float*)d_in[i];
    p.out = (float*)d_out; p.ws = (unsigned char*)d_ws;
#if ONE_LAUNCH
    p.ph_lo = 0; p.ph_hi = NPH;
    { void* args[] = {&p}; (void)hipLaunchKernel((const void*)fns[0], dim3(grid), dim3(NTHR), args, LDS_BYTES, stream); }
#else
    for (int ph = 0; ph < NPH; ++ph) { p.ph_lo = ph; p.ph_hi = ph + 1; void* args[] = {&p}; (void)hipLaunchKernel((const void*)fns[phase_bit(ph)], dim3(grid), dim3(NTHR), args, LDS_BYTES, stream); }
#endif
}
```

```cpp
#include <hip/hip_runtime.h>
#include <cstdio>
#include <cstdint>

#ifndef ONE_LAUNCH
#define ONE_LAUNCH 1
#endif
#ifndef DBG_NOSEQ
#define DBG_NOSEQ 0
#endif
#ifndef DBG_NOMOE
#define DBG_NOMOE 0
#endif
#ifndef DBG_NOMIX
#define DBG_NOMIX 0
#endif
#ifndef DBG_MOE_SCALE
#define DBG_MOE_SCALE 1.0f
#endif
#ifndef DBG_M
#define DBG_M 0
#endif
#ifndef DBG_ZERO_BR
#define DBG_ZERO_BR 0
#endif

#define LAS __attribute__((address_space(3)))
typedef unsigned short bf16_t;
typedef short bf16x8 __attribute__((ext_vector_type(8)));
typedef float f32x4 __attribute__((ext_vector_type(4)));
typedef float f32x2 __attribute__((ext_vector_type(2)));
typedef unsigned u32x4 __attribute__((ext_vector_type(4)));
typedef unsigned u32x2 __attribute__((ext_vector_type(2)));

constexpr int S_ = 16384, D_ = 2048, NL = 2;
constexpr int NZ = 16384;
constexpr int NZP = 16640;
constexpr int INC = 16400;
constexpr int NWAVES = 8, NTHR = 512;
constexpr float EPS = 1e-6f;
constexpr int ZC_RQ = 0, ZC_RK = 1024, ZC_RV = 2048, ZC_RG = 3072, ZC_LX = 4096, ZC_LG = 5120, ZC_GQ = 6144, ZC_GK = 7168, ZC_GV = 8192, ZC_GZ = 9216, ZC_BR = 10240;
constexpr int MO_SH1 = 0, MO_SC1 = 2048, MO_GT1 = 4096, MO_SH2 = 6144, MO_SC2 = 8192, MO_GT2 = 10240;

constexpr size_t MiB = 1u << 20;
constexpr size_t WS_CTL = 0, CTL_BYTES = 1 * MiB;
constexpr size_t WS_MODV = 1 * MiB;
constexpr size_t WS_RTW = 2 * MiB;
constexpr size_t WS_GAB = 3 * MiB;
constexpr size_t WS_GABW = 2 * MiB + 512 * 1024;
constexpr size_t WS_ROWINFO = 4 * MiB;
constexpr size_t WS_TOK = 5 * MiB;
constexpr size_t WS_WIN = 8 * MiB;
constexpr size_t WS_BP = 73 * MiB;
constexpr size_t WS_WO = 85 * MiB;
constexpr size_t WS_W13 = 93 * MiB;
constexpr size_t WS_W2 = 221 * MiB;
constexpr size_t WS_H = 285 * MiB;
constexpr size_t WS_Y = 349 * MiB;
constexpr size_t WS_MF = 445 * MiB;
constexpr size_t WS_Z = 573 * MiB;
constexpr size_t WS_XB = WS_Z;
constexpr size_t WS_HID = WS_Z + 160 * MiB;
constexpr size_t WS_SLOT = WS_Z + 200 * MiB;
constexpr size_t WS_LWT = 1085 * MiB;
constexpr size_t WS_LPH = 1086 * MiB;
constexpr size_t WS_LCARRY = 1088 * MiB;
constexpr size_t WS_ROPE_C = 1089 * MiB;
constexpr size_t WS_ROPE_S = 1093 * MiB;
constexpr size_t WS_KV = 1100 * MiB;
constexpr size_t WS_GP2 = 1164 * MiB;
constexpr size_t WS_GPO = WS_GP2 + 64 * MiB;
constexpr size_t WS_GSV = 445 * MiB;
constexpr size_t WS_GUP = 1276 * MiB;
constexpr size_t WS_GGL = 1340 * MiB;
constexpr size_t WS_GO = 1341 * MiB;
constexpr size_t WS_END = 1373 * MiB;
constexpr int CW_BAR = 4096;
constexpr int CW_CNT = 16384;
constexpr int CW_SUB = 17408;
constexpr int CW_MOEQ = 65536;

constexpr int LDS_STAGE = 131072;
constexpr int LDS_BYTES = 163840;
constexpr int LDS_MISC = LDS_BYTES - 1024;
constexpr int MAXTILES = 160;

constexpr int PH_MOD = 0, PH_L0 = 1, PH_PER_LAYER = 11, PH_FINAL = 23, NPH = 24;

struct Params { const float* in[29]; float* out; unsigned char* ws; int ph_lo, ph_hi; };


#define CAS __attribute__((address_space(4)))
__device__ __forceinline__ const CAS char* karg_base() { const CAS char* ka = (const CAS char*)__builtin_amdgcn_kernarg_segment_ptr(); asm volatile("" : "+s"(ka)); return ka; }
__device__ __forceinline__ const float* KIN(int i) { return *(const float* const CAS*)(karg_base() + 8 * i); }
__device__ __forceinline__ float* KOUT() { return *(float* const CAS*)(karg_base() + 232); }
__device__ __forceinline__ unsigned char* KWS() { return *(unsigned char* const CAS*)(karg_base() + 240); }

typedef __bf16 bf16x2_n __attribute__((ext_vector_type(2)));
__device__ __forceinline__ unsigned pk2(float lo, float hi) { const f32x2 f = {lo, hi}; const bf16x2_n b = __builtin_convertvector(f, bf16x2_n); return __builtin_bit_cast(unsigned, b); }
__device__ __forceinline__ unsigned f2bf(float f) { return pk2(f, 0.f) & 0xffffu; }
__device__ __forceinline__ float bf2f(unsigned short b) { return __builtin_bit_cast(float, ((unsigned)b) << 16); }
__device__ __forceinline__ float bflo(unsigned w) { return __builtin_bit_cast(float, w << 16); }
__device__ __forceinline__ float bfhi(unsigned w) { return __builtin_bit_cast(float, w & 0xffff0000u); }
__device__ __forceinline__ float wave_sum(float v) {
#pragma unroll
    for (int o = 1; o < 64; o <<= 1) v += __shfl_xor(v, o);
    return v;
}
__device__ __forceinline__ float sigm(float x) { return 1.0f / (1.0f + expf(-x)); }
__device__ __forceinline__ float fexp(float x) { return __builtin_amdgcn_exp2f(x * 1.4426950408889634f); }
__device__ __forceinline__ float fsigm(float x) { return __builtin_amdgcn_rcpf(1.0f + __builtin_amdgcn_exp2f(-x * 1.4426950408889634f)); }
__device__ __forceinline__ float fsilu(float x) { return x * fsigm(x); }
__device__ __forceinline__ float siluf(float x) { return x * sigm(x); }
__device__ __forceinline__ float softplusf(float x) { return fmaxf(x, 0.f) + log1pf(expf(-fabsf(x))); }
__device__ __forceinline__ void unpack8(const u32x4 a, float (&o)[8]) { o[0] = bflo(a.x); o[1] = bfhi(a.x); o[2] = bflo(a.y); o[3] = bfhi(a.y); o[4] = bflo(a.z); o[5] = bfhi(a.z); o[6] = bflo(a.w); o[7] = bfhi(a.w); }
__device__ __forceinline__ float gelu_tanh(float x) { return 0.5f * x * (1.0f + tanhf(0.7978845608028654f * (x + 0.044715f * x * x * x))); }

#define XB_TMO      128
#define XB_XCNT(j)  (256  + 64 * (j))
#define XB_XSUB(j)  (1280 + 64 * (j))
#define XB_XGEN(j)  (2304 + 64 * (j))
#define XB_TOP      3328
#define XB_TOPGEN   3392
#define XCD_BAR_WORDS 3456
#define XB_SPIN_CAP (1u << 24)
__device__ __forceinline__ unsigned xb_ld(unsigned* p)              { return __hip_atomic_load(p, __ATOMIC_RELAXED, __HIP_MEMORY_SCOPE_AGENT); }
__device__ __forceinline__ unsigned xb_add(unsigned* p, unsigned v) { return __hip_atomic_fetch_add(p, v, __ATOMIC_RELAXED, __HIP_MEMORY_SCOPE_AGENT); }
__device__ __forceinline__ unsigned xb_xcc_id() { return (unsigned)__builtin_amdgcn_s_getreg((3 << 11) | 20) & 0xFu; }
#define XB_SPIN(cond, bar) do { unsigned _sp = 0; while (cond) { __builtin_amdgcn_s_sleep(1); \
    if ((++_sp & 255u) == 0u) { if (xb_ld(&(bar)[XB_TMO])) break; if (_sp > XB_SPIN_CAP) { atomicAdd(&(bar)[XB_TMO], 1u); break; } } } } while (0)
struct XcdBarrier { unsigned* bar; unsigned x; volatile LAS unsigned* st; };
__device__ __forceinline__ XcdBarrier xcd_barrier_post(unsigned* bar, volatile LAS unsigned* st) {
    XcdBarrier b; b.bar = bar; b.x = xb_xcc_id(); b.st = st;
    if (threadIdx.x == 0) (void)xb_add(&bar[XB_XCNT(b.x)], 1u);
    return b;
}
__device__ __forceinline__ void xcd_barrier_complete(unsigned* bar, unsigned x, unsigned& nloc, unsigned& nx) {
    const unsigned G = gridDim.x * gridDim.y * gridDim.z;
    unsigned sum, cnt, mine, sp = 0u;
    for (;;) {
        sum = 0u; cnt = 0u; mine = 0u;
#pragma unroll 1
        for (unsigned j = 0; j < 16; ++j) { const unsigned c = xb_ld(&bar[XB_XCNT(j)]); sum += c; cnt += (c > 0u) ? 1u : 0u; mine = (j == x) ? c : mine; }
        if (sum == G) break;
        __builtin_amdgcn_s_sleep(1);
        if ((++sp & 255u) == 0u) { if (xb_ld(&bar[XB_TMO])) break; if (sp > XB_SPIN_CAP) { atomicAdd(&bar[XB_TMO], 1u); break; } }
    }
    nloc = mine > 0u ? mine : 1u; nx = cnt > 0u ? cnt : 1u;
}
__device__ __forceinline__ void xcd_barrier(const XcdBarrier& b) {
    asm volatile("s_waitcnt vmcnt(0)" ::: "memory");
    __syncthreads();
    if (threadIdx.x == 0) {
        unsigned* bar = b.bar;
        __builtin_amdgcn_s_waitcnt(0);
        unsigned nloc = b.st[0], nx = b.st[1];
        if (nloc == 0u) { xcd_barrier_complete(bar, b.x, nloc, nx); b.st[0] = nloc; b.st[1] = nx; }
        const unsigned old = xb_add(&bar[XB_XSUB(b.x)], 1u);
        const unsigned gen = old / nloc;
        if (old + 1u == (gen + 1u) * nloc) {
            __builtin_amdgcn_fence(__ATOMIC_RELEASE, "agent");
            asm volatile("s_waitcnt vmcnt(0)" ::: "memory");
            const unsigned og = xb_add(&bar[XB_TOP], 1u);
            const unsigned tg = og / nx;
            if (og + 1u == (tg + 1u) * nx) xb_add(&bar[XB_TOPGEN], 1u);
            else XB_SPIN(xb_ld(&bar[XB_TOPGEN]) == tg, bar);
            __builtin_amdgcn_fence(__ATOMIC_ACQUIRE, "agent");
            xb_add(&bar[XB_XGEN(b.x)], 1u);
            asm volatile("s_waitcnt vmcnt(0)" ::: "memory");
        } else {
            XB_SPIN(xb_ld(&bar[XB_XGEN(b.x)]) == gen, bar);
            __builtin_amdgcn_fence(__ATOMIC_ACQUIRE, "agent");
            asm volatile("s_waitcnt vmcnt(0)" ::: "memory");
        }
    }
    __syncthreads();
}


__device__ __forceinline__ void sub_barrier(unsigned* cnt, unsigned target, unsigned* tmo) {
    asm volatile("s_waitcnt vmcnt(0)" ::: "memory");
    __syncthreads();
    if (threadIdx.x == 0) {
        __builtin_amdgcn_fence(__ATOMIC_RELEASE, "agent");
        asm volatile("s_waitcnt vmcnt(0)" ::: "memory");
        (void)xb_add(cnt, 1u);
        unsigned sp = 0u;
        while (xb_ld(cnt) < target) { __builtin_amdgcn_s_sleep(1); if ((++sp & 255u) == 0u) { if (xb_ld(tmo)) break; if (sp > XB_SPIN_CAP) { atomicAdd(tmo, 1u); break; } } }
        __builtin_amdgcn_fence(__ATOMIC_ACQUIRE, "agent");
        asm volatile("s_waitcnt vmcnt(0)" ::: "memory");
    }
    __syncthreads();
}

namespace pg8 {
constexpr int BM = 256, BK = 64, HALF = 128, HTB = HALF * BK * 2, STAGE_BYTES = 8 * HTB, NXCD = 8, WGM = 8;
__device__ __forceinline__ int lds_byte(int r, int c) { const int st = (r >> 4) * 2 + (c >> 5), rr = r & 15, cc = c & 31, ob = rr * 64 + cc * 2; return st * 1024 + (ob ^ (((ob >> 9) & 1) << 5)); }
__device__ __forceinline__ void stage_rc(int b, int& R, int& C) { const int st = b / 1024, sb = b % 1024, swz = sb ^ (((sb >> 9) & 1) << 5); R = (st >> 1) * 16 + swz / 64; C = (st & 1) * 32 + (swz % 64) / 2; }
__device__ __forceinline__ int perm32(int rho) { const int n = rho >> 4, i = rho & 15; return 8 * (i >> 2) + 4 * n + (i & 3); }
struct Unit { int pm, pn, aoff; };
struct Gemm { const bf16_t* A; const bf16_t* Bt; int lda, ldb, K; };
__device__ __forceinline__ bool static_tile(int L, int nM, int nN, int& pm, int& pn) {
    const int nwg = nM * nN; if (L >= nwg) return false;
    int wgid = L; { const int q = nwg / NXCD, r = nwg % NXCD, xcd = wgid % NXCD, off = wgid / NXCD; wgid = (xcd < r ? xcd * (q + 1) : r * (q + 1) + (xcd - r) * q) + off; }
    const int nig = WGM * nN, gid = wgid / nig, fm = gid * WGM, gsz = (nM - fm) < WGM ? (nM - fm) : WGM;
    pm = fm + ((wgid % nig) % gsz); pn = (wgid % nig) / gsz; return true;
}
__device__ __forceinline__ unsigned cvt_pk_bf16(float lo, float hi) { return pk2(lo, hi); }

template <class E, class = void> struct epi_early { static constexpr bool value = false; };
template <class E> struct epi_early<E, decltype((void)E::EARLY)> { static constexpr bool value = E::EARLY; };
template <class Epi, class Sched>
__device__ __forceinline__ void gemm_phase(LAS unsigned char* lds, const Gemm g, const Sched& S, const Epi& E) {
    int tid = threadIdx.x; asm volatile("" : "+v"(tid)); const int wid = __builtin_amdgcn_readfirstlane(tid >> 6), lane = tid & 63, wr = wid >> 2, wc = wid & 3, fr = lane & 15, fq = lane >> 4;
    int K = g.K; asm volatile("" : "+s"(K)); const int nt = K / BK; int lda_ = g.lda, ldb_ = g.ldb; asm volatile("" : "+s"(lda_), "+s"(ldb_));
    unsigned voffA[2], voffB[2];
#pragma unroll
    for (int i = 0; i < 2; ++i) { int R, C; stage_rc(tid * 16 + i * 8192, R, C); const int Rb = Epi::PERM ? ((R & ~31) + perm32(R & 31)) : R;
        voffA[i] = (unsigned)(R * lda_ + C) * 2u; voffB[i] = (unsigned)(Rb * ldb_ + C) * 2u; }
    const size_t kstep = (size_t)(BK * 2);
    const int* rtab = S.row_table();
    const size_t hstepA = Sched::GATHER ? (size_t)0 : (size_t)HALF * lda_ * 2, hstepB = (size_t)HALF * ldb_ * 2;
    const size_t tstepA = 2 * hstepA, tstepB = 2 * hstepB;
    unsigned vc0[2], vc1[2], vn0[2], vn1[2];
#define PG8_ROWS(pm_, o0, o1) do { _Pragma("unroll") for (int _i = 0; _i < 2; ++_i) { int _R, _C; stage_rc(tid * 16 + _i * 8192, _R, _C); \
        if (Sched::GATHER) { o0[_i] = (unsigned)(rtab[(pm_) * 256 + _R] * lda_ + _C) * 2u; o1[_i] = (unsigned)(rtab[(pm_) * 256 + 128 + _R] * lda_ + _C) * 2u; } else { o0[_i] = voffA[_i]; o1[_i] = voffA[_i]; } } } while (0)
    const unsigned ldsw = (unsigned)wid * 1024u;
    const int aoff = lds_byte(wr * 64 + fr, fq * 8), boff = lds_byte(wc * 32 + fr, fq * 8);
#define PG8_SA(b, h) (((b) * 2 + (h)) * HTB)
#define PG8_SB(b, h) ((4 + (b) * 2 + (h)) * HTB)
#define PG8_STAGE(bufoff, gbase, voff) do { _Pragma("unroll") for (int _i = 0; _i < 2; ++_i) \
        __builtin_amdgcn_global_load_lds((const unsigned*)((const char*)(gbase) + (voff)[_i]), (LAS unsigned*)(lds + (bufoff) + ldsw + _i * 8192), 16, 0, 0); } while (0)
#define PG8_LDA(dst, b, h) do { _Pragma("unroll") for (int m = 0; m < 4; ++m) _Pragma("unroll") for (int k = 0; k < 2; ++k) dst[m][k] = *(const LAS bf16x8*)(lds + PG8_SA(b, h) + aoff + m * 2048 + k * 1024); } while (0)
#define PG8_LDB(dst, b, h) do { _Pragma("unroll") for (int n = 0; n < 2; ++n) _Pragma("unroll") for (int k = 0; k < 2; ++k) dst[n][k] = *(const LAS bf16x8*)(lds + PG8_SB(b, h) + boff + n * 2048 + k * 1024); } while (0)
#define PG8_MMA(ai, bj, At, Bt) do { __builtin_amdgcn_s_setprio(1); _Pragma("unroll") for (int m = 0; m < 4; ++m) _Pragma("unroll") for (int n = 0; n < 2; ++n) _Pragma("unroll") for (int k = 0; k < 2; ++k) \
        acc[ai][bj][m][n] = __builtin_amdgcn_mfma_f32_16x16x32_bf16(Bt[n][k], At[m][k], acc[ai][bj][m][n], 0, 0, 0); __builtin_amdgcn_s_setprio(0); } while (0)
#define PG8_WAIT_V(n) asm volatile("s_waitcnt vmcnt(" #n ")" ::: "memory")
#define PG8_WAIT_L(n) asm volatile("s_waitcnt lgkmcnt(" #n ")" ::: "memory")
#define PG8_BAR __builtin_amdgcn_s_barrier()
#define PG8_SCHED __builtin_amdgcn_sched_barrier(0)
    Unit cur, nxt; int ui = 0;
    if (!S.next(0, cur)) return;
    f32x4 acc[2][2][4][2];
#pragma unroll
    for (int a = 0; a < 2; ++a)
#pragma unroll
        for (int b = 0; b < 2; ++b)
#pragma unroll
            for (int m = 0; m < 4; ++m)
#pragma unroll
                for (int n = 0; n < 2; ++n) acc[a][b][m][n] = (f32x4){0.f, 0.f, 0.f, 0.f};
    bf16x8 At[4][2], B0[2][2], B1[2][2];
    const char* cA = (const char*)g.A + (size_t)cur.pm * tstepA + (size_t)cur.aoff; const char* cB = (const char*)g.Bt + (size_t)cur.pn * tstepB;
    PG8_ROWS(cur.pm, vc0, vc1);
#define PG8_PROLOGUE_A(cA_, cB_, v0_, v1_) do { PG8_STAGE(PG8_SB(0, 0), cB_, voffB); PG8_STAGE(PG8_SA(0, 0), cA_, v0_); PG8_STAGE(PG8_SB(0, 1), (cB_) + hstepB, voffB); PG8_STAGE(PG8_SA(0, 1), (cA_) + hstepA, v1_); } while (0)
#define PG8_PROLOGUE_B() do { if (wr == 1) PG8_BAR; PG8_WAIT_V(4); PG8_BAR; \
        PG8_STAGE(PG8_SB(1, 0), cB + kstep, voffB); PG8_STAGE(PG8_SA(1, 0), cA + kstep, vc0); PG8_STAGE(PG8_SB(1, 1), cB + hstepB + kstep, voffB); \
        PG8_WAIT_V(6); PG8_BAR; } while (0)
#define PG8_PROLOGUE() do { PG8_PROLOGUE_A(cA, cB, vc0, vc1); PG8_PROLOGUE_B(); } while (0)
    if (!Epi::LDS_EPI) PG8_PROLOGUE();
    for (;;) {
        const bool has_next = S.next(ui + 1, nxt);
        if (Epi::LDS_EPI) { S.ready(cur); if (!(epi_early<Epi>::value && ui > 0)) PG8_PROLOGUE_A(cA, cB, vc0, vc1); PG8_PROLOGUE_B(); }
        const bool chain = has_next && !Epi::LDS_EPI;
        const char* nA = chain ? (const char*)g.A + (size_t)nxt.pm * tstepA + (size_t)nxt.aoff : cA; const char* nB = chain ? (const char*)g.Bt + (size_t)nxt.pn * tstepB : cB;
        if (chain) PG8_ROWS(nxt.pm, vn0, vn1); else { vn0[0] = vc0[0]; vn0[1] = vc0[1]; vn1[0] = vc1[0]; vn1[1] = vc1[1]; }
        for (int t = 0; t < nt; t += 2) {
            const bool last = (t == nt - 2);
            const char* a1 = cA + (size_t)(t + 1) * kstep;
            const char* a2 = last ? nA : cA + (size_t)(t + 2) * kstep; const char* b2 = last ? nB : cB + (size_t)(t + 2) * kstep;
            const char* a3 = a2 + kstep; const char* b3 = b2 + kstep;
            unsigned x0[2], x1[2]; x0[0] = last ? vn0[0] : vc0[0]; x0[1] = last ? vn0[1] : vc0[1]; x1[0] = last ? vn1[0] : vc1[0]; x1[1] = last ? vn1[1] : vc1[1];
            PG8_LDB(B0, 0, 0); PG8_SCHED; PG8_LDA(At, 0, 0); PG8_STAGE(PG8_SA(1, 1), a1 + hstepA, vc1);
            PG8_WAIT_L(8); PG8_BAR; PG8_WAIT_L(0); PG8_MMA(0, 0, At, B0); PG8_BAR; PG8_SCHED;
            PG8_LDB(B1, 0, 1); PG8_STAGE(PG8_SB(0, 0), b2, voffB);
            PG8_BAR; PG8_WAIT_L(0); PG8_MMA(0, 1, At, B1); PG8_BAR;
            PG8_LDA(At, 0, 1); PG8_STAGE(PG8_SA(0, 0), a2, x0);
            PG8_BAR; PG8_WAIT_L(0); PG8_MMA(1, 0, At, B0); PG8_BAR; PG8_SCHED;
            PG8_STAGE(PG8_SB(0, 1), b2 + hstepB, voffB);
            PG8_WAIT_V(6); PG8_BAR; PG8_MMA(1, 1, At, B1); PG8_BAR;
            PG8_LDB(B0, 1, 0); PG8_SCHED; PG8_LDA(At, 1, 0); PG8_STAGE(PG8_SA(0, 1), a2 + hstepA, x1);
            PG8_WAIT_L(8); PG8_BAR; PG8_WAIT_L(0); PG8_MMA(0, 0, At, B0); PG8_BAR; PG8_SCHED;
            PG8_LDB(B1, 1, 1); PG8_STAGE(PG8_SB(1, 0), b3, voffB);
            PG8_BAR; PG8_WAIT_L(0); PG8_MMA(0, 1, At, B1); PG8_BAR;
            PG8_LDA(At, 1, 1); PG8_STAGE(PG8_SA(1, 0), a3, x0);
            PG8_BAR; PG8_WAIT_L(0); PG8_MMA(1, 0, At, B0); PG8_BAR; PG8_SCHED;
            PG8_STAGE(PG8_SB(1, 1), b3 + hstepB, voffB);
            PG8_WAIT_V(6); PG8_BAR; PG8_MMA(1, 1, At, B1); PG8_BAR;
        }
        if (Epi::LDS_EPI) { PG8_WAIT_V(0); if (wr == 0) PG8_BAR; PG8_BAR;
            if constexpr (epi_early<Epi>::value) { static_assert(!Sched::GATHER, "early prologue: plain row tiles only");
                E.run_a(acc, cur, wr, wc, lds, tid);
                if (has_next) { const char* eA = (const char*)g.A + (size_t)nxt.pm * tstepA + (size_t)nxt.aoff; const char* eB = (const char*)g.Bt + (size_t)nxt.pn * tstepB; PG8_PROLOGUE_A(eA, eB, voffA, voffA); }
                E.run_b(cur, lds, tid); }
            else E.run(acc, cur, wr, wc, fr, fq, lds, tid); }
        else E(acc, cur, wr, wc, fr, fq);
        if (!has_next) break;
        if (!E.keep(cur))
#pragma unroll
        for (int a = 0; a < 2; ++a)
#pragma unroll
            for (int b = 0; b < 2; ++b)
#pragma unroll
                for (int m = 0; m < 4; ++m)
#pragma unroll
                    for (int n = 0; n < 2; ++n) acc[a][b][m][n] = (f32x4){0.f, 0.f, 0.f, 0.f};
        if (Epi::LDS_EPI) { cur = nxt; cA = (const char*)g.A + (size_t)cur.pm * tstepA + (size_t)cur.aoff; cB = (const char*)g.Bt + (size_t)cur.pn * tstepB; ++ui; PG8_ROWS(cur.pm, vc0, vc1); }
        else { cur = nxt; cA = nA; cB = nB; ++ui; vc0[0] = vn0[0]; vc0[1] = vn0[1]; vc1[0] = vn1[0]; vc1[1] = vn1[1]; }
    }
    if (!Epi::LDS_EPI) { PG8_WAIT_V(0); if (wr == 0) PG8_BAR; PG8_BAR; }
#undef PG8_ROWS
#undef PG8_PROLOGUE
#undef PG8_PROLOGUE_A
#undef PG8_PROLOGUE_B
#undef PG8_SA
#undef PG8_SB
#undef PG8_STAGE
#undef PG8_LDA
#undef PG8_LDB
#undef PG8_MMA
#undef PG8_WAIT_V
#undef PG8_WAIT_L
#undef PG8_BAR
#undef PG8_SCHED
}
}
using pg8::Unit;

struct SchedStatic { static constexpr bool GATHER = false; __device__ __forceinline__ const int* row_table() const { return nullptr; } __device__ __forceinline__ void ready(const Unit&) const {} int nM, nN, G, c;
    __device__ __forceinline__ bool next(int i, Unit& u) const { int pm, pn; if (!pg8::static_tile(i * G + c, nM, nN, pm, pn)) return false; u.pm = pm; u.pn = pn; u.aoff = 0; return true; } };
struct SchedMerge { static constexpr bool GATHER = false; __device__ __forceinline__ const int* row_table() const { return nullptr; } __device__ __forceinline__ void ready(const Unit&) const {} int G, c;
    __device__ __forceinline__ bool next(int i, Unit& u) const { const int ti = i / 3, b = i - 3 * ti; int pm, pn; if (!pg8::static_tile(ti * G + c, 64, 8, pm, pn)) return false;
        u.pm = pm; u.pn = b * 8 + pn; u.aoff = b * 1024 * 2; return true; } };
template <bool GATH>
struct SchedMoe { static constexpr bool GATHER = GATH; const int* rtab; __device__ __forceinline__ const int* row_table() const { return rtab; } __device__ __forceinline__ void ready(const Unit&) const {} int G, c, nN; const LAS int* tbl;
    __device__ __forceinline__ bool next(int i, Unit& u) const { const int L = i * G + c; const int ntl = __builtin_amdgcn_readfirstlane(tbl[224]); if (L >= ntl * nN) return false;
        const int pm = L / nN; u.pm = pm; u.pn = __builtin_amdgcn_readfirstlane(tbl[pm]) * nN + (L - pm * nN); u.aoff = 0; return true; } };
struct SchedMoeDyn { static constexpr bool GATHER = false; __device__ __forceinline__ const int* row_table() const { return nullptr; } int nN; const LAS int* tbl; volatile LAS int* slot; unsigned* done; unsigned* tmo;
    __device__ __forceinline__ bool next(int i, Unit& u) const { const int L = __builtin_amdgcn_readfirstlane(slot[i & 1]); const int ntl = __builtin_amdgcn_readfirstlane(tbl[224]); if (L >= ntl * nN) return false;
        const int pm = L / nN; u.pm = pm; u.pn = __builtin_amdgcn_readfirstlane(tbl[pm]) * nN + (L - pm * nN); u.aoff = 0; return true; }
    __device__ __forceinline__ void ready(const Unit& u) const {
        if (threadIdx.x == 0) { if (slot[4] == 0) { unsigned* d = done + 64 * (u.pm + 1); unsigned sp = 0u;
                while (xb_ld(d) < 32u) { __builtin_amdgcn_s_sleep(1); if ((++sp & 255u) == 0u) { if (xb_ld(tmo)) break; if (sp > XB_SPIN_CAP) { atomicAdd(tmo, 1u); break; } } } }
            slot[4] = 0; __builtin_amdgcn_fence(__ATOMIC_ACQUIRE, "agent"); asm volatile("s_waitcnt vmcnt(0)" ::: "memory"); }
        asm volatile("s_waitcnt lgkmcnt(0)" ::: "memory"); __builtin_amdgcn_s_barrier(); asm volatile("" ::: "memory"); } };

struct EpiZ { static constexpr bool LDS_EPI = false; template <class A_> __device__ __forceinline__ void run(A_&, const Unit&, int, int, int, int, LAS unsigned char*, int) const {} __device__ __forceinline__ bool keep(const Unit&) const { return false; } static constexpr bool PERM = true; bf16_t* Z; float* GAB;
    __device__ __forceinline__ void operator()(const f32x4 (&acc)[2][2][4][2], const Unit& u, int wr, int wc, int fr, int fq) const {
        const int row0 = u.pm * 256 + wr * 64 + fr;
        if (u.pn < 64) {
            const int col0 = u.pn * 256 + wc * 32 + 8 * fq;
#pragma unroll
            for (int ai = 0; ai < 2; ++ai)
#pragma unroll
                for (int m = 0; m < 4; ++m) { bf16_t* rowp = Z + (size_t)(row0 + ai * 128 + m * 16) * NZ + col0;
#pragma unroll
                    for (int bj = 0; bj < 2; ++bj) { const f32x4 v0 = acc[ai][bj][m][0], v1 = acc[ai][bj][m][1]; u32x4 w;
                        w.x = pg8::cvt_pk_bf16(v0[0], v0[1]); w.y = pg8::cvt_pk_bf16(v0[2], v0[3]); w.z = pg8::cvt_pk_bf16(v1[0], v1[1]); w.w = pg8::cvt_pk_bf16(v1[2], v1[3]);
                        *(u32x4*)(rowp + bj * 128) = w; } }
        } else if (wc == 0 && fq < 2) {
#pragma unroll
            for (int ai = 0; ai < 2; ++ai)
#pragma unroll
                for (int m = 0; m < 4; ++m) { float* gp = GAB + (size_t)(row0 + ai * 128 + m * 16) * 16 + 8 * fq;
                    *(f32x4*)gp = acc[ai][0][m][0]; *(f32x4*)(gp + 4) = acc[ai][0][m][1]; }
        }
    } };
struct EpiZL { static constexpr bool LDS_EPI = true, PERM = true, EARLY = true; bf16_t* Z;
    __device__ __forceinline__ bool keep(const Unit&) const { return false; }
    __device__ __forceinline__ void operator()(const f32x4 (&)[2][2][4][2], const Unit&, int, int, int, int) const {}
    template <class A_> __device__ __forceinline__ void run(A_&, const Unit&, int, int, int, int, LAS unsigned char*, int) const {}
    __device__ __forceinline__ void rows_out(const Unit& u, LAS unsigned char* lds, int tid, int i) const { const int c = tid & 31; const int row = (tid >> 5) + 16 * i;
        const u32x4 w = *(const LAS u32x4*)(lds + row * 512 + ((c ^ (row & 31)) << 4)); __builtin_nontemporal_store(w, (u32x4*)(Z + (size_t)(u.pm * 256 + row) * NZ + u.pn * 256 + c * 8)); }
    __device__ __forceinline__ void run_a(const f32x4 (&acc)[2][2][4][2], const Unit& u, int wr, int wc, LAS unsigned char* lds, int tid_) const {
        int tid = tid_; asm volatile("" : "+v"(tid));
        const int fr = tid & 15, fq = (tid >> 4) & 3;
#pragma unroll
        for (int ai = 0; ai < 2; ++ai)
#pragma unroll
            for (int m = 0; m < 4; ++m) { const int r = ai * 128 + wr * 64 + m * 16 + fr;
#pragma unroll
                for (int bj = 0; bj < 2; ++bj) { const int c16 = 16 * bj + 4 * wc + fq; const f32x4 v0 = acc[ai][bj][m][0], v1 = acc[ai][bj][m][1]; u32x4 w;
                    w.x = pk2(v0[0], v0[1]); w.y = pk2(v0[2], v0[3]); w.z = pk2(v1[0], v1[1]); w.w = pk2(v1[2], v1[3]);
                    *(LAS u32x4*)(lds + r * 512 + ((c16 ^ (r & 31)) << 4)) = w; }
                asm volatile("" ::: "memory"); }
        __syncthreads();
#pragma unroll
        for (int i = 0; i < 4; ++i) rows_out(u, lds, tid, i);
        asm volatile("" ::: "memory");
#pragma unroll
        for (int i = 8; i < 12; ++i) rows_out(u, lds, tid, i);
        asm volatile("s_waitcnt lgkmcnt(0)" ::: "memory"); __builtin_amdgcn_s_barrier(); asm volatile("" ::: "memory");
    }
    __device__ __forceinline__ void run_b(const Unit& u, LAS unsigned char* lds, int tid_) const {
        int tid = tid_; asm volatile("" : "+v"(tid));
#pragma unroll
        for (int i = 4; i < 8; ++i) rows_out(u, lds, tid, i);
        asm volatile("" ::: "memory");
#pragma unroll
        for (int i = 12; i < 16; ++i) rows_out(u, lds, tid, i);
        asm volatile("s_waitcnt lgkmcnt(0)" ::: "memory"); __builtin_amdgcn_s_barrier(); asm volatile("" ::: "memory");
    } };
struct EpiMerge { static constexpr bool LDS_EPI = false; template <class A_> __device__ __forceinline__ void run(A_&, const Unit&, int, int, int, int, LAS unsigned char*, int) const {} static constexpr bool PERM = true; const bf16_t* Z; bf16_t* OUT;
    __device__ __forceinline__ bool keep(const Unit& u) const { return (u.pn >> 3) < 2; }
    __device__ __forceinline__ void operator()(f32x4 (&acc)[2][2][4][2], const Unit& u, int wr, int wc, int fr, int fq) const {
        const int b = u.pn >> 3, pnl = u.pn & 7; const int row0 = u.pm * 256 + wr * 64 + fr, col0 = pnl * 256 + wc * 32 + 8 * fq;
        const bf16_t* zb = Z + ZC_BR + b * 2048 + col0;
        u32x4 gb[2][2][2], gn[2][2][2];
#define EM_LOAD(slot, aim_) do { const int ai_ = (aim_) >> 1, mh_ = (aim_) & 1; _Pragma("unroll") for (int mm = 0; mm < 2; ++mm) _Pragma("unroll") for (int bj = 0; bj < 2; ++bj) { \
            const bf16_t* zp = zb + (size_t)(row0 + ai_ * 128 + (2 * mh_ + mm) * 16) * NZ + bj * 128; gb[slot][mm][bj] = *(const u32x4*)zp; gn[slot][mm][bj] = (b < 2) ? *(const u32x4*)(zp + 2048) : (u32x4){0u, 0u, 0u, 0u}; } } while (0)
        EM_LOAD(0, 0);
#pragma unroll
        for (int aim = 0; aim < 4; ++aim) { const int ai = aim >> 1, mh = aim & 1, sl = aim & 1;
            if (aim + 1 < 4) EM_LOAD((aim + 1) & 1, aim + 1);
#pragma unroll
            for (int mm = 0; mm < 2; ++mm) { const int m = 2 * mh + mm;
#pragma unroll
                for (int bj = 0; bj < 2; ++bj) { float eb[8]; { float x[8]; unpack8(gb[sl][mm][bj], x);
#pragma unroll
                        for (int i = 0; i < 8; ++i) eb[i] = __builtin_amdgcn_rcpf(1.0f + fexp(-fmaxf(fminf(x[i], 30.f), -30.f))); }
                    if (b < 2) { float x[8]; unpack8(gn[sl][mm][bj], x);
#pragma unroll
                        for (int i = 0; i < 8; ++i) eb[i] *= 1.0f + fexp(-fmaxf(fminf(x[i], 30.f), -30.f)); }
                    f32x4& v0 = acc[ai][bj][m][0]; f32x4& v1 = acc[ai][bj][m][1];
                    v0[0] *= eb[0]; v0[1] *= eb[1]; v0[2] *= eb[2]; v0[3] *= eb[3]; v1[0] *= eb[4]; v1[1] *= eb[5]; v1[2] *= eb[6]; v1[3] *= eb[7];
                    if (b == 2) { u32x4 w; w.x = pg8::cvt_pk_bf16(v0[0], v0[1]); w.y = pg8::cvt_pk_bf16(v0[2], v0[3]); w.z = pg8::cvt_pk_bf16(v1[0], v1[1]); w.w = pg8::cvt_pk_bf16(v1[2], v1[3]);
                        *(u32x4*)(OUT + (size_t)(row0 + ai * 128 + m * 16) * 2048 + col0 + bj * 128) = w; } } }
        }
#undef EM_LOAD
    } };
struct EpiWout { static constexpr bool LDS_EPI = false; template <class A_> __device__ __forceinline__ void run(A_&, const Unit&, int, int, int, int, LAS unsigned char*, int) const {} __device__ __forceinline__ bool keep(const Unit&) const { return false; } static constexpr bool PERM = false; const float* xsrc; float* xdst; const float* gt;
    __device__ __forceinline__ void operator()(const f32x4 (&acc)[2][2][4][2], const Unit& u, int wr, int wc, int fr, int fq) const {
        const int row0 = u.pm * 256 + wr * 64 + fr, col0 = u.pn * 256 + wc * 32 + 4 * fq;
        f32x4 gv[2][2];
#pragma unroll
        for (int bj = 0; bj < 2; ++bj)
#pragma unroll
            for (int n = 0; n < 2; ++n) gv[bj][n] = *(const f32x4*)(gt + col0 + bj * 128 + n * 16);
        f32x4 xo[2][2][2][2];
#define EW_LOAD(slot, q_) do { const int ai_ = (q_) >> 1, mh_ = (q_) & 1; _Pragma("unroll") for (int mm = 0; mm < 2; ++mm) { const size_t off_ = (size_t)(row0 + ai_ * 128 + (2 * mh_ + mm) * 16) * 2048 + col0; \
            _Pragma("unroll") for (int bj = 0; bj < 2; ++bj) _Pragma("unroll") for (int n = 0; n < 2; ++n) xo[slot][mm][bj][n] = *(const f32x4*)(xsrc + off_ + bj * 128 + n * 16); } } while (0)
        EW_LOAD(0, 0);
#pragma unroll
        for (int q = 0; q < 4; ++q) { const int ai = q >> 1, mh = q & 1, sl = q & 1;
            if (q + 1 < 4) EW_LOAD((q + 1) & 1, q + 1);
#pragma unroll
            for (int mm = 0; mm < 2; ++mm) { const int m = 2 * mh + mm; const size_t off = (size_t)(row0 + ai * 128 + m * 16) * 2048 + col0;
#pragma unroll
                for (int bj = 0; bj < 2; ++bj)
#pragma unroll
                    for (int n = 0; n < 2; ++n) *(f32x4*)(xdst + off + bj * 128 + n * 16) = xo[sl][mm][bj][n] + gv[bj][n] * acc[ai][bj][m][n]; } }
#undef EW_LOAD
    } };
struct EpiW13 { static constexpr bool LDS_EPI = false; template <class A_> __device__ __forceinline__ void run(A_&, const Unit&, int, int, int, int, LAS unsigned char*, int) const {} __device__ __forceinline__ bool keep(const Unit&) const { return false; } static constexpr bool PERM = true; bf16_t* HID; unsigned* done;
    __device__ __forceinline__ void operator()(const f32x4 (&acc)[2][2][4][2], const Unit& u, int wr, int wc, int fr, int fq) const {
        const int pnl = u.pn & 3; const int row0 = u.pm * 256 + wr * 64 + fr, col0 = pnl * 128 + wc * 32 + 8 * fq;
        const __amdgpu_buffer_rsrc_t rs = __builtin_amdgcn_make_buffer_rsrc(HID, 0, MAXTILES * 256 * 512 * 2, 0x00020000);
#pragma unroll
        for (int ai = 0; ai < 2; ++ai)
#pragma unroll
            for (int m = 0; m < 4; ++m) { float hv[8];
#pragma unroll
                for (int n = 0; n < 2; ++n)
#pragma unroll
                    for (int j = 0; j < 4; ++j) hv[n * 4 + j] = fsilu(acc[ai][0][m][n][j]) * acc[ai][1][m][n][j];
                u32x4 w; w.x = pg8::cvt_pk_bf16(hv[0], hv[1]); w.y = pg8::cvt_pk_bf16(hv[2], hv[3]); w.z = pg8::cvt_pk_bf16(hv[4], hv[5]); w.w = pg8::cvt_pk_bf16(hv[6], hv[7]);
                __builtin_amdgcn_raw_buffer_store_b128(w, rs, (unsigned)(((row0 + ai * 128 + m * 16) * 512 + col0) * 2), 0,   16); }
        asm volatile("s_waitcnt vmcnt(0)" ::: "memory");
        if (fr == 0 && fq == 0) (void)xb_add(done + 64 * (u.pm + 1), 1u);
    } };
struct EpiW2 { static constexpr bool LDS_EPI = false; template <class A_> __device__ __forceinline__ void run(A_&, const Unit&, int, int, int, int, LAS unsigned char*, int) const {} __device__ __forceinline__ bool keep(const Unit&) const { return false; } static constexpr bool PERM = true; bf16_t* SLOT; const u32x2* rowinfo; const LAS int* tbl;
    __device__ __forceinline__ void operator()(const f32x4 (&acc)[2][2][4][2], const Unit& u, int wr, int wc, int fr, int fq) const {
        const int e = u.pn >> 3, pnl = u.pn & 7; const int row0 = u.pm * 256 + wr * 64 + fr, col0 = pnl * 256 + wc * 32 + 8 * fq; const int rend = __builtin_amdgcn_readfirstlane(tbl[192 + e]);
        u32x2 inf[2][4];
#pragma unroll
        for (int ai = 0; ai < 2; ++ai)
#pragma unroll
            for (int m = 0; m < 4; ++m) inf[ai][m] = rowinfo[row0 + ai * 128 + m * 16];
#pragma unroll
        for (int ai = 0; ai < 2; ++ai)
#pragma unroll
            for (int m = 0; m < 4; ++m) { const int r = row0 + ai * 128 + m * 16;
                if (r < rend) { const unsigned wbits = inf[ai][m].y; const float w = __uint_as_float(wbits); const unsigned tx = inf[ai][m].x; const unsigned tok = tx >> 1, k = tx & 1u;
                    bf16_t* dst = SLOT + ((size_t)k * S_ + tok) * 2048 + col0;
#pragma unroll
                    for (int bj = 0; bj < 2; ++bj) { const f32x4 v0 = acc[ai][bj][m][0] * w, v1 = acc[ai][bj][m][1] * w; u32x4 o;
                        o.x = pg8::cvt_pk_bf16(v0[0], v0[1]); o.y = pg8::cvt_pk_bf16(v0[2], v0[3]); o.z = pg8::cvt_pk_bf16(v1[0], v1[1]); o.w = pg8::cvt_pk_bf16(v1[2], v1[3]);
                        *(u32x4*)(dst + bj * 128) = o; } } }
    } };

struct EpiW2L { static constexpr bool LDS_EPI = true, PERM = true; bf16_t* SLOT; const u32x2* rowinfo; const LAS int* tbl; unsigned* q; volatile LAS int* slot; unsigned* done;
    __device__ __forceinline__ bool keep(const Unit&) const { return false; }
    __device__ __forceinline__ void operator()(const f32x4 (&)[2][2][4][2], const Unit&, int, int, int, int) const {}
    __device__ __forceinline__ void run(const f32x4 (&acc)[2][2][4][2], const Unit& u, int wr, int wc, int fr_, int fq_, LAS unsigned char* lds, int tid_) const {
        int tid = tid_; asm volatile("" : "+v"(tid));
        int qn = 0; unsigned dn = 0u;
        if (tid == 0) { qn = (int)xb_add(q, 1u); const int Ln = slot[(slot[2] + 1) & 1]; if (Ln < tbl[224] * 8) dn = xb_ld(done + 64 * ((Ln >> 3) + 1)); }
        const int fr = tid & 15, fq = (tid >> 4) & 3; const int e = u.pn >> 3, pnl = u.pn & 7; const int rend = __builtin_amdgcn_readfirstlane(tbl[192 + e]);
        LAS unsigned* rowx = (LAS unsigned*)(lds + 131072);
        u32x2 inf[2][4];
#pragma unroll
        for (int ai = 0; ai < 2; ++ai)
#pragma unroll
            for (int m = 0; m < 4; ++m) inf[ai][m] = rowinfo[u.pm * 256 + ai * 128 + wr * 64 + m * 16 + fr];
#pragma unroll
        for (int ai = 0; ai < 2; ++ai)
#pragma unroll
            for (int m = 0; m < 4; ++m) { const int r = ai * 128 + wr * 64 + m * 16 + fr; const bool valid = (u.pm * 256 + r) < rend; const float w = valid ? __uint_as_float(inf[ai][m].y) : 0.f;
                if (wc == 0 && fq == 0) rowx[r] = valid ? inf[ai][m].x : 0xffffffffu;
#pragma unroll
                for (int bj = 0; bj < 2; ++bj) { const int c16 = 16 * bj + 4 * wc + fq; const f32x4 v0 = acc[ai][bj][m][0] * w, v1 = acc[ai][bj][m][1] * w; u32x4 o;
                    o.x = pk2(v0[0], v0[1]); o.y = pk2(v0[2], v0[3]); o.z = pk2(v1[0], v1[1]); o.w = pk2(v1[2], v1[3]);
                    *(LAS u32x4*)(lds + r * 512 + ((c16 ^ (r & 31)) << 4)) = o; }
                asm volatile("" ::: "memory"); }
        __syncthreads();
        const int c = tid & 31;
#pragma unroll
        for (int i = 0; i < 16; ++i) { const int row = (tid >> 5) + 16 * i; const unsigned tx = rowx[row];
            if (tx != 0xffffffffu) { const u32x4 o = *(const LAS u32x4*)(lds + row * 512 + ((c ^ (row & 31)) << 4));
                *(u32x4*)(SLOT + ((size_t)(tx & 1u) * S_ + (tx >> 1)) * 2048 + pnl * 256 + c * 8) = o; }
            if ((i & 3) == 3) asm volatile("" ::: "memory"); }
        if (tid == 0) { const int n = slot[2]; slot[n & 1] = qn; slot[2] = n + 1; slot[4] = dn >= 32u ? 1 : 0; }
        asm volatile("s_waitcnt lgkmcnt(0)" ::: "memory"); __builtin_amdgcn_s_barrier(); asm volatile("" ::: "memory");
    } };

struct Frame { LAS unsigned char* lds; unsigned char* ldsg; int tid, lane, wave, G, bx; };
extern __shared__ __attribute__((aligned(16))) unsigned char lds_raw[];
__device__ __forceinline__ Frame make_frame() { Frame F; int tz = threadIdx.x; asm volatile("" : "+v"(tz)); F.lds = (LAS unsigned char*)lds_raw; F.ldsg = lds_raw; F.tid = tz; F.lane = tz & 63;
    F.wave = __builtin_amdgcn_readfirstlane(tz >> 6); F.G = gridDim.x; F.bx = blockIdx.x; return F; }

struct TItem { const float* W; bf16_t* WT; int ldw, srccol, k0, ldk, dstrow; };
__device__ __forceinline__ void titem_load(const TItem& t, f32x4 (&x)[8], int lane) {
    const int n4 = (lane & 7) * 4, kr = lane >> 3;
#pragma unroll
    for (int i = 0; i < 8; ++i) x[i] = __builtin_nontemporal_load((const f32x4*)(t.W + (size_t)(t.k0 + kr + 8 * i) * t.ldw + t.srccol + n4));
}
__device__ __forceinline__ void titem_store(const TItem& t, const f32x4 (&x)[8], float* scr, int lane) {
    const int n4 = (lane & 7) * 4, kr = lane >> 3;
#pragma unroll
    for (int i = 0; i < 8; ++i) { float* s = scr + (kr + 8 * i) * 33 + n4; s[0] = x[i][0]; s[1] = x[i][1]; s[2] = x[i][2]; s[3] = x[i][3]; }
    asm volatile("s_waitcnt lgkmcnt(0)" ::: "memory");
    const int c = lane & 7;
#pragma unroll
    for (int j = 0; j < 4; ++j) { const int n = (lane >> 3) + 8 * j; const float* s = scr + (8 * c) * 33 + n;
        u32x4 o; o.x = pk2(s[0 * 33], s[1 * 33]); o.y = pk2(s[2 * 33], s[3 * 33]); o.z = pk2(s[4 * 33], s[5 * 33]); o.w = pk2(s[6 * 33], s[7 * 33]);
        *(u32x4*)(t.WT + (size_t)(t.dstrow + n) * t.ldk + t.k0 + 8 * c) = o; }
    asm volatile("s_waitcnt lgkmcnt(0)" ::: "memory");
}

__device__ __forceinline__ void phase_mod(const Frame& F, const Params& p) {
    const float* cvec = KIN(1); const float* ada_w = KIN(3); const float* ada_b = KIN(4);
    float* modv = (float*)(KWS() + WS_MODV);
    float* sc = (float*)F.ldsg;
    f32x2* red = (f32x2*)(sc + 2048);
    for (int k = F.tid; k < 2048; k += NTHR) sc[k] = siluf(cvec[k]);
    __syncthreads();
    for (int u = F.bx; u < 2 * 96; u += F.G) {
        const int l = u / 96, cb = u % 96, col = cb * 128 + 2 * F.lane;
        const float* wp = ada_w + ((size_t)l * 2048 + F.wave * 256) * 12288 + col; const float* sp = sc + F.wave * 256;
        f32x2 acc = (f32x2){0.f, 0.f};
#pragma unroll 16
        for (int k = 0; k < 256; ++k) { const f32x2 w = __builtin_nontemporal_load((const f32x2*)(wp + (size_t)k * 12288)); const float s = sp[k]; acc[0] += s * w[0]; acc[1] += s * w[1]; }
        red[F.wave * 64 + F.lane] = acc;
        __syncthreads();
        if (F.wave == 0) { f32x2 s = *(const f32x2*)(ada_b + l * 12288 + col);
#pragma unroll
            for (int w = 0; w < 8; ++w) s += red[w * 64 + F.lane];
            *(f32x2*)(modv + l * 12288 + col) = s; }
        __syncthreads();
    }
}

__device__ __forceinline__ void phase_convert(const Frame& F, const Params& p, int l) {
    float* scr = (float*)(F.ldsg + F.wave * 8448);
    const int gw = F.bx * NWAVES + F.wave, NGW = F.G * NWAVES;
    bf16_t* WIN = (bf16_t*)(KWS() + WS_WIN); bf16_t* BP = (bf16_t*)(KWS() + WS_BP); bf16_t* WO = (bf16_t*)(KWS() + WS_WO); bf16_t* W13 = (bf16_t*)(KWS() + WS_W13); bf16_t* W2 = (bf16_t*)(KWS() + WS_W2);
    const float* w_in = KIN(7) + (size_t)l * 2048 * INC;
    const float* bp = KIN(19) + (size_t)l * 3 * 1024 * 2048;
    const float* wo = KIN(20) + (size_t)l * 2048 * 2048;
    const float* w1 = KIN(25) + (size_t)l * 32 * 2048 * 512; const float* w3 = KIN(26) + (size_t)l * 32 * 2048 * 512; const float* w2 = KIN(27) + (size_t)l * 32 * 512 * 2048;
    const float* lwa = KIN(10) + (size_t)l * 8 * 16384; const float* lwx = KIN(12) + (size_t)l * 8 * 16384; bf16_t* LWT = (bf16_t*)(KWS() + WS_LWT);
    constexpr int I_IN = 512 * 32, I_BP = 3 * 16 * 64, I_WO = 32 * 64, I_W13 = 32 * 2 * 512, I_W2 = 32 * 512, I_LRU = 8 * 2 * 8;
    constexpr int NITEMS = I_IN + I_BP + I_WO + I_W13 + I_W2 + I_LRU;
    auto decode = [&](int it) -> TItem { TItem t; int r = it;
        if (r < I_IN) { const int nb = r % 512, kb = r / 512; t.W = w_in; t.ldw = INC; t.srccol = (nb < 320) ? 32 * nb : 10256 + 32 * (nb - 320); t.k0 = 64 * kb; t.WT = WIN; t.ldk = 2048; t.dstrow = 32 * nb; return t; }
        r -= I_IN;
        if (r < I_BP) { const int b = r / 1024, q = r % 1024, nb = q % 64, kb = q / 64; t.W = bp + (size_t)b * 1024 * 2048; t.ldw = 2048; t.srccol = 32 * nb; t.k0 = 64 * kb; t.WT = BP + (size_t)b * 2048 * 1024; t.ldk = 1024; t.dstrow = 32 * nb; return t; }
        r -= I_BP;
        if (r < I_WO) { const int nb = r % 64, kb = r / 64; t.W = wo; t.ldw = 2048; t.srccol = 32 * nb; t.k0 = 64 * kb; t.WT = WO; t.ldk = 2048; t.dstrow = 32 * nb; return t; }
        r -= I_WO;
        if (r < I_W13) { const int e = r / 1024, q = r % 1024, which = q / 512, q2 = q % 512, nb = q2 % 16, kb = q2 / 16; const int pn = nb >> 2, j = nb & 3;
            t.W = (which ? w3 : w1) + (size_t)e * 2048 * 512; t.ldw = 512; t.srccol = 32 * nb; t.k0 = 64 * kb; t.WT = W13 + (size_t)e * 1024 * 2048; t.ldk = 2048; t.dstrow = pn * 256 + which * 128 + 32 * j; return t; }
        r -= I_W13;
        if (r < I_W2) { const int e = r / 512, q = r % 512, nb = q % 64, kb = q / 64; t.W = w2 + (size_t)e * 512 * 2048; t.ldw = 2048; t.srccol = 32 * nb; t.k0 = 64 * kb; t.WT = W2 + (size_t)e * 2048 * 512; t.ldk = 512; t.dstrow = 32 * nb; return t; }
        r -= I_W2;
        { const int n = r / 16, q = r % 16, which = q / 8, q2 = q % 8, nb = q2 % 4, kb = q2 / 4; t.W = (which ? lwx : lwa) + (size_t)n * 16384; t.ldw = 128; t.srccol = 32 * nb; t.k0 = 64 * kb; t.WT = LWT + (size_t)n * 256 * 128; t.ldk = 128; t.dstrow = which * 128 + 32 * nb; return t; } };
    if (gw < NITEMS) { TItem ta = decode(gw); f32x4 xa[8]; titem_load(ta, xa, F.lane);
        for (int it = gw; it < NITEMS; it += NGW) { const int nx = it + NGW; TItem tb = ta; f32x4 xb[8];
            if (nx < NITEMS) { tb = decode(nx); titem_load(tb, xb, F.lane); }
            titem_store(ta, xa, scr, F.lane);
            if (nx < NITEMS) { ta = tb;
#pragma unroll
                for (int i = 0; i < 8; ++i) xa[i] = xb[i]; } } }
    float* rtw = (float*)(KWS() + WS_RTW); const float* rgw = KIN(21) + (size_t)l * 2048 * 4; const float* rew = KIN(23) + (size_t)l * 2048 * 32;
    for (int idx = F.bx * NTHR + F.tid; idx < 36 * 2048; idx += F.G * NTHR) { const int j = idx >> 11, k = idx & 2047; rtw[idx] = (j < 32) ? rew[k * 32 + j] : rgw[k * 4 + (j - 32)]; }
}

template <int MODE>
__device__ __forceinline__ void phase_norm(const Frame& F, const Params& p, int l, bool fold) {
    float* tA = (float*)(F.ldsg + 98304);
    float* tB = tA + 2048;
    float* tG = tB + 2048;
    const float* modv = (const float*)(KWS() + WS_MODV);
    const float* xin = (MODE == 0 && l == 0) ? KIN(0) : KOUT();
    float* xio = KOUT();
    bf16_t* H = (bf16_t*)(KWS() + WS_H);
    const bf16_t* SL = (const bf16_t*)(KWS() + WS_SLOT);
    for (int c = F.tid; c < 2048; c += NTHR) {
        if (MODE == 0) { tA[c] = KIN(5)[l * 2048 + c] * (1.f + modv[l * 12288 + MO_SC1 + c]); tB[c] = modv[l * 12288 + MO_SH1 + c]; }
        if (MODE == 1) { tA[c] = KIN(6)[l * 2048 + c] * (1.f + modv[l * 12288 + MO_SC2 + c]); tB[c] = modv[l * 12288 + MO_SH2 + c]; }
        if (MODE == 2) { tA[c] = KIN(28)[c]; tB[c] = 0.f; }
        tG[c] = fold ? DBG_MOE_SCALE * modv[(MODE == 2 ? 1 : l - 1) * 12288 + MO_GT2 + c] : 0.f;
    }
    __syncthreads();
    const int gw = F.bx * NWAVES + F.wave, NGW = F.G * NWAVES;
    const float* rtw = (const float*)(KWS() + WS_RTW);
    for (int row = gw; row < S_; row += NGW) {
        f32x4 v[8]; float ss = 0.f;
#pragma unroll
        for (int j = 0; j < 8; ++j) { const int c = 4 * F.lane + 256 * j; v[j] = *(const f32x4*)(xin + (size_t)row * 2048 + c);
            if (fold) { const u32x2 a = *(const u32x2*)(SL + (size_t)row * 2048 + c), b = *(const u32x2*)(SL + ((size_t)S_ + row) * 2048 + c); const f32x4 g = *(const f32x4*)(tG + c);
#if DBG_M == 1
                v[j][0] += g[0]; v[j][1] += g[1]; v[j][2] += g[2]; v[j][3] += g[3];
#else
                v[j][0] += g[0] * (bflo(a.x) + bflo(b.x)); v[j][1] += g[1] * (bfhi(a.x) + bfhi(b.x)); v[j][2] += g[2] * (bflo(a.y) + bflo(b.y)); v[j][3] += g[3] * (bfhi(a.y) + bfhi(b.y));
#endif
                if (MODE != 2) *(f32x4*)(xio + (size_t)row * 2048 + c) = v[j]; }
            ss += (v[j][0] * v[j][0] + v[j][1] * v[j][1]) + (v[j][2] * v[j][2] + v[j][3] * v[j][3]); }
        const float rstd = 1.0f / sqrtf(wave_sum(ss) * (1.0f / 2048.0f) + EPS);
#pragma unroll
        for (int j = 0; j < 8; ++j) { const int c = 4 * F.lane + 256 * j; const f32x4 a = *(const f32x4*)(tA + c), b = *(const f32x4*)(tB + c);
            v[j] = v[j] * rstd * a + b;
            if (MODE == 2) *(f32x4*)(xio + (size_t)row * 2048 + c) = v[j];
            else { u32x2 w; w.x = pk2(v[j][0], v[j][1]); w.y = pk2(v[j][2], v[j][3]); *(u32x2*)(H + (size_t)row * 2048 + c) = w; } }
        if (MODE == 1) {
            float mine = 0.f;
#pragma unroll 2
            for (int jo = 0; jo < 36; ++jo) { float d = 0.f;
#pragma unroll
                for (int j = 0; j < 8; ++j) { const f32x4 w = *(const f32x4*)(rtw + (size_t)jo * 2048 + 4 * F.lane + 256 * j); d += (v[j][0] * w[0] + v[j][1] * w[1]) + (v[j][2] * w[2] + v[j][3] * w[3]); }
                d = wave_sum(d); mine = (F.lane == jo) ? d : mine; }
            if (F.lane < 32) mine += KIN(24)[l * 32 + F.lane]; else if (F.lane < 36) mine += KIN(22)[l * 4 + (F.lane - 32)];
            const float g0 = __shfl(mine, 32), g1 = __shfl(mine, 33), g2 = __shfl(mine, 34), g3 = __shfl(mine, 35);
            int gs = 0; float gm = g0; if (g1 > gm) { gm = g1; gs = 1; } if (g2 > gm) { gm = g2; gs = 2; } if (g3 > gm) { gm = g3; gs = 3; }
            const float pg = 1.0f / (expf(g0 - gm) + expf(g1 - gm) + expf(g2 - gm) + expf(g3 - gm));
            float ev[8];
#pragma unroll
            for (int i = 0; i < 8; ++i) ev[i] = __shfl(mine, gs * 8 + i);
            int i0 = 0; float v0 = ev[0];
#pragma unroll
            for (int i = 1; i < 8; ++i) if (ev[i] > v0) { v0 = ev[i]; i0 = i; }
            int i1 = -1; float v1 = -3.0e38f;
#pragma unroll
            for (int i = 0; i < 8; ++i) if (i != i0 && ev[i] > v1) { v1 = ev[i]; i1 = i; }
            const float e1 = expf(v1 - v0);
#if DBG_M == 6
            const float w0 = 0.3f, w1 = 0.2f;
#elif DBG_M == 7
            const float w0 = pg, w1 = 0.f;
#elif DBG_M == 8
            const float w0 = 1.0f / (1.0f + e1), w1 = 0.f;
#else
            const float w0 = pg / (1.0f + e1), w1 = pg * e1 / (1.0f + e1);
#endif
            if (F.lane == 0) { unsigned* cnt = (unsigned*)(KWS() + WS_CTL) + CW_CNT + l * 32; const int ex0 = gs * 8 + i0, ex1 = gs * 8 + i1;
                const unsigned p0 = atomicAdd(cnt + ex0, 1u), p1 = atomicAdd(cnt + ex1, 1u);
                unsigned* tk = (unsigned*)(KWS() + WS_TOK) + (size_t)row * 8;
                tk[0] = (unsigned)ex0; tk[1] = p0; tk[2] = __builtin_bit_cast(unsigned, w0); tk[3] = 0u; tk[4] = (unsigned)ex1; tk[5] = p1; tk[6] = __builtin_bit_cast(unsigned, w1); tk[7] = 0u; }
        }
    }
}

__device__ __forceinline__ void phase_norm1_gab(const Frame& F, const Params& p, int l, bool fold) {
    float* tA = (float*)(F.ldsg + 98304); float* tB = tA + 2048; float* tG = tB + 2048;
    bf16_t* Wl = (bf16_t*)F.ldsg;
    const float* modv = (const float*)(KWS() + WS_MODV); const float* xin = (l == 0) ? KIN(0) : KOUT(); float* xio = KOUT(); bf16_t* H = (bf16_t*)(KWS() + WS_H);
    const bf16_t* SL = (const bf16_t*)(KWS() + WS_SLOT); float* GAB = (float*)(KWS() + WS_GAB);
    __syncthreads();
    for (int c = F.tid; c < 2048; c += NTHR) { tA[c] = KIN(5)[l * 2048 + c] * (1.f + modv[l * 12288 + MO_SC1 + c]); tB[c] = modv[l * 12288 + MO_SH1 + c]; tG[c] = fold ? modv[(l - 1) * 12288 + MO_GT2 + c] : 0.f; }
    { const float* gabw = (const float*)(KWS() + WS_GABW) + (size_t)l * 16 * 2048;
        for (int i = F.tid; i < 16 * 2048 / 4; i += NTHR) { const f32x4 v = *(const f32x4*)(gabw + 4 * i); u32x2 o; o.x = pk2(v[0], v[1]); o.y = pk2(v[2], v[3]); *(u32x2*)(Wl + 4 * i) = o; } }
    __syncthreads();
    const int gw = F.bx * NWAVES + F.wave, NGW = F.G * NWAVES;
    for (int rb = gw * 2; rb < S_; rb += NGW * 2) {
        f32x4 v[2][8];
#pragma unroll
        for (int r = 0; r < 2; ++r) { const size_t row = (size_t)(rb + r); float ss = 0.f;
#pragma unroll
            for (int j = 0; j < 8; ++j) { const int c = 4 * F.lane + 256 * j; v[r][j] = *(const f32x4*)(xin + row * 2048 + c);
                if (fold) { const u32x2 a = *(const u32x2*)(SL + row * 2048 + c), b = *(const u32x2*)(SL + ((size_t)S_ + row) * 2048 + c); const f32x4 g = *(const f32x4*)(tG + c);
                    v[r][j][0] += g[0] * (bflo(a.x) + bflo(b.x)); v[r][j][1] += g[1] * (bfhi(a.x) + bfhi(b.x)); v[r][j][2] += g[2] * (bflo(a.y) + bflo(b.y)); v[r][j][3] += g[3] * (bfhi(a.y) + bfhi(b.y));
                    *(f32x4*)(xio + row * 2048 + c) = v[r][j]; }
                ss += (v[r][j][0] * v[r][j][0] + v[r][j][1] * v[r][j][1]) + (v[r][j][2] * v[r][j][2] + v[r][j][3] * v[r][j][3]); }
            const float rstd = 1.0f / sqrtf(wave_sum(ss) * (1.0f / 2048.0f) + EPS);
#pragma unroll
            for (int j = 0; j < 8; ++j) { const int c = 4 * F.lane + 256 * j; const f32x4 a = *(const f32x4*)(tA + c), b = *(const f32x4*)(tB + c); v[r][j] = v[r][j] * rstd * a + b;
                u32x2 w; w.x = pk2(v[r][j][0], v[r][j][1]); w.y = pk2(v[r][j][2], v[r][j][3]); *(u32x2*)(H + row * 2048 + c) = w; }
            asm volatile("" ::: "memory"); }
        float mine[2] = {0.f, 0.f};
#pragma unroll 1
        for (int jo = 0; jo < 16; ++jo) { float d[2] = {0.f, 0.f};
#pragma unroll
            for (int j = 0; j < 8; ++j) { const u32x2 wq = *(const u32x2*)(Wl + jo * 2048 + 4 * F.lane + 256 * j); const float w0 = bflo(wq.x), w1 = bfhi(wq.x), w2 = bflo(wq.y), w3 = bfhi(wq.y);
#pragma unroll
                for (int r = 0; r < 2; ++r) { d[r] = __builtin_fmaf(v[r][j][0], w0, d[r]); d[r] = __builtin_fmaf(v[r][j][1], w1, d[r]); d[r] = __builtin_fmaf(v[r][j][2], w2, d[r]); d[r] = __builtin_fmaf(v[r][j][3], w3, d[r]); } }
#pragma unroll
            for (int r = 0; r < 2; ++r) { const float s = wave_sum(d[r]); mine[r] = (F.lane == jo) ? s : mine[r]; } }
        if (F.lane < 16) {
#pragma unroll
            for (int r = 0; r < 2; ++r) GAB[(size_t)(rb + r) * 16 + F.lane] = mine[r]; }
    }
}

__device__ __forceinline__ void phase_norm2_router(const Frame& F, const Params& p, int l) {
    float* tA = (float*)(F.ldsg + 98304); float* tB = tA + 2048;
    const float* modv = (const float*)(KWS() + WS_MODV); const float* xin = KOUT(); bf16_t* H = (bf16_t*)(KWS() + WS_H);
    for (int c = F.tid; c < 2048; c += NTHR) { tA[c] = KIN(6)[l * 2048 + c] * (1.f + modv[l * 12288 + MO_SC2 + c]); tB[c] = modv[l * 12288 + MO_SH2 + c]; }
    __syncthreads();
    const int gw = F.bx * NWAVES + F.wave, NGW = F.G * NWAVES; const float* rtw = (const float*)(KWS() + WS_RTW);
    const float be = (F.lane < 32) ? KIN(24)[l * 32 + F.lane] : ((F.lane < 36) ? KIN(22)[l * 4 + (F.lane - 32)] : 0.f);
    for (int rb = gw * 4; rb < S_; rb += NGW * 4) {
        f32x4 v[4][8];
#pragma unroll
        for (int r = 0; r < 4; ++r) { const size_t row = (size_t)(rb + r); float ss = 0.f;
#pragma unroll
            for (int j = 0; j < 8; ++j) { v[r][j] = *(const f32x4*)(xin + row * 2048 + 4 * F.lane + 256 * j); ss += (v[r][j][0] * v[r][j][0] + v[r][j][1] * v[r][j][1]) + (v[r][j][2] * v[r][j][2] + v[r][j][3] * v[r][j][3]); }
            const float rstd = 1.0f / sqrtf(wave_sum(ss) * (1.0f / 2048.0f) + EPS);
#pragma unroll
            for (int j = 0; j < 8; ++j) { const int c = 4 * F.lane + 256 * j; const f32x4 a = *(const f32x4*)(tA + c), b = *(const f32x4*)(tB + c); v[r][j] = v[r][j] * rstd * a + b;
                u32x2 w; w.x = pk2(v[r][j][0], v[r][j][1]); w.y = pk2(v[r][j][2], v[r][j][3]); *(u32x2*)(H + row * 2048 + c) = w; } }
        float mine[4] = {0.f, 0.f, 0.f, 0.f};
#pragma unroll 2
        for (int jo = 0; jo < 36; ++jo) { f32x4 wv[8];
#pragma unroll
            for (int j = 0; j < 8; ++j) wv[j] = *(const f32x4*)(rtw + (size_t)jo * 2048 + 4 * F.lane + 256 * j);
#pragma unroll
            for (int r = 0; r < 4; ++r) { float d = 0.f;
#pragma unroll
                for (int j = 0; j < 8; ++j) { d = __builtin_fmaf(v[r][j][0], wv[j][0], d); d = __builtin_fmaf(v[r][j][1], wv[j][1], d); d = __builtin_fmaf(v[r][j][2], wv[j][2], d); d = __builtin_fmaf(v[r][j][3], wv[j][3], d); }
                d = wave_sum(d); mine[r] = (F.lane == jo) ? d : mine[r]; } }
#pragma unroll
        for (int r = 0; r < 4; ++r) { const float lg = mine[r] + be; const int row = rb + r;
            const float g0 = __shfl(lg, 32), g1 = __shfl(lg, 33), g2 = __shfl(lg, 34), g3 = __shfl(lg, 35);
            int gs = 0; float gm = g0; if (g1 > gm) { gm = g1; gs = 1; } if (g2 > gm) { gm = g2; gs = 2; } if (g3 > gm) { gm = g3; gs = 3; }
            const float pg = 1.0f / (expf(g0 - gm) + expf(g1 - gm) + expf(g2 - gm) + expf(g3 - gm));
            float ev[8];
#pragma unroll
            for (int i = 0; i < 8; ++i) ev[i] = __shfl(lg, gs * 8 + i);
            int i0 = 0; float v0 = ev[0];
#pragma unroll
            for (int i = 1; i < 8; ++i) if (ev[i] > v0) { v0 = ev[i]; i0 = i; }
            int i1 = -1; float v1 = -3.0e38f;
#pragma unroll
            for (int i = 0; i < 8; ++i) if (i != i0 && ev[i] > v1) { v1 = ev[i]; i1 = i; }
            const float e1 = expf(v1 - v0); const float w0 = pg / (1.0f + e1), w1 = pg * e1 / (1.0f + e1);
            if (F.lane == 0) { unsigned* cnt = (unsigned*)(KWS() + WS_CTL) + CW_CNT + l * 32; const int ex0 = gs * 8 + i0, ex1 = gs * 8 + i1;
                const unsigned p0 = atomicAdd(cnt + ex0, 1u), p1 = atomicAdd(cnt + ex1, 1u);
                unsigned* tk = (unsigned*)(KWS() + WS_TOK) + (size_t)row * 8;
                tk[0] = (unsigned)ex0; tk[1] = p0; tk[2] = __float_as_uint(w0); tk[3] = 0u; tk[4] = (unsigned)ex1; tk[5] = p1; tk[6] = __float_as_uint(w1); tk[7] = 0u; } }
    }
}

__device__ __forceinline__ void phase_norm2_router_lds(const Frame& F, const Params& p, int l) {
    float* tA = (float*)(F.ldsg + 131072); float* tB = tA + 2048;
    const float* modv = (const float*)(KWS() + WS_MODV); const float* xin = KOUT(); bf16_t* H = (bf16_t*)(KWS() + WS_H);
    for (int c = F.tid; c < 2048; c += NTHR) { tA[c] = KIN(6)[l * 2048 + c] * (1.f + modv[l * 12288 + MO_SC2 + c]); tB[c] = modv[l * 12288 + MO_SH2 + c]; }
    const int gw = F.bx * NWAVES + F.wave, NGW = F.G * NWAVES, ng = S_ / (NGW * 4), w = F.wave, lane = F.lane;
    const unsigned char* rtwb = (const unsigned char*)(KWS() + WS_RTW);
    const float be = (lane < 32) ? KIN(24)[l * 32 + lane] : ((lane < 36) ? KIN(22)[l * 4 + (lane - 32)] : 0.f);
#pragma unroll
    for (int k = 0; k < 8; ++k) __builtin_amdgcn_global_load_lds((const unsigned*)(rtwb + (size_t)(w + 8 * k) * 1024 + lane * 16), (LAS unsigned*)(F.lds + (w + 8 * k) * 1024), 16, 0, 0);
    __syncthreads();
    int s = 0;
#pragma unroll 1
    for (int g = 0; g < ng; ++g) { const int rb = gw * 4 + g * NGW * 4;
        f32x4 v[4][8]; float mine[4] = {0.f, 0.f, 0.f, 0.f};
        { float rstd[4];
#pragma unroll
        for (int r = 0; r < 4; ++r) { const size_t row = (size_t)(rb + r); float ss = 0.f;
#pragma unroll
            for (int j = 0; j < 8; ++j) { v[r][j] = *(const f32x4*)(xin + row * 2048 + 4 * lane + 256 * j); ss += (v[r][j][0] * v[r][j][0] + v[r][j][1] * v[r][j][1]) + (v[r][j][2] * v[r][j][2] + v[r][j][3] * v[r][j][3]); }
            rstd[r] = 1.0f / sqrtf(wave_sum(ss) * (1.0f / 2048.0f) + EPS); }
#pragma unroll
        for (int j = 0; j < 8; ++j) { const int c = 4 * lane + 256 * j; const f32x4 a = *(const f32x4*)(tA + c), b = *(const f32x4*)(tB + c);
#pragma unroll
            for (int r = 0; r < 4; ++r) { v[r][j] = v[r][j] * rstd[r] * a + b;
                u32x2 wq; wq.x = pk2(v[r][j][0], v[r][j][1]); wq.y = pk2(v[r][j][2], v[r][j][3]); *(u32x2*)(H + (size_t)(rb + r) * 2048 + c) = wq; }
            asm volatile("" ::: "memory"); } }
        f32x2 vp[2][8][4];
#pragma unroll
        for (int rp = 0; rp < 2; ++rp)
#pragma unroll
            for (int j = 0; j < 8; ++j)
#pragma unroll
                for (int i = 0; i < 4; ++i) vp[rp][j][i] = (f32x2){v[2 * rp][j][i], v[2 * rp + 1][j][i]};
#pragma unroll 1
        for (int blk = 0; blk < 5; ++blk, ++s) {
            asm volatile("s_waitcnt vmcnt(0)" ::: "memory");
            __syncthreads();
            if (blk < 4 || g + 1 < ng) { const int nb = (blk + 1) % 5; const int nld = (nb == 4) ? 4 : 8; int lz = lane * 16; asm volatile("" : "+v"(lz));
                const unsigned char* src = rtwb + (size_t)nb * 65536 + lz; LAS unsigned char* dst = F.lds + ((s + 1) & 1) * 65536;
#pragma unroll
                for (int k = 0; k < 8; ++k) if (k < nld) __builtin_amdgcn_global_load_lds((const unsigned*)(src + (size_t)(w + 8 * k) * 1024), (LAS unsigned*)(dst + (w + 8 * k) * 1024), 16, 0, 0); }
            { int l4 = 4 * lane; asm volatile("" : "+v"(l4)); const LAS float* wb = (const LAS float*)(F.lds + (s & 1) * 65536) + l4; const int nout = (blk == 4) ? 4 : 8;
#pragma unroll 1
                for (int q = 0; q < nout; ++q) { f32x2 dp[2] = {(f32x2){0.f, 0.f}, (f32x2){0.f, 0.f}};
#pragma unroll
                    for (int j = 0; j < 8; ++j) { const f32x4 wv = *(const LAS f32x4*)(wb + q * 2048 + 256 * j);
#pragma unroll
                        for (int rp = 0; rp < 2; ++rp)
#pragma unroll
                            for (int i = 0; i < 4; ++i) dp[rp] = __builtin_elementwise_fma(vp[rp][j][i], (f32x2){wv[i], wv[i]}, dp[rp]);
                        if ((j & 1) == 1) asm volatile("" ::: "memory"); }
                    const float d[4] = {dp[0][0], dp[0][1], dp[1][0], dp[1][1]};
                    const int jo = blk * 8 + q;
#pragma unroll
                    for (int r = 0; r < 4; ++r) { const float sm = wave_sum(d[r]); mine[r] = (lane == jo) ? sm : mine[r]; } } }
        }
#pragma unroll
        for (int r = 0; r < 4; ++r) { const float lg = mine[r] + be; const int row = rb + r;
            const float g0 = __shfl(lg, 32), g1 = __shfl(lg, 33), g2 = __shfl(lg, 34), g3 = __shfl(lg, 35);
            int gs = 0; float gm = g0; if (g1 > gm) { gm = g1; gs = 1; } if (g2 > gm) { gm = g2; gs = 2; } if (g3 > gm) { gm = g3; gs = 3; }
            const float pg = 1.0f / (expf(g0 - gm) + expf(g1 - gm) + expf(g2 - gm) + expf(g3 - gm));
            float ev[8];
#pragma unroll
            for (int i = 0; i < 8; ++i) ev[i] = __shfl(lg, gs * 8 + i);
            int i0 = 0; float v0 = ev[0];
#pragma unroll
            for (int i = 1; i < 8; ++i) if (ev[i] > v0) { v0 = ev[i]; i0 = i; }
            int i1 = -1; float v1 = -3.0e38f;
#pragma unroll
            for (int i = 0; i < 8; ++i) if (i != i0 && ev[i] > v1) { v1 = ev[i]; i1 = i; }
            const float e1 = expf(v1 - v0); const float w0 = pg / (1.0f + e1), w1 = pg * e1 / (1.0f + e1);
            if (lane == 0) { unsigned* cnt = (unsigned*)(KWS() + WS_CTL) + CW_CNT + l * 32; const int ex0 = gs * 8 + i0, ex1 = gs * 8 + i1;
                const unsigned p0 = atomicAdd(cnt + ex0, 1u), p1 = atomicAdd(cnt + ex1, 1u);
                unsigned* tk = (unsigned*)(KWS() + WS_TOK) + (size_t)row * 8;
                tk[0] = (unsigned)ex0; tk[1] = p0; tk[2] = __float_as_uint(w0); tk[3] = 0u; tk[4] = (unsigned)ex1; tk[5] = p1; tk[6] = __float_as_uint(w1); tk[7] = 0u; } }
    }
}


__device__ __forceinline__ void moe_tables(const Frame& F, const Params& p, int l) {
    LAS int* tbl = (LAS int*)(F.lds + LDS_MISC + 64);
    int* gtbl = (int*)(KWS() + WS_ROWINFO + 512 * 1024);
    if (F.wave == 0) { const unsigned* cnt = (const unsigned*)(KWS() + WS_CTL) + CW_CNT + l * 32; const int e = F.lane;
        const int c = (e < 32) ? (int)__hip_atomic_load(cnt + e, __ATOMIC_RELAXED, __HIP_MEMORY_SCOPE_AGENT) : 0; const int t = (c + 255) >> 8;
        int incl = t;
#pragma unroll
        for (int o = 1; o < 32; o <<= 1) { const int v = __shfl_up(incl, o); if (e >= o) incl += v; }
        const int start = incl - t; const int total = __shfl(incl, 31);
        if (e < 32) { tbl[160 + e] = start; tbl[192 + e] = start * 256 + c; for (int k = 0; k < t && start + k < MAXTILES; ++k) tbl[start + k] = e; }
        const int nt = total < MAXTILES ? total : MAXTILES;
        for (int k = nt + e; k < MAXTILES; k += 64) tbl[k] = 0;
        if (e == 0) tbl[224] = nt; }
    __syncthreads();
    if (F.bx == 0 && F.tid < 225) gtbl[F.tid] = tbl[F.tid];
}
__device__ __forceinline__ void moe_tables_load(const Frame& F, const Params& p) {
    LAS int* tbl = (LAS int*)(F.lds + LDS_MISC + 64);
    const int* gtbl = (const int*)(KWS() + WS_ROWINFO + 512 * 1024);
    if (F.tid < 225) tbl[F.tid] = gtbl[F.tid];
    __syncthreads();
}
__device__ __forceinline__ void phase_gather(const Frame& F, const Params& p, int l) {
    moe_tables(F, p, l);
    const LAS int* tbl = (const LAS int*)(F.lds + LDS_MISC + 64);
    u32x2* rowinfo = (u32x2*)(KWS() + WS_ROWINFO); int* rowtok = (int*)(KWS() + WS_TOK + 512 * 1024);
    for (int a = F.bx * NTHR + F.tid; a < 2 * S_; a += F.G * NTHR) { const int t = a >> 1, k = a & 1; const unsigned* tk = (const unsigned*)(KWS() + WS_TOK) + (size_t)t * 8 + 4 * k;
        const int e = (int)tk[0], pos = (int)tk[1]; const int dest = tbl[160 + e] * 256 + pos; u32x2 inf; inf.x = (unsigned)a; inf.y = tk[2]; rowinfo[dest] = inf; rowtok[dest] = t; }
    if (F.bx < 32) { const int e = F.bx; const int r0 = tbl[192 + e]; const int tend = (e < 31 ? tbl[160 + e + 1] : tbl[224]) * 256;
        for (int r = r0 + F.tid; r < tend; r += NTHR) rowtok[r] = 0; }
}

__device__ __forceinline__ void phase_lru_gates(const Frame& F, const Params& p, int l) {
    float* U = (float*)F.ldsg;
    const bf16_t* Z = (const bf16_t*)(KWS() + WS_Z); float* LA = (float*)(KWS() + WS_MF); float* LB = LA + (size_t)S_ * 1024;
    const float* cw = KIN(8) + l * 4 * 1024; const float* cb = KIN(9) + l * 1024; const float* wa = KIN(10) + (size_t)l * 8 * 128 * 128; const float* ba = KIN(11) + l * 1024;
    const float* wx = KIN(12) + (size_t)l * 8 * 128 * 128; const float* bx = KIN(13) + l * 1024; const float* lam = KIN(14) + l * 1024;
    for (int u = F.bx; u < 4096; u += F.G) {
        const int tt = u >> 1, half = u & 1, t0 = tt * 8, ch = half * 512 + F.tid, n = ch >> 7, j = ch & 127;
        float xr[11];
#pragma unroll
        for (int i = 0; i < 11; ++i) { const int t = t0 - 3 + i; xr[i] = (t >= 0) ? bf2f(Z[(size_t)t * NZ + ZC_LX + ch]) : 0.f; }
        const float c0 = cw[ch], c1 = cw[1024 + ch], c2 = cw[2048 + ch], c3 = cw[3072 + ch], cbv = cb[ch];
        float uo[8];
#pragma unroll
        for (int i = 0; i < 8; ++i) { uo[i] = c0 * xr[i] + c1 * xr[i + 1] + c2 * xr[i + 2] + c3 * xr[i + 3] + cbv; U[i * 512 + F.tid] = uo[i]; }
        __syncthreads();
        float ar[8], ai[8];
#pragma unroll
        for (int i = 0; i < 8; ++i) { ar[i] = 0.f; ai[i] = 0.f; }
        const float* wap = wa + (size_t)n * 16384 + j; const float* wxp = wx + (size_t)n * 16384 + j; const float* up = U + (F.tid & ~127);
        for (int i = 0; i < 128; ++i) { const float a = wap[i * 128], x = wxp[i * 128];
#pragma unroll
            for (int tk = 0; tk < 8; ++tk) { const float uu = up[tk * 512 + i]; ar[tk] += uu * a; ai[tk] += uu * x; } }
        const float bav = ba[ch], bxv = bx[ch], spl = softplusf(-lam[ch]);
#pragma unroll
        for (int tk = 0; tk < 8; ++tk) { const float r = sigm(ar[tk] + bav), ii = sigm(ai[tk] + bxv); const float la = -8.0f * r * spl;
            LA[(size_t)(t0 + tk) * 1024 + ch] = expf(la); LB[(size_t)(t0 + tk) * 1024 + ch] = sqrtf(-expm1f(2.0f * la)) * (ii * uo[tk]); }
        __syncthreads();
    }
}


constexpr int LRU_UF_PITCH = 132, LRU_UB_PITCH = 136;
template <bool FINAL>
__device__ __forceinline__ void lru_units(const Frame& F, const Params& p, int l, int first, int stride) {
    float* Uf = (float*)F.ldsg;
    float* Al = Uf + 64 * LRU_UF_PITCH;
    bf16_t* Ub = (bf16_t*)(Al + 64 * LRU_UF_PITCH);
    float* Cw = (float*)(Ub + 64 * LRU_UB_PITCH);
    const bf16_t* Z = (const bf16_t*)(KWS() + WS_Z); const bf16_t* LWT = (const bf16_t*)(KWS() + WS_LWT);
    float* PHb = (float*)(KWS() + WS_LPH); const float* CAR = (const float*)(KWS() + WS_LCARRY); bf16_t* Y = (bf16_t*)(KWS() + WS_Y);
    const float* cw = KIN(8) + l * 4 * 1024; const float* cb = KIN(9) + l * 1024; const float* ba = KIN(11) + l * 1024; const float* bx = KIN(13) + l * 1024; const float* lam = KIN(14) + l * 1024;
    const int w = F.wave, lane = F.lane, fr = lane & 15, fg = lane >> 4;
    int cur_n = -1; bf16x8 Bf[2][4]; float bav = 0.f, bxv = 0.f, spl = 0.f;
    u32x4 raw[4][2];
#define LRU_RAW(u_) do { const int n_ = (u_) & 7, t0_ = ((u_) >> 3) * 64, tt_ = F.tid >> 3, cg_ = F.tid & 7; _Pragma("unroll") for (int k = 0; k < 4; ++k) { const int t = t0_ + tt_ - 3 + k; \
        if (t >= 0) { const bf16_t* zp = Z + (size_t)t * NZ + ZC_LX + n_ * 128 + 16 * cg_; raw[k][0] = *(const u32x4*)zp; raw[k][1] = *(const u32x4*)(zp + 8); } \
        else { raw[k][0] = (u32x4){0u, 0u, 0u, 0u}; raw[k][1] = raw[k][0]; } } } while (0)
    if (first < 2048) LRU_RAW(first);
    for (int u = first; u < 2048; u += stride) {
        const int n = u & 7, ci = u >> 3, t0 = ci * 64;
        if (n != cur_n) {
            cur_n = n;
#pragma unroll
            for (int q = 0; q < 2; ++q)
#pragma unroll
                for (int ks = 0; ks < 4; ++ks) Bf[q][ks] = *(const bf16x8*)(LWT + ((size_t)n * 256 + q * 128 + 16 * w + fr) * 128 + 32 * ks + 8 * fg);
            const int ch = n * 128 + 16 * w + fr; bav = ba[ch]; bxv = bx[ch]; spl = softplusf(-lam[ch]);
            __syncthreads();
            for (int i = F.tid; i < 640; i += NTHR) { const int k = i >> 7, c = i & 127; Cw[i] = (k < 4) ? cw[k * 1024 + n * 128 + c] : cb[n * 128 + c]; }
            __syncthreads();
        }
        { const int tt = F.tid >> 3, cg = F.tid & 7; float xr[4][16];
#pragma unroll
            for (int k = 0; k < 4; ++k) { const u32x4 a = raw[k][0], b = raw[k][1];
                xr[k][0] = bflo(a.x); xr[k][1] = bfhi(a.x); xr[k][2] = bflo(a.y); xr[k][3] = bfhi(a.y); xr[k][4] = bflo(a.z); xr[k][5] = bfhi(a.z); xr[k][6] = bflo(a.w); xr[k][7] = bfhi(a.w);
                xr[k][8] = bflo(b.x); xr[k][9] = bfhi(b.x); xr[k][10] = bflo(b.y); xr[k][11] = bfhi(b.y); xr[k][12] = bflo(b.z); xr[k][13] = bfhi(b.z); xr[k][14] = bflo(b.w); xr[k][15] = bfhi(b.w); }
            if (u + stride < 2048) LRU_RAW(u + stride);
            float uo[16];
#pragma unroll
            for (int i = 0; i < 16; ++i) { const int c = 16 * cg + i; uo[i] = Cw[c] * xr[0][i] + Cw[128 + c] * xr[1][i] + Cw[256 + c] * xr[2][i] + Cw[384 + c] * xr[3][i] + Cw[512 + c]; }
#pragma unroll
            for (int i = 0; i < 4; ++i) *(f32x4*)(Uf + tt * LRU_UF_PITCH + 16 * cg + 4 * i) = (f32x4){uo[4 * i], uo[4 * i + 1], uo[4 * i + 2], uo[4 * i + 3]};
            u32x4 o0, o1; o0.x = pk2(uo[0], uo[1]); o0.y = pk2(uo[2], uo[3]); o0.z = pk2(uo[4], uo[5]); o0.w = pk2(uo[6], uo[7]); o1.x = pk2(uo[8], uo[9]); o1.y = pk2(uo[10], uo[11]); o1.z = pk2(uo[12], uo[13]); o1.w = pk2(uo[14], uo[15]);
            *(u32x4*)(Ub + tt * LRU_UB_PITCH + 16 * cg) = o0; *(u32x4*)(Ub + tt * LRU_UB_PITCH + 16 * cg + 8) = o1; }
        __syncthreads();
        f32x4 acc[4][2];
#pragma unroll
        for (int mt = 0; mt < 4; ++mt) { acc[mt][0] = (f32x4){0.f, 0.f, 0.f, 0.f}; acc[mt][1] = acc[mt][0]; }
#pragma unroll
        for (int mt = 0; mt < 4; ++mt)
#pragma unroll
            for (int ks = 0; ks < 4; ++ks) { const bf16x8 af = *(const bf16x8*)(Ub + (16 * mt + fr) * LRU_UB_PITCH + 32 * ks + 8 * fg);
                acc[mt][0] = __builtin_amdgcn_mfma_f32_16x16x32_bf16(af, Bf[0][ks], acc[mt][0], 0, 0, 0);
                acc[mt][1] = __builtin_amdgcn_mfma_f32_16x16x32_bf16(af, Bf[1][ks], acc[mt][1], 0, 0, 0); }
#pragma unroll
        for (int mt = 0; mt < 4; ++mt)
#pragma unroll
            for (int r = 0; r < 4; ++r) { const int tk = 16 * mt + 4 * fg + r, cc = 16 * w + fr;
                const float rr = fsigm(acc[mt][0][r] + bav), ii = fsigm(acc[mt][1][r] + bxv), la = -8.0f * rr * spl;
                const float uu = Uf[tk * LRU_UF_PITCH + cc]; const float av = fexp(la);
                Al[tk * LRU_UF_PITCH + cc] = av; Uf[tk * LRU_UF_PITCH + cc] = __builtin_amdgcn_sqrtf(fmaxf(1.0f - av * av, 0.f)) * (ii * uu); }
        __syncthreads();
        { const int chl = F.tid & 127, seg = F.tid >> 7, ch = n * 128 + chl; float* SP = (float*)(Cw + 640); float* SH = SP + 512;
            unsigned short gq[16];
            if (FINAL) {
#pragma unroll
                for (int t = 0; t < 16; ++t) gq[t] = Z[(size_t)(t0 + 16 * seg + t) * NZ + ZC_LG + ch]; }
            float h = 0.f, P = 1.f;
#pragma unroll
            for (int t = 0; t < 16; ++t) { const float a = Al[(16 * seg + t) * LRU_UF_PITCH + chl], bb = Uf[(16 * seg + t) * LRU_UF_PITCH + chl]; h = a * h + bb; P *= a; }
            SP[seg * 128 + chl] = P; SH[seg * 128 + chl] = h;
            __syncthreads();
            float hin = FINAL ? CAR[(size_t)ci * 1024 + ch] : 0.f;
            if (FINAL) {
                for (int s = 0; s < seg; ++s) hin = SP[s * 128 + chl] * hin + SH[s * 128 + chl];
                h = hin;
#pragma unroll
                for (int t = 0; t < 16; ++t) { const float a = Al[(16 * seg + t) * LRU_UF_PITCH + chl], bb = Uf[(16 * seg + t) * LRU_UF_PITCH + chl]; h = a * h + bb;
                    const float g = bf2f(gq[t]); const float gl = g * fsigm(1.5957691216057308f * (g + 0.044715f * g * g * g));
                    Y[(size_t)(t0 + 16 * seg + t) * 3072 + 1024 + ch] = (bf16_t)f2bf(h * gl); }
            } else if (seg == 0) { float Pt = 1.f, Ht = 0.f;
#pragma unroll
                for (int s = 0; s < 4; ++s) { Ht = SP[s * 128 + chl] * Ht + SH[s * 128 + chl]; Pt *= SP[s * 128 + chl]; }
                *(f32x2*)(PHb + ((size_t)ci * 1024 + ch) * 2) = (f32x2){Pt, Ht}; } }
        __syncthreads();
    }
}
#undef LRU_RAW
__device__ __forceinline__ void lru_carry(const Frame& F, int part) {
    const float* PHb = (const float*)(KWS() + WS_LPH); float* CAR = (float*)(KWS() + WS_LCARRY);
    const int ch = part * 512 + F.tid; float h = 0.f;
    for (int c0 = 0; c0 < 256; c0 += 32) { f32x2 v[32];
#pragma unroll
        for (int i = 0; i < 32; ++i) v[i] = *(const f32x2*)(PHb + ((size_t)(c0 + i) * 1024 + ch) * 2);
#pragma unroll
        for (int i = 0; i < 32; ++i) { CAR[(size_t)(c0 + i) * 1024 + ch] = h; h = v[i][0] * h + v[i][1]; } }
}


constexpr int RT_PITCH = 136;
__device__ __forceinline__ float ret_log2g(int h) { return log2f(1.0f - exp2f(-5.0f - (float)h)); }
__device__ __forceinline__ void phase_gabw(const Frame& F) {
    float* gabw = (float*)(KWS() + WS_GABW); const float* w_in = KIN(7);
    for (int idx = F.bx * NTHR + F.tid; idx < 2 * 16 * 2048; idx += F.G * NTHR) { const int j = idx & 15, lk = idx >> 4, l = lk >> 11, k = lk & 2047; gabw[(l * 16 + j) * 2048 + k] = w_in[(size_t)lk * INC + 10240 + j]; }
}
__device__ __forceinline__ void phase_rope_table(const Frame& F) {
    float* RC = (float*)(KWS() + WS_ROPE_C); float* RS = (float*)(KWS() + WS_ROPE_S); const int* pos = (const int*)KIN(2);
    for (int idx = F.bx * NTHR + F.tid; idx < S_ * 64; idx += F.G * NTHR) { const int t = idx >> 6, i = idx & 63;
        const float invf = (float)exp2(-(double)i * (13.287712379549449 / 64.0)); const float angf = (float)pos[t] * invf;
        const double rev = (double)angf * 0.15915494309189535; const float fr = (float)(rev - rint(rev));
        RC[idx] = __builtin_amdgcn_cosf(fr); RS[idx] = __builtin_amdgcn_sinf(fr); }
}
template <bool ROPE>
__device__ __forceinline__ void stage_transposed(const Frame& F, const bf16_t* src  , int t0, bf16_t* T, float mul0, float mul1) {
    const int p = F.lane, c = F.wave; const float* RC = (const float*)(KWS() + WS_ROPE_C); const float* RS = (const float*)(KWS() + WS_ROPE_S);
    float a[2][8], b[2][8];
#pragma unroll
    for (int q = 0; q < 2; ++q) { const bf16_t* rp = src + (size_t)(2 * p + q) * NZ; unpack8(*(const u32x4*)(rp + 8 * c), a[q]); unpack8(*(const u32x4*)(rp + 64 + 8 * c), b[q]);
        if (ROPE) { const size_t ro = (size_t)(t0 + 2 * p + q) * 64 + 8 * c; const f32x4 c0 = *(const f32x4*)(RC + ro), c1 = *(const f32x4*)(RC + ro + 4), s0 = *(const f32x4*)(RS + ro), s1 = *(const f32x4*)(RS + ro + 4);
#pragma unroll
            for (int i = 0; i < 8; ++i) { const float cs = i < 4 ? c0[i & 3] : c1[i & 3], sn = i < 4 ? s0[i & 3] : s1[i & 3]; const float x1 = a[q][i], x2 = b[q][i]; a[q][i] = x1 * cs - x2 * sn; b[q][i] = x2 * cs + x1 * sn; } }
        const float m = q ? mul1 : mul0;
#pragma unroll
        for (int i = 0; i < 8; ++i) { a[q][i] *= m; b[q][i] *= m; } }
#pragma unroll
    for (int i = 0; i < 8; ++i) { *(unsigned*)(T + (8 * c + i) * RT_PITCH + 2 * p) = pk2(a[0][i], a[1][i]); *(unsigned*)(T + (64 + 8 * c + i) * RT_PITCH + 2 * p) = pk2(b[0][i], b[1][i]); }
}
__device__ __forceinline__ void stage_natural_rope(const Frame& F, const bf16_t* src, int t0, bf16_t* N, float mul) {
    const float* RC = (const float*)(KWS() + WS_ROPE_C); const float* RS = (const float*)(KWS() + WS_ROPE_S);
#pragma unroll
    for (int rep = 0; rep < 2; ++rep) { const int c = F.tid & 7, tok = (F.tid >> 3) + 64 * rep; const bf16_t* rp = src + (size_t)tok * NZ; float a[8], b[8];
        unpack8(*(const u32x4*)(rp + 8 * c), a); unpack8(*(const u32x4*)(rp + 64 + 8 * c), b);
        const size_t ro = (size_t)(t0 + tok) * 64 + 8 * c; const f32x4 c0 = *(const f32x4*)(RC + ro), c1 = *(const f32x4*)(RC + ro + 4), s0 = *(const f32x4*)(RS + ro), s1 = *(const f32x4*)(RS + ro + 4);
        float y1[8], y2[8];
#pragma unroll
        for (int i = 0; i < 8; ++i) { const float cs = i < 4 ? c0[i & 3] : c1[i & 3], sn = i < 4 ? s0[i & 3] : s1[i & 3]; y1[i] = (a[i] * cs - b[i] * sn) * mul; y2[i] = (b[i] * cs + a[i] * sn) * mul; }
        u32x4 o1, o2; o1.x = pk2(y1[0], y1[1]); o1.y = pk2(y1[2], y1[3]); o1.z = pk2(y1[4], y1[5]); o1.w = pk2(y1[6], y1[7]); o2.x = pk2(y2[0], y2[1]); o2.y = pk2(y2[2], y2[3]); o2.z = pk2(y2[4], y2[5]); o2.w = pk2(y2[6], y2[7]);
        *(u32x4*)(N + tok * RT_PITCH + 8 * c) = o1; *(u32x4*)(N + tok * RT_PITCH + 64 + 8 * c) = o2; }
}

struct RopeCS { f32x4 c0, c1, s0, s1; };
__device__ __forceinline__ void rope_store_natural(bf16_t* N, int tok, int c, const u32x4 xa, const u32x4 xb, const RopeCS& cs, float mul) {
    float a[8], b[8]; unpack8(xa, a); unpack8(xb, b); float y1[8], y2[8];
#pragma unroll
    for (int i = 0; i < 8; ++i) { const float co = i < 4 ? cs.c0[i & 3] : cs.c1[i & 3], sn = i < 4 ? cs.s0[i & 3] : cs.s1[i & 3]; y1[i] = (a[i] * co - b[i] * sn) * mul; y2[i] = (b[i] * co + a[i] * sn) * mul; }
    u32x4 o1, o2; o1.x = pk2(y1[0], y1[1]); o1.y = pk2(y1[2], y1[3]); o1.z = pk2(y1[4], y1[5]); o1.w = pk2(y1[6], y1[7]); o2.x = pk2(y2[0], y2[1]); o2.y = pk2(y2[2], y2[3]); o2.z = pk2(y2[4], y2[5]); o2.w = pk2(y2[6], y2[7]);
    *(u32x4*)(N + tok * RT_PITCH + 8 * c) = o1; *(u32x4*)(N + tok * RT_PITCH + 64 + 8 * c) = o2;
}
template <bool ROPE>
__device__ __forceinline__ void store_transposed(bf16_t* T, int p, int c, const u32x4 (&xa)[2], const u32x4 (&xb)[2], const RopeCS (&cs)[2], float mul0, float mul1) {
    float a[2][8], b[2][8];
#pragma unroll
    for (int q = 0; q < 2; ++q) { unpack8(xa[q], a[q]); unpack8(xb[q], b[q]);
        if (ROPE) {
#pragma unroll
            for (int i = 0; i < 8; ++i) { const float co = i < 4 ? cs[q].c0[i & 3] : cs[q].c1[i & 3], sn = i < 4 ? cs[q].s0[i & 3] : cs[q].s1[i & 3]; const float x1 = a[q][i], x2 = b[q][i]; a[q][i] = x1 * co - x2 * sn; b[q][i] = x2 * co + x1 * sn; } }
        const float m = q ? mul1 : mul0;
#pragma unroll
        for (int i = 0; i < 8; ++i) { a[q][i] *= m; b[q][i] *= m; } }
#pragma unroll
    for (int i = 0; i < 8; ++i) { *(unsigned*)(T + (8 * c + i) * RT_PITCH + 2 * p) = pk2(a[0][i], a[1][i]); *(unsigned*)(T + (64 + 8 * c + i) * RT_PITCH + 2 * p) = pk2(b[0][i], b[1][i]); }
}
__device__ __forceinline__ RopeCS load_cs(int tok_global, int c) { const float* RC = (const float*)(KWS() + WS_ROPE_C); const float* RS = (const float*)(KWS() + WS_ROPE_S); const size_t ro = (size_t)tok_global * 64 + 8 * c;
    RopeCS r; r.c0 = *(const f32x4*)(RC + ro); r.c1 = *(const f32x4*)(RC + ro + 4); r.s0 = *(const f32x4*)(RS + ro); r.s1 = *(const f32x4*)(RS + ro + 4); return r; }
__device__ __forceinline__ void ret_units_a(const Frame& F, int first, int stride) {
    bf16_t* Kt = (bf16_t*)F.ldsg; bf16_t* Vt = Kt + 128 * RT_PITCH;
    const bf16_t* Z = (const bf16_t*)(KWS() + WS_Z); float* KV = (float*)(KWS() + WS_KV);
    const int w = F.wave, lane = F.lane, fr = lane & 15, fg = lane >> 4, pp = F.lane, cw = F.wave;
    u32x4 ka[2], kb[2], va[2], vb[2]; RopeCS cs[2];
#define RETA_RAW(u_) do { const int h_ = (u_) & 7, t0_ = ((u_) >> 3) * 128; const bf16_t* zk = Z + (size_t)t0_ * NZ + ZC_RK + h_ * 128; const bf16_t* zv = Z + (size_t)t0_ * NZ + ZC_RV + h_ * 128; \
        _Pragma("unroll") for (int q = 0; q < 2; ++q) { const size_t ro = (size_t)(2 * pp + q) * NZ; ka[q] = *(const u32x4*)(zk + ro + 8 * cw); kb[q] = *(const u32x4*)(zk + ro + 64 + 8 * cw); \
            va[q] = *(const u32x4*)(zv + ro + 8 * cw); vb[q] = *(const u32x4*)(zv + ro + 64 + 8 * cw); cs[q] = load_cs(t0_ + 2 * pp + q, cw); } } while (0)
    if (first < 1024) RETA_RAW(first);
    for (int u = first; u < 1024; u += stride) {
        const int h = u & 7, n = u >> 3; const float l2g = ret_log2g(h);
        const float m0 = 0.08838834764831845f * exp2f((float)(127 - 2 * lane) * l2g), m1 = 0.08838834764831845f * exp2f((float)(126 - 2 * lane) * l2g);
        store_transposed<true>(Kt, pp, cw, ka, kb, cs, m0, m1); store_transposed<false>(Vt, pp, cw, va, vb, cs, 1.0f, 1.0f);
        if (u + stride < 1024) RETA_RAW(u + stride);
        __syncthreads();
        f32x4 acc[8];
#pragma unroll
        for (int nt = 0; nt < 8; ++nt) acc[nt] = (f32x4){0.f, 0.f, 0.f, 0.f};
#pragma unroll
        for (int ks = 0; ks < 4; ++ks) { const bf16x8 af = *(const bf16x8*)(Kt + (16 * w + fr) * RT_PITCH + 32 * ks + 8 * fg);
#pragma unroll
            for (int nt = 0; nt < 8; ++nt) { const bf16x8 bfr = *(const bf16x8*)(Vt + (16 * nt + fr) * RT_PITCH + 32 * ks + 8 * fg); acc[nt] = __builtin_amdgcn_mfma_f32_16x16x32_bf16(af, bfr, acc[nt], 0, 0, 0); } }
        float* kvp = KV + ((size_t)(n * 8 + h) * 128) * 128;
#pragma unroll
        for (int nt = 0; nt < 8; ++nt) *(f32x4*)(kvp + (size_t)(16 * nt + fr) * 128 + 16 * w + 4 * fg) = acc[nt];
        __syncthreads();
    }
#undef RETA_RAW
}
__device__ __forceinline__ void ret_scan(const Frame& F, int wg, int nwg) {
    float* KV = (float*)(KWS() + WS_KV);
    for (int idx = wg * NTHR + F.tid; idx < 8 * 8192; idx += nwg * NTHR) { const int h = idx >> 13, ed = (idx & 8191) * 2; const float cd = exp2f(128.0f * ret_log2g(h)); f32x2 R = (f32x2){0.f, 0.f};
        for (int n0 = 0; n0 < 128; n0 += 16) { f32x2 v[16];
#pragma unroll
            for (int i = 0; i < 16; ++i) v[i] = *(const f32x2*)(KV + ((size_t)((n0 + i) * 8 + h) << 14) + ed);
#pragma unroll
            for (int i = 0; i < 16; ++i) { *(f32x2*)(KV + ((size_t)((n0 + i) * 8 + h) << 14) + ed) = R; R[0] = cd * R[0] + v[i][0]; R[1] = cd * R[1] + v[i][1]; } } }
}
__device__ __forceinline__ void ret_units_c(const Frame& F, int first, int stride) {
    bf16_t* Qs = (bf16_t*)F.ldsg; bf16_t* Ks = Qs + 128 * RT_PITCH; bf16_t* Vt = Ks + 128 * RT_PITCH; bf16_t* Rt = Vt + 128 * RT_PITCH;
    const bf16_t* Z = (const bf16_t*)(KWS() + WS_Z); const float* KV = (const float*)(KWS() + WS_KV); bf16_t* Y = (bf16_t*)(KWS() + WS_Y);
    const int w = F.wave, lane = F.lane, fr = lane & 15, fg = lane >> 4;
    for (int u = first; u < 1024; u += stride) {
        const int h = u & 7, n = u >> 3, t0 = n * 128; const float l2g = ret_log2g(h);
        { const int pp = F.lane, cw = F.wave, cn = F.tid & 7; const bf16_t* zq = Z + (size_t)t0 * NZ + ZC_RQ + h * 128; const bf16_t* zk = Z + (size_t)t0 * NZ + ZC_RK + h * 128; const bf16_t* zv = Z + (size_t)t0 * NZ + ZC_RV + h * 128;
            const float* kvp = KV + ((size_t)(n * 8 + h) << 14);
            u32x4 qa[2], qb[2], ka[2], kb[2], va[2], vb[2]; RopeCS cs[2]; f32x4 rv[8];
#pragma unroll
            for (int rep = 0; rep < 2; ++rep) { const int tok = (F.tid >> 3) + 64 * rep; const size_t ro = (size_t)tok * NZ; qa[rep] = *(const u32x4*)(zq + ro + 8 * cn); qb[rep] = *(const u32x4*)(zq + ro + 64 + 8 * cn);
                ka[rep] = *(const u32x4*)(zk + ro + 8 * cn); kb[rep] = *(const u32x4*)(zk + ro + 64 + 8 * cn); cs[rep] = load_cs(t0 + tok, cn); }
#pragma unroll
            for (int q = 0; q < 2; ++q) { const size_t ro = (size_t)(2 * pp + q) * NZ; va[q] = *(const u32x4*)(zv + ro + 8 * cw); vb[q] = *(const u32x4*)(zv + ro + 64 + 8 * cw); }
#pragma unroll
            for (int i = 0; i < 8; ++i) { const int i4 = F.tid + NTHR * i; rv[i] = *(const f32x4*)(kvp + (i4 >> 5) * 128 + (i4 & 31) * 4); }
#pragma unroll
            for (int rep = 0; rep < 2; ++rep) { const int tok = (F.tid >> 3) + 64 * rep; rope_store_natural(Qs, tok, cn, qa[rep], qb[rep], cs[rep], 1.0f); rope_store_natural(Ks, tok, cn, ka[rep], kb[rep], cs[rep], 0.08838834764831845f); }
            store_transposed<false>(Vt, pp, cw, va, vb, cs, 1.0f, 1.0f);
#pragma unroll
            for (int i = 0; i < 8; ++i) { const int i4 = F.tid + NTHR * i, e = i4 >> 5, d4 = (i4 & 31) * 4; u32x2 o; o.x = pk2(rv[i][0], rv[i][1]); o.y = pk2(rv[i][2], rv[i][3]); *(u32x2*)(Rt + e * RT_PITCH + d4) = o; } }
        if (u + stride < 1024) { const int un = u + stride, hn = un & 7, nn = un >> 3; const int part = F.tid & 3, tokn = F.tid >> 2;
            const bf16_t* zr = Z + (size_t)(nn * 128 + tokn) * NZ + (part == 0 ? ZC_RQ : part == 1 ? ZC_RK : ZC_RV) + hn * 128;
            if (part < 3) { (void)*(const volatile unsigned*)zr; (void)*(const volatile unsigned*)(zr + 64); }
            (void)*(const volatile unsigned*)(KV + ((size_t)(nn * 8 + hn) << 14) + F.tid * 32); }
        __syncthreads();
#pragma unroll 1
        for (int half = 0; half < 2; ++half) {
            const int T = half ? 7 - w : w;
            u32x2 gpre[8]; { const size_t tgp = (size_t)(t0 + 16 * T + fr);
#pragma unroll
                for (int mt = 0; mt < 8; ++mt) gpre[mt] = *(const u32x2*)(Z + tgp * NZ + ZC_RG + h * 128 + 16 * mt + 4 * fg); }
            bf16x8 qf[4];
#pragma unroll
            for (int ks = 0; ks < 4; ++ks) qf[ks] = *(const bf16x8*)(Qs + (16 * T + fr) * RT_PITCH + 32 * ks + 8 * fg);
            f32x4 ao[8], ar[8];
#pragma unroll
            for (int mt = 0; mt < 8; ++mt) { ao[mt] = (f32x4){0.f, 0.f, 0.f, 0.f}; ar[mt] = ao[mt]; }
#pragma unroll
            for (int mt = 0; mt < 8; ++mt)
#pragma unroll
                for (int ks = 0; ks < 4; ++ks) { const bf16x8 af = *(const bf16x8*)(Rt + (16 * mt + fr) * RT_PITCH + 32 * ks + 8 * fg); ar[mt] = __builtin_amdgcn_mfma_f32_16x16x32_bf16(af, qf[ks], ar[mt], 0, 0, 0);
                    if (ks == 3 && (mt & 3) == 3) asm volatile("" ::: "memory"); }
            const int il = 16 * T + fr;
            for (int kp = 0; kp <= (T >> 1); ++kp) {
                u32x2 pt[2];
#pragma unroll
                for (int q = 0; q < 2; ++q) { const int jt = 2 * kp + q; f32x4 s = (f32x4){0.f, 0.f, 0.f, 0.f};
                    if (jt <= T) {
#pragma unroll
                        for (int ks = 0; ks < 4; ++ks) { const bf16x8 kf = *(const bf16x8*)(Ks + (16 * jt + fr) * RT_PITCH + 32 * ks + 8 * fg); s = __builtin_amdgcn_mfma_f32_16x16x32_bf16(kf, qf[ks], s, 0, 0, 0); }
#pragma unroll
                        for (int r = 0; r < 4; ++r) { const int jl = 16 * jt + 4 * fg + r; s[r] = (il >= jl) ? s[r] * __builtin_amdgcn_exp2f((float)(il - jl) * l2g) : 0.f; }
                        asm volatile("" ::: "memory"); }
                    pt[q].x = pk2(s[0], s[1]); pt[q].y = pk2(s[2], s[3]); }
                bf16x8 pf; { u32x4 t4; t4.x = pt[0].x; t4.y = pt[0].y; t4.z = pt[1].x; t4.w = pt[1].y; pf = __builtin_bit_cast(bf16x8, t4); }
#pragma unroll
                for (int mt = 0; mt < 8; ++mt) { const u32x2 v0 = *(const u32x2*)(Vt + (16 * mt + fr) * RT_PITCH + 32 * kp + 4 * fg), v1 = *(const u32x2*)(Vt + (16 * mt + fr) * RT_PITCH + 32 * kp + 16 + 4 * fg);
                    u32x4 t4; t4.x = v0.x; t4.y = v0.y; t4.z = v1.x; t4.w = v1.y; const bf16x8 vf = __builtin_bit_cast(bf16x8, t4);
                    ao[mt] = __builtin_amdgcn_mfma_f32_16x16x32_bf16(vf, pf, ao[mt], 0, 0, 0); if (mt == 7) asm volatile("" ::: "memory"); } }
            const float qd = exp2f((float)(il + 1) * l2g); float ss = 0.f;
#pragma unroll
            for (int mt = 0; mt < 8; ++mt) { ao[mt] = ao[mt] + ar[mt] * qd; ss += (ao[mt][0] * ao[mt][0] + ao[mt][1] * ao[mt][1]) + (ao[mt][2] * ao[mt][2] + ao[mt][3] * ao[mt][3]); }
            ss += __shfl_xor(ss, 16); ss += __shfl_xor(ss, 32);
            const float rstd = 1.0f / sqrtf(ss * (1.0f / 128.0f) + EPS); const size_t tg = (size_t)(t0 + il);
#pragma unroll
            for (int mt = 0; mt < 8; ++mt) { const int e0 = h * 128 + 16 * mt + 4 * fg; const u32x2 gw = gpre[mt];
                u32x2 o; o.x = pk2(ao[mt][0] * rstd * fsilu(bflo(gw.x)), ao[mt][1] * rstd * fsilu(bfhi(gw.x))); o.y = pk2(ao[mt][2] * rstd * fsilu(bflo(gw.y)), ao[mt][3] * rstd * fsilu(bfhi(gw.y)));
                *(u32x2*)(Y + tg * 3072 + e0) = o; }
        }
        __syncthreads();
    }
}


constexpr int GP = 136;
constexpr int GMP = 68;
constexpr int GS_FRAGS = 32, GS_PACK_BYTES = GS_FRAGS * 1024, GO_FRAGS = 24, GO_PACK_BYTES = GO_FRAGS * 1024;
__device__ __forceinline__ bf16x8 mk_frag(u32x2 lo, u32x2 hi) { u32x4 t; t.x = lo.x; t.y = lo.y; t.z = hi.x; t.w = hi.y; return __builtin_bit_cast(bf16x8, t); }
__device__ __forceinline__ bf16x8 pack_acc2(const f32x4 a, const f32x4 b) { u32x4 t; t.x = pk2(a[0], a[1]); t.y = pk2(a[2], a[3]); t.z = pk2(b[0], b[1]); t.w = pk2(b[2], b[3]); return __builtin_bit_cast(bf16x8, t); }
__device__ __forceinline__ u32x4 tile_frag_scaled(const bf16_t* T, int mt, int ks, int fr, int fg, float sc) {
    const u32x2 lo = *(const u32x2*)(T + (16 * mt + fr) * GP + 32 * ks + 4 * fg), hi = *(const u32x2*)(T + (16 * mt + fr) * GP + 32 * ks + 16 + 4 * fg);
    u32x4 o; o.x = pk2(bflo(lo.x) * sc, bfhi(lo.x) * sc); o.y = pk2(bflo(lo.y) * sc, bfhi(lo.y) * sc); o.z = pk2(bflo(hi.x) * sc, bfhi(hi.x) * sc); o.w = pk2(bflo(hi.y) * sc, bfhi(hi.y) * sc); return o;
}
__device__ __forceinline__ void gdn_units_a(const Frame& F, const Params& p, int l) {
    bf16_t* Qn = (bf16_t*)F.ldsg; bf16_t* Kn = Qn + 64 * GP; bf16_t* Vn = Kn + 64 * GP; bf16_t* Wl = Vn + 64 * GP;
    float* Mm = (float*)(Wl + 64 * GP);
    float* gcv = Mm + 64 * GMP; float* bet = gcv + 64; float* beg = bet + 64; float* ekd = beg + 64; float* egc = ekd + 64;
    float* cwl = egc + 64;
    const bf16_t* Z = (const bf16_t*)(KWS() + WS_Z); const float* GAB = (const float*)(KWS() + WS_GAB);
    unsigned char* P2 = KWS() + WS_GP2; float* UP = (float*)(KWS() + WS_GUP); float* GL = (float*)(KWS() + WS_GGL);
    const float* cw = KIN(15) + (size_t)l * 4 * 3072;
    const int w = F.wave, lane = F.lane, fr = lane & 15, fg = lane >> 4;
    int cur_h = -1; float Aexp = 0.f, dtb = 0.f;
    for (int u = F.bx; u < 2048; u += F.G) {
        const int h = u & 7, n = u >> 3, t0 = n * 64;
        if (h != cur_h) { cur_h = h; Aexp = expf(KIN(16)[l * 8 + h]); dtb = KIN(17)[l * 8 + h];
            __syncthreads();
            for (int i = F.tid; i < 1536; i += NTHR) { const int ten = i >> 9, k = (i >> 7) & 3, c = i & 127; cwl[i] = cw[k * 3072 + ten * 1024 + h * 128 + c]; }
            __syncthreads(); }
        { const int tt = F.tid >> 3, cg = F.tid & 7;
#pragma unroll
            for (int ten = 0; ten < 3; ++ten) { float y[16];
#pragma unroll
                for (int i = 0; i < 16; ++i) y[i] = 0.f;
#pragma unroll
                for (int k = 0; k < 4; ++k) { const int t = t0 + tt - 3 + k;
                    if (t >= 0) { const bf16_t* zp = Z + (size_t)t * NZ + ZC_GQ + ten * 1024 + h * 128 + 16 * cg; float x[16]; float x8a[8], x8b[8]; unpack8(*(const u32x4*)zp, x8a); unpack8(*(const u32x4*)(zp + 8), x8b);
#pragma unroll
                        for (int i = 0; i < 8; ++i) { x[i] = x8a[i]; x[8 + i] = x8b[i]; }
#pragma unroll
                        for (int i = 0; i < 16; ++i) y[i] += cwl[(ten * 4 + k) * 128 + 16 * cg + i] * x[i]; } }
                float ss = 0.f;
#pragma unroll
                for (int i = 0; i < 16; ++i) { y[i] = fsilu(y[i]); ss += y[i] * y[i]; }
                float mul = 1.0f;
                if (ten < 2) { ss += __shfl_xor(ss, 1); ss += __shfl_xor(ss, 2); ss += __shfl_xor(ss, 4); mul = (1.0f / sqrtf(ss + EPS)) * (ten == 0 ? 0.08838834764831845f : 1.0f); }
                bf16_t* dst = (ten == 0 ? Qn : (ten == 1 ? Kn : Vn)) + tt * GP + 16 * cg; u32x4 o0, o1;
                o0.x = pk2(y[0] * mul, y[1] * mul); o0.y = pk2(y[2] * mul, y[3] * mul); o0.z = pk2(y[4] * mul, y[5] * mul); o0.w = pk2(y[6] * mul, y[7] * mul);
                o1.x = pk2(y[8] * mul, y[9] * mul); o1.y = pk2(y[10] * mul, y[11] * mul); o1.z = pk2(y[12] * mul, y[13] * mul); o1.w = pk2(y[14] * mul, y[15] * mul);
                *(u32x4*)dst = o0; *(u32x4*)(dst + 8) = o1;
                asm volatile("" ::: "memory"); } }
        if (w == 0) { const size_t gi = (size_t)(t0 + lane) * 16; const float g = -Aexp * softplusf(GAB[gi + h] + dtb); const float beta = sigm(GAB[gi + 8 + h]);
            float gc = g;
#pragma unroll
            for (int o = 1; o < 64; o <<= 1) { const float t = __shfl_up(gc, o); if (lane >= o) gc += t; }
            const float gl = __shfl(gc, 63);
            gcv[lane] = gc; bet[lane] = beta; { const float eg = expf(gc); egc[lane] = eg; beg[lane] = beta * eg; } ekd[lane] = expf(gl - gc);
            if (lane == 0) GL[u] = expf(gl); }
        __syncthreads();
        unsigned char* pk = P2 + (size_t)u * GS_PACK_BYTES; unsigned char* pko = KWS() + WS_GPO + (size_t)u * GO_PACK_BYTES;
        { const int mt = w >> 1;
#pragma unroll
            for (int q = 0; q < 2; ++q) { const int nt = 2 * (w & 1) + q;
                if (nt <= mt) { f32x4 s = (f32x4){0.f, 0.f, 0.f, 0.f};
#pragma unroll
                    for (int ks = 0; ks < 4; ++ks) { const bf16x8 af = *(const bf16x8*)(Kn + (16 * mt + fr) * GP + 32 * ks + 8 * fg), bf_ = *(const bf16x8*)(Kn + (16 * nt + fr) * GP + 32 * ks + 8 * fg); s = __builtin_amdgcn_mfma_f32_16x16x32_bf16(af, bf_, s, 0, 0, 0); }
                    const int j = 16 * nt + fr; const float gj = gcv[j];
#pragma unroll
                    for (int r = 0; r < 4; ++r) { const int i = 16 * mt + 4 * fg + r; Mm[i * GMP + j] = (i > j) ? bet[i] * s[r] * fexp(gcv[i] - gj) : 0.f; } } } }
        { const int it = w >> 1, ksA = w & 1; f32x4 s2[2];
#pragma unroll
            for (int q = 0; q < 2; ++q) { const int jt = 2 * ksA + q; s2[q] = (f32x4){0.f, 0.f, 0.f, 0.f};
                if (jt <= it) {
#pragma unroll
                    for (int ks = 0; ks < 4; ++ks) { const bf16x8 af = *(const bf16x8*)(Kn + (16 * jt + fr) * GP + 32 * ks + 8 * fg), bf_ = *(const bf16x8*)(Qn + (16 * it + fr) * GP + 32 * ks + 8 * fg); s2[q] = __builtin_amdgcn_mfma_f32_16x16x32_bf16(af, bf_, s2[q], 0, 0, 0); }
                    const int i = 16 * it + fr; const float gi = gcv[i];
#pragma unroll
                    for (int r = 0; r < 4; ++r) { const int j = 16 * jt + 4 * fg + r; s2[q][r] = (i >= j) ? s2[q][r] * fexp(gi - gcv[j]) : 0.f; } } }
            *(bf16x8*)(pko + (size_t)(16 + it * 2 + ksA) * 1024 + lane * 16) = pack_acc2(s2[0], s2[1]); }
        __syncthreads();
        if (w < 4) { const int c = F.tid; float sol[64];
#pragma unroll
            for (int i = 0; i < 64; ++i) sol[i] = 0.f;
            LAS const bf16_t* colp = (LAS const bf16_t*)(F.lds) + ((c < 128) ? (2 * 64 * GP + c) : (64 * GP + (c - 128))); asm volatile("" : "+v"(colp));
            LAS const float* mm = (LAS const float*)(F.lds + 4 * 64 * GP * 2); asm volatile("" : "+v"(mm));
            LAS const float* tb = mm + 64 * GMP + ((c < 128) ? 64 : 128); asm volatile("" : "+v"(tb));
#pragma unroll
            for (int i = 0; i < 64; ++i) { float a = bf2f(colp[i * GP]) * tb[i];
#pragma unroll
                for (int jb = 0; jb < (i + 3) / 4; ++jb) { const f32x4 m4 = *(LAS const f32x4*)(mm + i * GMP + 4 * jb);
                    a -= m4[0] * sol[4 * jb]; a -= m4[1] * sol[4 * jb + 1]; a -= m4[2] * sol[4 * jb + 2]; a -= m4[3] * sol[4 * jb + 3];
                    if ((jb & 3) == 3) asm volatile("" ::: "memory"); }
                sol[i] = a; asm volatile("" ::: "memory"); }
            if (c < 128) { float* up = UP + (size_t)u * 8192 + (size_t)(c >> 4) * 1024;
#pragma unroll
                for (int t = 0; t < 4; ++t)
#pragma unroll
                    for (int G = 0; G < 4; ++G) *(f32x4*)(up + (t * 64 + (c & 15) + 16 * G) * 4) = (f32x4){sol[16 * t + 4 * G], sol[16 * t + 4 * G + 1], sol[16 * t + 4 * G + 2], sol[16 * t + 4 * G + 3]}; }
            else { const int d = c - 128;
#pragma unroll
                for (int i = 0; i < 64; ++i) Wl[i * GP + d] = (bf16_t)f2bf(-sol[i]); }
        } else { const int w4 = w - 4;
#pragma unroll
            for (int q = 0; q < 4; ++q) { const int f = w4 * 4 + q, mt = f >> 2, ks = f & 3;
                *(u32x4*)(pko + (size_t)f * 1024 + lane * 16) = tile_frag_scaled(Qn, mt, ks, fr, fg, egc[16 * mt + fr]); }
#pragma unroll
            for (int q = 0; q < 4; ++q) { const int f = w4 * 4 + q, mt = f >> 1, ks = f & 1;
                float v[8];
#pragma unroll
                for (int jj = 0; jj < 8; ++jj) { const int tk = 32 * ks + 16 * (jj >> 2) + 4 * fg + (jj & 3); v[jj] = bf2f(Kn[tk * GP + 16 * mt + fr]) * ekd[tk]; }
                u32x4 o; o.x = pk2(v[0], v[1]); o.y = pk2(v[2], v[3]); o.z = pk2(v[4], v[5]); o.w = pk2(v[6], v[7]);
                *(u32x4*)(pk + (size_t)(16 + f) * 1024 + lane * 16) = o; } }
        __syncthreads();
#pragma unroll
        for (int q = 0; q < 2; ++q) { const int f = w * 2 + q, mt = f >> 2, ks = f & 3; *(u32x4*)(pk + (size_t)f * 1024 + lane * 16) = tile_frag_scaled(Wl, mt, ks, fr, fg, 1.0f); }
        __syncthreads();
    }
}

constexpr int GA_SET = 3 * 64 * GP * 2 + 5 * 64 * 4, GA_WL = 2 * GA_SET, GA_MM = GA_WL + 64 * GP * 2, GA_CW = GA_MM + 64 * GMP * 4, GA_END = GA_CW + 1536 * 4;
static_assert(GA_END <= LDS_MISC, "gdn prep LDS map");
__device__ __forceinline__ void gdn_stage_unit(const Frame& F, const Params& p, int l, int u, int h, float Aexp, float dtb, unsigned char* setb, const float* cwl) {
    bf16_t* Qn = (bf16_t*)setb; bf16_t* Kn = Qn + 64 * GP; bf16_t* Vn = Kn + 64 * GP; float* gcv = (float*)(Vn + 64 * GP); float* bet = gcv + 64; float* beg = bet + 64; float* ekd = beg + 64; float* egc = ekd + 64;
    const bf16_t* Z = (const bf16_t*)(KWS() + WS_Z); const float* GAB = (const float*)(KWS() + WS_GAB); float* GL = (float*)(KWS() + WS_GGL);
    const int n = u >> 3, t0 = n * 64, lane = F.lane;
    float ga_pre = 0.f, gb_pre = 0.f; if (F.wave == 4) { const size_t gi = (size_t)(t0 + lane) * 16; ga_pre = GAB[gi + h]; gb_pre = GAB[gi + 8 + h]; }
#pragma unroll 1
    for (int rep = 0; rep < 2; ++rep) { const int it = (F.tid - 256) + 256 * rep, tt = it >> 3, cg = it & 7;
        u32x4 raw[3][4][2];
#pragma unroll
        for (int ten = 0; ten < 3; ++ten)
#pragma unroll
            for (int k = 0; k < 4; ++k) { const int t = t0 + tt - 3 + k;
                if (t >= 0) { const bf16_t* zp = Z + (size_t)t * NZ + ZC_GQ + ten * 1024 + h * 128 + 16 * cg; raw[ten][k][0] = *(const u32x4*)zp; raw[ten][k][1] = *(const u32x4*)(zp + 8); }
                else { raw[ten][k][0] = (u32x4){0u, 0u, 0u, 0u}; raw[ten][k][1] = raw[ten][k][0]; } }
#pragma unroll
        for (int ten = 0; ten < 3; ++ten) { float y[16];
#pragma unroll
            for (int i = 0; i < 16; ++i) y[i] = 0.f;
#pragma unroll
            for (int k = 0; k < 4; ++k) { float x8a[8], x8b[8]; unpack8(raw[ten][k][0], x8a); unpack8(raw[ten][k][1], x8b);
#pragma unroll
                for (int i = 0; i < 8; ++i) { y[i] += cwl[(ten * 4 + k) * 128 + 16 * cg + i] * x8a[i]; y[8 + i] += cwl[(ten * 4 + k) * 128 + 16 * cg + 8 + i] * x8b[i]; } }
            float ss = 0.f;
#pragma unroll
            for (int i = 0; i < 16; ++i) { y[i] = fsilu(y[i]); ss += y[i] * y[i]; }
            float mul = 1.0f;
            if (ten < 2) { ss += __shfl_xor(ss, 1); ss += __shfl_xor(ss, 2); ss += __shfl_xor(ss, 4); mul = (1.0f / sqrtf(ss + EPS)) * (ten == 0 ? 0.08838834764831845f : 1.0f); }
            bf16_t* dst = (ten == 0 ? Qn : (ten == 1 ? Kn : Vn)) + tt * GP + 16 * cg; u32x4 o0, o1;
            o0.x = pk2(y[0] * mul, y[1] * mul); o0.y = pk2(y[2] * mul, y[3] * mul); o0.z = pk2(y[4] * mul, y[5] * mul); o0.w = pk2(y[6] * mul, y[7] * mul);
            o1.x = pk2(y[8] * mul, y[9] * mul); o1.y = pk2(y[10] * mul, y[11] * mul); o1.z = pk2(y[12] * mul, y[13] * mul); o1.w = pk2(y[14] * mul, y[15] * mul);
            *(u32x4*)dst = o0; *(u32x4*)(dst + 8) = o1; }
        asm volatile("" ::: "memory"); }
    if (F.wave == 4) { const float g = -Aexp * softplusf(ga_pre + dtb); const float beta = sigm(gb_pre);
        float gc = g;
#pragma unroll
        for (int o = 1; o < 64; o <<= 1) { const float t = __shfl_up(gc, o); if (lane >= o) gc += t; }
        const float gl = __shfl(gc, 63);
        gcv[lane] = gc; bet[lane] = beta; { const float eg = expf(gc); egc[lane] = eg; beg[lane] = beta * eg; } ekd[lane] = expf(gl - gc);
        if (lane == 0) GL[u] = expf(gl); }
}
__device__ __forceinline__ void gdn_units_a_pipe(const Frame& F, const Params& p, int l) {
    unsigned char* L = F.ldsg; bf16_t* Wl = (bf16_t*)(L + GA_WL); float* Mm = (float*)(L + GA_MM); float* cwl = (float*)(L + GA_CW);
    unsigned char* P2 = KWS() + WS_GP2; float* UP = (float*)(KWS() + WS_GUP);
    const float* cw = KIN(15) + (size_t)l * 4 * 3072;
    const int w = F.wave, lane = F.lane, fr = lane & 15, fg = lane >> 4, h = F.bx & 7;
    const float Aexp = expf(KIN(16)[l * 8 + h]), dtb = KIN(17)[l * 8 + h];
    for (int i = F.tid; i < 1536; i += NTHR) { const int ten = i >> 9, k = (i >> 7) & 3, c = i & 127; cwl[i] = cw[k * 3072 + ten * 1024 + h * 128 + c]; }
    __syncthreads();
    if (w >= 4 && F.bx < 2048) gdn_stage_unit(F, p, l, F.bx, h, Aexp, dtb, L, cwl);
    __syncthreads();
    int prev_u = -1, it = 0;
    for (int u = F.bx; u < 2048; u += F.G, ++it) {
        unsigned char* setb = L + (it & 1) * GA_SET; unsigned char* setn = L + ((it + 1) & 1) * GA_SET;
        const bf16_t* Qn = (const bf16_t*)setb; const bf16_t* Kn = Qn + 64 * GP; const float* gcv = (const float*)(Kn + 2 * 64 * GP); const float* bet = gcv + 64; const float* ekd = gcv + 192; const float* egc = gcv + 256;
        unsigned char* pk = P2 + (size_t)u * GS_PACK_BYTES; unsigned char* pko = KWS() + WS_GPO + (size_t)u * GO_PACK_BYTES;
        if (prev_u >= 0) { unsigned char* pkp = P2 + (size_t)prev_u * GS_PACK_BYTES;
#pragma unroll
            for (int q = 0; q < 2; ++q) { const int f = w * 2 + q, mt = f >> 2, ks = f & 3; *(u32x4*)(pkp + (size_t)f * 1024 + lane * 16) = tile_frag_scaled(Wl, mt, ks, fr, fg, 1.0f); } }
        { const int mt = w >> 1;
#pragma unroll
            for (int q = 0; q < 2; ++q) { const int nt = 2 * (w & 1) + q;
                if (nt <= mt) { f32x4 s = (f32x4){0.f, 0.f, 0.f, 0.f};
#pragma unroll
                    for (int ks = 0; ks < 4; ++ks) { const bf16x8 af = *(const bf16x8*)(Kn + (16 * mt + fr) * GP + 32 * ks + 8 * fg), bf_ = *(const bf16x8*)(Kn + (16 * nt + fr) * GP + 32 * ks + 8 * fg); s = __builtin_amdgcn_mfma_f32_16x16x32_bf16(af, bf_, s, 0, 0, 0); }
                    const int j = 16 * nt + fr; const float gj = gcv[j];
#pragma unroll
                    for (int r = 0; r < 4; ++r) { const int i = 16 * mt + 4 * fg + r; Mm[i * GMP + j] = (i > j) ? bet[i] * s[r] * fexp(gcv[i] - gj) : 0.f; } } } }
        { const int itl = w >> 1, ksA = w & 1; f32x4 s2[2];
#pragma unroll
            for (int q = 0; q < 2; ++q) { const int jt = 2 * ksA + q; s2[q] = (f32x4){0.f, 0.f, 0.f, 0.f};
                if (jt <= itl) {
#pragma unroll
                    for (int ks = 0; ks < 4; ++ks) { const bf16x8 af = *(const bf16x8*)(Kn + (16 * jt + fr) * GP + 32 * ks + 8 * fg), bf_ = *(const bf16x8*)(Qn + (16 * itl + fr) * GP + 32 * ks + 8 * fg); s2[q] = __builtin_amdgcn_mfma_f32_16x16x32_bf16(af, bf_, s2[q], 0, 0, 0); }
                    const int i = 16 * itl + fr; const float gi = gcv[i];
#pragma unroll
                    for (int r = 0; r < 4; ++r) { const int j = 16 * jt + 4 * fg + r; s2[q][r] = (i >= j) ? s2[q][r] * fexp(gi - gcv[j]) : 0.f; } } }
            *(bf16x8*)(pko + (size_t)(16 + itl * 2 + ksA) * 1024 + lane * 16) = pack_acc2(s2[0], s2[1]); }
#pragma unroll
        for (int q = 0; q < 2; ++q) { const int f = w * 2 + q, mt = f >> 2, ks = f & 3;
            *(u32x4*)(pko + (size_t)f * 1024 + lane * 16) = tile_frag_scaled(Qn, mt, ks, fr, fg, egc[16 * mt + fr]); }
#pragma unroll
        for (int q = 0; q < 2; ++q) { const int f = w * 2 + q, mt = f >> 1, ks = f & 1; float v[8];
#pragma unroll
            for (int jj = 0; jj < 8; ++jj) { const int tk = 32 * ks + 16 * (jj >> 2) + 4 * fg + (jj & 3); v[jj] = bf2f(Kn[tk * GP + 16 * mt + fr]) * ekd[tk]; }
            u32x4 o; o.x = pk2(v[0], v[1]); o.y = pk2(v[2], v[3]); o.z = pk2(v[4], v[5]); o.w = pk2(v[6], v[7]);
            *(u32x4*)(pk + (size_t)(16 + f) * 1024 + lane * 16) = o; }
        __syncthreads();
        if (w < 4) { const int c = F.tid; float sol[64];
#pragma unroll
            for (int i = 0; i < 64; ++i) sol[i] = 0.f;
            LAS const bf16_t* colp = (LAS const bf16_t*)(F.lds + (it & 1) * GA_SET) + ((c < 128) ? (2 * 64 * GP + c) : (64 * GP + (c - 128))); asm volatile("" : "+v"(colp));
            LAS const float* mm = (LAS const float*)(F.lds + GA_MM); asm volatile("" : "+v"(mm));
            LAS const float* tb = (LAS const float*)(F.lds + (it & 1) * GA_SET + 3 * 64 * GP * 2) + ((c < 128) ? 64 : 128); asm volatile("" : "+v"(tb));
#pragma unroll
            for (int i = 0; i < 64; ++i) { float a = bf2f(colp[i * GP]) * tb[i];
#pragma unroll
                for (int jb = 0; jb < (i + 3) / 4; ++jb) { const f32x4 m4 = *(LAS const f32x4*)(mm + i * GMP + 4 * jb);
                    a -= m4[0] * sol[4 * jb]; a -= m4[1] * sol[4 * jb + 1]; a -= m4[2] * sol[4 * jb + 2]; a -= m4[3] * sol[4 * jb + 3];
                    if ((jb & 3) == 3) asm volatile("" ::: "memory"); }
                sol[i] = a; asm volatile("" ::: "memory"); }
            if (c < 128) { float* up = UP + (size_t)u * 8192 + (size_t)(c >> 4) * 1024;
#pragma unroll
                for (int t = 0; t < 4; ++t)
#pragma unroll
                    for (int G = 0; G < 4; ++G) *(f32x4*)(up + (t * 64 + (c & 15) + 16 * G) * 4) = (f32x4){sol[16 * t + 4 * G], sol[16 * t + 4 * G + 1], sol[16 * t + 4 * G + 2], sol[16 * t + 4 * G + 3]}; }
            else { const int d = c - 128;
#pragma unroll
                for (int i = 0; i < 64; ++i) Wl[i * GP + d] = (bf16_t)f2bf(-sol[i]); }
        } else if (u + F.G < 2048) gdn_stage_unit(F, p, l, u + F.G, h, Aexp, dtb, setn, cwl);
        __syncthreads();
        prev_u = u;
    }
    if (prev_u >= 0) { unsigned char* pkp = P2 + (size_t)prev_u * GS_PACK_BYTES;
#pragma unroll
        for (int q = 0; q < 2; ++q) { const int f = w * 2 + q, mt = f >> 2, ks = f & 3; *(u32x4*)(pkp + (size_t)f * 1024 + lane * 16) = tile_frag_scaled(Wl, mt, ks, fr, fg, 1.0f); } }
    __syncthreads();
}

constexpr int GS_Q = 8192, GS_NQ = 19;
static_assert(GS_NQ * GS_Q <= LDS_MISC, "scan ring");
__device__ __forceinline__ void gdn_scan(const Frame& F, int b) {
    const int h = b >> 1, w = F.wave, lane = F.lane; const int slice = (b & 1) * 4 + (w & 3); const bool comp = w < 4;
    const unsigned char* P2 = KWS() + WS_GP2; const float* UP = (const float*)(KWS() + WS_GUP); const float* GL = (const float*)(KWS() + WS_GGL); unsigned char* SV = KWS() + WS_GSV;
    f32x4 S[8];
#pragma unroll
    for (int i = 0; i < 8; ++i) S[i] = (f32x4){0.f, 0.f, 0.f, 0.f};
    if (!comp) {
#pragma unroll
        for (int q = 0; q < 15; ++q) { const unsigned char* src = P2 + (size_t)((q >> 2) * 8 + h) * GS_PACK_BYTES + (q & 3) * GS_Q;
#pragma unroll
            for (int i = 0; i < 2; ++i) { const int f = (w - 4) + 4 * i; __builtin_amdgcn_global_load_lds((const unsigned*)(src + f * 1024 + lane * 16), (LAS unsigned*)(F.lds + q * GS_Q + f * 1024), 16, 0, 0); } }
        asm volatile("s_waitcnt vmcnt(22)" ::: "memory"); }
    f32x4 ua[4], ub[4]; float gla = 0.f, glb = 0.f;
#pragma unroll
    for (int t = 0; t < 4; ++t) { ua[t] = (f32x4){0.f, 0.f, 0.f, 0.f}; ub[t] = ua[t]; }
    if (comp) {
#pragma unroll
        for (int t = 0; t < 4; ++t) { ua[t] = *(const f32x4*)(UP + (size_t)h * 8192 + slice * 1024 + (t * 64 + lane) * 4); ub[t] = *(const f32x4*)(UP + (size_t)(8 + h) * 8192 + slice * 1024 + (t * 64 + lane) * 4); }
        gla = GL[h]; glb = GL[8 + h]; }
    __syncthreads();
    int hq = 0;
#define GS_WRAP(x) (((x) >= GS_NQ) ? (x) - GS_NQ : (x))
    for (int n = 0; n < 256; ++n) {
        const int unit = n * 8 + h; const int e1 = GS_WRAP(hq + 1), e2 = GS_WRAP(hq + 2), e3 = GS_WRAP(hq + 3);
        const LAS unsigned char* bW0 = F.lds + hq * GS_Q; const LAS unsigned char* bW1 = F.lds + e1 * GS_Q; const LAS unsigned char* bK0 = F.lds + e2 * GS_Q; const LAS unsigned char* bK1 = F.lds + e3 * GS_Q;
        if (!comp) {
            if (n + 3 < 256) { const int e = GS_WRAP(hq + 15); const unsigned char* src = P2 + (size_t)(unit + 24) * GS_PACK_BYTES + 3 * GS_Q;
#pragma unroll
                for (int i = 0; i < 2; ++i) { const int f = (w - 4) + 4 * i; __builtin_amdgcn_global_load_lds((const unsigned*)(src + f * 1024 + lane * 16), (LAS unsigned*)(F.lds + e * GS_Q + f * 1024), 16, 0, 0); } }
            if (n + 4 < 256) {
#pragma unroll
                for (int j = 0; j < 3; ++j) { const int e = GS_WRAP(hq + 16 + j); const unsigned char* src = P2 + (size_t)(unit + 32) * GS_PACK_BYTES + j * GS_Q;
#pragma unroll
                    for (int i = 0; i < 2; ++i) { const int f = (w - 4) + 4 * i; __builtin_amdgcn_global_load_lds((const unsigned*)(src + f * 1024 + lane * 16), (LAS unsigned*)(F.lds + e * GS_Q + f * 1024), 16, 0, 0); } }
                asm volatile("s_waitcnt vmcnt(22)" ::: "memory"); }
            else asm volatile("s_waitcnt vmcnt(0)" ::: "memory");
        } else {
            f32x4 vn[4];
#pragma unroll
            for (int t = 0; t < 4; ++t) { vn[t] = ua[t]; ua[t] = ub[t]; }
            const float gl = gla; gla = glb;
            if (n + 2 < 256) {
#pragma unroll
                for (int t = 0; t < 4; ++t) ub[t] = *(const f32x4*)(UP + (size_t)(unit + 16) * 8192 + slice * 1024 + (t * 64 + lane) * 4);
                glb = GL[unit + 16]; }
            bf16x8* svp = (bf16x8*)(SV + ((size_t)(unit * 8 + slice) * 6) * 1024 + lane * 16);
            bf16x8 Sb[4];
#pragma unroll
            for (int ks = 0; ks < 4; ++ks) { Sb[ks] = pack_acc2(S[2 * ks], S[2 * ks + 1]); svp[ks * 64] = Sb[ks]; }
#pragma unroll
            for (int t = 0; t < 4; ++t)
#pragma unroll
                for (int ks = 0; ks < 4; ++ks) vn[t] = __builtin_amdgcn_mfma_f32_16x16x32_bf16(*(const LAS bf16x8*)((t < 2 ? bW0 : bW1) + ((t & 1) * 4 + ks) * 1024 + lane * 16), Sb[ks], vn[t], 0, 0, 0);
            bf16x8 vb[2];
#pragma unroll
            for (int ks = 0; ks < 2; ++ks) { vb[ks] = pack_acc2(vn[2 * ks], vn[2 * ks + 1]); svp[(4 + ks) * 64] = vb[ks]; }
#pragma unroll
            for (int dt = 0; dt < 8; ++dt) { S[dt] = S[dt] * gl;
#pragma unroll
                for (int ks = 0; ks < 2; ++ks) S[dt] = __builtin_amdgcn_mfma_f32_16x16x32_bf16(*(const LAS bf16x8*)((dt < 4 ? bK0 : bK1) + ((dt & 3) * 2 + ks) * 1024 + lane * 16), vb[ks], S[dt], 0, 0, 0); }
        }
        __syncthreads();
        hq += 4; if (hq >= GS_NQ) hq -= GS_NQ;
    }
#undef GS_WRAP
}
constexpr int GO_PITCH = 132;
__device__ __forceinline__ void gdn_output(const Frame& F, const Params& p, int l) {
    float* Ot = (float*)F.ldsg;
    const unsigned char* PO = KWS() + WS_GPO; const unsigned char* SV = KWS() + WS_GSV; const bf16_t* Z = (const bf16_t*)(KWS() + WS_Z); bf16_t* Y = (bf16_t*)(KWS() + WS_Y); const float* ng = KIN(18) + l * 128;
    const int w = F.wave, lane = F.lane, fr = lane & 15, fg = lane >> 4;
    const int tt = F.tid >> 3, cg = F.tid & 7; float gn[16];
#pragma unroll
    for (int i = 0; i < 16; ++i) gn[i] = ng[16 * cg + i];
    for (int u = F.bx; u < 2048; u += F.G) {
        const int h = u & 7, n = u >> 3;
        const bf16x8* svp = (const bf16x8*)(SV + ((size_t)(u * 8 + w) * 6) * 1024 + lane * 16); const bf16x8* pop = (const bf16x8*)(PO + (size_t)u * GO_PACK_BYTES + lane * 16);
        const u32x4 gzp0 = *(const u32x4*)(Z + (size_t)(n * 64 + tt) * NZ + ZC_GZ + h * 128 + 16 * cg), gzp1 = *(const u32x4*)(Z + (size_t)(n * 64 + tt) * NZ + ZC_GZ + h * 128 + 16 * cg + 8);
        bf16x8 Sb[4], vb[2];
#pragma unroll
        for (int ks = 0; ks < 4; ++ks) Sb[ks] = svp[ks * 64];
#pragma unroll
        for (int ks = 0; ks < 2; ++ks) vb[ks] = svp[(4 + ks) * 64];
#pragma unroll
        for (int t = 0; t < 4; ++t) { f32x4 o = (f32x4){0.f, 0.f, 0.f, 0.f};
#pragma unroll
            for (int ks = 0; ks < 4; ++ks) o = __builtin_amdgcn_mfma_f32_16x16x32_bf16(pop[(t * 4 + ks) * 64], Sb[ks], o, 0, 0, 0);
#pragma unroll
            for (int ks = 0; ks < 2; ++ks) o = __builtin_amdgcn_mfma_f32_16x16x32_bf16(pop[(16 + t * 2 + ks) * 64], vb[ks], o, 0, 0, 0);
#pragma unroll
            for (int r = 0; r < 4; ++r) Ot[(16 * t + 4 * fg + r) * GO_PITCH + 16 * w + fr] = o[r]; }
        __syncthreads();
        { const size_t tg = (size_t)(n * 64 + tt); float o[16], g[8], g2[8]; float ss = 0.f;
#pragma unroll
            for (int i = 0; i < 4; ++i) { const f32x4 v = *(const f32x4*)(Ot + tt * GO_PITCH + 16 * cg + 4 * i); o[4 * i] = v[0]; o[4 * i + 1] = v[1]; o[4 * i + 2] = v[2]; o[4 * i + 3] = v[3]; }
#pragma unroll
            for (int i = 0; i < 16; ++i) ss += o[i] * o[i];
            ss += __shfl_xor(ss, 1); ss += __shfl_xor(ss, 2); ss += __shfl_xor(ss, 4);
            const float rstd = 1.0f / sqrtf(ss * (1.0f / 128.0f) + EPS);
            unpack8(gzp0, g); unpack8(gzp1, g2);
            float y[16];
#pragma unroll
            for (int i = 0; i < 8; ++i) { y[i] = o[i] * rstd * gn[i] * fsilu(g[i]); y[8 + i] = o[8 + i] * rstd * gn[8 + i] * fsilu(g2[i]); }
            u32x4 o0, o1; o0.x = pk2(y[0], y[1]); o0.y = pk2(y[2], y[3]); o0.z = pk2(y[4], y[5]); o0.w = pk2(y[6], y[7]); o1.x = pk2(y[8], y[9]); o1.y = pk2(y[10], y[11]); o1.z = pk2(y[12], y[13]); o1.w = pk2(y[14], y[15]);
            bf16_t* yp = Y + tg * 3072 + 2048 + h * 128 + 16 * cg; *(u32x4*)yp = o0; *(u32x4*)(yp + 8) = o1; }
        __syncthreads();
    }
}

__device__ __forceinline__ void seq_retention(const Frame& F, const Params& p, int h) {
    float* sq = (float*)F.ldsg; float* sk = sq + 128; float* red = sk + 128;
    const bf16_t* Z = (const bf16_t*)(KWS() + WS_Z); bf16_t* Y = (bf16_t*)(KWS() + WS_Y); const int* pos = (const int*)KIN(2);
    const int c = F.tid & 127; const bool act = F.tid < 128, rot = F.tid < 64;
    float R[128];
#pragma unroll
    for (int d = 0; d < 128; ++d) R[d] = 0.f;
    const float gamma = 1.0f - exp2f(-5.0f - (float)h);
    const float invf = (float)exp2(-(double)(F.tid & 63) * (13.287712379549449 / 64.0));
    unsigned short nq1 = 0, nq2 = 0, nk1 = 0, nk2 = 0, nv = 0, ng = 0; int npos = 0;
    if (rot) { nq1 = Z[ZC_RQ + h * 128 + F.tid]; nq2 = Z[ZC_RQ + h * 128 + 64 + F.tid]; nk1 = Z[ZC_RK + h * 128 + F.tid]; nk2 = Z[ZC_RK + h * 128 + 64 + F.tid]; npos = pos[0]; }
    if (act) { nv = Z[ZC_RV + h * 128 + c]; ng = Z[ZC_RG + h * 128 + c]; }
    for (int t = 0; t < S_; ++t) {
        const unsigned short q1 = nq1, q2 = nq2, k1 = nk1, k2 = nk2, vv = nv, gg = ng; const int ps = npos;
        if (t + 1 < S_) { const size_t zo = (size_t)(t + 1) * NZ;
            if (rot) { nq1 = Z[zo + ZC_RQ + h * 128 + F.tid]; nq2 = Z[zo + ZC_RQ + h * 128 + 64 + F.tid]; nk1 = Z[zo + ZC_RK + h * 128 + F.tid]; nk2 = Z[zo + ZC_RK + h * 128 + 64 + F.tid]; npos = pos[t + 1]; }
            if (act) { nv = Z[zo + ZC_RV + h * 128 + c]; ng = Z[zo + ZC_RG + h * 128 + c]; } }
        if (rot) { const float angf = (float)ps * invf; const double ad = (double)angf; const double nn = rint(ad * 0.15915494309189535); const float rr = (float)(ad - nn * 6.283185307179586);
            const float cs = cosf(rr), sn = sinf(rr); const float a1 = bf2f(q1), a2 = bf2f(q2), b1 = bf2f(k1), b2 = bf2f(k2);
            sq[F.tid] = a1 * cs - a2 * sn; sq[F.tid + 64] = a2 * cs + a1 * sn;
            sk[F.tid] = (b1 * cs - b2 * sn) * 0.08838834764831845f; sk[F.tid + 64] = (b2 * cs + b1 * sn) * 0.08838834764831845f; }
        __syncthreads();
        float o = 0.f;
        if (act) { const float v = bf2f(vv);
#pragma unroll
            for (int d0 = 0; d0 < 128; d0 += 16) {
#pragma unroll
                for (int d = d0; d < d0 + 16; ++d) { R[d] = gamma * R[d] + sk[d] * v; o += sq[d] * R[d]; }
                asm volatile("" ::: "memory"); }
            const float ss = wave_sum(o * o); if (F.lane == 0) red[F.wave] = ss; }
        __syncthreads();
        if (act) { const float ms = (red[0] + red[1]) * (1.0f / 128.0f); const float y = o * (1.0f / sqrtf(ms + EPS)) * siluf(bf2f(gg)); Y[(size_t)t * 3072 + h * 128 + c] = (bf16_t)f2bf(y); }
    }
}
__device__ __forceinline__ void seq_gdn(const Frame& F, const Params& p, int l, int h) {
    float* sq = (float*)F.ldsg; float* sk = sq + 128; float* red = sk + 128; float* red2 = red + 8;
    const bf16_t* Z = (const bf16_t*)(KWS() + WS_Z); bf16_t* Y = (bf16_t*)(KWS() + WS_Y); const float* GAB = (const float*)(KWS() + WS_GAB);
    const int c = F.tid & 127; const bool act = F.tid < 128;
    float St[128];
#pragma unroll
    for (int d = 0; d < 128; ++d) St[d] = 0.f;
    const float* cw = KIN(15) + (size_t)l * 4 * 3072;
    float wq[4], wk[4], wv[4];
#pragma unroll
    for (int k = 0; k < 4; ++k) { wq[k] = cw[k * 3072 + h * 128 + c]; wk[k] = cw[k * 3072 + 1024 + h * 128 + c]; wv[k] = cw[k * 3072 + 2048 + h * 128 + c]; }
    const float Aexp = expf(KIN(16)[l * 8 + h]), dtb = KIN(17)[l * 8 + h], ngain = KIN(18)[l * 128 + c];
    float xq1 = 0, xq2 = 0, xq3 = 0, xk1 = 0, xk2 = 0, xk3 = 0, xv1 = 0, xv2 = 0, xv3 = 0;
    unsigned short nq = 0, nk = 0, nv = 0, nz = 0; float nga = 0.f, ngb = 0.f;
    if (act) { nq = Z[ZC_GQ + h * 128 + c]; nk = Z[ZC_GK + h * 128 + c]; nv = Z[ZC_GV + h * 128 + c]; nz = Z[ZC_GZ + h * 128 + c]; nga = GAB[h]; ngb = GAB[8 + h]; }
    for (int t = 0; t < S_; ++t) {
        const float rq = bf2f(nq), rk = bf2f(nk), rv = bf2f(nv), gz = bf2f(nz), ga = nga, gb = ngb;
        if (act && t + 1 < S_) { const size_t zo = (size_t)(t + 1) * NZ; nq = Z[zo + ZC_GQ + h * 128 + c]; nk = Z[zo + ZC_GK + h * 128 + c]; nv = Z[zo + ZC_GV + h * 128 + c]; nz = Z[zo + ZC_GZ + h * 128 + c];
            nga = GAB[(size_t)(t + 1) * 16 + h]; ngb = GAB[(size_t)(t + 1) * 16 + 8 + h]; }
        float q = 0.f, k = 0.f, v = 0.f;
        if (act) { const float cq = wq[0] * xq3 + wq[1] * xq2 + wq[2] * xq1 + wq[3] * rq, ck = wk[0] * xk3 + wk[1] * xk2 + wk[2] * xk1 + wk[3] * rk, cv = wv[0] * xv3 + wv[1] * xv2 + wv[2] * xv1 + wv[3] * rv;
            xq3 = xq2; xq2 = xq1; xq1 = rq; xk3 = xk2; xk2 = xk1; xk1 = rk; xv3 = xv2; xv2 = xv1; xv1 = rv;
            q = siluf(cq); k = siluf(ck); v = siluf(cv);
            const float s1 = wave_sum(q * q), s2 = wave_sum(k * k); if (F.lane == 0) { red[F.wave] = s1; red[2 + F.wave] = s2; } }
        __syncthreads();
        if (act) { sq[c] = q * (1.0f / sqrtf(red[0] + red[1] + EPS)) * 0.08838834764831845f; sk[c] = k * (1.0f / sqrtf(red[2] + red[3] + EPS)); }
        __syncthreads();
        float o = 0.f;
        if (act) { const float g = -Aexp * softplusf(ga + dtb), e = expf(g), beta = sigm(gb);
            float dot = 0.f;
#pragma unroll
            for (int d0 = 0; d0 < 128; d0 += 16) {
#pragma unroll
                for (int d = d0; d < d0 + 16; ++d) dot += sk[d] * St[d];
                asm volatile("" ::: "memory"); }
            const float coef = beta * (v - e * dot);
#pragma unroll
            for (int d0 = 0; d0 < 128; d0 += 16) {
#pragma unroll
                for (int d = d0; d < d0 + 16; ++d) { St[d] = e * St[d] + sk[d] * coef; o += sq[d] * St[d]; }
                asm volatile("" ::: "memory"); }
            const float ss = wave_sum(o * o); if (F.lane == 0) red2[F.wave] = ss; }
        __syncthreads();
        if (act) { const float ms = (red2[0] + red2[1]) * (1.0f / 128.0f); const float y = o * (1.0f / sqrtf(ms + EPS)) * ngain * siluf(gz); Y[(size_t)t * 3072 + 2048 + h * 128 + c] = (bf16_t)f2bf(y); }
    }
}
__device__ __forceinline__ void seq_lru(const Frame& F, const Params& p, int part) {
    const bf16_t* Z = (const bf16_t*)(KWS() + WS_Z); bf16_t* Y = (bf16_t*)(KWS() + WS_Y); const float* LA = (const float*)(KWS() + WS_MF); const float* LB = LA + (size_t)S_ * 1024;
    const int ch = part * 512 + F.tid; float h = 0.f;
    for (int t0 = 0; t0 < S_; t0 += 8) { float a[8], b[8]; unsigned short g[8];
#pragma unroll
        for (int i = 0; i < 8; ++i) { a[i] = LA[(size_t)(t0 + i) * 1024 + ch]; b[i] = LB[(size_t)(t0 + i) * 1024 + ch]; g[i] = Z[(size_t)(t0 + i) * NZ + ZC_LG + ch]; }
#pragma unroll
        for (int i = 0; i < 8; ++i) { h = a[i] * h + b[i]; Y[(size_t)(t0 + i) * 3072 + 1024 + ch] = (bf16_t)f2bf(h * gelu_tanh(bf2f(g[i]))); } }
}

__device__ __forceinline__ void phase_seq(const Frame& F, const Params& p, int l) {
#if DBG_NOSEQ
    { u32x4* yy = (u32x4*)(KWS() + WS_Y); for (size_t i = (size_t)F.bx * NTHR + F.tid; i < (size_t)S_ * 3072 / 8; i += (size_t)F.G * NTHR) yy[i] = (u32x4){0u, 0u, 0u, 0u}; }
#else
    if (F.bx < 16) { gdn_scan(F, ((F.bx & 7) << 1) | (F.bx >> 3)); return; }
    const int wg = F.bx - 16, nwg = F.G - 16; unsigned* ctl = (unsigned*)(KWS() + WS_CTL); unsigned* cnt = ctl + CW_SUB + 64 * l; unsigned* tmo = ctl + CW_BAR + XB_TMO;
    const int rwg = (wg + nwg - (2048 % nwg)) % nwg;
    lru_units<false>(F, p, l, wg, nwg); __syncthreads(); ret_units_a(F, rwg, nwg);
    sub_barrier(cnt, (unsigned)nwg, tmo);
    if (wg < 2) lru_carry(F, wg); else ret_scan(F, wg - 2, nwg - 2);
    sub_barrier(cnt, 2u * (unsigned)nwg, tmo);
    lru_units<true>(F, p, l, wg, nwg); __syncthreads(); ret_units_c(F, rwg, nwg);
#endif
}

#define LAYER(l) do { \
const int pb = PH_L0 + l * PH_PER_LAYER; \
        if (EN(0) && IN(pb + 0)) { const Frame F = make_frame(); phase_convert(F, p, l); phase_norm1_gab(F, p, l, l > 0 && !DBG_NOMOE); __syncthreads(); } \
        SEAM(pb + 0); \
        if (EN(1) && IN(pb + 1)) { const Frame F = make_frame(); pg8::Gemm g{(const bf16_t*)(KWS() + WS_H), (const bf16_t*)(KWS() + WS_WIN), 2048, 2048, 2048}; SchedStatic sc{64, 64, F.G, F.bx}; \
            EpiZL E{(bf16_t*)(KWS() + WS_Z)}; pg8::gemm_phase(F.lds, g, sc, E); } \
        SEAM(pb + 1); \
        if (EN(2) && IN(pb + 2)) { const Frame F = make_frame(); if ((F.G & 7) == 0) gdn_units_a_pipe(F, p, l); else gdn_units_a(F, p, l); } \
        SEAM(pb + 2); \
        if (EN(3) && IN(pb + 3)) { const Frame F = make_frame(); \
            phase_seq(F, p, l); \
        } \
        SEAM(pb + 3); \
        if (EN(4) && IN(pb + 4)) { const Frame F = make_frame(); gdn_output(F, p, l); } \
        SEAM(pb + 4); \
        if (EN(5) && IN(pb + 5)) { const Frame F = make_frame(); pg8::Gemm g{(const bf16_t*)(KWS() + WS_Y), (const bf16_t*)(KWS() + WS_BP), 3072, 1024, 1024}; SchedMerge sc{F.G, F.bx}; \
            EpiMerge E{(const bf16_t*)(KWS() + WS_Z), (bf16_t*)(KWS() + WS_H)}; pg8::gemm_phase(F.lds, g, sc, E); } \
        SEAM(pb + 5); \
        if (EN(6) && IN(pb + 6)) { const Frame F = make_frame(); pg8::Gemm g{(const bf16_t*)(KWS() + WS_H), (const bf16_t*)(KWS() + WS_WO), 2048, 2048, 2048}; SchedStatic sc{64, 8, F.G, F.bx}; \
            EpiWout E{l == 0 ? KIN(0) : KOUT(), KOUT(), (const float*)(KWS() + WS_MODV) + l * 12288 + MO_GT1}; pg8::gemm_phase(F.lds, g, sc, E); } \
        SEAM(pb + 6); \
        if (!DBG_NOMOE && EN(7) && IN(pb + 7)) { const Frame F = make_frame(); if ((S_ % (F.G * NWAVES * 4)) == 0) phase_norm2_router_lds(F, p, l); else phase_norm2_router(F, p, l); __syncthreads(); } \
        SEAM(pb + 7); \
        if (!DBG_NOMOE && EN(8) && IN(pb + 8)) { const Frame F = make_frame(); phase_gather(F, p, l); } \
        SEAM(pb + 8); \
        if (!DBG_NOMOE && EN(9) && IN(pb + 9)) { const Frame F = make_frame(); moe_tables_load(F, p); unsigned* mq = (unsigned*)(KWS() + WS_CTL) + CW_MOEQ + l * 16384; \
            { pg8::Gemm g{(const bf16_t*)(KWS() + WS_H), (const bf16_t*)(KWS() + WS_W13), 2048, 2048, 2048}; SchedMoe<true> sc{(const int*)(KWS() + WS_TOK + 512 * 1024), F.G, F.bx, 4, (const LAS int*)(F.lds + LDS_MISC + 64)}; \
              EpiW13 E{(bf16_t*)(KWS() + WS_HID), mq}; pg8::gemm_phase(F.lds, g, sc, E); } \
            { volatile LAS int* slot = (volatile LAS int*)(F.lds + LDS_MISC + 32); \
              if (F.tid == 0) { const int q0 = (int)xb_add(mq, 1u), q1 = (int)xb_add(mq, 1u); slot[0] = q0; slot[1] = q1; slot[2] = 2; slot[4] = 0; } __syncthreads(); \
              pg8::Gemm g{(const bf16_t*)(KWS() + WS_HID), (const bf16_t*)(KWS() + WS_W2), 512, 512, 512}; SchedMoeDyn sc{8, (const LAS int*)(F.lds + LDS_MISC + 64), slot, mq, (unsigned*)(KWS() + WS_CTL) + CW_BAR + XB_TMO}; \
              EpiW2L E{(bf16_t*)(KWS() + WS_SLOT), (const u32x2*)(KWS() + WS_ROWINFO), (const LAS int*)(F.lds + LDS_MISC + 64), mq, slot, mq}; pg8::gemm_phase(F.lds, g, sc, E); } } \
        SEAM(pb + 10); \
    } while (0)
template <unsigned PMASK, bool ALL>
__global__ void __launch_bounds__(NTHR, 2) fwd(Params p) {
    Frame F = make_frame();
    if (F.tid < 4) ((LAS unsigned*)(F.lds + LDS_MISC))[F.tid] = 0u;
    __syncthreads();
    unsigned* ctl = (unsigned*)(KWS() + WS_CTL);
    XcdBarrier bar; bar.bar = ctl + CW_BAR; bar.x = 0; bar.st = nullptr;
    const int lo = p.ph_lo, hi = p.ph_hi;
    const bool multi = ALL || (hi - lo) > 1;
    if (multi) bar = xcd_barrier_post(ctl + CW_BAR, (volatile LAS unsigned*)(F.lds + LDS_MISC));
#define IN(k) (ALL || (lo <= (k) && (k) < hi))
#define EN(b) ((PMASK >> (b)) & 1u)
#define SEAM(k) do { if (IN(k) && IN((k) + 1)) xcd_barrier(bar); } while (0)

    if (EN(11) && IN(PH_MOD)) { const Frame F = make_frame(); phase_mod(F, p); phase_rope_table(F); phase_gabw(F); }
    SEAM(PH_MOD);
    LAYER(0);
    LAYER(1);
    if (EN(12) && IN(PH_FINAL)) { const Frame F = make_frame(); phase_norm<2>(F, p, 0, !DBG_NOMOE); }
#undef IN
#undef SEAM
}

typedef void (*KernelFn)(Params);
static int phase_bit(int ph) { if (ph == PH_MOD) return 11; if (ph == PH_FINAL) return 12; return (ph - PH_L0) % PH_PER_LAYER; }
extern "C" void kernel_launch(void* const* d_in, const int* in_sizes, int n_in, void* d_out, int out_size, void* d_ws, size_t ws_size, hipStream_t stream) {
    static int grid = 0;
#if ONE_LAUNCH
    static KernelFn fns[1] = { fwd<0x1FFFu, true> };
    constexpr int NFN = 1;
#else
    static KernelFn fns[13] = { fwd<0x001u, false>, fwd<0x002u, false>, fwd<0x004u, false>, fwd<0x008u, false>, fwd<0x010u, false>, fwd<0x020u, false>, fwd<0x040u, false>, fwd<0x080u, false>, fwd<0x100u, false>, fwd<0x200u, false>, fwd<0x400u, false>, fwd<0x800u, false>, fwd<0x1000u, false> };
    constexpr int NFN = 13;
#endif
    if (grid == 0) {
        if (n_in != 29 || out_size != S_ * D_ || ws_size < WS_END) { fprintf(stderr, "kernel_launch: unexpected shapes (n_in %d out %d ws %zu)\n", n_in, out_size, ws_size); grid = -1; return; }
        int dev = 0, cus = 0, per_cu = 0;
        if (hipGetDevice(&dev) != hipSuccess || hipDeviceGetAttribute(&cus, hipDeviceAttributeMultiprocessorCount, dev) != hipSuccess) { grid = -1; return; }
        for (int i = 0; i < NFN; ++i) {
            if (hipFuncSetAttribute((const void*)fns[i], hipFuncAttributeMaxDynamicSharedMemorySize, LDS_BYTES) != hipSuccess) { fprintf(stderr, "kernel_launch: hipFuncSetAttribute failed\n"); grid = -1; return; }
            if (hipOccupancyMaxActiveBlocksPerMultiprocessor(&per_cu, (const void*)fns[i], NTHR, LDS_BYTES) != hipSuccess || per_cu < 1) fprintf(stderr, "kernel_launch: occupancy query says %d for fn %d\n", per_cu, i);
        }
        (void)hipGetLastError();
        grid = cus > 0 ? cus : 256;
    }
    if (grid < 0) return;
    (void)hipMemsetAsync((char*)d_ws + WS_CTL, 0, CTL_BYTES, stream);
    Params p{};
    for (int i = 0; i < 29; ++i) p.in[i] = (const float*)d_in[i];
    p.out = (float*)d_out; p.ws = (unsigned char*)d_ws;
#if ONE_LAUNCH
    p.ph_lo = 0; p.ph_hi = NPH;
    { void* args[] = {&p}; (void)hipLaunchKernel((const void*)fns[0], dim3(grid), dim3(NTHR), args, LDS_BYTES, stream); }
#else
    for (int ph = 0; ph < NPH; ++ph) { p.ph_lo = ph; p.ph_hi = ph + 1; void* args[] = {&p}; (void)hipLaunchKernel((const void*)fns[phase_bit(ph)], dim3(grid), dim3(NTHR), args, LDS_BYTES, stream); }
#endif
}
```

```cpp
#include <hip/hip_runtime.h>
#include <cstdio>
#include <cstdint>

#ifndef ONE_LAUNCH
#define ONE_LAUNCH 1
#endif
#ifndef DBG_NOSEQ
#define DBG_NOSEQ 0
#endif
#ifndef DBG_NOMOE
#define DBG_NOMOE 0
#endif
#ifndef DBG_NOMIX
#define DBG_NOMIX 0
#endif
#ifndef DBG_MOE_SCALE
#define DBG_MOE_SCALE 1.0f
#endif
#ifndef DBG_M
#define DBG_M 0
#endif
#ifndef DBG_ZERO_BR
#define DBG_ZERO_BR 0
#endif

#define LAS __attribute__((address_space(3)))
typedef unsigned short bf16_t;
typedef short bf16x8 __attribute__((ext_vector_type(8)));
typedef float f32x4 __attribute__((ext_vector_type(4)));
typedef float f32x2 __attribute__((ext_vector_type(2)));
typedef unsigned u32x4 __attribute__((ext_vector_type(4)));
typedef unsigned u32x2 __attribute__((ext_vector_type(2)));

constexpr int S_ = 16384, D_ = 2048, NL = 2;
constexpr int NZ = 16384;
constexpr int NZP = 16640;
constexpr int INC = 16400;
constexpr int NWAVES = 8, NTHR = 512;
constexpr float EPS = 1e-6f;
constexpr int ZC_RQ = 0, ZC_RK = 1024, ZC_RV = 2048, ZC_RG = 3072, ZC_LX = 4096, ZC_LG = 5120, ZC_GQ = 6144, ZC_GK = 7168, ZC_GV = 8192, ZC_GZ = 9216, ZC_BR = 10240;
constexpr int MO_SH1 = 0, MO_SC1 = 2048, MO_GT1 = 4096, MO_SH2 = 6144, MO_SC2 = 8192, MO_GT2 = 10240;

constexpr size_t MiB = 1u << 20;
constexpr size_t WS_CTL = 0, CTL_BYTES = 1 * MiB;
constexpr size_t WS_MODV = 1 * MiB;
constexpr size_t WS_RTW = 2 * MiB;
constexpr size_t WS_GAB = 3 * MiB;
constexpr size_t WS_GABW = 2 * MiB + 512 * 1024;
constexpr size_t WS_ROWINFO = 4 * MiB;
constexpr size_t WS_TOK = 5 * MiB;
constexpr size_t WS_WIN = 8 * MiB;
constexpr size_t WS_BP = 73 * MiB;
constexpr size_t WS_WO = 85 * MiB;
constexpr size_t WS_W13 = 93 * MiB;
constexpr size_t WS_W2 = 221 * MiB;
constexpr size_t WS_H = 285 * MiB;
constexpr size_t WS_Y = 349 * MiB;
constexpr size_t WS_MF = 445 * MiB;
constexpr size_t WS_Z = 573 * MiB;
constexpr size_t WS_XB = WS_Z;
constexpr size_t WS_HID = WS_Z + 160 * MiB;
constexpr size_t WS_SLOT = WS_Z + 200 * MiB;
constexpr size_t WS_LWT = 1085 * MiB;
constexpr size_t WS_LPH = 1086 * MiB;
constexpr size_t WS_LCARRY = 1088 * MiB;
constexpr size_t WS_ROPE_C = 1089 * MiB;
constexpr size_t WS_ROPE_S = 1093 * MiB;
constexpr size_t WS_KV = 1100 * MiB;
constexpr size_t WS_GP2 = 1164 * MiB;
constexpr size_t WS_GPO = WS_GP2 + 64 * MiB;
constexpr size_t WS_GSV = 445 * MiB;
constexpr size_t WS_GUP = 1276 * MiB;
constexpr size_t WS_GGL = 1340 * MiB;
constexpr size_t WS_GO = 1341 * MiB;
constexpr size_t WS_END = 1373 * MiB;
constexpr int CW_BAR = 4096;
constexpr int CW_CNT = 16384;
constexpr int CW_SUB = 17408;
constexpr int CW_MOEQ = 65536;

constexpr int LDS_STAGE = 131072;
constexpr int LDS_BYTES = 163840;
constexpr int LDS_MISC = LDS_BYTES - 1024;
constexpr int MAXTILES = 160;

constexpr int PH_MOD = 0, PH_L0 = 1, PH_PER_LAYER = 11, PH_FINAL = 23, NPH = 24;

struct Params { const float* in[29]; float* out; unsigned char* ws; int ph_lo, ph_hi; };


#define CAS __attribute__((address_space(4)))
__device__ __forceinline__ const CAS char* karg_base() { const CAS char* ka = (const CAS char*)__builtin_amdgcn_kernarg_segment_ptr(); asm volatile("" : "+s"(ka)); return ka; }
__device__ __forceinline__ const float* KIN(int i) { return *(const float* const CAS*)(karg_base() + 8 * i); }
__device__ __forceinline__ float* KOUT() { return *(float* const CAS*)(karg_base() + 232); }
__device__ __forceinline__ unsigned char* KWS() { return *(unsigned char* const CAS*)(karg_base() + 240); }

typedef __bf16 bf16x2_n __attribute__((ext_vector_type(2)));
__device__ __forceinline__ unsigned pk2(float lo, float hi) { const f32x2 f = {lo, hi}; const bf16x2_n b = __builtin_convertvector(f, bf16x2_n); return __builtin_bit_cast(unsigned, b); }
__device__ __forceinline__ unsigned f2bf(float f) { return pk2(f, 0.f) & 0xffffu; }
__device__ __forceinline__ float bf2f(unsigned short b) { return __builtin_bit_cast(float, ((unsigned)b) << 16); }
__device__ __forceinline__ float bflo(unsigned w) { return __builtin_bit_cast(float, w << 16); }
__device__ __forceinline__ float bfhi(unsigned w) { return __builtin_bit_cast(float, w & 0xffff0000u); }
__device__ __forceinline__ float wave_sum(float v) {
#pragma unroll
    for (int o = 1; o < 64; o <<= 1) v += __shfl_xor(v, o);
    return v;
}
__device__ __forceinline__ float sigm(float x) { return 1.0f / (1.0f + expf(-x)); }
__device__ __forceinline__ float fexp(float x) { return __builtin_amdgcn_exp2f(x * 1.4426950408889634f); }
__device__ __forceinline__ float fsigm(float x) { return __builtin_amdgcn_rcpf(1.0f + __builtin_amdgcn_exp2f(-x * 1.4426950408889634f)); }
__device__ __forceinline__ float fsilu(float x) { return x * fsigm(x); }
__device__ __forceinline__ float siluf(float x) { return x * sigm(x); }
__device__ __forceinline__ float softplusf(float x) { return fmaxf(x, 0.f) + log1pf(expf(-fabsf(x))); }
__device__ __forceinline__ void unpack8(const u32x4 a, float (&o)[8]) { o[0] = bflo(a.x); o[1] = bfhi(a.x); o[2] = bflo(a.y); o[3] = bfhi(a.y); o[4] = bflo(a.z); o[5] = bfhi(a.z); o[6] = bflo(a.w); o[7] = bfhi(a.w); }
__device__ __forceinline__ float gelu_tanh(float x) { return 0.5f * x * (1.0f + tanhf(0.7978845608028654f * (x + 0.044715f * x * x * x))); }

#define XB_TMO      128
#define XB_XCNT(j)  (256  + 64 * (j))
#define XB_XSUB(j)  (1280 + 64 * (j))
#define XB_XGEN(j)  (2304 + 64 * (j))
#define XB_TOP      3328
#define XB_TOPGEN   3392
#define XCD_BAR_WORDS 3456
#define XB_SPIN_CAP (1u << 24)
__device__ __forceinline__ unsigned xb_ld(unsigned* p)              { return __hip_atomic_load(p, __ATOMIC_RELAXED, __HIP_MEMORY_SCOPE_AGENT); }
__device__ __forceinline__ unsigned xb_add(unsigned* p, unsigned v) { return __hip_atomic_fetch_add(p, v, __ATOMIC_RELAXED, __HIP_MEMORY_SCOPE_AGENT); }
__device__ __forceinline__ unsigned xb_xcc_id() { return (unsigned)__builtin_amdgcn_s_getreg((3 << 11) | 20) & 0xFu; }
#define XB_SPIN(cond, bar) do { unsigned _sp = 0; while (cond) { __builtin_amdgcn_s_sleep(1); \
    if ((++_sp & 255u) == 0u) { if (xb_ld(&(bar)[XB_TMO])) break; if (_sp > XB_SPIN_CAP) { atomicAdd(&(bar)[XB_TMO], 1u); break; } } } } while (0)
struct XcdBarrier { unsigned* bar; unsigned x; volatile LAS unsigned* st; };
__device__ __forceinline__ XcdBarrier xcd_barrier_post(unsigned* bar, volatile LAS unsigned* st) {
    XcdBarrier b; b.bar = bar; b.x = xb_xcc_id(); b.st = st;
    if (threadIdx.x == 0) (void)xb_add(&bar[XB_XCNT(b.x)], 1u);
    return b;
}
__device__ __forceinline__ void xcd_barrier_complete(unsigned* bar, unsigned x, unsigned& nloc, unsigned& nx) {
    const unsigned G = gridDim.x * gridDim.y * gridDim.z;
    unsigned sum, cnt, mine, sp = 0u;
    for (;;) {
        sum = 0u; cnt = 0u; mine = 0u;
#pragma unroll 1
        for (unsigned j = 0; j < 16; ++j) { const unsigned c = xb_ld(&bar[XB_XCNT(j)]); sum += c; cnt += (c > 0u) ? 1u : 0u; mine = (j == x) ? c : mine; }
        if (sum == G) break;
        __builtin_amdgcn_s_sleep(1);
        if ((++sp & 255u) == 0u) { if (xb_ld(&bar[XB_TMO])) break; if (sp > XB_SPIN_CAP) { atomicAdd(&bar[XB_TMO], 1u); break; } }
    }
    nloc = mine > 0u ? mine : 1u; nx = cnt > 0u ? cnt : 1u;
}
__device__ __forceinline__ void xcd_barrier(const XcdBarrier& b) {
    asm volatile("s_waitcnt vmcnt(0)" ::: "memory");
    __syncthreads();
    if (threadIdx.x == 0) {
        unsigned* bar = b.bar;
        __builtin_amdgcn_s_waitcnt(0);
        unsigned nloc = b.st[0], nx = b.st[1];
        if (nloc == 0u) { xcd_barrier_complete(bar, b.x, nloc, nx); b.st[0] = nloc; b.st[1] = nx; }
        const unsigned old = xb_add(&bar[XB_XSUB(b.x)], 1u);
        const unsigned gen = old / nloc;
        if (old + 1u == (gen + 1u) * nloc) {
            __builtin_amdgcn_fence(__ATOMIC_RELEASE, "agent");
            asm volatile("s_waitcnt vmcnt(0)" ::: "memory");
            const unsigned og = xb_add(&bar[XB_TOP], 1u);
            const unsigned tg = og / nx;
            if (og + 1u == (tg + 1u) * nx) xb_add(&bar[XB_TOPGEN], 1u);
            else XB_SPIN(xb_ld(&bar[XB_TOPGEN]) == tg, bar);
            __builtin_amdgcn_fence(__ATOMIC_ACQUIRE, "agent");
            xb_add(&bar[XB_XGEN(b.x)], 1u);
            asm volatile("s_waitcnt vmcnt(0)" ::: "memory");
        } else {
            XB_SPIN(xb_ld(&bar[XB_XGEN(b.x)]) == gen, bar);
            __builtin_amdgcn_fence(__ATOMIC_ACQUIRE, "agent");
            asm volatile("s_waitcnt vmcnt(0)" ::: "memory");
        }
    }
    __syncthreads();
}


__device__ __forceinline__ void sub_barrier(unsigned* cnt, unsigned target, unsigned* tmo) {
    asm volatile("s_waitcnt vmcnt(0)" ::: "memory");
    __syncthreads();
    if (threadIdx.x == 0) {
        __builtin_amdgcn_fence(__ATOMIC_RELEASE, "agent");
        asm volatile("s_waitcnt vmcnt(0)" ::: "memory");
        (void)xb_add(cnt, 1u);
        unsigned sp = 0u;
        while (xb_ld(cnt) < target) { __builtin_amdgcn_s_sleep(1); if ((++sp & 255u) == 0u) { if (xb_ld(tmo)) break; if (sp > XB_SPIN_CAP) { atomicAdd(tmo, 1u); break; } } }
        __builtin_amdgcn_fence(__ATOMIC_ACQUIRE, "agent");
        asm volatile("s_waitcnt vmcnt(0)" ::: "memory");
    }
    __syncthreads();
}

namespace pg8 {
constexpr int BM = 256, BK = 64, HALF = 128, HTB = HALF * BK * 2, STAGE_BYTES = 8 * HTB, NXCD = 8, WGM = 8;
__device__ __forceinline__ int lds_byte(int r, int c) { const int st = (r >> 4) * 2 + (c >> 5), rr = r & 15, cc = c & 31, ob = rr * 64 + cc * 2; return st * 1024 + (ob ^ (((ob >> 9) & 1) << 5)); }
__device__ __forceinline__ void stage_rc(int b, int& R, int& C) { const int st = b / 1024, sb = b % 1024, swz = sb ^ (((sb >> 9) & 1) << 5); R = (st >> 1) * 16 + swz / 64; C = (st & 1) * 32 + (swz % 64) / 2; }
__device__ __forceinline__ int perm32(int rho) { const int n = rho >> 4, i = rho & 15; return 8 * (i >> 2) + 4 * n + (i & 3); }
struct Unit { int pm, pn, aoff; };
struct Gemm { const bf16_t* A; const bf16_t* Bt; int lda, ldb, K; };
__device__ __forceinline__ bool static_tile(int L, int nM, int nN, int& pm, int& pn) {
    const int nwg = nM * nN; if (L >= nwg) return false;
    int wgid = L; { const int q = nwg / NXCD, r = nwg % NXCD, xcd = wgid % NXCD, off = wgid / NXCD; wgid = (xcd < r ? xcd * (q + 1) : r * (q + 1) + (xcd - r) * q) + off; }
    const int nig = WGM * nN, gid = wgid / nig, fm = gid * WGM, gsz = (nM - fm) < WGM ? (nM - fm) : WGM;
    pm = fm + ((wgid % nig) % gsz); pn = (wgid % nig) / gsz; return true;
}
__device__ __forceinline__ unsigned cvt_pk_bf16(float lo, float hi) { return pk2(lo, hi); }

template <class E, class = void> struct epi_early { static constexpr bool value = false; };
template <class E> struct epi_early<E, decltype((void)E::EARLY)> { static constexpr bool value = E::EARLY; };
template <class Epi, class Sched>
__device__ __forceinline__ void gemm_phase(LAS unsigned char* lds, const Gemm g, const Sched& S, const Epi& E) {
    int tid = threadIdx.x; asm volatile("" : "+v"(tid)); const int wid = __builtin_amdgcn_readfirstlane(tid >> 6), lane = tid & 63, wr = wid >> 2, wc = wid & 3, fr = lane & 15, fq = lane >> 4;
    int K = g.K; asm volatile("" : "+s"(K)); const int nt = K / BK; int lda_ = g.lda, ldb_ = g.ldb; asm volatile("" : "+s"(lda_), "+s"(ldb_));
    unsigned voffA[2], voffB[2];
#pragma unroll
    for (int i = 0; i < 2; ++i) { int R, C; stage_rc(tid * 16 + i * 8192, R, C); const int Rb = Epi::PERM ? ((R & ~31) + perm32(R & 31)) : R;
        voffA[i] = (unsigned)(R * lda_ + C) * 2u; voffB[i] = (unsigned)(Rb * ldb_ + C) * 2u; }
    const size_t kstep = (size_t)(BK * 2);
    const int* rtab = S.row_table();
    const size_t hstepA = Sched::GATHER ? (size_t)0 : (size_t)HALF * lda_ * 2, hstepB = (size_t)HALF * ldb_ * 2;
    const size_t tstepA = 2 * hstepA, tstepB = 2 * hstepB;
    unsigned vc0[2], vc1[2], vn0[2], vn1[2];
#define PG8_ROWS(pm_, o0, o1) do { _Pragma("unroll") for (int _i = 0; _i < 2; ++_i) { int _R, _C; stage_rc(tid * 16 + _i * 8192, _R, _C); \
        if (Sched::GATHER) { o0[_i] = (unsigned)(rtab[(pm_) * 256 + _R] * lda_ + _C) * 2u; o1[_i] = (unsigned)(rtab[(pm_) * 256 + 128 + _R] * lda_ + _C) * 2u; } else { o0[_i] = voffA[_i]; o1[_i] = voffA[_i]; } } } while (0)
    const unsigned ldsw = (unsigned)wid * 1024u;
    const int aoff = lds_byte(wr * 64 + fr, fq * 8), boff = lds_byte(wc * 32 + fr, fq * 8);
#define PG8_SA(b, h) (((b) * 2 + (h)) * HTB)
#define PG8_SB(b, h) ((4 + (b) * 2 + (h)) * HTB)
#define PG8_STAGE(bufoff, gbase, voff) do { _Pragma("unroll") for (int _i = 0; _i < 2; ++_i) \
        __builtin_amdgcn_global_load_lds((const unsigned*)((const char*)(gbase) + (voff)[_i]), (LAS unsigned*)(lds + (bufoff) + ldsw + _i * 8192), 16, 0, 0); } while (0)
#define PG8_LDA(dst, b, h) do { _Pragma("unroll") for (int m = 0; m < 4; ++m) _Pragma("unroll") for (int k = 0; k < 2; ++k) dst[m][k] = *(const LAS bf16x8*)(lds + PG8_SA(b, h) + aoff + m * 2048 + k * 1024); } while (0)
#define PG8_LDB(dst, b, h) do { _Pragma("unroll") for (int n = 0; n < 2; ++n) _Pragma("unroll") for (int k = 0; k < 2; ++k) dst[n][k] = *(const LAS bf16x8*)(lds + PG8_SB(b, h) + boff + n * 2048 + k * 1024); } while (0)
#define PG8_MMA(ai, bj, At, Bt) do { __builtin_amdgcn_s_setprio(1); _Pragma("unroll") for (int m = 0; m < 4; ++m) _Pragma("unroll") for (int n = 0; n < 2; ++n) _Pragma("unroll") for (int k = 0; k < 2; ++k) \
        acc[ai][bj][m][n] = __builtin_amdgcn_mfma_f32_16x16x32_bf16(Bt[n][k], At[m][k], acc[ai][bj][m][n], 0, 0, 0); __builtin_amdgcn_s_setprio(0); } while (0)
#define PG8_WAIT_V(n) asm volatile("s_waitcnt vmcnt(" #n ")" ::: "memory")
#define PG8_WAIT_L(n) asm volatile("s_waitcnt lgkmcnt(" #n ")" ::: "memory")
#define PG8_BAR __builtin_amdgcn_s_barrier()
#define PG8_SCHED __builtin_amdgcn_sched_barrier(0)
    Unit cur, nxt; int ui = 0;
    if (!S.next(0, cur)) return;
    f32x4 acc[2][2][4][2];
#pragma unroll
    for (int a = 0; a < 2; ++a)
#pragma unroll
        for (int b = 0; b < 2; ++b)
#pragma unroll
            for (int m = 0; m < 4; ++m)
#pragma unroll
                for (int n = 0; n < 2; ++n) acc[a][b][m][n] = (f32x4){0.f, 0.f, 0.f, 0.f};
    bf16x8 At[4][2], B0[2][2], B1[2][2];
    const char* cA = (const char*)g.A + (size_t)cur.pm * tstepA + (size_t)cur.aoff; const char* cB = (const char*)g.Bt + (size_t)cur.pn * tstepB;
    PG8_ROWS(cur.pm, vc0, vc1);
#define PG8_PROLOGUE_A(cA_, cB_, v0_, v1_) do { PG8_STAGE(PG8_SB(0, 0), cB_, voffB); PG8_STAGE(PG8_SA(0, 0), cA_, v0_); PG8_STAGE(PG8_SB(0, 1), (cB_) + hstepB, voffB); PG8_STAGE(PG8_SA(0, 1), (cA_) + hstepA, v1_); } while (0)
#define PG8_PROLOGUE_B() do { if (wr == 1) PG8_BAR; PG8_WAIT_V(4); PG8_BAR; \
        PG8_STAGE(PG8_SB(1, 0), cB + kstep, voffB); PG8_STAGE(PG8_SA(1, 0), cA + kstep, vc0); PG8_STAGE(PG8_SB(1, 1), cB + hstepB + kstep, voffB); \
        PG8_WAIT_V(6); PG8_BAR; } while (0)
#define PG8_PROLOGUE() do { PG8_PROLOGUE_A(cA, cB, vc0, vc1); PG8_PROLOGUE_B(); } while (0)
    if (!Epi::LDS_EPI) PG8_PROLOGUE();
    for (;;) {
        const bool has_next = S.next(ui + 1, nxt);
        if (Epi::LDS_EPI) { S.ready(cur); if (!(epi_early<Epi>::value && ui > 0)) PG8_PROLOGUE_A(cA, cB, vc0, vc1); PG8_PROLOGUE_B(); }
        const bool chain = has_next && !Epi::LDS_EPI;
        const char* nA = chain ? (const char*)g.A + (size_t)nxt.pm * tstepA + (size_t)nxt.aoff : cA; const char* nB = chain ? (const char*)g.Bt + (size_t)nxt.pn * tstepB : cB;
        if (chain) PG8_ROWS(nxt.pm, vn0, vn1); else { vn0[0] = vc0[0]; vn0[1] = vc0[1]; vn1[0] = vc1[0]; vn1[1] = vc1[1]; }
        for (int t = 0; t < nt; t += 2) {
            const bool last = (t == nt - 2);
            const char* a1 = cA + (size_t)(t + 1) * kstep;
            const char* a2 = last ? nA : cA + (size_t)(t + 2) * kstep; const char* b2 = last ? nB : cB + (size_t)(t + 2) * kstep;
            const char* a3 = a2 + kstep; const char* b3 = b2 + kstep;
            unsigned x0[2], x1[2]; x0[0] = last ? vn0[0] : vc0[0]; x0[1] = last ? vn0[1] : vc0[1]; x1[0] = last ? vn1[0] : vc1[0]; x1[1] = last ? vn1[1] : vc1[1];
            PG8_LDB(B0, 0, 0); PG8_SCHED; PG8_LDA(At, 0, 0); PG8_STAGE(PG8_SA(1, 1), a1 + hstepA, vc1);
            PG8_WAIT_L(8); PG8_BAR; PG8_WAIT_L(0); PG8_MMA(0, 0, At, B0); PG8_BAR; PG8_SCHED;
            PG8_LDB(B1, 0, 1); PG8_STAGE(PG8_SB(0, 0), b2, voffB);
            PG8_BAR; PG8_WAIT_L(0); PG8_MMA(0, 1, At, B1); PG8_BAR;
            PG8_LDA(At, 0, 1); PG8_STAGE(PG8_SA(0, 0), a2, x0);
            PG8_BAR; PG8_WAIT_L(0); PG8_MMA(1, 0, At, B0); PG8_BAR; PG8_SCHED;
            PG8_STAGE(PG8_SB(0, 1), b2 + hstepB, voffB);
            PG8_WAIT_V(6); PG8_BAR; PG8_MMA(1, 1, At, B1); PG8_BAR;
            PG8_LDB(B0, 1, 0); PG8_SCHED; PG8_LDA(At, 1, 0); PG8_STAGE(PG8_SA(0, 1), a2 + hstepA, x1);
            PG8_WAIT_L(8); PG8_BAR; PG8_WAIT_L(0); PG8_MMA(0, 0, At, B0); PG8_BAR; PG8_SCHED;
            PG8_LDB(B1, 1, 1); PG8_STAGE(PG8_SB(1, 0), b3, voffB);
            PG8_BAR; PG8_WAIT_L(0); PG8_MMA(0, 1, At, B1); PG8_BAR;
            PG8_LDA(At, 1, 1); PG8_STAGE(PG8_SA(1, 0), a3, x0);
            PG8_BAR; PG8_WAIT_L(0); PG8_MMA(1, 0, At, B0); PG8_BAR; PG8_SCHED;
            PG8_STAGE(PG8_SB(1, 1), b3 + hstepB, voffB);
            PG8_WAIT_V(6); PG8_BAR; PG8_MMA(1, 1, At, B1); PG8_BAR;
        }
        if (Epi::LDS_EPI) { PG8_WAIT_V(0); if (wr == 0) PG8_BAR; PG8_BAR;
            if constexpr (epi_early<Epi>::value) { static_assert(!Sched::GATHER, "early prologue: plain row tiles only");
                E.run_a(acc, cur, wr, wc, lds, tid);
                if (has_next) { const char* eA = (const char*)g.A + (size_t)nxt.pm * tstepA + (size_t)nxt.aoff; const char* eB = (const char*)g.Bt + (size_t)nxt.pn * tstepB; PG8_PROLOGUE_A(eA, eB, voffA, voffA); }
                E.run_b(cur, lds, tid); }
            else E.run(acc, cur, wr, wc, fr, fq, lds, tid); }
        else E(acc, cur, wr, wc, fr, fq);
        if (!has_next) break;
        if (!E.keep(cur))
#pragma unroll
        for (int a = 0; a < 2; ++a)
#pragma unroll
            for (int b = 0; b < 2; ++b)
#pragma unroll
                for (int m = 0; m < 4; ++m)
#pragma unroll
                    for (int n = 0; n < 2; ++n) acc[a][b][m][n] = (f32x4){0.f, 0.f, 0.f, 0.f};
        if (Epi::LDS_EPI) { cur = nxt; cA = (const char*)g.A + (size_t)cur.pm * tstepA + (size_t)cur.aoff; cB = (const char*)g.Bt + (size_t)cur.pn * tstepB; ++ui; PG8_ROWS(cur.pm, vc0, vc1); }
        else { cur = nxt; cA = nA; cB = nB; ++ui; vc0[0] = vn0[0]; vc0[1] = vn0[1]; vc1[0] = vn1[0]; vc1[1] = vn1[1]; }
    }
    if (!Epi::LDS_EPI) { PG8_WAIT_V(0); if (wr == 0) PG8_BAR; PG8_BAR; }
#undef PG8_ROWS
#undef PG8_PROLOGUE
#undef PG8_PROLOGUE_A
#undef PG8_PROLOGUE_B
#undef PG8_SA
#undef PG8_SB
#undef PG8_STAGE
#undef PG8_LDA
#undef PG8_LDB
#undef PG8_MMA
#undef PG8_WAIT_V
#undef PG8_WAIT_L
#undef PG8_BAR
#undef PG8_SCHED
}
}
using pg8::Unit;

struct SchedStatic { static constexpr bool GATHER = false; __device__ __forceinline__ const int* row_table() const { return nullptr; } __device__ __forceinline__ void ready(const Unit&) const {} int nM, nN, G, c;
    __device__ __forceinline__ bool next(int i, Unit& u) const { int pm, pn; if (!pg8::static_tile(i * G + c, nM, nN, pm, pn)) return false; u.pm = pm; u.pn = pn; u.aoff = 0; return true; } };
struct SchedMerge { static constexpr bool GATHER = false; __device__ __forceinline__ const int* row_table() const { return nullptr; } __device__ __forceinline__ void ready(const Unit&) const {} int G, c;
    __device__ __forceinline__ bool next(int i, Unit& u) const { const int ti = i / 3, b = i - 3 * ti; int pm, pn; if (!pg8::static_tile(ti * G + c, 64, 8, pm, pn)) return false;
        u.pm = pm; u.pn = b * 8 + pn; u.aoff = b * 1024 * 2; return true; } };
template <bool GATH>
struct SchedMoe { static constexpr bool GATHER = GATH; const int* rtab; __device__ __forceinline__ const int* row_table() const { return rtab; } __device__ __forceinline__ void ready(const Unit&) const {} int G, c, nN; const LAS int* tbl;
    __device__ __forceinline__ bool next(int i, Unit& u) const { const int L = i * G + c; const int ntl = __builtin_amdgcn_readfirstlane(tbl[224]); if (L >= ntl * nN) return false;
        const int pm = L / nN; u.pm = pm; u.pn = __builtin_amdgcn_readfirstlane(tbl[pm]) * nN + (L - pm * nN); u.aoff = 0; return true; } };
struct SchedMoeDyn { static constexpr bool GATHER = false; __device__ __forceinline__ const int* row_table() const { return nullptr; } int nN; const LAS int* tbl; volatile LAS int* slot; unsigned* done; unsigned* tmo;
    __device__ __forceinline__ bool next(int i, Unit& u) const { const int L = __builtin_amdgcn_readfirstlane(slot[i & 1]); const int ntl = __builtin_amdgcn_readfirstlane(tbl[224]); if (L >= ntl * nN) return false;
        const int pm = L / nN; u.pm = pm; u.pn = __builtin_amdgcn_readfirstlane(tbl[pm]) * nN + (L - pm * nN); u.aoff = 0; return true; }
    __device__ __forceinline__ void ready(const Unit& u) const {
        if (threadIdx.x == 0) { if (slot[4] == 0) { unsigned* d = done + 64 * (u.pm + 1); unsigned sp = 0u;
                while (xb_ld(d) < 32u) { __builtin_amdgcn_s_sleep(1); if ((++sp & 255u) == 0u) { if (xb_ld(tmo)) break; if (sp > XB_SPIN_CAP) { atomicAdd(tmo, 1u); break; } } } }
            slot[4] = 0; __builtin_amdgcn_fence(__ATOMIC_ACQUIRE, "agent"); asm volatile("s_waitcnt vmcnt(0)" ::: "memory"); }
        asm volatile("s_waitcnt lgkmcnt(0)" ::: "memory"); __builtin_amdgcn_s_barrier(); asm volatile("" ::: "memory"); } };

struct EpiZ { static constexpr bool LDS_EPI = false; template <class A_> __device__ __forceinline__ void run(A_&, const Unit&, int, int, int, int, LAS unsigned char*, int) const {} __device__ __forceinline__ bool keep(const Unit&) const { return false; } static constexpr bool PERM = true; bf16_t* Z; float* GAB;
    __device__ __forceinline__ void operator()(const f32x4 (&acc)[2][2][4][2], const Unit& u, int wr, int wc, int fr, int fq) const {
        const int row0 = u.pm * 256 + wr * 64 + fr;
        if (u.pn < 64) {
            const int col0 = u.pn * 256 + wc * 32 + 8 * fq;
#pragma unroll
            for (int ai = 0; ai < 2; ++ai)
#pragma unroll
                for (int m = 0; m < 4; ++m) { bf16_t* rowp = Z + (size_t)(row0 + ai * 128 + m * 16) * NZ + col0;
#pragma unroll
                    for (int bj = 0; bj < 2; ++bj) { const f32x4 v0 = acc[ai][bj][m][0], v1 = acc[ai][bj][m][1]; u32x4 w;
                        w.x = pg8::cvt_pk_bf16(v0[0], v0[1]); w.y = pg8::cvt_pk_bf16(v0[2], v0[3]); w.z = pg8::cvt_pk_bf16(v1[0], v1[1]); w.w = pg8::cvt_pk_bf16(v1[2], v1[3]);
                        *(u32x4*)(rowp + bj * 128) = w; } }
        } else if (wc == 0 && fq < 2) {
#pragma unroll
            for (int ai = 0; ai < 2; ++ai)
#pragma unroll
                for (int m = 0; m < 4; ++m) { float* gp = GAB + (size_t)(row0 + ai * 128 + m * 16) * 16 + 8 * fq;
                    *(f32x4*)gp = acc[ai][0][m][0]; *(f32x4*)(gp + 4) = acc[ai][0][m][1]; }
        }
    } };
struct EpiZL { static constexpr bool LDS_EPI = true, PERM = true, EARLY = true; bf16_t* Z;
    __device__ __forceinline__ bool keep(const Unit&) const { return false; }
    __device__ __forceinline__ void operator()(const f32x4 (&)[2][2][4][2], const Unit&, int, int, int, int) const {}
    template <class A_> __device__ __forceinline__ void run(A_&, const Unit&, int, int, int, int, LAS unsigned char*, int) const {}
    __device__ __forceinline__ void rows_out(const Unit& u, LAS unsigned char* lds, int tid, int i) const { const int c = tid & 31; const int row = (tid >> 5) + 16 * i;
        const u32x4 w = *(const LAS u32x4*)(lds + row * 512 + ((c ^ (row & 31)) << 4)); __builtin_nontemporal_store(w, (u32x4*)(Z + (size_t)(u.pm * 256 + row) * NZ + u.pn * 256 + c * 8)); }
    __device__ __forceinline__ void run_a(const f32x4 (&acc)[2][2][4][2], const Unit& u, int wr, int wc, LAS unsigned char* lds, int tid_) const {
        int tid = tid_; asm volatile("" : "+v"(tid));
        const int fr = tid & 15, fq = (tid >> 4) & 3;
#pragma unroll
        for (int ai = 0; ai < 2; ++ai)
#pragma unroll
            for (int m = 0; m < 4; ++m) { const int r = ai * 128 + wr * 64 + m * 16 + fr;
#pragma unroll
                for (int bj = 0; bj < 2; ++bj) { const int c16 = 16 * bj + 4 * wc + fq; const f32x4 v0 = acc[ai][bj][m][0], v1 = acc[ai][bj][m][1]; u32x4 w;
                    w.x = pk2(v0[0], v0[1]); w.y = pk2(v0[2], v0[3]); w.z = pk2(v1[0], v1[1]); w.w = pk2(v1[2], v1[3]);
                    *(LAS u32x4*)(lds + r * 512 + ((c16 ^ (r & 31)) << 4)) = w; }
                asm volatile("" ::: "memory"); }
        __syncthreads();
#pragma unroll
        for (int i = 0; i < 4; ++i) rows_out(u, lds, tid, i);
        asm volatile("" ::: "memory");
#pragma unroll
        for (int i = 8; i < 12; ++i) rows_out(u, lds, tid, i);
        asm volatile("s_waitcnt lgkmcnt(0)" ::: "memory"); __builtin_amdgcn_s_barrier(); asm volatile("" ::: "memory");
    }
    __device__ __forceinline__ void run_b(const Unit& u, LAS unsigned char* lds, int tid_) const {
        int tid = tid_; asm volatile("" : "+v"(tid));
#pragma unroll
        for (int i = 4; i < 8; ++i) rows_out(u, lds, tid, i);
        asm volatile("" ::: "memory");
#pragma unroll
        for (int i = 12; i < 16; ++i) rows_out(u, lds, tid, i);
        asm volatile("s_waitcnt lgkmcnt(0)" ::: "memory"); __builtin_amdgcn_s_barrier(); asm volatile("" ::: "memory");
    } };
struct EpiMerge { static constexpr bool LDS_EPI = false; template <class A_> __device__ __forceinline__ void run(A_&, const Unit&, int, int, int, int, LAS unsigned char*, int) const {} static constexpr bool PERM = true; const bf16_t* Z; bf16_t* OUT;
    __device__ __forceinline__ bool keep(const Unit& u) const { return (u.pn >> 3) < 2; }
    __device__ __forceinline__ void operator()(f32x4 (&acc)[2][2][4][2], const Unit& u, int wr, int wc, int fr, int fq) const {
        const int b = u.pn >> 3, pnl = u.pn & 7; const int row0 = u.pm * 256 + wr * 64 + fr, col0 = pnl * 256 + wc * 32 + 8 * fq;
        const bf16_t* zb = Z + ZC_BR + b * 2048 + col0;
        u32x4 gb[2][2][2], gn[2][2][2];
#define EM_LOAD(slot, aim_) do { const int ai_ = (aim_) >> 1, mh_ = (aim_) & 1; _Pragma("unroll") for (int mm = 0; mm < 2; ++mm) _Pragma("unroll") for (int bj = 0; bj < 2; ++bj) { \
            const bf16_t* zp = zb + (size_t)(row0 + ai_ * 128 + (2 * mh_ + mm) * 16) * NZ + bj * 128; gb[slot][mm][bj] = *(const u32x4*)zp; gn[slot][mm][bj] = (b < 2) ? *(const u32x4*)(zp + 2048) : (u32x4){0u, 0u, 0u, 0u}; } } while (0)
        EM_LOAD(0, 0);
#pragma unroll
        for (int aim = 0; aim < 4; ++aim) { const int ai = aim >> 1, mh = aim & 1, sl = aim & 1;
            if (aim + 1 < 4) EM_LOAD((aim + 1) & 1, aim + 1);
#pragma unroll
            for (int mm = 0; mm < 2; ++mm) { const int m = 2 * mh + mm;
#pragma unroll
                for (int bj = 0; bj < 2; ++bj) { float eb[8]; { float x[8]; unpack8(gb[sl][mm][bj], x);
#pragma unroll
                        for (int i = 0; i < 8; ++i) eb[i] = __builtin_amdgcn_rcpf(1.0f + fexp(-fmaxf(fminf(x[i], 30.f), -30.f))); }
                    if (b < 2) { float x[8]; unpack8(gn[sl][mm][bj], x);
#pragma unroll
                        for (int i = 0; i < 8; ++i) eb[i] *= 1.0f + fexp(-fmaxf(fminf(x[i], 30.f), -30.f)); }
                    f32x4& v0 = acc[ai][bj][m][0]; f32x4& v1 = acc[ai][bj][m][1];
                    v0[0] *= eb[0]; v0[1] *= eb[1]; v0[2] *= eb[2]; v0[3] *= eb[3]; v1[0] *= eb[4]; v1[1] *= eb[5]; v1[2] *= eb[6]; v1[3] *= eb[7];
                    if (b == 2) { u32x4 w; w.x = pg8::cvt_pk_bf16(v0[0], v0[1]); w.y = pg8::cvt_pk_bf16(v0[2], v0[3]); w.z = pg8::cvt_pk_bf16(v1[0], v1[1]); w.w = pg8::cvt_pk_bf16(v1[2], v1[3]);
                        *(u32x4*)(OUT + (size_t)(row0 + ai * 128 + m * 16) * 2048 + col0 + bj * 128) = w; } } }
        }
#undef EM_LOAD
    } };
struct EpiWout { static constexpr bool LDS_EPI = false; template <class A_> __device__ __forceinline__ void run(A_&, const Unit&, int, int, int, int, LAS unsigned char*, int) const {} __device__ __forceinline__ bool keep(const Unit&) const { return false; } static constexpr bool PERM = false; const float* xsrc; float* xdst; const float* gt;
    __device__ __forceinline__ void operator()(const f32x4 (&acc)[2][2][4][2], const Unit& u, int wr, int wc, int fr, int fq) const {
        const int row0 = u.pm * 256 + wr * 64 + fr, col0 = u.pn * 256 + wc * 32 + 4 * fq;
        f32x4 gv[2][2];
#pragma unroll
        for (int bj = 0; bj < 2; ++bj)
#pragma unroll
            for (int n = 0; n < 2; ++n) gv[bj][n] = *(const f32x4*)(gt + col0 + bj * 128 + n * 16);
        f32x4 xo[2][2][2][2];
#define EW_LOAD(slot, q_) do { const int ai_ = (q_) >> 1, mh_ = (q_) & 1; _Pragma("unroll") for (int mm = 0; mm < 2; ++mm) { const size_t off_ = (size_t)(row0 + ai_ * 128 + (2 * mh_ + mm) * 16) * 2048 + col0; \
            _Pragma("unroll") for (int bj = 0; bj < 2; ++bj) _Pragma("unroll") for (int n = 0; n < 2; ++n) xo[slot][mm][bj][n] = *(const f32x4*)(xsrc + off_ + bj * 128 + n * 16); } } while (0)
        EW_LOAD(0, 0);
#pragma unroll
        for (int q = 0; q < 4; ++q) { const int ai = q >> 1, mh = q & 1, sl = q & 1;
            if (q + 1 < 4) EW_LOAD((q + 1) & 1, q + 1);
#pragma unroll
            for (int mm = 0; mm < 2; ++mm) { const int m = 2 * mh + mm; const size_t off = (size_t)(row0 + ai * 128 + m * 16) * 2048 + col0;
#pragma unroll
                for (int bj = 0; bj < 2; ++bj)
#pragma unroll
                    for (int n = 0; n < 2; ++n) *(f32x4*)(xdst + off + bj * 128 + n * 16) = xo[sl][mm][bj][n] + gv[bj][n] * acc[ai][bj][m][n]; } }
#undef EW_LOAD
    } };
struct EpiW13 { static constexpr bool LDS_EPI = false; template <class A_> __device__ __forceinline__ void run(A_&, const Unit&, int, int, int, int, LAS unsigned char*, int) const {} __device__ __forceinline__ bool keep(const Unit&) const { return false; } static constexpr bool PERM = true; bf16_t* HID; unsigned* done;
    __device__ __forceinline__ void operator()(const f32x4 (&acc)[2][2][4][2], const Unit& u, int wr, int wc, int fr, int fq) const {
        const int pnl = u.pn & 3; const int row0 = u.pm * 256 + wr * 64 + fr, col0 = pnl * 128 + wc * 32 + 8 * fq;
        const __amdgpu_buffer_rsrc_t rs = __builtin_amdgcn_make_buffer_rsrc(HID, 0, MAXTILES * 256 * 512 * 2, 0x00020000);
#pragma unroll
        for (int ai = 0; ai < 2; ++ai)
#pragma unroll
            for (int m = 0; m < 4; ++m) { float hv[8];
#pragma unroll
                for (int n = 0; n < 2; ++n)
#pragma unroll
                    for (int j = 0; j < 4; ++j) hv[n * 4 + j] = fsilu(acc[ai][0][m][n][j]) * acc[ai][1][m][n][j];
                u32x4 w; w.x = pg8::cvt_pk_bf16(hv[0], hv[1]); w.y = pg8::cvt_pk_bf16(hv[2], hv[3]); w.z = pg8::cvt_pk_bf16(hv[4], hv[5]); w.w = pg8::cvt_pk_bf16(hv[6], hv[7]);
                __builtin_amdgcn_raw_buffer_store_b128(w, rs, (unsigned)(((row0 + ai * 128 + m * 16) * 512 + col0) * 2), 0,   16); }
        asm volatile("s_waitcnt vmcnt(0)" ::: "memory");
        if (fr == 0 && fq == 0) (void)xb_add(done + 64 * (u.pm + 1), 1u);
    } };
struct EpiW2 { static constexpr bool LDS_EPI = false; template <class A_> __device__ __forceinline__ void run(A_&, const Unit&, int, int, int, int, LAS unsigned char*, int) const {} __device__ __forceinline__ bool keep(const Unit&) const { return false; } static constexpr bool PERM = true; bf16_t* SLOT; const u32x2* rowinfo; const LAS int* tbl;
    __device__ __forceinline__ void operator()(const f32x4 (&acc)[2][2][4][2], const Unit& u, int wr, int wc, int fr, int fq) const {
        const int e = u.pn >> 3, pnl = u.pn & 7; const int row0 = u.pm * 256 + wr * 64 + fr, col0 = pnl * 256 + wc * 32 + 8 * fq; const int rend = __builtin_amdgcn_readfirstlane(tbl[192 + e]);
        u32x2 inf[2][4];
#pragma unroll
        for (int ai = 0; ai < 2; ++ai)
#pragma unroll
            for (int m = 0; m < 4; ++m) inf[ai][m] = rowinfo[row0 + ai * 128 + m * 16];
#pragma unroll
        for (int ai = 0; ai < 2; ++ai)
#pragma unroll
            for (int m = 0; m < 4; ++m) { const int r = row0 + ai * 128 + m * 16;
                if (r < rend) { const unsigned wbits = inf[ai][m].y; const float w = __uint_as_float(wbits); const unsigned tx = inf[ai][m].x; const unsigned tok = tx >> 1, k = tx & 1u;
                    bf16_t* dst = SLOT + ((size_t)k * S_ + tok) * 2048 + col0;
#pragma unroll
                    for (int bj = 0; bj < 2; ++bj) { const f32x4 v0 = acc[ai][bj][m][0] * w, v1 = acc[ai][bj][m][1] * w; u32x4 o;
                        o.x = pg8::cvt_pk_bf16(v0[0], v0[1]); o.y = pg8::cvt_pk_bf16(v0[2], v0[3]); o.z = pg8::cvt_pk_bf16(v1[0], v1[1]); o.w = pg8::cvt_pk_bf16(v1[2], v1[3]);
                        *(u32x4*)(dst + bj * 128) = o; } } }
    } };

struct EpiW2L { static constexpr bool LDS_EPI = true, PERM = true; bf16_t* SLOT; const u32x2* rowinfo; const LAS int* tbl; unsigned* q; volatile LAS int* slot; unsigned* done;
    __device__ __forceinline__ bool keep(const Unit&) const { return false; }
    __device__ __forceinline__ void operator()(const f32x4 (&)[2][2][4][2], const Unit&, int, int, int, int) const {}
    __device__ __forceinline__ void run(const f32x4 (&acc)[2][2][4][2], const Unit& u, int wr, int wc, int fr_, int fq_, LAS unsigned char* lds, int tid_) const {
        int tid = tid_; asm volatile("" : "+v"(tid));
        int qn = 0; unsigned dn = 0u;
        if (tid == 0) { qn = (int)xb_add(q, 1u); const int Ln = slot[(slot[2] + 1) & 1]; if (Ln < tbl[224] * 8) dn = xb_ld(done + 64 * ((Ln >> 3) + 1)); }
        const int fr = tid & 15, fq = (tid >> 4) & 3; const int e = u.pn >> 3, pnl = u.pn & 7; const int rend = __builtin_amdgcn_readfirstlane(tbl[192 + e]);
        LAS unsigned* rowx = (LAS unsigned*)(lds + 131072);
        u32x2 inf[2][4];
#pragma unroll
        for (int ai = 0; ai < 2; ++ai)
#pragma unroll
            for (int m = 0; m < 4; ++m) inf[ai][m] = rowinfo[u.pm * 256 + ai * 128 + wr * 64 + m * 16 + fr];
#pragma unroll
        for (int ai = 0; ai < 2; ++ai)
#pragma unroll
            for (int m = 0; m < 4; ++m) { const int r = ai * 128 + wr * 64 + m * 16 + fr; const bool valid = (u.pm * 256 + r) < rend; const float w = valid ? __uint_as_float(inf[ai][m].y) : 0.f;
                if (wc == 0 && fq == 0) rowx[r] = valid ? inf[ai][m].x : 0xffffffffu;
#pragma unroll
                for (int bj = 0; bj < 2; ++bj) { const int c16 = 16 * bj + 4 * wc + fq; const f32x4 v0 = acc[ai][bj][m][0] * w, v1 = acc[ai][bj][m][1] * w; u32x4 o;
                    o.x = pk2(v0[0], v0[1]); o.y = pk2(v0[2], v0[3]); o.z = pk2(v1[0], v1[1]); o.w = pk2(v1[2], v1[3]);
                    *(LAS u32x4*)(lds + r * 512 + ((c16 ^ (r & 31)) << 4)) = o; }
                asm volatile("" ::: "memory"); }
        __syncthreads();
        const int c = tid & 31;
#pragma unroll
        for (int i = 0; i < 16; ++i) { const int row = (tid >> 5) + 16 * i; const unsigned tx = rowx[row];
            if (tx != 0xffffffffu) { const u32x4 o = *(const LAS u32x4*)(lds + row * 512 + ((c ^ (row & 31)) << 4));
                *(u32x4*)(SLOT + ((size_t)(tx & 1u) * S_ + (tx >> 1)) * 2048 + pnl * 256 + c * 8) = o; }
            if ((i & 3) == 3) asm volatile("" ::: "memory"); }
        if (tid == 0) { const int n = slot[2]; slot[n & 1] = qn; slot[2] = n + 1; slot[4] = dn >= 32u ? 1 : 0; }
        asm volatile("s_waitcnt lgkmcnt(0)" ::: "memory"); __builtin_amdgcn_s_barrier(); asm volatile("" ::: "memory");
    } };

struct Frame { LAS unsigned char* lds; unsigned char* ldsg; int tid, lane, wave, G, bx; };
extern __shared__ __attribute__((aligned(16))) unsigned char lds_raw[];
__device__ __forceinline__ Frame make_frame() { Frame F; int tz = threadIdx.x; asm volatile("" : "+v"(tz)); F.lds = (LAS unsigned char*)lds_raw; F.ldsg = lds_raw; F.tid = tz; F.lane = tz & 63;
    F.wave = __builtin_amdgcn_readfirstlane(tz >> 6); F.G = gridDim.x; F.bx = blockIdx.x; return F; }

struct TItem { const float* W; bf16_t* WT; int ldw, srccol, k0, ldk, dstrow; };
__device__ __forceinline__ void titem_load(const TItem& t, f32x4 (&x)[8], int lane) {
    const int n4 = (lane & 7) * 4, kr = lane >> 3;
#pragma unroll
    for (int i = 0; i < 8; ++i) x[i] = __builtin_nontemporal_load((const f32x4*)(t.W + (size_t)(t.k0 + kr + 8 * i) * t.ldw + t.srccol + n4));
}
__device__ __forceinline__ void titem_store(const TItem& t, const f32x4 (&x)[8], float* scr, int lane) {
    const int n4 = (lane & 7) * 4, kr = lane >> 3;
#pragma unroll
    for (int i = 0; i < 8; ++i) { float* s = scr + (kr + 8 * i) * 33 + n4; s[0] = x[i][0]; s[1] = x[i][1]; s[2] = x[i][2]; s[3] = x[i][3]; }
    asm volatile("s_waitcnt lgkmcnt(0)" ::: "memory");
    const int c = lane & 7;
#pragma unroll
    for (int j = 0; j < 4; ++j) { const int n = (lane >> 3) + 8 * j; const float* s = scr + (8 * c) * 33 + n;
        u32x4 o; o.x = pk2(s[0 * 33], s[1 * 33]); o.y = pk2(s[2 * 33], s[3 * 33]); o.z = pk2(s[4 * 33], s[5 * 33]); o.w = pk2(s[6 * 33], s[7 * 33]);
        *(u32x4*)(t.WT + (size_t)(t.dstrow + n) * t.ldk + t.k0 + 8 * c) = o; }
    asm volatile("s_waitcnt lgkmcnt(0)" ::: "memory");
}

__device__ __forceinline__ void phase_mod(const Frame& F, const Params& p) {
    const float* cvec = KIN(1); const float* ada_w = KIN(3); const float* ada_b = KIN(4);
    float* modv = (float*)(KWS() + WS_MODV);
    float* sc = (float*)F.ldsg;
    f32x2* red = (f32x2*)(sc + 2048);
    for (int k = F.tid; k < 2048; k += NTHR) sc[k] = siluf(cvec[k]);
    __syncthreads();
    for (int u = F.bx; u < 2 * 96; u += F.G) {
        const int l = u / 96, cb = u % 96, col = cb * 128 + 2 * F.lane;
        const float* wp = ada_w + ((size_t)l * 2048 + F.wave * 256) * 12288 + col; const float* sp = sc + F.wave * 256;
        f32x2 acc = (f32x2){0.f, 0.f};
#pragma unroll 16
        for (int k = 0; k < 256; ++k) { const f32x2 w = __builtin_nontemporal_load((const f32x2*)(wp + (size_t)k * 12288)); const float s = sp[k]; acc[0] += s * w[0]; acc[1] += s * w[1]; }
        red[F.wave * 64 + F.lane] = acc;
        __syncthreads();
        if (F.wave == 0) { f32x2 s = *(const f32x2*)(ada_b + l * 12288 + col);
#pragma unroll
            for (int w = 0; w < 8; ++w) s += red[w * 64 + F.lane];
            *(f32x2*)(modv + l * 12288 + col) = s; }
        __syncthreads();
    }
}

__device__ __forceinline__ void phase_convert(const Frame& F, const Params& p, int l) {
    float* scr = (float*)(F.ldsg + F.wave * 8448);
    const int gw = F.bx * NWAVES + F.wave, NGW = F.G * NWAVES;
    bf16_t* WIN = (bf16_t*)(KWS() + WS_WIN); bf16_t* BP = (bf16_t*)(KWS() + WS_BP); bf16_t* WO = (bf16_t*)(KWS() + WS_WO); bf16_t* W13 = (bf16_t*)(KWS() + WS_W13); bf16_t* W2 = (bf16_t*)(KWS() + WS_W2);
    const float* w_in = KIN(7) + (size_t)l * 2048 * INC;
    const float* bp = KIN(19) + (size_t)l * 3 * 1024 * 2048;
    const float* wo = KIN(20) + (size_t)l * 2048 * 2048;
    const float* w1 = KIN(25) + (size_t)l * 32 * 2048 * 512; const float* w3 = KIN(26) + (size_t)l * 32 * 2048 * 512; const float* w2 = KIN(27) + (size_t)l * 32 * 512 * 2048;
    const float* lwa = KIN(10) + (size_t)l * 8 * 16384; const float* lwx = KIN(12) + (size_t)l * 8 * 16384; bf16_t* LWT = (bf16_t*)(KWS() + WS_LWT);
    constexpr int I_IN = 512 * 32, I_BP = 3 * 16 * 64, I_WO = 32 * 64, I_W13 = 32 * 2 * 512, I_W2 = 32 * 512, I_LRU = 8 * 2 * 8;
    constexpr int NITEMS = I_IN + I_BP + I_WO + I_W13 + I_W2 + I_LRU;
    auto decode = [&](int it) -> TItem { TItem t; int r = it;
        if (r < I_IN) { const int nb = r % 512, kb = r / 512; t.W = w_in; t.ldw = INC; t.srccol = (nb < 320) ? 32 * nb : 10256 + 32 * (nb - 320); t.k0 = 64 * kb; t.WT = WIN; t.ldk = 2048; t.dstrow = 32 * nb; return t; }
        r -= I_IN;
        if (r < I_BP) { const int b = r / 1024, q = r % 1024, nb = q % 64, kb = q / 64; t.W = bp + (size_t)b * 1024 * 2048; t.ldw = 2048; t.srccol = 32 * nb; t.k0 = 64 * kb; t.WT = BP + (size_t)b * 2048 * 1024; t.ldk = 1024; t.dstrow = 32 * nb; return t; }
        r -= I_BP;
        if (r < I_WO) { const int nb = r % 64, kb = r / 64; t.W = wo; t.ldw = 2048; t.srccol = 32 * nb; t.k0 = 64 * kb; t.WT = WO; t.ldk = 2048; t.dstrow = 32 * nb; return t; }
        r -= I_WO;
        if (r < I_W13) { const int e = r / 1024, q = r % 1024, which = q / 512, q2 = q % 512, nb = q2 % 16, kb = q2 / 16; const int pn = nb >> 2, j = nb & 3;
            t.W = (which ? w3 : w1) + (size_t)e * 2048 * 512; t.ldw = 512; t.srccol = 32 * nb; t.k0 = 64 * kb; t.WT = W13 + (size_t)e * 1024 * 2048; t.ldk = 2048; t.dstrow = pn * 256 + which * 128 + 32 * j; return t; }
        r -= I_W13;
        if (r < I_W2) { const int e = r / 512, q = r % 512, nb = q % 64, kb = q / 64; t.W = w2 + (size_t)e * 512 * 2048; t.ldw = 2048; t.srccol = 32 * nb; t.k0 = 64 * kb; t.WT = W2 + (size_t)e * 2048 * 512; t.ldk = 512; t.dstrow = 32 * nb; return t; }
        r -= I_W2;
        { const int n = r / 16, q = r % 16, which = q / 8, q2 = q % 8, nb = q2 % 4, kb = q2 / 4; t.W = (which ? lwx : lwa) + (size_t)n * 16384; t.ldw = 128; t.srccol = 32 * nb; t.k0 = 64 * kb; t.WT = LWT + (size_t)n * 256 * 128; t.ldk = 128; t.dstrow = which * 128 + 32 * nb; return t; } };
    if (gw < NITEMS) { TItem ta = decode(gw); f32x4 xa[8]; titem_load(ta, xa, F.lane);
        for (int it = gw; it < NITEMS; it += NGW) { const int nx = it + NGW; TItem tb = ta; f32x4 xb[8];
            if (nx < NITEMS) { tb = decode(nx); titem_load(tb, xb, F.lane); }
            titem_store(ta, xa, scr, F.lane);
            if (nx < NITEMS) { ta = tb;
#pragma unroll
                for (int i = 0; i < 8; ++i) xa[i] = xb[i]; } } }
    float* rtw = (float*)(KWS() + WS_RTW); const float* rgw = KIN(21) + (size_t)l * 2048 * 4; const float* rew = KIN(23) + (size_t)l * 2048 * 32;
    for (int idx = F.bx * NTHR + F.tid; idx < 36 * 2048; idx += F.G * NTHR) { const int j = idx >> 11, k = idx & 2047; rtw[idx] = (j < 32) ? rew[k * 32 + j] : rgw[k * 4 + (j - 32)]; }
}

template <int MODE>
__device__ __forceinline__ void phase_norm(const Frame& F, const Params& p, int l, bool fold) {
    float* tA = (float*)(F.ldsg + 98304);
    float* tB = tA + 2048;
    float* tG = tB + 2048;
    const float* modv = (const float*)(KWS() + WS_MODV);
    const float* xin = (MODE == 0 && l == 0) ? KIN(0) : KOUT();
    float* xio = KOUT();
    bf16_t* H = (bf16_t*)(KWS() + WS_H);
    const bf16_t* SL = (const bf16_t*)(KWS() + WS_SLOT);
    for (int c = F.tid; c < 2048; c += NTHR) {
        if (MODE == 0) { tA[c] = KIN(5)[l * 2048 + c] * (1.f + modv[l * 12288 + MO_SC1 + c]); tB[c] = modv[l * 12288 + MO_SH1 + c]; }
        if (MODE == 1) { tA[c] = KIN(6)[l * 2048 + c] * (1.f + modv[l * 12288 + MO_SC2 + c]); tB[c] = modv[l * 12288 + MO_SH2 + c]; }
        if (MODE == 2) { tA[c] = KIN(28)[c]; tB[c] = 0.f; }
        tG[c] = fold ? DBG_MOE_SCALE * modv[(MODE == 2 ? 1 : l - 1) * 12288 + MO_GT2 + c] : 0.f;
    }
    __syncthreads();
    const int gw = F.bx * NWAVES + F.wave, NGW = F.G * NWAVES;
    const float* rtw = (const float*)(KWS() + WS_RTW);
    for (int row = gw; row < S_; row += NGW) {
        f32x4 v[8]; float ss = 0.f;
#pragma unroll
        for (int j = 0; j < 8; ++j) { const int c = 4 * F.lane + 256 * j; v[j] = *(const f32x4*)(xin + (size_t)row * 2048 + c);
            if (fold) { const u32x2 a = *(const u32x2*)(SL + (size_t)row * 2048 + c), b = *(const u32x2*)(SL + ((size_t)S_ + row) * 2048 + c); const f32x4 g = *(const f32x4*)(tG + c);
#if DBG_M == 1
                v[j][0] += g[0]; v[j][1] += g[1]; v[j][2] += g[2]; v[j][3] += g[3];
#else
                v[j][0] += g[0] * (bflo(a.x) + bflo(b.x)); v[j][1] += g[1] * (bfhi(a.x) + bfhi(b.x)); v[j][2] += g[2] * (bflo(a.y) + bflo(b.y)); v[j][3] += g[3] * (bfhi(a.y) + bfhi(b.y));
#endif
                if (MODE != 2) *(f32x4*)(xio + (size_t)row * 2048 + c) = v[j]; }
            ss += (v[j][0] * v[j][0] + v[j][1] * v[j][1]) + (v[j][2] * v[j][2] + v[j][3] * v[j][3]); }
        const float rstd = 1.0f / sqrtf(wave_sum(ss) * (1.0f / 2048.0f) + EPS);
#pragma unroll
        for (int j = 0; j < 8; ++j) { const int c = 4 * F.lane + 256 * j; const f32x4 a = *(const f32x4*)(tA + c), b = *(const f32x4*)(tB + c);
            v[j] = v[j] * rstd * a + b;
            if (MODE == 2) *(f32x4*)(xio + (size_t)row * 2048 + c) = v[j];
            else { u32x2 w; w.x = pk2(v[j][0], v[j][1]); w.y = pk2(v[j][2], v[j][3]); *(u32x2*)(H + (size_t)row * 2048 + c) = w; } }
        if (MODE == 1) {
            float mine = 0.f;
#pragma unroll 2
            for (int jo = 0; jo < 36; ++jo) { float d = 0.f;
#pragma unroll
                for (int j = 0; j < 8; ++j) { const f32x4 w = *(const f32x4*)(rtw + (size_t)jo * 2048 + 4 * F.lane + 256 * j); d += (v[j][0] * w[0] + v[j][1] * w[1]) + (v[j][2] * w[2] + v[j][3] * w[3]); }
                d = wave_sum(d); mine = (F.lane == jo) ? d : mine; }
            if (F.lane < 32) mine += KIN(24)[l * 32 + F.lane]; else if (F.lane < 36) mine += KIN(22)[l * 4 + (F.lane - 32)];
            const float g0 = __shfl(mine, 32), g1 = __shfl(mine, 33), g2 = __shfl(mine, 34), g3 = __shfl(mine, 35);
            int gs = 0; float gm = g0; if (g1 > gm) { gm = g1; gs = 1; } if (g2 > gm) { gm = g2; gs = 2; } if (g3 > gm) { gm = g3; gs = 3; }
            const float pg = 1.0f / (expf(g0 - gm) + expf(g1 - gm) + expf(g2 - gm) + expf(g3 - gm));
            float ev[8];
#pragma unroll
            for (int i = 0; i < 8; ++i) ev[i] = __shfl(mine, gs * 8 + i);
            int i0 = 0; float v0 = ev[0];
#pragma unroll
            for (int i = 1; i < 8; ++i) if (ev[i] > v0) { v0 = ev[i]; i0 = i; }
            int i1 = -1; float v1 = -3.0e38f;
#pragma unroll
            for (int i = 0; i < 8; ++i) if (i != i0 && ev[i] > v1) { v1 = ev[i]; i1 = i; }
            const float e1 = expf(v1 - v0);
#if DBG_M == 6
            const float w0 = 0.3f, w1 = 0.2f;
#elif DBG_M == 7
            const float w0 = pg, w1 = 0.f;
#elif DBG_M == 8
            const float w0 = 1.0f / (1.0f + e1), w1 = 0.f;
#else
            const float w0 = pg / (1.0f + e1), w1 = pg * e1 / (1.0f + e1);
#endif
            if (F.lane == 0) { unsigned* cnt = (unsigned*)(KWS() + WS_CTL) + CW_CNT + l * 32; const int ex0 = gs * 8 + i0, ex1 = gs * 8 + i1;
                const unsigned p0 = atomicAdd(cnt + ex0, 1u), p1 = atomicAdd(cnt + ex1, 1u);
                unsigned* tk = (unsigned*)(KWS() + WS_TOK) + (size_t)row * 8;
                tk[0] = (unsigned)ex0; tk[1] = p0; tk[2] = __builtin_bit_cast(unsigned, w0); tk[3] = 0u; tk[4] = (unsigned)ex1; tk[5] = p1; tk[6] = __builtin_bit_cast(unsigned, w1); tk[7] = 0u; }
        }
    }
}

__device__ __forceinline__ void phase_norm1_gab(const Frame& F, const Params& p, int l, bool fold) {
    float* tA = (float*)(F.ldsg + 98304); float* tB = tA + 2048; float* tG = tB + 2048;
    bf16_t* Wl = (bf16_t*)F.ldsg;
    const float* modv = (const float*)(KWS() + WS_MODV); const float* xin = (l == 0) ? KIN(0) : KOUT(); float* xio = KOUT(); bf16_t* H = (bf16_t*)(KWS() + WS_H);
    const bf16_t* SL = (const bf16_t*)(KWS() + WS_SLOT); float* GAB = (float*)(KWS() + WS_GAB);
    __syncthreads();
    for (int c = F.tid; c < 2048; c += NTHR) { tA[c] = KIN(5)[l * 2048 + c] * (1.f + modv[l * 12288 + MO_SC1 + c]); tB[c] = modv[l * 12288 + MO_SH1 + c]; tG[c] = fold ? modv[(l - 1) * 12288 + MO_GT2 + c] : 0.f; }
    { const float* gabw = (const float*)(KWS() + WS_GABW) + (size_t)l * 16 * 2048;
        for (int i = F.tid; i < 16 * 2048 / 4; i += NTHR) { const f32x4 v = *(const f32x4*)(gabw + 4 * i); u32x2 o; o.x = pk2(v[0], v[1]); o.y = pk2(v[2], v[3]); *(u32x2*)(Wl + 4 * i) = o; } }
    __syncthreads();
    const int gw = F.bx * NWAVES + F.wave, NGW = F.G * NWAVES;
    for (int rb = gw * 2; rb < S_; rb += NGW * 2) {
        f32x4 v[2][8];
#pragma unroll
        for (int r = 0; r < 2; ++r) { const size_t row = (size_t)(rb + r); float ss = 0.f;
#pragma unroll
            for (int j = 0; j < 8; ++j) { const int c = 4 * F.lane + 256 * j; v[r][j] = *(const f32x4*)(xin + row * 2048 + c);
                if (fold) { const u32x2 a = *(const u32x2*)(SL + row * 2048 + c), b = *(const u32x2*)(SL + ((size_t)S_ + row) * 2048 + c); const f32x4 g = *(const f32x4*)(tG + c);
                    v[r][j][0] += g[0] * (bflo(a.x) + bflo(b.x)); v[r][j][1] += g[1] * (bfhi(a.x) + bfhi(b.x)); v[r][j][2] += g[2] * (bflo(a.y) + bflo(b.y)); v[r][j][3] += g[3] * (bfhi(a.y) + bfhi(b.y));
                    *(f32x4*)(xio + row * 2048 + c) = v[r][j]; }
                ss += (v[r][j][0] * v[r][j][0] + v[r][j][1] * v[r][j][1]) + (v[r][j][2] * v[r][j][2] + v[r][j][3] * v[r][j][3]); }
            const float rstd = 1.0f / sqrtf(wave_sum(ss) * (1.0f / 2048.0f) + EPS);
#pragma unroll
            for (int j = 0; j < 8; ++j) { const int c = 4 * F.lane + 256 * j; const f32x4 a = *(const f32x4*)(tA + c), b = *(const f32x4*)(tB + c); v[r][j] = v[r][j] * rstd * a + b;
                u32x2 w; w.x = pk2(v[r][j][0], v[r][j][1]); w.y = pk2(v[r][j][2], v[r][j][3]); *(u32x2*)(H + row * 2048 + c) = w; }
            asm volatile("" ::: "memory"); }
        float mine[2] = {0.f, 0.f};
#pragma unroll 1
        for (int jo = 0; jo < 16; ++jo) { float d[2] = {0.f, 0.f};
#pragma unroll
            for (int j = 0; j < 8; ++j) { const u32x2 wq = *(const u32x2*)(Wl + jo * 2048 + 4 * F.lane + 256 * j); const float w0 = bflo(wq.x), w1 = bfhi(wq.x), w2 = bflo(wq.y), w3 = bfhi(wq.y);
#pragma unroll
                for (int r = 0; r < 2; ++r) { d[r] = __builtin_fmaf(v[r][j][0], w0, d[r]); d[r] = __builtin_fmaf(v[r][j][1], w1, d[r]); d[r] = __builtin_fmaf(v[r][j][2], w2, d[r]); d[r] = __builtin_fmaf(v[r][j][3], w3, d[r]); } }
#pragma unroll
            for (int r = 0; r < 2; ++r) { const float s = wave_sum(d[r]); mine[r] = (F.lane == jo) ? s : mine[r]; } }
        if (F.lane < 16) {
#pragma unroll
            for (int r = 0; r < 2; ++r) GAB[(size_t)(rb + r) * 16 + F.lane] = mine[r]; }
    }
}

__device__ __forceinline__ void phase_norm2_router(const Frame& F, const Params& p, int l) {
    float* tA = (float*)(F.ldsg + 98304); float* tB = tA + 2048;
    const float* modv = (const float*)(KWS() + WS_MODV); const float* xin = KOUT(); bf16_t* H = (bf16_t*)(KWS() + WS_H);
    for (int c = F.tid; c < 2048; c += NTHR) { tA[c] = KIN(6)[l * 2048 + c] * (1.f + modv[l * 12288 + MO_SC2 + c]); tB[c] = modv[l * 12288 + MO_SH2 + c]; }
    __syncthreads();
    const int gw = F.bx * NWAVES + F.wave, NGW = F.G * NWAVES; const float* rtw = (const float*)(KWS() + WS_RTW);
    const float be = (F.lane < 32) ? KIN(24)[l * 32 + F.lane] : ((F.lane < 36) ? KIN(22)[l * 4 + (F.lane - 32)] : 0.f);
    for (int rb = gw * 4; rb < S_; rb += NGW * 4) {
        f32x4 v[4][8];
#pragma unroll
        for (int r = 0; r < 4; ++r) { const size_t row = (size_t)(rb + r); float ss = 0.f;
#pragma unroll
            for (int j = 0; j < 8; ++j) { v[r][j] = *(const f32x4*)(xin + row * 2048 + 4 * F.lane + 256 * j); ss += (v[r][j][0] * v[r][j][0] + v[r][j][1] * v[r][j][1]) + (v[r][j][2] * v[r][j][2] + v[r][j][3] * v[r][j][3]); }
            const float rstd = 1.0f / sqrtf(wave_sum(ss) * (1.0f / 2048.0f) + EPS);
#pragma unroll
            for (int j = 0; j < 8; ++j) { const int c = 4 * F.lane + 256 * j; const f32x4 a = *(const f32x4*)(tA + c), b = *(const f32x4*)(tB + c); v[r][j] = v[r][j] * rstd * a + b;
                u32x2 w; w.x = pk2(v[r][j][0], v[r][j][1]); w.y = pk2(v[r][j][2], v[r][j][3]); *(u32x2*)(H + row * 2048 + c) = w; } }
        float mine[4] = {0.f, 0.f, 0.f, 0.f};
#pragma unroll 2
        for (int jo = 0; jo < 36; ++jo) { f32x4 wv[8];
#pragma unroll
            for (int j = 0; j < 8; ++j) wv[j] = *(const f32x4*)(rtw + (size_t)jo * 2048 + 4 * F.lane + 256 * j);
#pragma unroll
            for (int r = 0; r < 4; ++r) { float d = 0.f;
#pragma unroll
                for (int j = 0; j < 8; ++j) { d = __builtin_fmaf(v[r][j][0], wv[j][0], d); d = __builtin_fmaf(v[r][j][1], wv[j][1], d); d = __builtin_fmaf(v[r][j][2], wv[j][2], d); d = __builtin_fmaf(v[r][j][3], wv[j][3], d); }
                d = wave_sum(d); mine[r] = (F.lane == jo) ? d : mine[r]; } }
#pragma unroll
        for (int r = 0; r < 4; ++r) { const float lg = mine[r] + be; const int row = rb + r;
            const float g0 = __shfl(lg, 32), g1 = __shfl(lg, 33), g2 = __shfl(lg, 34), g3 = __shfl(lg, 35);
            int gs = 0; float gm = g0; if (g1 > gm) { gm = g1; gs = 1; } if (g2 > gm) { gm = g2; gs = 2; } if (g3 > gm) { gm = g3; gs = 3; }
            const float pg = 1.0f / (expf(g0 - gm) + expf(g1 - gm) + expf(g2 - gm) + expf(g3 - gm));
            float ev[8];
#pragma unroll
            for (int i = 0; i < 8; ++i) ev[i] = __shfl(lg, gs * 8 + i);
            int i0 = 0; float v0 = ev[0];
#pragma unroll
            for (int i = 1; i < 8; ++i) if (ev[i] > v0) { v0 = ev[i]; i0 = i; }
            int i1 = -1; float v1 = -3.0e38f;
#pragma unroll
            for (int i = 0; i < 8; ++i) if (i != i0 && ev[i] > v1) { v1 = ev[i]; i1 = i; }
            const float e1 = expf(v1 - v0); const float w0 = pg / (1.0f + e1), w1 = pg * e1 / (1.0f + e1);
            if (F.lane == 0) { unsigned* cnt = (unsigned*)(KWS() + WS_CTL) + CW_CNT + l * 32; const int ex0 = gs * 8 + i0, ex1 = gs * 8 + i1;
                const unsigned p0 = atomicAdd(cnt + ex0, 1u), p1 = atomicAdd(cnt + ex1, 1u);
                unsigned* tk = (unsigned*)(KWS() + WS_TOK) + (size_t)row * 8;
                tk[0] = (unsigned)ex0; tk[1] = p0; tk[2] = __float_as_uint(w0); tk[3] = 0u; tk[4] = (unsigned)ex1; tk[5] = p1; tk[6] = __float_as_uint(w1); tk[7] = 0u; } }
    }
}

__device__ __forceinline__ void phase_norm2_router_lds(const Frame& F, const Params& p, int l) {
    float* tA = (float*)(F.ldsg + 131072); float* tB = tA + 2048;
    const float* modv = (const float*)(KWS() + WS_MODV); const float* xin = KOUT(); bf16_t* H = (bf16_t*)(KWS() + WS_H);
    for (int c = F.tid; c < 2048; c += NTHR) { tA[c] = KIN(6)[l * 2048 + c] * (1.f + modv[l * 12288 + MO_SC2 + c]); tB[c] = modv[l * 12288 + MO_SH2 + c]; }
    const int gw = F.bx * NWAVES + F.wave, NGW = F.G * NWAVES, ng = S_ / (NGW * 4), w = F.wave, lane = F.lane;
    const unsigned char* rtwb = (const unsigned char*)(KWS() + WS_RTW);
    const float be = (lane < 32) ? KIN(24)[l * 32 + lane] : ((lane < 36) ? KIN(22)[l * 4 + (lane - 32)] : 0.f);
#pragma unroll
    for (int k = 0; k < 8; ++k) __builtin_amdgcn_global_load_lds((const unsigned*)(rtwb + (size_t)(w + 8 * k) * 1024 + lane * 16), (LAS unsigned*)(F.lds + (w + 8 * k) * 1024), 16, 0, 0);
    __syncthreads();
    int s = 0;
#pragma unroll 1
    for (int g = 0; g < ng; ++g) { const int rb = gw * 4 + g * NGW * 4;
        f32x4 v[4][8]; float mine[4] = {0.f, 0.f, 0.f, 0.f};
        { float rstd[4];
#pragma unroll
        for (int r = 0; r < 4; ++r) { const size_t row = (size_t)(rb + r); float ss = 0.f;
#pragma unroll
            for (int j = 0; j < 8; ++j) { v[r][j] = *(const f32x4*)(xin + row * 2048 + 4 * lane + 256 * j); ss += (v[r][j][0] * v[r][j][0] + v[r][j][1] * v[r][j][1]) + (v[r][j][2] * v[r][j][2] + v[r][j][3] * v[r][j][3]); }
            rstd[r] = 1.0f / sqrtf(wave_sum(ss) * (1.0f / 2048.0f) + EPS); }
#pragma unroll
        for (int j = 0; j < 8; ++j) { const int c = 4 * lane + 256 * j; const f32x4 a = *(const f32x4*)(tA + c), b = *(const f32x4*)(tB + c);
#pragma unroll
            for (int r = 0; r < 4; ++r) { v[r][j] = v[r][j] * rstd[r] * a + b;
                u32x2 wq; wq.x = pk2(v[r][j][0], v[r][j][1]); wq.y = pk2(v[r][j][2], v[r][j][3]); *(u32x2*)(H + (size_t)(rb + r) * 2048 + c) = wq; }
            asm volatile("" ::: "memory"); } }
        f32x2 vp[2][8][4];
#pragma unroll
        for (int rp = 0; rp < 2; ++rp)
#pragma unroll
            for (int j = 0; j < 8; ++j)
#pragma unroll
                for (int i = 0; i < 4; ++i) vp[rp][j][i] = (f32x2){v[2 * rp][j][i], v[2 * rp + 1][j][i]};
#pragma unroll 1
        for (int blk = 0; blk < 5; ++blk, ++s) {
            asm volatile("s_waitcnt vmcnt(0)" ::: "memory");
            __syncthreads();
            if (blk < 4 || g + 1 < ng) { const int nb = (blk + 1) % 5; const int nld = (nb == 4) ? 4 : 8; int lz = lane * 16; asm volatile("" : "+v"(lz));
                const unsigned char* src = rtwb + (size_t)nb * 65536 + lz; LAS unsigned char* dst = F.lds + ((s + 1) & 1) * 65536;
#pragma unroll
                for (int k = 0; k < 8; ++k) if (k < nld) __builtin_amdgcn_global_load_lds((const unsigned*)(src + (size_t)(w + 8 * k) * 1024), (LAS unsigned*)(dst + (w + 8 * k) * 1024), 16, 0, 0); }
            { int l4 = 4 * lane; asm volatile("" : "+v"(l4)); const LAS float* wb = (const LAS float*)(F.lds + (s & 1) * 65536) + l4; const int nout = (blk == 4) ? 4 : 8;
#pragma unroll 1
                for (int q = 0; q < nout; ++q) { f32x2 dp[2] = {(f32x2){0.f, 0.f}, (f32x2){0.f, 0.f}};
#pragma unroll
                    for (int j = 0; j < 8; ++j) { const f32x4 wv = *(const LAS f32x4*)(wb + q * 2048 + 256 * j);
#pragma unroll
                        for (int rp = 0; rp < 2; ++rp)
#pragma unroll
                            for (int i = 0; i < 4; ++i) dp[rp] = __builtin_elementwise_fma(vp[rp][j][i], (f32x2){wv[i], wv[i]}, dp[rp]);
                        if ((j & 1) == 1) asm volatile("" ::: "memory"); }
                    const float d[4] = {dp[0][0], dp[0][1], dp[1][0], dp[1][1]};
                    const int jo = blk * 8 + q;
#pragma unroll
                    for (int r = 0; r < 4; ++r) { const float sm = wave_sum(d[r]); mine[r] = (lane == jo) ? sm : mine[r]; } } }
        }
#pragma unroll
        for (int r = 0; r < 4; ++r) { const float lg = mine[r] + be; const int row = rb + r;
            const float g0 = __shfl(lg, 32), g1 = __shfl(lg, 33), g2 = __shfl(lg, 34), g3 = __shfl(lg, 35);
            int gs = 0; float gm = g0; if (g1 > gm) { gm = g1; gs = 1; } if (g2 > gm) { gm = g2; gs = 2; } if (g3 > gm) { gm = g3; gs = 3; }
            const float pg = 1.0f / (expf(g0 - gm) + expf(g1 - gm) + expf(g2 - gm) + expf(g3 - gm));
            float ev[8];
#pragma unroll
            for (int i = 0; i < 8; ++i) ev[i] = __shfl(lg, gs * 8 + i);
            int i0 = 0; float v0 = ev[0];
#pragma unroll
            for (int i = 1; i < 8; ++i) if (ev[i] > v0) { v0 = ev[i]; i0 = i; }
            int i1 = -1; float v1 = -3.0e38f;
#pragma unroll
            for (int i = 0; i < 8; ++i) if (i != i0 && ev[i] > v1) { v1 = ev[i]; i1 = i; }
            const float e1 = expf(v1 - v0); const float w0 = pg / (1.0f + e1), w1 = pg * e1 / (1.0f + e1);
            if (lane == 0) { unsigned* cnt = (unsigned*)(KWS() + WS_CTL) + CW_CNT + l * 32; const int ex0 = gs * 8 + i0, ex1 = gs * 8 + i1;
                const unsigned p0 = atomicAdd(cnt + ex0, 1u), p1 = atomicAdd(cnt + ex1, 1u);
                unsigned* tk = (unsigned*)(KWS() + WS_TOK) + (size_t)row * 8;
                tk[0] = (unsigned)ex0; tk[1] = p0; tk[2] = __float_as_uint(w0); tk[3] = 0u; tk[4] = (unsigned)ex1; tk[5] = p1; tk[6] = __float_as_uint(w1); tk[7] = 0u; } }
    }
}


__device__ __forceinline__ void moe_tables(const Frame& F, const Params& p, int l) {
    LAS int* tbl = (LAS int*)(F.lds + LDS_MISC + 64);
    int* gtbl = (int*)(KWS() + WS_ROWINFO + 512 * 1024);
    if (F.wave == 0) { const unsigned* cnt = (const unsigned*)(KWS() + WS_CTL) + CW_CNT + l * 32; const int e = F.lane;
        const int c = (e < 32) ? (int)__hip_atomic_load(cnt + e, __ATOMIC_RELAXED, __HIP_MEMORY_SCOPE_AGENT) : 0; const int t = (c + 255) >> 8;
        int incl = t;
#pragma unroll
        for (int o = 1; o < 32; o <<= 1) { const int v = __shfl_up(incl, o); if (e >= o) incl += v; }
        const int start = incl - t; const int total = __shfl(incl, 31);
        if (e < 32) { tbl[160 + e] = start; tbl[192 + e] = start * 256 + c; for (int k = 0; k < t && start + k < MAXTILES; ++k) tbl[start + k] = e; }
        const int nt = total < MAXTILES ? total : MAXTILES;
        for (int k = nt + e; k < MAXTILES; k += 64) tbl[k] = 0;
        if (e == 0) tbl[224] = nt; }
    __syncthreads();
    if (F.bx == 0 && F.tid < 225) gtbl[F.tid] = tbl[F.tid];
}
__device__ __forceinline__ void moe_tables_load(const Frame& F, const Params& p) {
    LAS int* tbl = (LAS int*)(F.lds + LDS_MISC + 64);
    const int* gtbl = (const int*)(KWS() + WS_ROWINFO + 512 * 1024);
    if (F.tid < 225) tbl[F.tid] = gtbl[F.tid];
    __syncthreads();
}
__device__ __forceinline__ void phase_gather(const Frame& F, const Params& p, int l) {
    moe_tables(F, p, l);
    const LAS int* tbl = (const LAS int*)(F.lds + LDS_MISC + 64);
    u32x2* rowinfo = (u32x2*)(KWS() + WS_ROWINFO); int* rowtok = (int*)(KWS() + WS_TOK + 512 * 1024);
    for (int a = F.bx * NTHR + F.tid; a < 2 * S_; a += F.G * NTHR) { const int t = a >> 1, k = a & 1; const unsigned* tk = (const unsigned*)(KWS() + WS_TOK) + (size_t)t * 8 + 4 * k;
        const int e = (int)tk[0], pos = (int)tk[1]; const int dest = tbl[160 + e] * 256 + pos; u32x2 inf; inf.x = (unsigned)a; inf.y = tk[2]; rowinfo[dest] = inf; rowtok[dest] = t; }
    if (F.bx < 32) { const int e = F.bx; const int r0 = tbl[192 + e]; const int tend = (e < 31 ? tbl[160 + e + 1] : tbl[224]) * 256;
        for (int r = r0 + F.tid; r < tend; r += NTHR) rowtok[r] = 0; }
}

__device__ __forceinline__ void phase_lru_gates(const Frame& F, const Params& p, int l) {
    float* U = (float*)F.ldsg;
    const bf16_t* Z = (const bf16_t*)(KWS() + WS_Z); float* LA = (float*)(KWS() + WS_MF); float* LB = LA + (size_t)S_ * 1024;
    const float* cw = KIN(8) + l * 4 * 1024; const float* cb = KIN(9) + l * 1024; const float* wa = KIN(10) + (size_t)l * 8 * 128 * 128; const float* ba = KIN(11) + l * 1024;
    const float* wx = KIN(12) + (size_t)l * 8 * 128 * 128; const float* bx = KIN(13) + l * 1024; const float* lam = KIN(14) + l * 1024;
    for (int u = F.bx; u < 4096; u += F.G) {
        const int tt = u >> 1, half = u & 1, t0 = tt * 8, ch = half * 512 + F.tid, n = ch >> 7, j = ch & 127;
        float xr[11];
#pragma unroll
        for (int i = 0; i < 11; ++i) { const int t = t0 - 3 + i; xr[i] = (t >= 0) ? bf2f(Z[(size_t)t * NZ + ZC_LX + ch]) : 0.f; }
        const float c0 = cw[ch], c1 = cw[1024 + ch], c2 = cw[2048 + ch], c3 = cw[3072 + ch], cbv = cb[ch];
        float uo[8];
#pragma unroll
        for (int i = 0; i < 8; ++i) { uo[i] = c0 * xr[i] + c1 * xr[i + 1] + c2 * xr[i + 2] + c3 * xr[i + 3] + cbv; U[i * 512 + F.tid] = uo[i]; }
        __syncthreads();
        float ar[8], ai[8];
#pragma unroll
        for (int i = 0; i < 8; ++i) { ar[i] = 0.f; ai[i] = 0.f; }
        const float* wap = wa + (size_t)n * 16384 + j; const float* wxp = wx + (size_t)n * 16384 + j; const float* up = U + (F.tid & ~127);
        for (int i = 0; i < 128; ++i) { const float a = wap[i * 128], x = wxp[i * 128];
#pragma unroll
            for (int tk = 0; tk < 8; ++tk) { const float uu = up[tk * 512 + i]; ar[tk] += uu * a; ai[tk] += uu * x; } }
        const float bav = ba[ch], bxv = bx[ch], spl = softplusf(-lam[ch]);
#pragma unroll
        for (int tk = 0; tk < 8; ++tk) { const float r = sigm(ar[tk] + bav), ii = sigm(ai[tk] + bxv); const float la = -8.0f * r * spl;
            LA[(size_t)(t0 + tk) * 1024 + ch] = expf(la); LB[(size_t)(t0 + tk) * 1024 + ch] = sqrtf(-expm1f(2.0f * la)) * (ii * uo[tk]); }
        __syncthreads();
    }
}


constexpr int LRU_UF_PITCH = 132, LRU_UB_PITCH = 136;
template <bool FINAL>
__device__ __forceinline__ void lru_units(const Frame& F, const Params& p, int l, int first, int stride) {
    float* Uf = (float*)F.ldsg;
    float* Al = Uf + 64 * LRU_UF_PITCH;
    bf16_t* Ub = (bf16_t*)(Al + 64 * LRU_UF_PITCH);
    float* Cw = (float*)(Ub + 64 * LRU_UB_PITCH);
    const bf16_t* Z = (const bf16_t*)(KWS() + WS_Z); const bf16_t* LWT = (const bf16_t*)(KWS() + WS_LWT);
    float* PHb = (float*)(KWS() + WS_LPH); const float* CAR = (const float*)(KWS() + WS_LCARRY); bf16_t* Y = (bf16_t*)(KWS() + WS_Y);
    const float* cw = KIN(8) + l * 4 * 1024; const float* cb = KIN(9) + l * 1024; const float* ba = KIN(11) + l * 1024; const float* bx = KIN(13) + l * 1024; const float* lam = KIN(14) + l * 1024;
    const int w = F.wave, lane = F.lane, fr = lane & 15, fg = lane >> 4;
    int cur_n = -1; bf16x8 Bf[2][4]; float bav = 0.f, bxv = 0.f, spl = 0.f;
    u32x4 raw[4][2];
#define LRU_RAW(u_) do { const int n_ = (u_) & 7, t0_ = ((u_) >> 3) * 64, tt_ = F.tid >> 3, cg_ = F.tid & 7; _Pragma("unroll") for (int k = 0; k < 4; ++k) { const int t = t0_ + tt_ - 3 + k; \
        if (t >= 0) { const bf16_t* zp = Z + (size_t)t * NZ + ZC_LX + n_ * 128 + 16 * cg_; raw[k][0] = *(const u32x4*)zp; raw[k][1] = *(const u32x4*)(zp + 8); } \
        else { raw[k][0] = (u32x4){0u, 0u, 0u, 0u}; raw[k][1] = raw[k][0]; } } } while (0)
    if (first < 2048) LRU_RAW(first);
    for (int u = first; u < 2048; u += stride) {
        const int n = u & 7, ci = u >> 3, t0 = ci * 64;
        if (n != cur_n) {
            cur_n = n;
#pragma unroll
            for (int q = 0; q < 2; ++q)
#pragma unroll
                for (int ks = 0; ks < 4; ++ks) Bf[q][ks] = *(const bf16x8*)(LWT + ((size_t)n * 256 + q * 128 + 16 * w + fr) * 128 + 32 * ks + 8 * fg);
            const int ch = n * 128 + 16 * w + fr; bav = ba[ch]; bxv = bx[ch]; spl = softplusf(-lam[ch]);
            __syncthreads();
            for (int i = F.tid; i < 640; i += NTHR) { const int k = i >> 7, c = i & 127; Cw[i] = (k < 4) ? cw[k * 1024 + n * 128 + c] : cb[n * 128 + c]; }
            __syncthreads();
        }
        { const int tt = F.tid >> 3, cg = F.tid & 7; float xr[4][16];
#pragma unroll
            for (int k = 0; k < 4; ++k) { const u32x4 a = raw[k][0], b = raw[k][1];
                xr[k][0] = bflo(a.x); xr[k][1] = bfhi(a.x); xr[k][2] = bflo(a.y); xr[k][3] = bfhi(a.y); xr[k][4] = bflo(a.z); xr[k][5] = bfhi(a.z); xr[k][6] = bflo(a.w); xr[k][7] = bfhi(a.w);
                xr[k][8] = bflo(b.x); xr[k][9] = bfhi(b.x); xr[k][10] = bflo(b.y); xr[k][11] = bfhi(b.y); xr[k][12] = bflo(b.z); xr[k][13] = bfhi(b.z); xr[k][14] = bflo(b.w); xr[k][15] = bfhi(b.w); }
            if (u + stride < 2048) LRU_RAW(u + stride);
            if (FINAL && u + stride < 2048 && F.tid < 128) { const int un = u + stride; (void)*(const volatile unsigned*)(Z + (size_t)((un >> 3) * 64 + (F.tid >> 1)) * NZ + ZC_LG + (un & 7) * 128 + (F.tid & 1) * 64); }
            float uo[16];
#pragma unroll
            for (int i = 0; i < 16; ++i) { const int c = 16 * cg + i; uo[i] = Cw[c] * xr[0][i] + Cw[128 + c] * xr[1][i] + Cw[256 + c] * xr[2][i] + Cw[384 + c] * xr[3][i] + Cw[512 + c]; }
#pragma unroll
            for (int i = 0; i < 4; ++i) *(f32x4*)(Uf + tt * LRU_UF_PITCH + 16 * cg + 4 * i) = (f32x4){uo[4 * i], uo[4 * i + 1], uo[4 * i + 2], uo[4 * i + 3]};
            u32x4 o0, o1; o0.x = pk2(uo[0], uo[1]); o0.y = pk2(uo[2], uo[3]); o0.z = pk2(uo[4], uo[5]); o0.w = pk2(uo[6], uo[7]); o1.x = pk2(uo[8], uo[9]); o1.y = pk2(uo[10], uo[11]); o1.z = pk2(uo[12], uo[13]); o1.w = pk2(uo[14], uo[15]);
            *(u32x4*)(Ub + tt * LRU_UB_PITCH + 16 * cg) = o0; *(u32x4*)(Ub + tt * LRU_UB_PITCH + 16 * cg + 8) = o1; }
        __syncthreads();
        f32x4 acc[4][2];
#pragma unroll
        for (int mt = 0; mt < 4; ++mt) { acc[mt][0] = (f32x4){0.f, 0.f, 0.f, 0.f}; acc[mt][1] = acc[mt][0]; }
#pragma unroll
        for (int mt = 0; mt < 4; ++mt)
#pragma unroll
            for (int ks = 0; ks < 4; ++ks) { const bf16x8 af = *(const bf16x8*)(Ub + (16 * mt + fr) * LRU_UB_PITCH + 32 * ks + 8 * fg);
                acc[mt][0] = __builtin_amdgcn_mfma_f32_16x16x32_bf16(af, Bf[0][ks], acc[mt][0], 0, 0, 0);
                acc[mt][1] = __builtin_amdgcn_mfma_f32_16x16x32_bf16(af, Bf[1][ks], acc[mt][1], 0, 0, 0); }
#pragma unroll
        for (int mt = 0; mt < 4; ++mt)
#pragma unroll
            for (int r = 0; r < 4; ++r) { const int tk = 16 * mt + 4 * fg + r, cc = 16 * w + fr;
                const float rr = fsigm(acc[mt][0][r] + bav), ii = fsigm(acc[mt][1][r] + bxv), la = -8.0f * rr * spl;
                const float uu = Uf[tk * LRU_UF_PITCH + cc]; const float av = fexp(la);
                Al[tk * LRU_UF_PITCH + cc] = av; Uf[tk * LRU_UF_PITCH + cc] = __builtin_amdgcn_sqrtf(fmaxf(1.0f - av * av, 0.f)) * (ii * uu); }
        __syncthreads();
        { const int chl = F.tid & 127, seg = F.tid >> 7, ch = n * 128 + chl; float* SP = (float*)(Cw + 640); float* SH = SP + 512;
            unsigned short gq[16];
            if (FINAL) {
#pragma unroll
                for (int t = 0; t < 16; ++t) gq[t] = Z[(size_t)(t0 + 16 * seg + t) * NZ + ZC_LG + ch]; }
            float h = 0.f, P = 1.f;
#pragma unroll
            for (int t = 0; t < 16; ++t) { const float a = Al[(16 * seg + t) * LRU_UF_PITCH + chl], bb = Uf[(16 * seg + t) * LRU_UF_PITCH + chl]; h = a * h + bb; P *= a; }
            SP[seg * 128 + chl] = P; SH[seg * 128 + chl] = h;
            __syncthreads();
            float hin = FINAL ? CAR[(size_t)ci * 1024 + ch] : 0.f;
            if (FINAL) {
                for (int s = 0; s < seg; ++s) hin = SP[s * 128 + chl] * hin + SH[s * 128 + chl];
                h = hin;
#pragma unroll
                for (int t = 0; t < 16; ++t) { const float a = Al[(16 * seg + t) * LRU_UF_PITCH + chl], bb = Uf[(16 * seg + t) * LRU_UF_PITCH + chl]; h = a * h + bb;
                    const float g = bf2f(gq[t]); const float gl = g * fsigm(1.5957691216057308f * (g + 0.044715f * g * g * g));
                    Y[(size_t)(t0 + 16 * seg + t) * 3072 + 1024 + ch] = (bf16_t)f2bf(h * gl); }
            } else if (seg == 0) { float Pt = 1.f, Ht = 0.f;
#pragma unroll
                for (int s = 0; s < 4; ++s) { Ht = SP[s * 128 + chl] * Ht + SH[s * 128 + chl]; Pt *= SP[s * 128 + chl]; }
                *(f32x2*)(PHb + ((size_t)ci * 1024 + ch) * 2) = (f32x2){Pt, Ht}; } }
        __syncthreads();
    }
}
#undef LRU_RAW
__device__ __forceinline__ void lru_carry(const Frame& F, int part) {
    const float* PHb = (const float*)(KWS() + WS_LPH); float* CAR = (float*)(KWS() + WS_LCARRY);
    const int ch = part * 512 + F.tid; float h = 0.f;
    for (int c0 = 0; c0 < 256; c0 += 32) { f32x2 v[32];
#pragma unroll
        for (int i = 0; i < 32; ++i) v[i] = *(const f32x2*)(PHb + ((size_t)(c0 + i) * 1024 + ch) * 2);
#pragma unroll
        for (int i = 0; i < 32; ++i) { CAR[(size_t)(c0 + i) * 1024 + ch] = h; h = v[i][0] * h + v[i][1]; } }
}


constexpr int RT_PITCH = 136;
__device__ __forceinline__ float ret_log2g(int h) { return log2f(1.0f - exp2f(-5.0f - (float)h)); }
__device__ __forceinline__ void phase_gabw(const Frame& F) {
    float* gabw = (float*)(KWS() + WS_GABW); const float* w_in = KIN(7);
    for (int idx = F.bx * NTHR + F.tid; idx < 2 * 16 * 2048; idx += F.G * NTHR) { const int j = idx & 15, lk = idx >> 4, l = lk >> 11, k = lk & 2047; gabw[(l * 16 + j) * 2048 + k] = w_in[(size_t)lk * INC + 10240 + j]; }
}
__device__ __forceinline__ void phase_rope_table(const Frame& F) {
    float* RC = (float*)(KWS() + WS_ROPE_C); float* RS = (float*)(KWS() + WS_ROPE_S); const int* pos = (const int*)KIN(2);
    for (int idx = F.bx * NTHR + F.tid; idx < S_ * 64; idx += F.G * NTHR) { const int t = idx >> 6, i = idx & 63;
        const float invf = (float)exp2(-(double)i * (13.287712379549449 / 64.0)); const float angf = (float)pos[t] * invf;
        const double rev = (double)angf * 0.15915494309189535; const float fr = (float)(rev - rint(rev));
        RC[idx] = __builtin_amdgcn_cosf(fr); RS[idx] = __builtin_amdgcn_sinf(fr); }
}
template <bool ROPE>
__device__ __forceinline__ void stage_transposed(const Frame& F, const bf16_t* src  , int t0, bf16_t* T, float mul0, float mul1) {
    const int p = F.lane, c = F.wave; const float* RC = (const float*)(KWS() + WS_ROPE_C); const float* RS = (const float*)(KWS() + WS_ROPE_S);
    float a[2][8], b[2][8];
#pragma unroll
    for (int q = 0; q < 2; ++q) { const bf16_t* rp = src + (size_t)(2 * p + q) * NZ; unpack8(*(const u32x4*)(rp + 8 * c), a[q]); unpack8(*(const u32x4*)(rp + 64 + 8 * c), b[q]);
        if (ROPE) { const size_t ro = (size_t)(t0 + 2 * p + q) * 64 + 8 * c; const f32x4 c0 = *(const f32x4*)(RC + ro), c1 = *(const f32x4*)(RC + ro + 4), s0 = *(const f32x4*)(RS + ro), s1 = *(const f32x4*)(RS + ro + 4);
#pragma unroll
            for (int i = 0; i < 8; ++i) { const float cs = i < 4 ? c0[i & 3] : c1[i & 3], sn = i < 4 ? s0[i & 3] : s1[i & 3]; const float x1 = a[q][i], x2 = b[q][i]; a[q][i] = x1 * cs - x2 * sn; b[q][i] = x2 * cs + x1 * sn; } }
        const float m = q ? mul1 : mul0;
#pragma unroll
        for (int i = 0; i < 8; ++i) { a[q][i] *= m; b[q][i] *= m; } }
#pragma unroll
    for (int i = 0; i < 8; ++i) { *(unsigned*)(T + (8 * c + i) * RT_PITCH + 2 * p) = pk2(a[0][i], a[1][i]); *(unsigned*)(T + (64 + 8 * c + i) * RT_PITCH + 2 * p) = pk2(b[0][i], b[1][i]); }
}
__device__ __forceinline__ void stage_natural_rope(const Frame& F, const bf16_t* src, int t0, bf16_t* N, float mul) {
    const float* RC = (const float*)(KWS() + WS_ROPE_C); const float* RS = (const float*)(KWS() + WS_ROPE_S);
#pragma unroll
    for (int rep = 0; rep < 2; ++rep) { const int c = F.tid & 7, tok = (F.tid >> 3) + 64 * rep; const bf16_t* rp = src + (size_t)tok * NZ; float a[8], b[8];
        unpack8(*(const u32x4*)(rp + 8 * c), a); unpack8(*(const u32x4*)(rp + 64 + 8 * c), b);
        const size_t ro = (size_t)(t0 + tok) * 64 + 8 * c; const f32x4 c0 = *(const f32x4*)(RC + ro), c1 = *(const f32x4*)(RC + ro + 4), s0 = *(const f32x4*)(RS + ro), s1 = *(const f32x4*)(RS + ro + 4);
        float y1[8], y2[8];
#pragma unroll
        for (int i = 0; i < 8; ++i) { const float cs = i < 4 ? c0[i & 3] : c1[i & 3], sn = i < 4 ? s0[i & 3] : s1[i & 3]; y1[i] = (a[i] * cs - b[i] * sn) * mul; y2[i] = (b[i] * cs + a[i] * sn) * mul; }
        u32x4 o1, o2; o1.x = pk2(y1[0], y1[1]); o1.y = pk2(y1[2], y1[3]); o1.z = pk2(y1[4], y1[5]); o1.w = pk2(y1[6], y1[7]); o2.x = pk2(y2[0], y2[1]); o2.y = pk2(y2[2], y2[3]); o2.z = pk2(y2[4], y2[5]); o2.w = pk2(y2[6], y2[7]);
        *(u32x4*)(N + tok * RT_PITCH + 8 * c) = o1; *(u32x4*)(N + tok * RT_PITCH + 64 + 8 * c) = o2; }
}

struct RopeCS { f32x4 c0, c1, s0, s1; };
__device__ __forceinline__ void rope_store_natural(bf16_t* N, int tok, int c, const u32x4 xa, const u32x4 xb, const RopeCS& cs, float mul) {
    float a[8], b[8]; unpack8(xa, a); unpack8(xb, b); float y1[8], y2[8];
#pragma unroll
    for (int i = 0; i < 8; ++i) { const float co = i < 4 ? cs.c0[i & 3] : cs.c1[i & 3], sn = i < 4 ? cs.s0[i & 3] : cs.s1[i & 3]; y1[i] = (a[i] * co - b[i] * sn) * mul; y2[i] = (b[i] * co + a[i] * sn) * mul; }
    u32x4 o1, o2; o1.x = pk2(y1[0], y1[1]); o1.y = pk2(y1[2], y1[3]); o1.z = pk2(y1[4], y1[5]); o1.w = pk2(y1[6], y1[7]); o2.x = pk2(y2[0], y2[1]); o2.y = pk2(y2[2], y2[3]); o2.z = pk2(y2[4], y2[5]); o2.w = pk2(y2[6], y2[7]);
    *(u32x4*)(N + tok * RT_PITCH + 8 * c) = o1; *(u32x4*)(N + tok * RT_PITCH + 64 + 8 * c) = o2;
}
template <bool ROPE>
__device__ __forceinline__ void store_transposed(bf16_t* T, int p, int c, const u32x4 (&xa)[2], const u32x4 (&xb)[2], const RopeCS (&cs)[2], float mul0, float mul1) {
    float a[2][8], b[2][8];
#pragma unroll
    for (int q = 0; q < 2; ++q) { unpack8(xa[q], a[q]); unpack8(xb[q], b[q]);
        if (ROPE) {
#pragma unroll
            for (int i = 0; i < 8; ++i) { const float co = i < 4 ? cs[q].c0[i & 3] : cs[q].c1[i & 3], sn = i < 4 ? cs[q].s0[i & 3] : cs[q].s1[i & 3]; const float x1 = a[q][i], x2 = b[q][i]; a[q][i] = x1 * co - x2 * sn; b[q][i] = x2 * co + x1 * sn; } }
        const float m = q ? mul1 : mul0;
#pragma unroll
        for (int i = 0; i < 8; ++i) { a[q][i] *= m; b[q][i] *= m; } }
#pragma unroll
    for (int i = 0; i < 8; ++i) { *(unsigned*)(T + (8 * c + i) * RT_PITCH + 2 * p) = pk2(a[0][i], a[1][i]); *(unsigned*)(T + (64 + 8 * c + i) * RT_PITCH + 2 * p) = pk2(b[0][i], b[1][i]); }
}
__device__ __forceinline__ RopeCS load_cs(int tok_global, int c) { const float* RC = (const float*)(KWS() + WS_ROPE_C); const float* RS = (const float*)(KWS() + WS_ROPE_S); const size_t ro = (size_t)tok_global * 64 + 8 * c;
    RopeCS r; r.c0 = *(const f32x4*)(RC + ro); r.c1 = *(const f32x4*)(RC + ro + 4); r.s0 = *(const f32x4*)(RS + ro); r.s1 = *(const f32x4*)(RS + ro + 4); return r; }
__device__ __forceinline__ void ret_units_a(const Frame& F, int first, int stride) {
    bf16_t* Kt = (bf16_t*)F.ldsg; bf16_t* Vt = Kt + 128 * RT_PITCH;
    const bf16_t* Z = (const bf16_t*)(KWS() + WS_Z); float* KV = (float*)(KWS() + WS_KV);
    const int w = F.wave, lane = F.lane, fr = lane & 15, fg = lane >> 4, pp = F.lane, cw = F.wave;
    u32x4 ka[2], kb[2], va[2], vb[2]; RopeCS cs[2];
#define RETA_RAW(u_) do { const int h_ = (u_) & 7, t0_ = ((u_) >> 3) * 128; const bf16_t* zk = Z + (size_t)t0_ * NZ + ZC_RK + h_ * 128; const bf16_t* zv = Z + (size_t)t0_ * NZ + ZC_RV + h_ * 128; \
        _Pragma("unroll") for (int q = 0; q < 2; ++q) { const size_t ro = (size_t)(2 * pp + q) * NZ; ka[q] = *(const u32x4*)(zk + ro + 8 * cw); kb[q] = *(const u32x4*)(zk + ro + 64 + 8 * cw); \
            va[q] = *(const u32x4*)(zv + ro + 8 * cw); vb[q] = *(const u32x4*)(zv + ro + 64 + 8 * cw); cs[q] = load_cs(t0_ + 2 * pp + q, cw); } } while (0)
    if (first < 1024) RETA_RAW(first);
    for (int u = first; u < 1024; u += stride) {
        const int h = u & 7, n = u >> 3; const float l2g = ret_log2g(h);
        const float m0 = 0.08838834764831845f * exp2f((float)(127 - 2 * lane) * l2g), m1 = 0.08838834764831845f * exp2f((float)(126 - 2 * lane) * l2g);
        store_transposed<true>(Kt, pp, cw, ka, kb, cs, m0, m1); store_transposed<false>(Vt, pp, cw, va, vb, cs, 1.0f, 1.0f);
        if (u + stride < 1024) RETA_RAW(u + stride);
        __syncthreads();
        f32x4 acc[8];
#pragma unroll
        for (int nt = 0; nt < 8; ++nt) acc[nt] = (f32x4){0.f, 0.f, 0.f, 0.f};
#pragma unroll
        for (int ks = 0; ks < 4; ++ks) { const bf16x8 af = *(const bf16x8*)(Kt + (16 * w + fr) * RT_PITCH + 32 * ks + 8 * fg);
#pragma unroll
            for (int nt = 0; nt < 8; ++nt) { const bf16x8 bfr = *(const bf16x8*)(Vt + (16 * nt + fr) * RT_PITCH + 32 * ks + 8 * fg); acc[nt] = __builtin_amdgcn_mfma_f32_16x16x32_bf16(af, bfr, acc[nt], 0, 0, 0); } }
        float* kvp = KV + ((size_t)(n * 8 + h) * 128) * 128;
#pragma unroll
        for (int nt = 0; nt < 8; ++nt) *(f32x4*)(kvp + (size_t)(16 * nt + fr) * 128 + 16 * w + 4 * fg) = acc[nt];
        __syncthreads();
    }
#undef RETA_RAW
}
__device__ __forceinline__ void ret_scan(const Frame& F, int wg, int nwg) {
    float* KV = (float*)(KWS() + WS_KV);
    for (int idx = wg * NTHR + F.tid; idx < 8 * 8192; idx += nwg * NTHR) { const int h = idx >> 13, ed = (idx & 8191) * 2; const float cd = exp2f(128.0f * ret_log2g(h)); f32x2 R = (f32x2){0.f, 0.f};
        for (int n0 = 0; n0 < 128; n0 += 16) { f32x2 v[16];
#pragma unroll
            for (int i = 0; i < 16; ++i) v[i] = *(const f32x2*)(KV + ((size_t)((n0 + i) * 8 + h) << 14) + ed);
#pragma unroll
            for (int i = 0; i < 16; ++i) { *(f32x2*)(KV + ((size_t)((n0 + i) * 8 + h) << 14) + ed) = R; R[0] = cd * R[0] + v[i][0]; R[1] = cd * R[1] + v[i][1]; } } }
}
__device__ __forceinline__ void ret_units_c(const Frame& F, int first, int stride) {
    bf16_t* Qs = (bf16_t*)F.ldsg; bf16_t* Ks = Qs + 128 * RT_PITCH; bf16_t* Vt = Ks + 128 * RT_PITCH; bf16_t* Rt = Vt + 128 * RT_PITCH;
    const bf16_t* Z = (const bf16_t*)(KWS() + WS_Z); const float* KV = (const float*)(KWS() + WS_KV); bf16_t* Y = (bf16_t*)(KWS() + WS_Y);
    const int w = F.wave, lane = F.lane, fr = lane & 15, fg = lane >> 4;
    for (int u = first; u < 1024; u += stride) {
        const int h = u & 7, n = u >> 3, t0 = n * 128; const float l2g = ret_log2g(h);
        { const int pp = F.lane, cw = F.wave, cn = F.tid & 7; const bf16_t* zq = Z + (size_t)t0 * NZ + ZC_RQ + h * 128; const bf16_t* zk = Z + (size_t)t0 * NZ + ZC_RK + h * 128; const bf16_t* zv = Z + (size_t)t0 * NZ + ZC_RV + h * 128;
            const float* kvp = KV + ((size_t)(n * 8 + h) << 14);
            u32x4 qa[2], qb[2], ka[2], kb[2], va[2], vb[2]; RopeCS cs[2]; f32x4 rv[8];
#pragma unroll
            for (int rep = 0; rep < 2; ++rep) { const int tok = (F.tid >> 3) + 64 * rep; const size_t ro = (size_t)tok * NZ; qa[rep] = *(const u32x4*)(zq + ro + 8 * cn); qb[rep] = *(const u32x4*)(zq + ro + 64 + 8 * cn);
                ka[rep] = *(const u32x4*)(zk + ro + 8 * cn); kb[rep] = *(const u32x4*)(zk + ro + 64 + 8 * cn); cs[rep] = load_cs(t0 + tok, cn); }
#pragma unroll
            for (int q = 0; q < 2; ++q) { const size_t ro = (size_t)(2 * pp + q) * NZ; va[q] = *(const u32x4*)(zv + ro + 8 * cw); vb[q] = *(const u32x4*)(zv + ro + 64 + 8 * cw); }
#pragma unroll
            for (int i = 0; i < 8; ++i) { const int i4 = F.tid + NTHR * i; rv[i] = *(const f32x4*)(kvp + (i4 >> 5) * 128 + (i4 & 31) * 4); }
#pragma unroll
            for (int rep = 0; rep < 2; ++rep) { const int tok = (F.tid >> 3) + 64 * rep; rope_store_natural(Qs, tok, cn, qa[rep], qb[rep], cs[rep], 1.0f); rope_store_natural(Ks, tok, cn, ka[rep], kb[rep], cs[rep], 0.08838834764831845f); }
            store_transposed<false>(Vt, pp, cw, va, vb, cs, 1.0f, 1.0f);
#pragma unroll
            for (int i = 0; i < 8; ++i) { const int i4 = F.tid + NTHR * i, e = i4 >> 5, d4 = (i4 & 31) * 4; u32x2 o; o.x = pk2(rv[i][0], rv[i][1]); o.y = pk2(rv[i][2], rv[i][3]); *(u32x2*)(Rt + e * RT_PITCH + d4) = o; } }
        if (u + stride < 1024) { const int un = u + stride, hn = un & 7, nn = un >> 3; const int part = F.tid & 3, tokn = F.tid >> 2;
            const bf16_t* zr = Z + (size_t)(nn * 128 + tokn) * NZ + (part == 0 ? ZC_RQ : part == 1 ? ZC_RK : ZC_RV) + hn * 128;
            if (part < 3) { (void)*(const volatile unsigned*)zr; (void)*(const volatile unsigned*)(zr + 64); }
            (void)*(const volatile unsigned*)(KV + ((size_t)(nn * 8 + hn) << 14) + F.tid * 32); }
        __syncthreads();
#pragma unroll 1
        for (int half = 0; half < 2; ++half) {
            const int T = half ? 7 - w : w;
            u32x2 gpre[8]; { const size_t tgp = (size_t)(t0 + 16 * T + fr);
#pragma unroll
                for (int mt = 0; mt < 8; ++mt) gpre[mt] = *(const u32x2*)(Z + tgp * NZ + ZC_RG + h * 128 + 16 * mt + 4 * fg); }
            bf16x8 qf[4];
#pragma unroll
            for (int ks = 0; ks < 4; ++ks) qf[ks] = *(const bf16x8*)(Qs + (16 * T + fr) * RT_PITCH + 32 * ks + 8 * fg);
            f32x4 ao[8], ar[8];
#pragma unroll
            for (int mt = 0; mt < 8; ++mt) { ao[mt] = (f32x4){0.f, 0.f, 0.f, 0.f}; ar[mt] = ao[mt]; }
#pragma unroll
            for (int mt = 0; mt < 8; ++mt)
#pragma unroll
                for (int ks = 0; ks < 4; ++ks) { const bf16x8 af = *(const bf16x8*)(Rt + (16 * mt + fr) * RT_PITCH + 32 * ks + 8 * fg); ar[mt] = __builtin_amdgcn_mfma_f32_16x16x32_bf16(af, qf[ks], ar[mt], 0, 0, 0);
                    if (ks == 3 && (mt & 3) == 3) asm volatile("" ::: "memory"); }
            const int il = 16 * T + fr;
            for (int kp = 0; kp <= (T >> 1); ++kp) {
                u32x2 pt[2];
#pragma unroll
                for (int q = 0; q < 2; ++q) { const int jt = 2 * kp + q; f32x4 s = (f32x4){0.f, 0.f, 0.f, 0.f};
                    if (jt <= T) {
#pragma unroll
                        for (int ks = 0; ks < 4; ++ks) { const bf16x8 kf = *(const bf16x8*)(Ks + (16 * jt + fr) * RT_PITCH + 32 * ks + 8 * fg); s = __builtin_amdgcn_mfma_f32_16x16x32_bf16(kf, qf[ks], s, 0, 0, 0); }
#pragma unroll
                        for (int r = 0; r < 4; ++r) { const int jl = 16 * jt + 4 * fg + r; s[r] = (il >= jl) ? s[r] * __builtin_amdgcn_exp2f((float)(il - jl) * l2g) : 0.f; }
                        asm volatile("" ::: "memory"); }
                    pt[q].x = pk2(s[0], s[1]); pt[q].y = pk2(s[2], s[3]); }
                bf16x8 pf; { u32x4 t4; t4.x = pt[0].x; t4.y = pt[0].y; t4.z = pt[1].x; t4.w = pt[1].y; pf = __builtin_bit_cast(bf16x8, t4); }
#pragma unroll
                for (int mt = 0; mt < 8; ++mt) { const u32x2 v0 = *(const u32x2*)(Vt + (16 * mt + fr) * RT_PITCH + 32 * kp + 4 * fg), v1 = *(const u32x2*)(Vt + (16 * mt + fr) * RT_PITCH + 32 * kp + 16 + 4 * fg);
                    u32x4 t4; t4.x = v0.x; t4.y = v0.y; t4.z = v1.x; t4.w = v1.y; const bf16x8 vf = __builtin_bit_cast(bf16x8, t4);
                    ao[mt] = __builtin_amdgcn_mfma_f32_16x16x32_bf16(vf, pf, ao[mt], 0, 0, 0); if (mt == 7) asm volatile("" ::: "memory"); } }
            const float qd = exp2f((float)(il + 1) * l2g); float ss = 0.f;
#pragma unroll
            for (int mt = 0; mt < 8; ++mt) { ao[mt] = ao[mt] + ar[mt] * qd; ss += (ao[mt][0] * ao[mt][0] + ao[mt][1] * ao[mt][1]) + (ao[mt][2] * ao[mt][2] + ao[mt][3] * ao[mt][3]); }
            ss += __shfl_xor(ss, 16); ss += __shfl_xor(ss, 32);
            const float rstd = 1.0f / sqrtf(ss * (1.0f / 128.0f) + EPS); const size_t tg = (size_t)(t0 + il);
#pragma unroll
            for (int mt = 0; mt < 8; ++mt) { const int e0 = h * 128 + 16 * mt + 4 * fg; const u32x2 gw = gpre[mt];
                u32x2 o; o.x = pk2(ao[mt][0] * rstd * fsilu(bflo(gw.x)), ao[mt][1] * rstd * fsilu(bfhi(gw.x))); o.y = pk2(ao[mt][2] * rstd * fsilu(bflo(gw.y)), ao[mt][3] * rstd * fsilu(bfhi(gw.y)));
                *(u32x2*)(Y + tg * 3072 + e0) = o; }
        }
        __syncthreads();
    }
}


constexpr int GP = 136;
constexpr int GMP = 68;
constexpr int GS_FRAGS = 32, GS_PACK_BYTES = GS_FRAGS * 1024, GO_FRAGS = 24, GO_PACK_BYTES = GO_FRAGS * 1024;
__device__ __forceinline__ bf16x8 mk_frag(u32x2 lo, u32x2 hi) { u32x4 t; t.x = lo.x; t.y = lo.y; t.z = hi.x; t.w = hi.y; return __builtin_bit_cast(bf16x8, t); }
__device__ __forceinline__ bf16x8 pack_acc2(const f32x4 a, const f32x4 b) { u32x4 t; t.x = pk2(a[0], a[1]); t.y = pk2(a[2], a[3]); t.z = pk2(b[0], b[1]); t.w = pk2(b[2], b[3]); return __builtin_bit_cast(bf16x8, t); }
__device__ __forceinline__ u32x4 tile_frag_scaled(const bf16_t* T, int mt, int ks, int fr, int fg, float sc) {
    const u32x2 lo = *(const u32x2*)(T + (16 * mt + fr) * GP + 32 * ks + 4 * fg), hi = *(const u32x2*)(T + (16 * mt + fr) * GP + 32 * ks + 16 + 4 * fg);
    u32x4 o; o.x = pk2(bflo(lo.x) * sc, bfhi(lo.x) * sc); o.y = pk2(bflo(lo.y) * sc, bfhi(lo.y) * sc); o.z = pk2(bflo(hi.x) * sc, bfhi(hi.x) * sc); o.w = pk2(bflo(hi.y) * sc, bfhi(hi.y) * sc); return o;
}
__device__ __forceinline__ void gdn_units_a(const Frame& F, const Params& p, int l) {
    bf16_t* Qn = (bf16_t*)F.ldsg; bf16_t* Kn = Qn + 64 * GP; bf16_t* Vn = Kn + 64 * GP; bf16_t* Wl = Vn + 64 * GP;
    float* Mm = (float*)(Wl + 64 * GP);
    float* gcv = Mm + 64 * GMP; float* bet = gcv + 64; float* beg = bet + 64; float* ekd = beg + 64; float* egc = ekd + 64;
    float* cwl = egc + 64;
    const bf16_t* Z = (const bf16_t*)(KWS() + WS_Z); const float* GAB = (const float*)(KWS() + WS_GAB);
    unsigned char* P2 = KWS() + WS_GP2; float* UP = (float*)(KWS() + WS_GUP); float* GL = (float*)(KWS() + WS_GGL);
    const float* cw = KIN(15) + (size_t)l * 4 * 3072;
    const int w = F.wave, lane = F.lane, fr = lane & 15, fg = lane >> 4;
    int cur_h = -1; float Aexp = 0.f, dtb = 0.f;
    for (int u = F.bx; u < 2048; u += F.G) {
        const int h = u & 7, n = u >> 3, t0 = n * 64;
        if (h != cur_h) { cur_h = h; Aexp = expf(KIN(16)[l * 8 + h]); dtb = KIN(17)[l * 8 + h];
            __syncthreads();
            for (int i = F.tid; i < 1536; i += NTHR) { const int ten = i >> 9, k = (i >> 7) & 3, c = i & 127; cwl[i] = cw[k * 3072 + ten * 1024 + h * 128 + c]; }
            __syncthreads(); }
        { const int tt = F.tid >> 3, cg = F.tid & 7;
#pragma unroll
            for (int ten = 0; ten < 3; ++ten) { float y[16];
#pragma unroll
                for (int i = 0; i < 16; ++i) y[i] = 0.f;
#pragma unroll
                for (int k = 0; k < 4; ++k) { const int t = t0 + tt - 3 + k;
                    if (t >= 0) { const bf16_t* zp = Z + (size_t)t * NZ + ZC_GQ + ten * 1024 + h * 128 + 16 * cg; float x[16]; float x8a[8], x8b[8]; unpack8(*(const u32x4*)zp, x8a); unpack8(*(const u32x4*)(zp + 8), x8b);
#pragma unroll
                        for (int i = 0; i < 8; ++i) { x[i] = x8a[i]; x[8 + i] = x8b[i]; }
#pragma unroll
                        for (int i = 0; i < 16; ++i) y[i] += cwl[(ten * 4 + k) * 128 + 16 * cg + i] * x[i]; } }
                float ss = 0.f;
#pragma unroll
                for (int i = 0; i < 16; ++i) { y[i] = fsilu(y[i]); ss += y[i] * y[i]; }
                float mul = 1.0f;
                if (ten < 2) { ss += __shfl_xor(ss, 1); ss += __shfl_xor(ss, 2); ss += __shfl_xor(ss, 4); mul = (1.0f / sqrtf(ss + EPS)) * (ten == 0 ? 0.08838834764831845f : 1.0f); }
                bf16_t* dst = (ten == 0 ? Qn : (ten == 1 ? Kn : Vn)) + tt * GP + 16 * cg; u32x4 o0, o1;
                o0.x = pk2(y[0] * mul, y[1] * mul); o0.y = pk2(y[2] * mul, y[3] * mul); o0.z = pk2(y[4] * mul, y[5] * mul); o0.w = pk2(y[6] * mul, y[7] * mul);
                o1.x = pk2(y[8] * mul, y[9] * mul); o1.y = pk2(y[10] * mul, y[11] * mul); o1.z = pk2(y[12] * mul, y[13] * mul); o1.w = pk2(y[14] * mul, y[15] * mul);
                *(u32x4*)dst = o0; *(u32x4*)(dst + 8) = o1;
                asm volatile("" ::: "memory"); } }
        if (w == 0) { const size_t gi = (size_t)(t0 + lane) * 16; const float g = -Aexp * softplusf(GAB[gi + h] + dtb); const float beta = sigm(GAB[gi + 8 + h]);
            float gc = g;
#pragma unroll
            for (int o = 1; o < 64; o <<= 1) { const float t = __shfl_up(gc, o); if (lane >= o) gc += t; }
            const float gl = __shfl(gc, 63);
            gcv[lane] = gc; bet[lane] = beta; { const float eg = expf(gc); egc[lane] = eg; beg[lane] = beta * eg; } ekd[lane] = expf(gl - gc);
            if (lane == 0) GL[u] = expf(gl); }
        __syncthreads();
        unsigned char* pk = P2 + (size_t)u * GS_PACK_BYTES; unsigned char* pko = KWS() + WS_GPO + (size_t)u * GO_PACK_BYTES;
        { const int mt = w >> 1;
#pragma unroll
            for (int q = 0; q < 2; ++q) { const int nt = 2 * (w & 1) + q;
                if (nt <= mt) { f32x4 s = (f32x4){0.f, 0.f, 0.f, 0.f};
#pragma unroll
                    for (int ks = 0; ks < 4; ++ks) { const bf16x8 af = *(const bf16x8*)(Kn + (16 * mt + fr) * GP + 32 * ks + 8 * fg), bf_ = *(const bf16x8*)(Kn + (16 * nt + fr) * GP + 32 * ks + 8 * fg); s = __builtin_amdgcn_mfma_f32_16x16x32_bf16(af, bf_, s, 0, 0, 0); }
                    const int j = 16 * nt + fr; const float gj = gcv[j];
#pragma unroll
                    for (int r = 0; r < 4; ++r) { const int i = 16 * mt + 4 * fg + r; Mm[i * GMP + j] = (i > j) ? bet[i] * s[r] * fexp(gcv[i] - gj) : 0.f; } } } }
        { const int it = w >> 1, ksA = w & 1; f32x4 s2[2];
#pragma unroll
            for (int q = 0; q < 2; ++q) { const int jt = 2 * ksA + q; s2[q] = (f32x4){0.f, 0.f, 0.f, 0.f};
                if (jt <= it) {
#pragma unroll
                    for (int ks = 0; ks < 4; ++ks) { const bf16x8 af = *(const bf16x8*)(Kn + (16 * jt + fr) * GP + 32 * ks + 8 * fg), bf_ = *(const bf16x8*)(Qn + (16 * it + fr) * GP + 32 * ks + 8 * fg); s2[q] = __builtin_amdgcn_mfma_f32_16x16x32_bf16(af, bf_, s2[q], 0, 0, 0); }
                    const int i = 16 * it + fr; const float gi = gcv[i];
#pragma unroll
                    for (int r = 0; r < 4; ++r) { const int j = 16 * jt + 4 * fg + r; s2[q][r] = (i >= j) ? s2[q][r] * fexp(gi - gcv[j]) : 0.f; } } }
            *(bf16x8*)(pko + (size_t)(16 + it * 2 + ksA) * 1024 + lane * 16) = pack_acc2(s2[0], s2[1]); }
        __syncthreads();
        if (w < 4) { const int c = F.tid; float sol[64];
#pragma unroll
            for (int i = 0; i < 64; ++i) sol[i] = 0.f;
            LAS const bf16_t* colp = (LAS const bf16_t*)(F.lds) + ((c < 128) ? (2 * 64 * GP + c) : (64 * GP + (c - 128))); asm volatile("" : "+v"(colp));
            LAS const float* mm = (LAS const float*)(F.lds + 4 * 64 * GP * 2); asm volatile("" : "+v"(mm));
            LAS const float* tb = mm + 64 * GMP + ((c < 128) ? 64 : 128); asm volatile("" : "+v"(tb));
#pragma unroll
            for (int i = 0; i < 64; ++i) { float a = bf2f(colp[i * GP]) * tb[i];
#pragma unroll
                for (int jb = 0; jb < (i + 3) / 4; ++jb) { const f32x4 m4 = *(LAS const f32x4*)(mm + i * GMP + 4 * jb);
                    a -= m4[0] * sol[4 * jb]; a -= m4[1] * sol[4 * jb + 1]; a -= m4[2] * sol[4 * jb + 2]; a -= m4[3] * sol[4 * jb + 3];
                    if ((jb & 3) == 3) asm volatile("" ::: "memory"); }
                sol[i] = a; asm volatile("" ::: "memory"); }
            if (c < 128) { float* up = UP + (size_t)u * 8192 + (size_t)(c >> 4) * 1024;
#pragma unroll
                for (int t = 0; t < 4; ++t)
#pragma unroll
                    for (int G = 0; G < 4; ++G) *(f32x4*)(up + (t * 64 + (c & 15) + 16 * G) * 4) = (f32x4){sol[16 * t + 4 * G], sol[16 * t + 4 * G + 1], sol[16 * t + 4 * G + 2], sol[16 * t + 4 * G + 3]}; }
            else { const int d = c - 128;
#pragma unroll
                for (int i = 0; i < 64; ++i) Wl[i * GP + d] = (bf16_t)f2bf(-sol[i]); }
        } else { const int w4 = w - 4;
#pragma unroll
            for (int q = 0; q < 4; ++q) { const int f = w4 * 4 + q, mt = f >> 2, ks = f & 3;
                *(u32x4*)(pko + (size_t)f * 1024 + lane * 16) = tile_frag_scaled(Qn, mt, ks, fr, fg, egc[16 * mt + fr]); }
#pragma unroll
            for (int q = 0; q < 4; ++q) { const int f = w4 * 4 + q, mt = f >> 1, ks = f & 1;
                float v[8];
#pragma unroll
                for (int jj = 0; jj < 8; ++jj) { const int tk = 32 * ks + 16 * (jj >> 2) + 4 * fg + (jj & 3); v[jj] = bf2f(Kn[tk * GP + 16 * mt + fr]) * ekd[tk]; }
                u32x4 o; o.x = pk2(v[0], v[1]); o.y = pk2(v[2], v[3]); o.z = pk2(v[4], v[5]); o.w = pk2(v[6], v[7]);
                *(u32x4*)(pk + (size_t)(16 + f) * 1024 + lane * 16) = o; } }
        __syncthreads();
#pragma unroll
        for (int q = 0; q < 2; ++q) { const int f = w * 2 + q, mt = f >> 2, ks = f & 3; *(u32x4*)(pk + (size_t)f * 1024 + lane * 16) = tile_frag_scaled(Wl, mt, ks, fr, fg, 1.0f); }
        __syncthreads();
    }
}

constexpr int GA_SET = 3 * 64 * GP * 2 + 5 * 64 * 4, GA_WL = 2 * GA_SET, GA_MM = GA_WL + 64 * GP * 2, GA_CW = GA_MM + 64 * GMP * 4, GA_END = GA_CW + 1536 * 4;
static_assert(GA_END <= LDS_MISC, "gdn prep LDS map");
__device__ __forceinline__ void gdn_stage_unit(const Frame& F, const Params& p, int l, int u, int h, float Aexp, float dtb, unsigned char* setb, const float* cwl) {
    bf16_t* Qn = (bf16_t*)setb; bf16_t* Kn = Qn + 64 * GP; bf16_t* Vn = Kn + 64 * GP; float* gcv = (float*)(Vn + 64 * GP); float* bet = gcv + 64; float* beg = bet + 64; float* ekd = beg + 64; float* egc = ekd + 64;
    const bf16_t* Z = (const bf16_t*)(KWS() + WS_Z); const float* GAB = (const float*)(KWS() + WS_GAB); float* GL = (float*)(KWS() + WS_GGL);
    const int n = u >> 3, t0 = n * 64, lane = F.lane;
    float ga_pre = 0.f, gb_pre = 0.f; if (F.wave == 4) { const size_t gi = (size_t)(t0 + lane) * 16; ga_pre = GAB[gi + h]; gb_pre = GAB[gi + 8 + h]; }
#pragma unroll 1
    for (int rep = 0; rep < 2; ++rep) { const int it = (F.tid - 256) + 256 * rep, tt = it >> 3, cg = it & 7;
        u32x4 raw[3][4][2];
#pragma unroll
        for (int ten = 0; ten < 3; ++ten)
#pragma unroll
            for (int k = 0; k < 4; ++k) { const int t = t0 + tt - 3 + k;
                if (t >= 0) { const bf16_t* zp = Z + (size_t)t * NZ + ZC_GQ + ten * 1024 + h * 128 + 16 * cg; raw[ten][k][0] = *(const u32x4*)zp; raw[ten][k][1] = *(const u32x4*)(zp + 8); }
                else { raw[ten][k][0] = (u32x4){0u, 0u, 0u, 0u}; raw[ten][k][1] = raw[ten][k][0]; } }
#pragma unroll
        for (int ten = 0; ten < 3; ++ten) { float y[16];
#pragma unroll
            for (int i = 0; i < 16; ++i) y[i] = 0.f;
#pragma unroll
            for (int k = 0; k < 4; ++k) { float x8a[8], x8b[8]; unpack8(raw[ten][k][0], x8a); unpack8(raw[ten][k][1], x8b);
#pragma unroll
                for (int i = 0; i < 8; ++i) { y[i] += cwl[(ten * 4 + k) * 128 + 16 * cg + i] * x8a[i]; y[8 + i] += cwl[(ten * 4 + k) * 128 + 16 * cg + 8 + i] * x8b[i]; } }
            float ss = 0.f;
#pragma unroll
            for (int i = 0; i < 16; ++i) { y[i] = fsilu(y[i]); ss += y[i] * y[i]; }
            float mul = 1.0f;
            if (ten < 2) { ss += __shfl_xor(ss, 1); ss += __shfl_xor(ss, 2); ss += __shfl_xor(ss, 4); mul = (1.0f / sqrtf(ss + EPS)) * (ten == 0 ? 0.08838834764831845f : 1.0f); }
            bf16_t* dst = (ten == 0 ? Qn : (ten == 1 ? Kn : Vn)) + tt * GP + 16 * cg; u32x4 o0, o1;
            o0.x = pk2(y[0] * mul, y[1] * mul); o0.y = pk2(y[2] * mul, y[3] * mul); o0.z = pk2(y[4] * mul, y[5] * mul); o0.w = pk2(y[6] * mul, y[7] * mul);
            o1.x = pk2(y[8] * mul, y[9] * mul); o1.y = pk2(y[10] * mul, y[11] * mul); o1.z = pk2(y[12] * mul, y[13] * mul); o1.w = pk2(y[14] * mul, y[15] * mul);
            *(u32x4*)dst = o0; *(u32x4*)(dst + 8) = o1; }
        asm volatile("" ::: "memory"); }
    if (F.wave == 4) { const float g = -Aexp * softplusf(ga_pre + dtb); const float beta = sigm(gb_pre);
        float gc = g;
#pragma unroll
        for (int o = 1; o < 64; o <<= 1) { const float t = __shfl_up(gc, o); if (lane >= o) gc += t; }
        const float gl = __shfl(gc, 63);
        gcv[lane] = gc; bet[lane] = beta; { const float eg = expf(gc); egc[lane] = eg; beg[lane] = beta * eg; } ekd[lane] = expf(gl - gc);
        if (lane == 0) GL[u] = expf(gl); }
}
__device__ __forceinline__ void gdn_units_a_pipe(const Frame& F, const Params& p, int l) {
    unsigned char* L = F.ldsg; bf16_t* Wl = (bf16_t*)(L + GA_WL); float* Mm = (float*)(L + GA_MM); float* cwl = (float*)(L + GA_CW);
    unsigned char* P2 = KWS() + WS_GP2; float* UP = (float*)(KWS() + WS_GUP);
    const float* cw = KIN(15) + (size_t)l * 4 * 3072;
    const int w = F.wave, lane = F.lane, fr = lane & 15, fg = lane >> 4, h = F.bx & 7;
    const float Aexp = expf(KIN(16)[l * 8 + h]), dtb = KIN(17)[l * 8 + h];
    for (int i = F.tid; i < 1536; i += NTHR) { const int ten = i >> 9, k = (i >> 7) & 3, c = i & 127; cwl[i] = cw[k * 3072 + ten * 1024 + h * 128 + c]; }
    __syncthreads();
    if (w >= 4 && F.bx < 2048) gdn_stage_unit(F, p, l, F.bx, h, Aexp, dtb, L, cwl);
    __syncthreads();
    int prev_u = -1, it = 0;
    for (int u = F.bx; u < 2048; u += F.G, ++it) {
        unsigned char* setb = L + (it & 1) * GA_SET; unsigned char* setn = L + ((it + 1) & 1) * GA_SET;
        const bf16_t* Qn = (const bf16_t*)setb; const bf16_t* Kn = Qn + 64 * GP; const float* gcv = (const float*)(Kn + 2 * 64 * GP); const float* bet = gcv + 64; const float* ekd = gcv + 192; const float* egc = gcv + 256;
        unsigned char* pk = P2 + (size_t)u * GS_PACK_BYTES; unsigned char* pko = KWS() + WS_GPO + (size_t)u * GO_PACK_BYTES;
        if (prev_u >= 0) { unsigned char* pkp = P2 + (size_t)prev_u * GS_PACK_BYTES;
#pragma unroll
            for (int q = 0; q < 2; ++q) { const int f = w * 2 + q, mt = f >> 2, ks = f & 3; *(u32x4*)(pkp + (size_t)f * 1024 + lane * 16) = tile_frag_scaled(Wl, mt, ks, fr, fg, 1.0f); } }
        { const int mt = w >> 1;
#pragma unroll
            for (int q = 0; q < 2; ++q) { const int nt = 2 * (w & 1) + q;
                if (nt <= mt) { f32x4 s = (f32x4){0.f, 0.f, 0.f, 0.f};
#pragma unroll
                    for (int ks = 0; ks < 4; ++ks) { const bf16x8 af = *(const bf16x8*)(Kn + (16 * mt + fr) * GP + 32 * ks + 8 * fg), bf_ = *(const bf16x8*)(Kn + (16 * nt + fr) * GP + 32 * ks + 8 * fg); s = __builtin_amdgcn_mfma_f32_16x16x32_bf16(af, bf_, s, 0, 0, 0); }
                    const int j = 16 * nt + fr; const float gj = gcv[j];
#pragma unroll
                    for (int r = 0; r < 4; ++r) { const int i = 16 * mt + 4 * fg + r; Mm[i * GMP + j] = (i > j) ? bet[i] * s[r] * fexp(gcv[i] - gj) : 0.f; } } } }
        { const int itl = w >> 1, ksA = w & 1; f32x4 s2[2];
#pragma unroll
            for (int q = 0; q < 2; ++q) { const int jt = 2 * ksA + q; s2[q] = (f32x4){0.f, 0.f, 0.f, 0.f};
                if (jt <= itl) {
#pragma unroll
                    for (int ks = 0; ks < 4; ++ks) { const bf16x8 af = *(const bf16x8*)(Kn + (16 * jt + fr) * GP + 32 * ks + 8 * fg), bf_ = *(const bf16x8*)(Qn + (16 * itl + fr) * GP + 32 * ks + 8 * fg); s2[q] = __builtin_amdgcn_mfma_f32_16x16x32_bf16(af, bf_, s2[q], 0, 0, 0); }
                    const int i = 16 * itl + fr; const float gi = gcv[i];
#pragma unroll
                    for (int r = 0; r < 4; ++r) { const int j = 16 * jt + 4 * fg + r; s2[q][r] = (i >= j) ? s2[q][r] * fexp(gi - gcv[j]) : 0.f; } } }
            *(bf16x8*)(pko + (size_t)(16 + itl * 2 + ksA) * 1024 + lane * 16) = pack_acc2(s2[0], s2[1]); }
#pragma unroll
        for (int q = 0; q < 2; ++q) { const int f = w * 2 + q, mt = f >> 2, ks = f & 3;
            *(u32x4*)(pko + (size_t)f * 1024 + lane * 16) = tile_frag_scaled(Qn, mt, ks, fr, fg, egc[16 * mt + fr]); }
#pragma unroll
        for (int q = 0; q < 2; ++q) { const int f = w * 2 + q, mt = f >> 1, ks = f & 1; float v[8];
#pragma unroll
            for (int jj = 0; jj < 8; ++jj) { const int tk = 32 * ks + 16 * (jj >> 2) + 4 * fg + (jj & 3); v[jj] = bf2f(Kn[tk * GP + 16 * mt + fr]) * ekd[tk]; }
            u32x4 o; o.x = pk2(v[0], v[1]); o.y = pk2(v[2], v[3]); o.z = pk2(v[4], v[5]); o.w = pk2(v[6], v[7]);
            *(u32x4*)(pk + (size_t)(16 + f) * 1024 + lane * 16) = o; }
        __syncthreads();
        if (w < 4) { const int c = F.tid; float sol[64];
#pragma unroll
            for (int i = 0; i < 64; ++i) sol[i] = 0.f;
            LAS const bf16_t* colp = (LAS const bf16_t*)(F.lds + (it & 1) * GA_SET) + ((c < 128) ? (2 * 64 * GP + c) : (64 * GP + (c - 128))); asm volatile("" : "+v"(colp));
            LAS const float* mm = (LAS const float*)(F.lds + GA_MM); asm volatile("" : "+v"(mm));
            LAS const float* tb = (LAS const float*)(F.lds + (it & 1) * GA_SET + 3 * 64 * GP * 2) + ((c < 128) ? 64 : 128); asm volatile("" : "+v"(tb));
#pragma unroll
            for (int i = 0; i < 64; ++i) { float a = bf2f(colp[i * GP]) * tb[i];
#pragma unroll
                for (int jb = 0; jb < (i + 3) / 4; ++jb) { const f32x4 m4 = *(LAS const f32x4*)(mm + i * GMP + 4 * jb);
                    a -= m4[0] * sol[4 * jb]; a -= m4[1] * sol[4 * jb + 1]; a -= m4[2] * sol[4 * jb + 2]; a -= m4[3] * sol[4 * jb + 3];
                    if ((jb & 3) == 3) asm volatile("" ::: "memory"); }
                sol[i] = a; asm volatile("" ::: "memory"); }
            if (c < 128) { float* up = UP + (size_t)u * 8192 + (size_t)(c >> 4) * 1024;
#pragma unroll
                for (int t = 0; t < 4; ++t)
#pragma unroll
                    for (int G = 0; G < 4; ++G) *(f32x4*)(up + (t * 64 + (c & 15) + 16 * G) * 4) = (f32x4){sol[16 * t + 4 * G], sol[16 * t + 4 * G + 1], sol[16 * t + 4 * G + 2], sol[16 * t + 4 * G + 3]}; }
            else { const int d = c - 128;
#pragma unroll
                for (int i = 0; i < 64; ++i) Wl[i * GP + d] = (bf16_t)f2bf(-sol[i]); }
        } else if (u + F.G < 2048) gdn_stage_unit(F, p, l, u + F.G, h, Aexp, dtb, setn, cwl);
        __syncthreads();
        prev_u = u;
    }
    if (prev_u >= 0) { unsigned char* pkp = P2 + (size_t)prev_u * GS_PACK_BYTES;
#pragma unroll
        for (int q = 0; q < 2; ++q) { const int f = w * 2 + q, mt = f >> 2, ks = f & 3; *(u32x4*)(pkp + (size_t)f * 1024 + lane * 16) = tile_frag_scaled(Wl, mt, ks, fr, fg, 1.0f); } }
    __syncthreads();
}

constexpr int GS_Q = 8192, GS_NQ = 19;
static_assert(GS_NQ * GS_Q <= LDS_MISC, "scan ring");
__device__ __forceinline__ void gdn_scan(const Frame& F, int b) {
    const int h = b >> 1, w = F.wave, lane = F.lane; const int slice = (b & 1) * 4 + (w & 3); const bool comp = w < 4;
    const unsigned char* P2 = KWS() + WS_GP2; const float* UP = (const float*)(KWS() + WS_GUP); const float* GL = (const float*)(KWS() + WS_GGL); unsigned char* SV = KWS() + WS_GSV;
    f32x4 S[8];
#pragma unroll
    for (int i = 0; i < 8; ++i) S[i] = (f32x4){0.f, 0.f, 0.f, 0.f};
    if (!comp) {
#pragma unroll
        for (int q = 0; q < 15; ++q) { const unsigned char* src = P2 + (size_t)((q >> 2) * 8 + h) * GS_PACK_BYTES + (q & 3) * GS_Q;
#pragma unroll
            for (int i = 0; i < 2; ++i) { const int f = (w - 4) + 4 * i; __builtin_amdgcn_global_load_lds((const unsigned*)(src + f * 1024 + lane * 16), (LAS unsigned*)(F.lds + q * GS_Q + f * 1024), 16, 0, 0); } }
        asm volatile("s_waitcnt vmcnt(22)" ::: "memory"); }
    f32x4 ua[4], ub[4]; float gla = 0.f, glb = 0.f;
#pragma unroll
    for (int t = 0; t < 4; ++t) { ua[t] = (f32x4){0.f, 0.f, 0.f, 0.f}; ub[t] = ua[t]; }
    if (comp) {
#pragma unroll
        for (int t = 0; t < 4; ++t) { ua[t] = *(const f32x4*)(UP + (size_t)h * 8192 + slice * 1024 + (t * 64 + lane) * 4); ub[t] = *(const f32x4*)(UP + (size_t)(8 + h) * 8192 + slice * 1024 + (t * 64 + lane) * 4); }
        gla = GL[h]; glb = GL[8 + h]; }
    __syncthreads();
    int hq = 0;
#define GS_WRAP(x) (((x) >= GS_NQ) ? (x) - GS_NQ : (x))
    for (int n = 0; n < 256; ++n) {
        const int unit = n * 8 + h; const int e1 = GS_WRAP(hq + 1), e2 = GS_WRAP(hq + 2), e3 = GS_WRAP(hq + 3);
        const LAS unsigned char* bW0 = F.lds + hq * GS_Q; const LAS unsigned char* bW1 = F.lds + e1 * GS_Q; const LAS unsigned char* bK0 = F.lds + e2 * GS_Q; const LAS unsigned char* bK1 = F.lds + e3 * GS_Q;
        if (!comp) {
            if (n + 3 < 256) { const int e = GS_WRAP(hq + 15); const unsigned char* src = P2 + (size_t)(unit + 24) * GS_PACK_BYTES + 3 * GS_Q;
#pragma unroll
                for (int i = 0; i < 2; ++i) { const int f = (w - 4) + 4 * i; __builtin_amdgcn_global_load_lds((const unsigned*)(src + f * 1024 + lane * 16), (LAS unsigned*)(F.lds + e * GS_Q + f * 1024), 16, 0, 0); } }
            if (n + 4 < 256) {
#pragma unroll
                for (int j = 0; j < 3; ++j) { const int e = GS_WRAP(hq + 16 + j); const unsigned char* src = P2 + (size_t)(unit + 32) * GS_PACK_BYTES + j * GS_Q;
#pragma unroll
                    for (int i = 0; i < 2; ++i) { const int f = (w - 4) + 4 * i; __builtin_amdgcn_global_load_lds((const unsigned*)(src + f * 1024 + lane * 16), (LAS unsigned*)(F.lds + e * GS_Q + f * 1024), 16, 0, 0); } }
                asm volatile("s_waitcnt vmcnt(22)" ::: "memory"); }
            else asm volatile("s_waitcnt vmcnt(0)" ::: "memory");
        } else {
            f32x4 vn[4];
#pragma unroll
            for (int t = 0; t < 4; ++t) { vn[t] = ua[t]; ua[t] = ub[t]; }
            const float gl = gla; gla = glb;
            if (n + 2 < 256) {
#pragma unroll
                for (int t = 0; t < 4; ++t) ub[t] = *(const f32x4*)(UP + (size_t)(unit + 16) * 8192 + slice * 1024 + (t * 64 + lane) * 4);
                glb = GL[unit + 16]; }
            bf16x8* svp = (bf16x8*)(SV + ((size_t)(unit * 8 + slice) * 6) * 1024 + lane * 16);
            bf16x8 Sb[4];
#pragma unroll
            for (int ks = 0; ks < 4; ++ks) { Sb[ks] = pack_acc2(S[2 * ks], S[2 * ks + 1]); svp[ks * 64] = Sb[ks]; }
#pragma unroll
            for (int t = 0; t < 4; ++t)
#pragma unroll
                for (int ks = 0; ks < 4; ++ks) vn[t] = __builtin_amdgcn_mfma_f32_16x16x32_bf16(*(const LAS bf16x8*)((t < 2 ? bW0 : bW1) + ((t & 1) * 4 + ks) * 1024 + lane * 16), Sb[ks], vn[t], 0, 0, 0);
            bf16x8 vb[2];
#pragma unroll
            for (int ks = 0; ks < 2; ++ks) { vb[ks] = pack_acc2(vn[2 * ks], vn[2 * ks + 1]); svp[(4 + ks) * 64] = vb[ks]; }
#pragma unroll
            for (int dt = 0; dt < 8; ++dt) { S[dt] = S[dt] * gl;
#pragma unroll
                for (int ks = 0; ks < 2; ++ks) S[dt] = __builtin_amdgcn_mfma_f32_16x16x32_bf16(*(const LAS bf16x8*)((dt < 4 ? bK0 : bK1) + ((dt & 3) * 2 + ks) * 1024 + lane * 16), vb[ks], S[dt], 0, 0, 0); }
        }
        __syncthreads();
        hq += 4; if (hq >= GS_NQ) hq -= GS_NQ;
    }
#undef GS_WRAP
}
constexpr int GO_PITCH = 132;
__device__ __forceinline__ void gdn_output(const Frame& F, const Params& p, int l) {
    float* Ot = (float*)F.ldsg;
    const unsigned char* PO = KWS() + WS_GPO; const unsigned char* SV = KWS() + WS_GSV; const bf16_t* Z = (const bf16_t*)(KWS() + WS_Z); bf16_t* Y = (bf16_t*)(KWS() + WS_Y); const float* ng = KIN(18) + l * 128;
    const int w = F.wave, lane = F.lane, fr = lane & 15, fg = lane >> 4;
    const int tt = F.tid >> 3, cg = F.tid & 7; float gn[16];
#pragma unroll
    for (int i = 0; i < 16; ++i) gn[i] = ng[16 * cg + i];
    for (int u = F.bx; u < 2048; u += F.G) {
        const int h = u & 7, n = u >> 3;
        const bf16x8* svp = (const bf16x8*)(SV + ((size_t)(u * 8 + w) * 6) * 1024 + lane * 16); const bf16x8* pop = (const bf16x8*)(PO + (size_t)u * GO_PACK_BYTES + lane * 16);
        const u32x4 gzp0 = *(const u32x4*)(Z + (size_t)(n * 64 + tt) * NZ + ZC_GZ + h * 128 + 16 * cg), gzp1 = *(const u32x4*)(Z + (size_t)(n * 64 + tt) * NZ + ZC_GZ + h * 128 + 16 * cg + 8);
        bf16x8 Sb[4], vb[2];
#pragma unroll
        for (int ks = 0; ks < 4; ++ks) Sb[ks] = svp[ks * 64];
#pragma unroll
        for (int ks = 0; ks < 2; ++ks) vb[ks] = svp[(4 + ks) * 64];
#pragma unroll
        for (int t = 0; t < 4; ++t) { f32x4 o = (f32x4){0.f, 0.f, 0.f, 0.f};
#pragma unroll
            for (int ks = 0; ks < 4; ++ks) o = __builtin_amdgcn_mfma_f32_16x16x32_bf16(pop[(t * 4 + ks) * 64], Sb[ks], o, 0, 0, 0);
#pragma unroll
            for (int ks = 0; ks < 2; ++ks) o = __builtin_amdgcn_mfma_f32_16x16x32_bf16(pop[(16 + t * 2 + ks) * 64], vb[ks], o, 0, 0, 0);
#pragma unroll
            for (int r = 0; r < 4; ++r) Ot[(16 * t + 4 * fg + r) * GO_PITCH + 16 * w + fr] = o[r]; }
        __syncthreads();
        { const size_t tg = (size_t)(n * 64 + tt); float o[16], g[8], g2[8]; float ss = 0.f;
#pragma unroll
            for (int i = 0; i < 4; ++i) { const f32x4 v = *(const f32x4*)(Ot + tt * GO_PITCH + 16 * cg + 4 * i); o[4 * i] = v[0]; o[4 * i + 1] = v[1]; o[4 * i + 2] = v[2]; o[4 * i + 3] = v[3]; }
#pragma unroll
            for (int i = 0; i < 16; ++i) ss += o[i] * o[i];
            ss += __shfl_xor(ss, 1); ss += __shfl_xor(ss, 2); ss += __shfl_xor(ss, 4);
            const float rstd = 1.0f / sqrtf(ss * (1.0f / 128.0f) + EPS);
            unpack8(gzp0, g); unpack8(gzp1, g2);
            float y[16];
#pragma unroll
            for (int i = 0; i < 8; ++i) { y[i] = o[i] * rstd * gn[i] * fsilu(g[i]); y[8 + i] = o[8 + i] * rstd * gn[8 + i] * fsilu(g2[i]); }
            u32x4 o0, o1; o0.x = pk2(y[0], y[1]); o0.y = pk2(y[2], y[3]); o0.z = pk2(y[4], y[5]); o0.w = pk2(y[6], y[7]); o1.x = pk2(y[8], y[9]); o1.y = pk2(y[10], y[11]); o1.z = pk2(y[12], y[13]); o1.w = pk2(y[14], y[15]);
            bf16_t* yp = Y + tg * 3072 + 2048 + h * 128 + 16 * cg; *(u32x4*)yp = o0; *(u32x4*)(yp + 8) = o1; }
        __syncthreads();
    }
}

__device__ __forceinline__ void seq_retention(const Frame& F, const Params& p, int h) {
    float* sq = (float*)F.ldsg; float* sk = sq + 128; float* red = sk + 128;
    const bf16_t* Z = (const bf16_t*)(KWS() + WS_Z); bf16_t* Y = (bf16_t*)(KWS() + WS_Y); const int* pos = (const int*)KIN(2);
    const int c = F.tid & 127; const bool act = F.tid < 128, rot = F.tid < 64;
    float R[128];
#pragma unroll
    for (int d = 0; d < 128; ++d) R[d] = 0.f;
    const float gamma = 1.0f - exp2f(-5.0f - (float)h);
    const float invf = (float)exp2(-(double)(F.tid & 63) * (13.287712379549449 / 64.0));
    unsigned short nq1 = 0, nq2 = 0, nk1 = 0, nk2 = 0, nv = 0, ng = 0; int npos = 0;
    if (rot) { nq1 = Z[ZC_RQ + h * 128 + F.tid]; nq2 = Z[ZC_RQ + h * 128 + 64 + F.tid]; nk1 = Z[ZC_RK + h * 128 + F.tid]; nk2 = Z[ZC_RK + h * 128 + 64 + F.tid]; npos = pos[0]; }
    if (act) { nv = Z[ZC_RV + h * 128 + c]; ng = Z[ZC_RG + h * 128 + c]; }
    for (int t = 0; t < S_; ++t) {
        const unsigned short q1 = nq1, q2 = nq2, k1 = nk1, k2 = nk2, vv = nv, gg = ng; const int ps = npos;
        if (t + 1 < S_) { const size_t zo = (size_t)(t + 1) * NZ;
            if (rot) { nq1 = Z[zo + ZC_RQ + h * 128 + F.tid]; nq2 = Z[zo + ZC_RQ + h * 128 + 64 + F.tid]; nk1 = Z[zo + ZC_RK + h * 128 + F.tid]; nk2 = Z[zo + ZC_RK + h * 128 + 64 + F.tid]; npos = pos[t + 1]; }
            if (act) { nv = Z[zo + ZC_RV + h * 128 + c]; ng = Z[zo + ZC_RG + h * 128 + c]; } }
        if (rot) { const float angf = (float)ps * invf; const double ad = (double)angf; const double nn = rint(ad * 0.15915494309189535); const float rr = (float)(ad - nn * 6.283185307179586);
            const float cs = cosf(rr), sn = sinf(rr); const float a1 = bf2f(q1), a2 = bf2f(q2), b1 = bf2f(k1), b2 = bf2f(k2);
            sq[F.tid] = a1 * cs - a2 * sn; sq[F.tid + 64] = a2 * cs + a1 * sn;
            sk[F.tid] = (b1 * cs - b2 * sn) * 0.08838834764831845f; sk[F.tid + 64] = (b2 * cs + b1 * sn) * 0.08838834764831845f; }
        __syncthreads();
        float o = 0.f;
        if (act) { const float v = bf2f(vv);
#pragma unroll
            for (int d0 = 0; d0 < 128; d0 += 16) {
#pragma unroll
                for (int d = d0; d < d0 + 16; ++d) { R[d] = gamma * R[d] + sk[d] * v; o += sq[d] * R[d]; }
                asm volatile("" ::: "memory"); }
            const float ss = wave_sum(o * o); if (F.lane == 0) red[F.wave] = ss; }
        __syncthreads();
        if (act) { const float ms = (red[0] + red[1]) * (1.0f / 128.0f); const float y = o * (1.0f / sqrtf(ms + EPS)) * siluf(bf2f(gg)); Y[(size_t)t * 3072 + h * 128 + c] = (bf16_t)f2bf(y); }
    }
}
__device__ __forceinline__ void seq_gdn(const Frame& F, const Params& p, int l, int h) {
    float* sq = (float*)F.ldsg; float* sk = sq + 128; float* red = sk + 128; float* red2 = red + 8;
    const bf16_t* Z = (const bf16_t*)(KWS() + WS_Z); bf16_t* Y = (bf16_t*)(KWS() + WS_Y); const float* GAB = (const float*)(KWS() + WS_GAB);
    const int c = F.tid & 127; const bool act = F.tid < 128;
    float St[128];
#pragma unroll
    for (int d = 0; d < 128; ++d) St[d] = 0.f;
    const float* cw = KIN(15) + (size_t)l * 4 * 3072;
    float wq[4], wk[4], wv[4];
#pragma unroll
    for (int k = 0; k < 4; ++k) { wq[k] = cw[k * 3072 + h * 128 + c]; wk[k] = cw[k * 3072 + 1024 + h * 128 + c]; wv[k] = cw[k * 3072 + 2048 + h * 128 + c]; }
    const float Aexp = expf(KIN(16)[l * 8 + h]), dtb = KIN(17)[l * 8 + h], ngain = KIN(18)[l * 128 + c];
    float xq1 = 0, xq2 = 0, xq3 = 0, xk1 = 0, xk2 = 0, xk3 = 0, xv1 = 0, xv2 = 0, xv3 = 0;
    unsigned short nq = 0, nk = 0, nv = 0, nz = 0; float nga = 0.f, ngb = 0.f;
    if (act) { nq = Z[ZC_GQ + h * 128 + c]; nk = Z[ZC_GK + h * 128 + c]; nv = Z[ZC_GV + h * 128 + c]; nz = Z[ZC_GZ + h * 128 + c]; nga = GAB[h]; ngb = GAB[8 + h]; }
    for (int t = 0; t < S_; ++t) {
        const float rq = bf2f(nq), rk = bf2f(nk), rv = bf2f(nv), gz = bf2f(nz), ga = nga, gb = ngb;
        if (act && t + 1 < S_) { const size_t zo = (size_t)(t + 1) * NZ; nq = Z[zo + ZC_GQ + h * 128 + c]; nk = Z[zo + ZC_GK + h * 128 + c]; nv = Z[zo + ZC_GV + h * 128 + c]; nz = Z[zo + ZC_GZ + h * 128 + c];
            nga = GAB[(size_t)(t + 1) * 16 + h]; ngb = GAB[(size_t)(t + 1) * 16 + 8 + h]; }
        float q = 0.f, k = 0.f, v = 0.f;
        if (act) { const float cq = wq[0] * xq3 + wq[1] * xq2 + wq[2] * xq1 + wq[3] * rq, ck = wk[0] * xk3 + wk[1] * xk2 + wk[2] * xk1 + wk[3] * rk, cv = wv[0] * xv3 + wv[1] * xv2 + wv[2] * xv1 + wv[3] * rv;
            xq3 = xq2; xq2 = xq1; xq1 = rq; xk3 = xk2; xk2 = xk1; xk1 = rk; xv3 = xv2; xv2 = xv1; xv1 = rv;
            q = siluf(cq); k = siluf(ck); v = siluf(cv);
            const float s1 = wave_sum(q * q), s2 = wave_sum(k * k); if (F.lane == 0) { red[F.wave] = s1; red[2 + F.wave] = s2; } }
        __syncthreads();
        if (act) { sq[c] = q * (1.0f / sqrtf(red[0] + red[1] + EPS)) * 0.08838834764831845f; sk[c] = k * (1.0f / sqrtf(red[2] + red[3] + EPS)); }
        __syncthreads();
        float o = 0.f;
        if (act) { const float g = -Aexp * softplusf(ga + dtb), e = expf(g), beta = sigm(gb);
            float dot = 0.f;
#pragma unroll
            for (int d0 = 0; d0 < 128; d0 += 16) {
#pragma unroll
                for (int d = d0; d < d0 + 16; ++d) dot += sk[d] * St[d];
                asm volatile("" ::: "memory"); }
            const float coef = beta * (v - e * dot);
#pragma unroll
            for (int d0 = 0; d0 < 128; d0 += 16) {
#pragma unroll
                for (int d = d0; d < d0 + 16; ++d) { St[d] = e * St[d] + sk[d] * coef; o += sq[d] * St[d]; }
                asm volatile("" ::: "memory"); }
            const float ss = wave_sum(o * o); if (F.lane == 0) red2[F.wave] = ss; }
        __syncthreads();
        if (act) { const float ms = (red2[0] + red2[1]) * (1.0f / 128.0f); const float y = o * (1.0f / sqrtf(ms + EPS)) * ngain * siluf(gz); Y[(size_t)t * 3072 + 2048 + h * 128 + c] = (bf16_t)f2bf(y); }
    }
}
__device__ __forceinline__ void seq_lru(const Frame& F, const Params& p, int part) {
    const bf16_t* Z = (const bf16_t*)(KWS() + WS_Z); bf16_t* Y = (bf16_t*)(KWS() + WS_Y); const float* LA = (const float*)(KWS() + WS_MF); const float* LB = LA + (size_t)S_ * 1024;
    const int ch = part * 512 + F.tid; float h = 0.f;
    for (int t0 = 0; t0 < S_; t0 += 8) { float a[8], b[8]; unsigned short g[8];
#pragma unroll
        for (int i = 0; i < 8; ++i) { a[i] = LA[(size_t)(t0 + i) * 1024 + ch]; b[i] = LB[(size_t)(t0 + i) * 1024 + ch]; g[i] = Z[(size_t)(t0 + i) * NZ + ZC_LG + ch]; }
#pragma unroll
        for (int i = 0; i < 8; ++i) { h = a[i] * h + b[i]; Y[(size_t)(t0 + i) * 3072 + 1024 + ch] = (bf16_t)f2bf(h * gelu_tanh(bf2f(g[i]))); } }
}

__device__ __forceinline__ void phase_seq(const Frame& F, const Params& p, int l) {
#if DBG_NOSEQ
    { u32x4* yy = (u32x4*)(KWS() + WS_Y); for (size_t i = (size_t)F.bx * NTHR + F.tid; i < (size_t)S_ * 3072 / 8; i += (size_t)F.G * NTHR) yy[i] = (u32x4){0u, 0u, 0u, 0u}; }
#else
    if (F.bx < 16) { gdn_scan(F, ((F.bx & 7) << 1) | (F.bx >> 3)); return; }
    const int wg = F.bx - 16, nwg = F.G - 16; unsigned* ctl = (unsigned*)(KWS() + WS_CTL); unsigned* cnt = ctl + CW_SUB + 64 * l; unsigned* tmo = ctl + CW_BAR + XB_TMO;
    const int rwg = (wg + nwg - (2048 % nwg)) % nwg;
    lru_units<false>(F, p, l, wg, nwg); __syncthreads(); ret_units_a(F, rwg, nwg);
    sub_barrier(cnt, (unsigned)nwg, tmo);
    if (wg < 2) lru_carry(F, wg); else ret_scan(F, wg - 2, nwg - 2);
    sub_barrier(cnt, 2u * (unsigned)nwg, tmo);
    lru_units<true>(F, p, l, wg, nwg); __syncthreads(); ret_units_c(F, rwg, nwg);
#endif
}

#define LAYER(l) do { \
const int pb = PH_L0 + l * PH_PER_LAYER; \
        if (EN(0) && IN(pb + 0)) { const Frame F = make_frame(); phase_convert(F, p, l); phase_norm1_gab(F, p, l, l > 0 && !DBG_NOMOE); __syncthreads(); } \
        SEAM(pb + 0); \
        if (EN(1) && IN(pb + 1)) { const Frame F = make_frame(); pg8::Gemm g{(const bf16_t*)(KWS() + WS_H), (const bf16_t*)(KWS() + WS_WIN), 2048, 2048, 2048}; SchedStatic sc{64, 64, F.G, F.bx}; \
            EpiZL E{(bf16_t*)(KWS() + WS_Z)}; pg8::gemm_phase(F.lds, g, sc, E); } \
        SEAM(pb + 1); \
        if (EN(2) && IN(pb + 2)) { const Frame F = make_frame(); if ((F.G & 7) == 0) gdn_units_a_pipe(F, p, l); else gdn_units_a(F, p, l); } \
        SEAM(pb + 2); \
        if (EN(3) && IN(pb + 3)) { const Frame F = make_frame(); \
            phase_seq(F, p, l); \
        } \
        SEAM(pb + 3); \
        if (EN(4) && IN(pb + 4)) { const Frame F = make_frame(); gdn_output(F, p, l); } \
        SEAM(pb + 4); \
        if (EN(5) && IN(pb + 5)) { const Frame F = make_frame(); pg8::Gemm g{(const bf16_t*)(KWS() + WS_Y), (const bf16_t*)(KWS() + WS_BP), 3072, 1024, 1024}; SchedMerge sc{F.G, F.bx}; \
            EpiMerge E{(const bf16_t*)(KWS() + WS_Z), (bf16_t*)(KWS() + WS_H)}; pg8::gemm_phase(F.lds, g, sc, E); } \
        SEAM(pb + 5); \
        if (EN(6) && IN(pb + 6)) { const Frame F = make_frame(); pg8::Gemm g{(const bf16_t*)(KWS() + WS_H), (const bf16_t*)(KWS() + WS_WO), 2048, 2048, 2048}; SchedStatic sc{64, 8, F.G, F.bx}; \
            EpiWout E{l == 0 ? KIN(0) : KOUT(), KOUT(), (const float*)(KWS() + WS_MODV) + l * 12288 + MO_GT1}; pg8::gemm_phase(F.lds, g, sc, E); } \
        SEAM(pb + 6); \
        if (!DBG_NOMOE && EN(7) && IN(pb + 7)) { const Frame F = make_frame(); if ((S_ % (F.G * NWAVES * 4)) == 0) phase_norm2_router_lds(F, p, l); else phase_norm2_router(F, p, l); __syncthreads(); } \
        SEAM(pb + 7); \
        if (!DBG_NOMOE && EN(8) && IN(pb + 8)) { const Frame F = make_frame(); phase_gather(F, p, l); } \
        SEAM(pb + 8); \
        if (!DBG_NOMOE && EN(9) && IN(pb + 9)) { const Frame F = make_frame(); moe_tables_load(F, p); unsigned* mq = (unsigned*)(KWS() + WS_CTL) + CW_MOEQ + l * 16384; \
            { pg8::Gemm g{(const bf16_t*)(KWS() + WS_H), (const bf16_t*)(KWS() + WS_W13), 2048, 2048, 2048}; SchedMoe<true> sc{(const int*)(KWS() + WS_TOK + 512 * 1024), F.G, F.bx, 4, (const LAS int*)(F.lds + LDS_MISC + 64)}; \
              EpiW13 E{(bf16_t*)(KWS() + WS_HID), mq}; pg8::gemm_phase(F.lds, g, sc, E); } \
            { volatile LAS int* slot = (volatile LAS int*)(F.lds + LDS_MISC + 32); \
              if (F.tid == 0) { const int q0 = (int)xb_add(mq, 1u), q1 = (int)xb_add(mq, 1u); slot[0] = q0; slot[1] = q1; slot[2] = 2; slot[4] = 0; } __syncthreads(); \
              pg8::Gemm g{(const bf16_t*)(KWS() + WS_HID), (const bf16_t*)(KWS() + WS_W2), 512, 512, 512}; SchedMoeDyn sc{8, (const LAS int*)(F.lds + LDS_MISC + 64), slot, mq, (unsigned*)(KWS() + WS_CTL) + CW_BAR + XB_TMO}; \
              EpiW2L E{(bf16_t*)(KWS() + WS_SLOT), (const u32x2*)(KWS() + WS_ROWINFO), (const LAS int*)(F.lds + LDS_MISC + 64), mq, slot, mq}; pg8::gemm_phase(F.lds, g, sc, E); } } \
        SEAM(pb + 10); \
    } while (0)
template <unsigned PMASK, bool ALL>
__global__ void __launch_bounds__(NTHR, 2) fwd(Params p) {
    Frame F = make_frame();
    if (F.tid < 4) ((LAS unsigned*)(F.lds + LDS_MISC))[F.tid] = 0u;
    __syncthreads();
    unsigned* ctl = (unsigned*)(KWS() + WS_CTL);
    XcdBarrier bar; bar.bar = ctl + CW_BAR; bar.x = 0; bar.st = nullptr;
    const int lo = p.ph_lo, hi = p.ph_hi;
    const bool multi = ALL || (hi - lo) > 1;
    if (multi) bar = xcd_barrier_post(ctl + CW_BAR, (volatile LAS unsigned*)(F.lds + LDS_MISC));
#define IN(k) (ALL || (lo <= (k) && (k) < hi))
#define EN(b) ((PMASK >> (b)) & 1u)
#define SEAM(k) do { if (IN(k) && IN((k) + 1)) xcd_barrier(bar); } while (0)

    if (EN(11) && IN(PH_MOD)) { const Frame F = make_frame(); phase_mod(F, p); phase_rope_table(F); phase_gabw(F); }
    SEAM(PH_MOD);
    LAYER(0);
    LAYER(1);
    if (EN(12) && IN(PH_FINAL)) { const Frame F = make_frame(); phase_norm<2>(F, p, 0, !DBG_NOMOE); }
#undef IN
#undef SEAM
}

typedef void (*KernelFn)(Params);
static int phase_bit(int ph) { if (ph == PH_MOD) return 11; if (ph == PH_FINAL) return 12; return (ph - PH_L0) % PH_PER_LAYER; }
extern "C" void kernel_launch(void* const* d_in, const int* in_sizes, int n_in, void* d_out, int out_size, void* d_ws, size_t ws_size, hipStream_t stream) {
    static int grid = 0;
#if ONE_LAUNCH
    static KernelFn fns[1] = { fwd<0x1FFFu, true> };
    constexpr int NFN = 1;
#else
    static KernelFn fns[13] = { fwd<0x001u, false>, fwd<0x002u, false>, fwd<0x004u, false>, fwd<0x008u, false>, fwd<0x010u, false>, fwd<0x020u, false>, fwd<0x040u, false>, fwd<0x080u, false>, fwd<0x100u, false>, fwd<0x200u, false>, fwd<0x400u, false>, fwd<0x800u, false>, fwd<0x1000u, false> };
    constexpr int NFN = 13;
#endif
    if (grid == 0) {
        if (n_in != 29 || out_size != S_ * D_ || ws_size < WS_END) { fprintf(stderr, "kernel_launch: unexpected shapes (n_in %d out %d ws %zu)\n", n_in, out_size, ws_size); grid = -1; return; }
        int dev = 0, cus = 0, per_cu = 0;
        if (hipGetDevice(&dev) != hipSuccess || hipDeviceGetAttribute(&cus, hipDeviceAttributeMultiprocessorCount, dev) != hipSuccess) { grid = -1; return; }
        for (int i = 0; i < NFN; ++i) {
            if (hipFuncSetAttribute((const void*)fns[i], hipFuncAttributeMaxDynamicSharedMemorySize, LDS_BYTES) != hipSuccess) { fprintf(stderr, "kernel_launch: hipFuncSetAttribute failed\n"); grid = -1; return; }
            if (hipOccupancyMaxActiveBlocksPerMultiprocessor(&per_cu, (const void*)fns[i], NTHR, LDS_BYTES) != hipSuccess || per_cu < 1) fprintf(stderr, "kernel_launch: occupancy query says %d for fn %d\n", per_cu, i);
        }
        (void)hipGetLastError();
        grid = cus > 0 ? cus : 256;
    }
    if (grid < 0) return;
    (void)hipMemsetAsync((char*)d_ws + WS_CTL, 0, CTL_BYTES, stream);
    Params p{};
    for (int i = 0; i < 29; ++i) p.in[i] = (const float*)d_in[i];
    p.out = (float*)d_out; p.ws = (unsigned char*)d_ws;
#if ONE_LAUNCH
    p.ph_lo = 0; p.ph_hi = NPH;
    { void* args[] = {&p}; (void)hipLaunchKernel((const void*)fns[0], dim3(grid), dim3(NTHR), args, LDS_BYTES, stream); }
#else
    for (int ph = 0; ph < NPH; ++ph) { p.ph_lo = ph; p.ph_hi = ph + 1; void* args[] = {&p}; (void)hipLaunchKernel((const void*)fns[phase_bit(ph)], dim3(grid), dim3(NTHR), args, LDS_BYTES, stream); }
#endif
}
```
